# Optimizing an MI355X kernel written in HIP

```python
import math
import jax, jax.numpy as jnp
from jax import lax
import numpy as np

D_MODEL = 1024
BATCH = 8
SEQ = 2048
DEPTH = 2

MEM_LEN = 256
N_HEADS_GROUP = 4
HEAD_DIM = 64
GROUP_WIDTH = N_HEADS_GROUP * HEAD_DIM
N_GROUPS = 4
D_MIX = N_GROUPS * GROUP_WIDTH
ROPE_THETA = 10000.0
EPS = 1e-6
Q_BLOCK = 128
NEG_INF = -1e30
BIG = 1e30

NSA_CMP_BLOCK = 32
NSA_CMP_STRIDE = 16
NSA_SLC_BLOCK = 64
NSA_N_SELECT = 16
NSA_N_LOCAL = 2
NSA_WINDOW = 512
NSA_N_BRANCH = 3

DIFF_D = HEAD_DIM // 2

MLA_Q_RANK = 256
MLA_KV_RANK = 128
MLA_NOPE = 64
MLA_ROPE = 32
MLA_V = HEAD_DIM
MLA_QK = MLA_NOPE + MLA_ROPE

IN_SIZES = (
    GROUP_WIDTH, 6 * HEAD_DIM, NSA_N_BRANCH * N_HEADS_GROUP, GROUP_WIDTH,
    3 * GROUP_WIDTH, GROUP_WIDTH,
    MLA_Q_RANK, MLA_KV_RANK, MLA_ROPE, GROUP_WIDTH,
    GROUP_WIDTH, GROUP_WIDTH,
)
D_IN = sum(IN_SIZES)

kernel_name = 'hybrid_nsa_diff_mla_memory_block'


def rms_norm(x, g):
    xf = x.astype(jnp.float32)
    y = xf * lax.rsqrt(jnp.mean(xf * xf, axis=-1, keepdims=True) + EPS)
    return (y * g.astype(jnp.float32)).astype(x.dtype)


def rope(x, pos):
    half = x.shape[-1] // 2
    inv_freq = ROPE_THETA ** (-jnp.arange(half, dtype=jnp.float32) / half)
    ang = pos.astype(jnp.float32)[:, None] * inv_freq[None, :]
    cos = jnp.cos(ang)[:, None, :]
    sin = jnp.sin(ang)[:, None, :]
    xf = x.astype(jnp.float32)
    x1, x2 = xf[..., :half], xf[..., half:]
    return jnp.concatenate([x1 * cos - x2 * sin, x2 * cos + x1 * sin], axis=-1).astype(x.dtype)


def masked_softmax(s, mask):
    s = jnp.where(mask, s.astype(jnp.float32), NEG_INF)
    p = jax.nn.softmax(s, axis=-1)
    return jnp.where(mask, p, 0.0)


def causal_attention(q, k, v):
    B, S, H, Dk = q.shape
    nb = S // Q_BLOCK
    scale = Dk ** -0.5
    q_blocks = q.reshape(B, nb, Q_BLOCK, H, Dk).transpose(1, 0, 2, 3, 4)
    pos_blocks = jnp.arange(S).reshape(nb, Q_BLOCK)
    kpos = jnp.arange(S)

    def one_block(args):
        qi, qpos = args
        s = jnp.einsum('bqhd,bkhd->bhqk', qi, k).astype(jnp.float32) * scale
        p = masked_softmax(s, (kpos[None, :] <= qpos[:, None])[None, None])
        return jnp.einsum('bhqk,bkhd->bqhd', p.astype(v.dtype), v)

    o = lax.map(one_block, (q_blocks, pos_blocks))
    return o.transpose(1, 0, 2, 3, 4).reshape(B, S, H, v.shape[-1])


def nsa_mixer(q, kv, gate_logits, qk_gain, cmp_pe, w_cmp, pos):
    B, S, H, D = q.shape
    scale = D ** -0.5
    kc, vc, ks, vs, kw, vw = jnp.split(kv, 6, axis=-1)
    q = rope(rms_norm(q, qk_gain[0]), pos)

    nc = (S - NSA_CMP_BLOCK) // NSA_CMP_STRIDE + 1
    starts = jnp.arange(nc) * NSA_CMP_STRIDE
    idx = starts[:, None] + jnp.arange(NSA_CMP_BLOCK)[None, :]
    k_cmp = (kc[:, idx] + cmp_pe[0]).reshape(B, nc, NSA_CMP_BLOCK * D) @ w_cmp[0]
    v_cmp = (vc[:, idx] + cmp_pe[1]).reshape(B, nc, NSA_CMP_BLOCK * D) @ w_cmp[1]
    cmp_end = starts + NSA_CMP_BLOCK - 1
    k_cmp = rope(rms_norm(k_cmp, qk_gain[1])[:, :, None, :], cmp_end)[:, :, 0]
    s_cmp = jnp.einsum('bshd,bnd->bhsn', q, k_cmp).astype(jnp.float32) * scale
    p_cmp = masked_softmax(s_cmp, (cmp_end[None, :] <= pos[:, None])[None, None])
    o_cmp = jnp.einsum('bhsn,bnd->bshd', p_cmp.astype(v_cmp.dtype), v_cmp)

    ns = S // NSA_SLC_BLOCK
    ratio = NSA_SLC_BLOCK // NSA_CMP_STRIDE
    coef = np.convolve(np.ones(ratio), np.ones(NSA_CMP_BLOCK // NSA_CMP_STRIDE))
    need = ratio * (ns - 1) + len(coef)
    p_g = jnp.pad(p_cmp.sum(axis=1), ((0, 0), (0, 0), (0, need - nc)))
    p_slc = sum(float(c) * p_g[..., i: i + ratio * (ns - 1) + 1: ratio] for i, c in enumerate(coef))
    blk = jnp.arange(ns)[None, :]
    cur = (pos // NSA_SLC_BLOCK)[:, None]
    forced = (blk == 0) | ((blk <= cur) & (blk > cur - NSA_N_LOCAL))
    score = jnp.where(blk > cur, NEG_INF, jnp.where(forced, BIG, p_slc))
    n_sel = min(NSA_N_SELECT, ns)
    _, sel = lax.top_k(score, n_sel)

    ks = rope(rms_norm(ks, qk_gain[2])[:, :, None, :], pos)[:, :, 0]
    nb = S // Q_BLOCK
    q_blocks = q.reshape(B, nb, Q_BLOCK, H, D).transpose(1, 0, 2, 3, 4)
    sel_blocks = sel.reshape(B, nb, Q_BLOCK, n_sel).transpose(1, 0, 2, 3)
    pos_blocks = pos.reshape(nb, Q_BLOCK)
    in_block = jnp.arange(NSA_SLC_BLOCK)
    gather = jax.vmap(lambda t, i: t[i])

    def select_block(args):
        qi, si, qpos = args
        tok = (si[..., None] * NSA_SLC_BLOCK + in_block).reshape(B, Q_BLOCK, n_sel * NSA_SLC_BLOCK)
        k_sel = gather(ks, tok)
        v_sel = gather(vs, tok)
        s = jnp.einsum('bqhd,bqkd->bhqk', qi, k_sel).astype(jnp.float32) * scale
        p = masked_softmax(s, (tok <= qpos[None, :, None])[:, None])
        return jnp.einsum('bhqk,bqkd->bqhd', p.astype(v_sel.dtype), v_sel)

    o_slc = lax.map(select_block, (q_blocks, sel_blocks, pos_blocks))
    o_slc = o_slc.transpose(1, 0, 2, 3, 4).reshape(B, S, H, D)

    kw = rope(rms_norm(kw, qk_gain[3])[:, :, None, :], pos)[:, :, 0]
    nw = NSA_WINDOW // Q_BLOCK

    def band(t):
        tp = jnp.pad(t, ((0, 0), (NSA_WINDOW, 0), (0, 0))).reshape(B, nb + nw, Q_BLOCK, D)
        return jnp.concatenate([tp[:, i: i + nb] for i in range(nw + 1)], axis=2)

    kb, vb = band(kw), band(vw)
    qb = q.reshape(B, nb, Q_BLOCK, H, D)
    s_win = jnp.einsum('bnqhd,bnkd->bnhqk', qb, kb).astype(jnp.float32) * scale
    kpos = (jnp.arange(nb)[:, None] - nw) * Q_BLOCK + jnp.arange((nw + 1) * Q_BLOCK)[None, :]
    dist = pos_blocks[:, :, None] - kpos[:, None, :]
    win_mask = (kpos[:, None, :] >= 0) & (dist >= 0) & (dist < NSA_WINDOW)
    p_win = masked_softmax(s_win, win_mask[None, :, None])
    o_win = jnp.einsum('bnhqk,bnkd->bnqhd', p_win.astype(vb.dtype), vb).reshape(B, S, H, D)

    g = jax.nn.sigmoid(gate_logits.astype(jnp.float32)).reshape(B, S, NSA_N_BRANCH, H)[..., None]
    o = g[:, :, 0] * o_cmp + g[:, :, 1] * o_slc + g[:, :, 2] * o_win
    return o.astype(q.dtype).reshape(B, S, H * D)


def diff_mixer(q, k, v, qk_gain, lam, subln_gain, lambda_init, pos):
    B, S, _ = q.shape
    q = rope(rms_norm(q.reshape(B, S, N_HEADS_GROUP * 2, DIFF_D), qk_gain[0]), pos)
    k = rope(rms_norm(k.reshape(B, S, N_HEADS_GROUP * 2, DIFF_D), qk_gain[1]), pos)
    q = q.reshape(B, S, N_HEADS_GROUP, 2, DIFF_D)
    k = k.reshape(B, S, N_HEADS_GROUP, 2, DIFF_D)
    v = v.reshape(B, S, N_HEADS_GROUP, HEAD_DIM)
    o1 = causal_attention(q[:, :, :, 0], k[:, :, :, 0], v)
    o2 = causal_attention(q[:, :, :, 1], k[:, :, :, 1], v)
    lf = lam.astype(jnp.float32)
    lmbda = jnp.exp(jnp.sum(lf[0] * lf[1])) - jnp.exp(jnp.sum(lf[2] * lf[3])) + lambda_init
    o = o1.astype(jnp.float32) - lmbda * o2.astype(jnp.float32)
    o = rms_norm(o, subln_gain) * (1.0 - lambda_init)
    return o.astype(v.dtype).reshape(B, S, GROUP_WIDTH)


def mla_mixer(c_q, c_kv, k_rope, cq_gain, ckv_gain, w_uq, w_ukv, qk_gain, pos):
    B, S, _ = c_q.shape
    q = (rms_norm(c_q, cq_gain) @ w_uq).reshape(B, S, N_HEADS_GROUP, MLA_QK)
    kv = (rms_norm(c_kv, ckv_gain) @ w_ukv).reshape(B, S, N_HEADS_GROUP, MLA_NOPE + MLA_V)
    q = jnp.concatenate([q[..., :MLA_NOPE], rope(q[..., MLA_NOPE:], pos)], axis=-1)
    kr = rope(k_rope[:, :, None, :], pos)
    k = jnp.concatenate([kv[..., :MLA_NOPE], jnp.broadcast_to(kr, (B, S, N_HEADS_GROUP, MLA_ROPE))], axis=-1)
    v = kv[..., MLA_NOPE:]
    q = rms_norm(q, qk_gain[0])
    k = rms_norm(k, qk_gain[1])
    return causal_attention(q, k, v).reshape(B, S, GROUP_WIDTH)


def memory_mixer(q, mem, mem_gain, w_kv, qk_gain):
    B, S, _ = q.shape
    M = mem.shape[1]
    q = rms_norm(q.reshape(B, S, N_HEADS_GROUP, HEAD_DIM), qk_gain[0])
    k, v = jnp.split(rms_norm(mem, mem_gain) @ w_kv, 2, axis=-1)
    k = rms_norm(k.reshape(B, M, N_HEADS_GROUP, HEAD_DIM), qk_gain[1])
    v = v.reshape(B, M, N_HEADS_GROUP, HEAD_DIM)
    s = jnp.einsum('bshd,bmhd->bhsm', q, k).astype(jnp.float32) * HEAD_DIM ** -0.5
    p = jax.nn.softmax(s, axis=-1)
    return jnp.einsum('bhsm,bmhd->bshd', p.astype(v.dtype), v).reshape(B, S, GROUP_WIDTH)


def hybrid_layer(x, mem, layer_idx, norm_gain, w_in, w_out, nsa_qk_gain, nsa_cmp_pe, nsa_w_cmp,
                 diff_qk_gain, diff_lambda, diff_subln_gain, mla_cq_gain, mla_ckv_gain, mla_w_uq,
                 mla_w_ukv, mla_qk_gain, mem_norm_gain, mem_w_kv, mem_qk_gain):
    B, S, _ = x.shape
    pos = jnp.arange(S, dtype=jnp.int32)
    h = rms_norm(x, norm_gain)
    u = h @ w_in
    offsets = [int(o) for o in np.cumsum(IN_SIZES)[:-1]]
    (nsa_q, nsa_kv, nsa_gl, nsa_z, diff_qkv, diff_z,
     mla_cq, mla_ckv, mla_kr, mla_z, mem_q, mem_z) = jnp.split(u, offsets, axis=-1)

    y_nsa = nsa_mixer(nsa_q.reshape(B, S, N_HEADS_GROUP, HEAD_DIM), nsa_kv, nsa_gl,
                      nsa_qk_gain, nsa_cmp_pe, nsa_w_cmp, pos)
    dq, dk, dv = jnp.split(diff_qkv, 3, axis=-1)
    lambda_init = 0.8 - 0.6 * math.exp(-0.3 * layer_idx)
    y_diff = diff_mixer(dq, dk, dv, diff_qk_gain, diff_lambda, diff_subln_gain, lambda_init, pos)
    y_mla = mla_mixer(mla_cq, mla_ckv, mla_kr, mla_cq_gain, mla_ckv_gain, mla_w_uq, mla_w_ukv,
                      mla_qk_gain, pos)
    y_mem = memory_mixer(mem_q, mem, mem_norm_gain, mem_w_kv, mem_qk_gain)

    y = jnp.concatenate([y_nsa * jax.nn.silu(nsa_z), y_diff * jax.nn.silu(diff_z),
                         y_mla * jax.nn.silu(mla_z), y_mem * jax.nn.silu(mem_z)], axis=-1)
    return x + y @ w_out


def setup_inputs(seed: int = 0) -> dict:
    key = jax.random.key(seed)
    k = jax.random.split(key, 19)
    f32 = jnp.float32

    def dense(kk, shape, fan_in):
        return jax.random.normal(kk, shape, f32) * fan_in ** -0.5

    def gain(kk, shape):
        return 1.0 + 0.02 * jax.random.normal(kk, shape, f32)

    L = DEPTH
    return {
        'x': jax.random.normal(k[0], (BATCH, SEQ, D_MODEL), f32),
        'mem': jax.random.normal(k[1], (BATCH, MEM_LEN, D_MODEL), f32),
        'norm_gain': gain(k[2], (L, D_MODEL)),
        'w_in': dense(k[3], (L, D_MODEL, D_IN), D_MODEL),
        'w_out': dense(k[4], (L, D_MIX, D_MODEL), D_MIX),
        'nsa_qk_gain': gain(k[5], (L, 4, HEAD_DIM)),
        'nsa_cmp_pe': 0.1 * jax.random.normal(k[6], (L, 2, NSA_CMP_BLOCK, HEAD_DIM), f32),
        'nsa_w_cmp': dense(k[7], (L, 2, NSA_CMP_BLOCK * HEAD_DIM, HEAD_DIM), NSA_CMP_BLOCK * HEAD_DIM),
        'diff_qk_gain': gain(k[8], (L, 2, DIFF_D)),
        'diff_lambda': 0.1 * jax.random.normal(k[9], (L, 4, DIFF_D), f32),
        'diff_subln_gain': gain(k[10], (L, HEAD_DIM)),
        'mla_cq_gain': gain(k[11], (L, MLA_Q_RANK)),
        'mla_ckv_gain': gain(k[12], (L, MLA_KV_RANK)),
        'mla_w_uq': dense(k[13], (L, MLA_Q_RANK, N_HEADS_GROUP * MLA_QK), MLA_Q_RANK),
        'mla_w_ukv': dense(k[14], (L, MLA_KV_RANK, N_HEADS_GROUP * (MLA_NOPE + MLA_V)), MLA_KV_RANK),
        'mla_qk_gain': gain(k[15], (L, 2, MLA_QK)),
        'mem_norm_gain': gain(k[16], (L, D_MODEL)),
        'mem_w_kv': dense(k[17], (L, D_MODEL, 2 * GROUP_WIDTH), D_MODEL),
        'mem_qk_gain': gain(k[18], (L, 2, HEAD_DIM)),
    }


def reference(x, mem, norm_gain, w_in, w_out, nsa_qk_gain, nsa_cmp_pe, nsa_w_cmp, diff_qk_gain,
              diff_lambda, diff_subln_gain, mla_cq_gain, mla_ckv_gain, mla_w_uq, mla_w_ukv,
              mla_qk_gain, mem_norm_gain, mem_w_kv, mem_qk_gain):
    for l in range(DEPTH):
        x = hybrid_layer(x, mem, l, norm_gain[l], w_in[l], w_out[l], nsa_qk_gain[l], nsa_cmp_pe[l],
                         nsa_w_cmp[l], diff_qk_gain[l], diff_lambda[l], diff_subln_gain[l],
                         mla_cq_gain[l], mla_ckv_gain[l], mla_w_uq[l], mla_w_ukv[l], mla_qk_gain[l],
                         mem_norm_gain[l], mem_w_kv[l], mem_qk_gain[l])
    return x
```

```cpp
#include <hip/hip_runtime.h>
#include <hip/hip_cooperative_groups.h>
#include <stdint.h>
#include <cstdio>
namespace cg = cooperative_groups;

typedef unsigned short bf16;
using bf16x8 = __attribute__((ext_vector_type(8))) short;
using f32x16 = __attribute__((ext_vector_type(16))) float;
typedef __bf16 hbf2 __attribute__((ext_vector_type(2)));
typedef float hf2 __attribute__((ext_vector_type(2)));
typedef uint32_t u32x4 __attribute__((ext_vector_type(4)));
#define GLD16(dst, ptr) asm volatile("global_load_dwordx4 %0, %1, off" : "=&v"(dst) : "v"(ptr) : "memory")
#define WAIT_VM0() asm volatile("s_waitcnt vmcnt(0)" ::: "memory")
#define DI __device__ __forceinline__
#define MFMA(a, b, c) __builtin_amdgcn_mfma_f32_32x32x16_bf16((a), (b), (c), 0, 0, 0)

constexpr int Bn = 8, S = 2048, T = 16384, D = 1024, NP = 3200, ML = 256, TM = 2048;
constexpr float EPS = 1e-6f;
constexpr float LOG2E = 1.4426950408889634f;
constexpr int C_NQ = 0, C_KC = 256, C_VC = 320, C_KS = 384, C_VS = 448, C_KW = 512, C_VW = 576, C_NZ = 640,
              C_DQ = 896, C_DK = 1152, C_DV = 1408, C_DZ = 1664, C_CQ = 1920, C_CKV = 2176, C_KR = 2304,
              C_MZ = 2336, C_MQ = 2592, C_MEZ = 2848, C_GL = 3104;
constexpr size_t SZ_WI = (size_t)NP * 1024 * 2, SZ_WO = 1024 * 1024 * 2, SZ_WUQ = 384 * 256 * 2, SZ_WUKV = 512 * 128 * 2,
                 SZ_WMEM = 512 * 1024 * 2, SZ_WCMP = 128 * 2048 * 2;
constexpr size_t OFF_WI = 0;
constexpr size_t OFF_WO = OFF_WI + 2 * SZ_WI;
constexpr size_t OFF_WUQ = OFF_WO + 2 * SZ_WO;
constexpr size_t OFF_WUKV = OFF_WUQ + 2 * SZ_WUQ;
constexpr size_t OFF_WMEM = OFF_WUKV + 2 * SZ_WUKV;
constexpr size_t OFF_WCMP = OFF_WMEM + 2 * SZ_WMEM;
constexpr size_t OFF_CB = OFF_WCMP + 4 * SZ_WCMP;
constexpr size_t OFF_LAM = OFF_CB + 16384;
constexpr size_t OFF_CTR = OFF_LAM + 256;
constexpr size_t OFF_BAR = OFF_CTR + 1024;
constexpr size_t OFF_FLAG = OFF_BAR + 16384;
constexpr size_t OFF_PCNT = OFF_FLAG + 8192;
constexpr size_t OFF_ROPE = OFF_PCNT + 2048;
constexpr size_t OFF_SSQ = OFF_ROPE + 2048 * 32 * 8;
constexpr size_t OFF_RMEM = OFF_SSQ + (size_t)T * 8 * 4;
constexpr size_t OFF_MEMB = OFF_RMEM + 2048 * 4;
constexpr size_t OFF_XB = OFF_MEMB + (size_t)TM * 1024 * 2;
constexpr size_t OFF_U = OFF_XB + (size_t)T * 1024 * 2;
constexpr size_t OFF_R1 = OFF_U + (size_t)T * NP * 2;
constexpr size_t SLAB = (size_t)S * 1024 * 2;
constexpr size_t OFF_UQ = OFF_R1;
constexpr size_t OFF_UKV = OFF_R1 + (size_t)S * 384 * 2;
constexpr size_t OFF_Y = OFF_R1;
constexpr size_t OFF_QM = OFF_R1 + (size_t)T * 1024 * 2;
constexpr size_t OFF_KM = OFF_QM + (size_t)T * 384 * 2;
constexpr size_t OFF_MV = OFF_KM + (size_t)T * 384 * 2;
constexpr size_t OFF_KMEMRAW = OFF_MV + (size_t)T * 256 * 2;
constexpr size_t OFF_MK = OFF_KMEMRAW + (size_t)TM * 512 * 2;
constexpr size_t OFF_MVV = OFF_MK + (size_t)TM * 256 * 2;
constexpr size_t OFF_CMPRAW = OFF_MVV + (size_t)TM * 256 * 2;
constexpr size_t OFF_KCN = OFF_CMPRAW + 2 * 1024 * 128 * 2;
constexpr size_t OFF_VCN = OFF_KCN + 8 * 128 * 64 * 2;
constexpr size_t OFF_GT = OFF_VCN + 8 * 128 * 64 * 2;
constexpr size_t OFF_OCMP = OFF_GT + (size_t)T * 12 * 4;
constexpr size_t OFF_OWIN = OFF_OCMP + (size_t)T * 256 * 2;
constexpr size_t OFF_SEL = OFF_OWIN + (size_t)T * 256 * 2;
constexpr size_t WS_TOTAL = OFF_SEL + (size_t)T * 4;

constexpr int SMEM_BYTES = 73728;
constexpr int SM_VT = 2 * 64 * 104 * 2;
constexpr int SM_SC = SM_VT + 2 * 64 * 72 * 2;
constexpr int SM_MISC = SM_SC + 4 * 32 * 33 * 4;

struct Params {
  const float* in[19];
  float* out;
  char* ws;
};

DI int opq(int v) { asm volatile("" : "+v"(v)); return v; }
DI char* opqp(char* q) { size_t z = 0; asm volatile("" : "+s"(z)); return q + z; }
DI float bf2f(uint32_t v) { return __uint_as_float(v << 16); }
DI float bflo(uint32_t w) { return __uint_as_float(w << 16); }
DI float bfhi(uint32_t w) { return __uint_as_float(w & 0xffff0000u); }
DI uint32_t pack2(float a, float b) { hf2 f = {a, b}; hbf2 r = __builtin_convertvector(f, hbf2); return __builtin_bit_cast(uint32_t, r); }
DI bf16 f2bf(float a) { return (bf16)(pack2(a, 0.f) & 0xffffu); }
DI float fexp2(float x) { return __builtin_amdgcn_exp2f(x); }
DI float sigmoidf_(float x) { return __builtin_amdgcn_rcpf(1.f + fexp2(-LOG2E * x)); }
DI float siluf_(float x) { return x * __builtin_amdgcn_rcpf(1.f + fexp2(-LOG2E * x)); }
DI float shx(float v, int m) { return __shfl_xor(v, m); }
DI float dppf(float v, int ctrl_sel) {
  int x = __builtin_bit_cast(int, v), r;
  if (ctrl_sel == 0) r = __builtin_amdgcn_mov_dpp(x, 0xB1, 0xF, 0xF, true);
  else if (ctrl_sel == 1) r = __builtin_amdgcn_mov_dpp(x, 0x4E, 0xF, 0xF, true);
  else if (ctrl_sel == 2) r = __builtin_amdgcn_mov_dpp(x, 0x141, 0xF, 0xF, true);
  else r = __builtin_amdgcn_mov_dpp(x, 0x140, 0xF, 0xF, true);
  return __builtin_bit_cast(float, r);
}
DI float sum8(float v) { v += dppf(v, 0); v += dppf(v, 1); v += dppf(v, 2); return v; }
DI float sum16(float v) { v = sum8(v); v += dppf(v, 3); return v; }
DI float sum64(float v) { v = sum16(v); v += shx(v, 16); v += shx(v, 32); return v; }


#define XB_TMO      128
#define XB_XCNT(j)  (256  + 64 * (j))
#define XB_XSUB(j)  (1280 + 64 * (j))
#define XB_XGEN(j)  (2304 + 64 * (j))
#define XB_TOP      3328
#define XB_TOPGEN   3392
#define XB_SPIN_CAP (1u << 22)
#define LAS __attribute__((address_space(3)))
DI unsigned xb_ld(unsigned* p) { return __hip_atomic_load(p, __ATOMIC_RELAXED, __HIP_MEMORY_SCOPE_AGENT); }
DI unsigned xb_add(unsigned* p, unsigned v) { return __hip_atomic_fetch_add(p, v, __ATOMIC_RELAXED, __HIP_MEMORY_SCOPE_AGENT); }
DI unsigned xb_xcc_id() { return (unsigned)__builtin_amdgcn_readfirstlane((int)(__builtin_amdgcn_s_getreg((3 << 11) | 20) & 0xFu)); }
#define XB_SPIN(cond, bar) do { unsigned _sp = 0; while (cond) { __builtin_amdgcn_s_sleep(1); \
    if ((++_sp & 255u) == 0u) { if (xb_ld(&(bar)[XB_TMO])) break; if (_sp > XB_SPIN_CAP) { atomicAdd(&(bar)[XB_TMO], 1u); break; } } } } while (0)
struct XcdBarrier { unsigned* bar; unsigned x; volatile LAS unsigned* st; };
DI XcdBarrier xcd_barrier_post(unsigned* bar, volatile LAS unsigned* st) {
  XcdBarrier b; b.bar = bar; b.x = xb_xcc_id(); b.st = st;
  if (threadIdx.x == 0) (void)xb_add(&bar[XB_XCNT(b.x)], 1u);
  return b;
}
DI void xcd_barrier_complete(unsigned* bar, unsigned x, unsigned& nloc, unsigned& nx) {
  const unsigned G = gridDim.x * gridDim.y * gridDim.z;
  unsigned sum, cnt, mine, sp = 0u;
  for (;;) {
    sum = 0u; cnt = 0u; mine = 0u;
#pragma unroll
    for (unsigned j = 0; j < 16; ++j) { const unsigned c = xb_ld(&bar[XB_XCNT(j)]); sum += c; cnt += (c > 0u) ? 1u : 0u; mine = (j == x) ? c : mine; }
    if (sum == G) break;
    __builtin_amdgcn_s_sleep(1);
    if ((++sp & 255u) == 0u) { if (xb_ld(&bar[XB_TMO])) break; if (sp > XB_SPIN_CAP) { atomicAdd(&bar[XB_TMO], 1u); break; } }
  }
  nloc = mine > 0u ? mine : 1u; nx = cnt > 0u ? cnt : 1u;
}
DI void xcd_barrier(const XcdBarrier& b) {
  asm volatile("s_waitcnt vmcnt(0)" ::: "memory");
  __syncthreads();
  if (threadIdx.x == 0) {
    unsigned* bar = b.bar;
    const unsigned bx = xb_xcc_id();
    __builtin_amdgcn_s_waitcnt(0);
    unsigned nloc = b.st[0], nx = b.st[1];
    if (nloc == 0u) { xcd_barrier_complete(bar, bx, nloc, nx); b.st[0] = nloc; b.st[1] = nx; }
    const unsigned old = xb_add(&bar[XB_XSUB(bx)], 1u);
    const unsigned gen = old / nloc;
    if (old + 1u == (gen + 1u) * nloc) {
      __builtin_amdgcn_fence(__ATOMIC_RELEASE, "agent");
      asm volatile("s_waitcnt vmcnt(0)" ::: "memory");
      const unsigned og = xb_add(&bar[XB_TOP], 1u);
      const unsigned tg = og / nx;
      if (og + 1u == (tg + 1u) * nx) xb_add(&bar[XB_TOPGEN], 1u);
      else XB_SPIN(xb_ld(&bar[XB_TOPGEN]) == tg, bar);
      __builtin_amdgcn_fence(__ATOMIC_ACQUIRE, "agent");
      xb_add(&bar[XB_XGEN(bx)], 1u);
      asm volatile("s_waitcnt vmcnt(0)" ::: "memory");
    } else {
      XB_SPIN(xb_ld(&bar[XB_XGEN(bx)]) == gen, bar);
      __builtin_amdgcn_fence(__ATOMIC_ACQUIRE, "agent");
      asm volatile("s_waitcnt vmcnt(0)" ::: "memory");
    }
  }
  __syncthreads();
}

DI void part_barrier(unsigned* cnt, unsigned target) {
  asm volatile("s_waitcnt vmcnt(0)" ::: "memory");
  __syncthreads();
  if (threadIdx.x == 0) {
    __builtin_amdgcn_s_waitcnt(0);
    __builtin_amdgcn_fence(__ATOMIC_RELEASE, "agent");
    asm volatile("s_waitcnt vmcnt(0)" ::: "memory");
    xb_add(cnt, 1u);
    unsigned sp = 0;
    while (xb_ld(cnt) < target) { __builtin_amdgcn_s_sleep(1); if (++sp > (1u << 24)) break; }
    __builtin_amdgcn_fence(__ATOMIC_ACQUIRE, "agent");
    asm volatile("s_waitcnt vmcnt(0)" ::: "memory");
  }
  __syncthreads();
}

DI void wg_publish(unsigned* flag) {
  asm volatile("s_waitcnt vmcnt(0)" ::: "memory");
  __syncthreads();
  if (threadIdx.x == 0) {
    __builtin_amdgcn_fence(__ATOMIC_RELEASE, "agent");
    asm volatile("s_waitcnt vmcnt(0)" ::: "memory");
    xb_add(flag, 1u);
  }
}
DI void wg_wait2(unsigned* f0, unsigned* f1) {
  if (threadIdx.x == 0) {
    unsigned sp = 0;
    while (xb_ld(f0) < 1u || xb_ld(f1) < 1u) { __builtin_amdgcn_s_sleep(2); if (++sp > (1u << 22)) break; }
    __builtin_amdgcn_fence(__ATOMIC_ACQUIRE, "agent");
    asm volatile("s_waitcnt vmcnt(0)" ::: "memory");
  }
  __syncthreads();
}

DI int win_orig(int n) { return n < 640 ? n : (n < 3104 ? n + 12 : (n < 3116 ? n - 3104 + 640 : -1)); }

DI void convT_tile(const float* __restrict__ src, int Nsrc, const float* __restrict__ gain, bf16* __restrict__ dst, int K,
                   int k0, int n0, int mapmode, float* tile) {
  const int tid = opq(threadIdx.x);
  {
    const int nn = tid & 63, kk = tid >> 6;
    const int n = n0 + nn;
    const int on = mapmode == 1 ? win_orig(n) : (n < Nsrc ? n : -1);
    float v[16];
#pragma unroll
    for (int it = 0; it < 16; ++it) {
      const int k = k0 + kk + 4 * it;
      v[it] = 0.f;
      if (on >= 0) v[it] = src[(size_t)k * Nsrc + on];
    }
    if (gain) {
#pragma unroll
      for (int it = 0; it < 16; ++it) v[it] *= gain[k0 + kk + 4 * it];
    }
#pragma unroll
    for (int it = 0; it < 16; ++it) tile[(kk + 4 * it) * 65 + nn] = v[it];
  }
  __syncthreads();
  {
    const int k8 = (tid & 7) * 8, nb = tid >> 3;
#pragma unroll
    for (int it = 0; it < 2; ++it) {
      const int n = nb + 32 * it;
      uint4 o;
      o.x = pack2(tile[(k8 + 0) * 65 + n], tile[(k8 + 1) * 65 + n]);
      o.y = pack2(tile[(k8 + 2) * 65 + n], tile[(k8 + 3) * 65 + n]);
      o.z = pack2(tile[(k8 + 4) * 65 + n], tile[(k8 + 5) * 65 + n]);
      o.w = pack2(tile[(k8 + 6) * 65 + n], tile[(k8 + 7) * 65 + n]);
      *(uint4*)(dst + (size_t)(n0 + n) * K + k0 + k8) = o;
    }
  }
  __syncthreads();
}

DI void phase0(const Params& p, char* smem) {
  const int tid = opq(threadIdx.x), lane = tid & 63, wv = tid >> 6;
  float* tile = (float*)smem;
  char* ws = opqp(p.ws);
  constexpr int N_WI = 2 * 50 * 16, N_WO = 2 * 16 * 16, N_WUQ = 2 * 6 * 4, N_WUKV = 2 * 8 * 2, N_WMEM = 2 * 8 * 16,
                N_WCMP = 4 * 2 * 32, N_X = T / 4, N_MEM = TM / 4, N_ROPE = 256, N_CB = 64, N_LAM = 1;
  constexpr int E0 = N_WI, E1 = E0 + N_WO, E2 = E1 + N_WUQ, E3 = E2 + N_WUKV, E4 = E3 + N_WMEM, E5 = E4 + N_WCMP,
                E6 = E5 + N_X, E7 = E6 + N_MEM, E8 = E7 + N_ROPE, E9 = E8 + N_CB, E10 = E9 + N_LAM;
  for (int it = blockIdx.x; it < E10; it += gridDim.x) {
    if (it < E0) {
      int l = it / 800, r = it % 800, nt = r / 16, kt = r % 16;
      convT_tile(p.in[3] + (size_t)l * 1024 * 3116, 3116, p.in[2] + l * 1024, (bf16*)(ws + OFF_WI + l * SZ_WI), 1024, kt * 64, nt * 64, 1, tile);
    } else if (it < E1) {
      int i = it - E0; int l = i / 256, r = i % 256, nt = r / 16, kt = r % 16;
      convT_tile(p.in[4] + (size_t)l * 1024 * 1024, 1024, nullptr, (bf16*)(ws + OFF_WO + l * SZ_WO), 1024, kt * 64, nt * 64, 0, tile);
    } else if (it < E2) {
      int i = it - E1; int l = i / 24, r = i % 24, nt = r / 4, kt = r % 4;
      convT_tile(p.in[13] + (size_t)l * 256 * 384, 384, p.in[11] + l * 256, (bf16*)(ws + OFF_WUQ + l * SZ_WUQ), 256, kt * 64, nt * 64, 0, tile);
    } else if (it < E3) {
      int i = it - E2; int l = i / 16, r = i % 16, nt = r / 2, kt = r % 2;
      convT_tile(p.in[14] + (size_t)l * 128 * 512, 512, p.in[12] + l * 128, (bf16*)(ws + OFF_WUKV + l * SZ_WUKV), 128, kt * 64, nt * 64, 0, tile);
    } else if (it < E4) {
      int i = it - E3; int l = i / 128, r = i % 128, nt = r / 16, kt = r % 16;
      convT_tile(p.in[17] + (size_t)l * 1024 * 512, 512, p.in[16] + l * 1024, (bf16*)(ws + OFF_WMEM + l * SZ_WMEM), 1024, kt * 64, nt * 64, 0, tile);
    } else if (it < E5) {
      int i = it - E4; int lj = i / 64, r = i % 64, nt = r / 32, kt = r % 32;
      convT_tile(p.in[7] + (size_t)lj * 2048 * 64, 64, nullptr, (bf16*)(ws + OFF_WCMP + lj * SZ_WCMP), 2048, kt * 64, nt * 64, 0, tile);
    } else if (it < E6) {
      int row = (it - E5) * 4 + wv;
      const float4* xr = (const float4*)(p.in[0] + (size_t)row * 1024);
      bf16* xb = (bf16*)(ws + OFF_XB) + (size_t)row * 1024;
      float ss = 0.f;
#pragma unroll
      for (int i = 0; i < 4; ++i) {
        float4 v = xr[lane + 64 * i];
        ss += v.x * v.x + v.y * v.y + v.z * v.z + v.w * v.w;
        uint2 o; o.x = pack2(v.x, v.y); o.y = pack2(v.z, v.w);
        *(uint2*)(xb + (lane + 64 * i) * 4) = o;
      }
      ss = sum64(ss);
      float* sq = (float*)(ws + OFF_SSQ) + (size_t)row * 8;
      if (lane < 8) sq[lane] = lane == 0 ? ss : 0.f;
    } else if (it < E7) {
      int row = (it - E6) * 4 + wv;
      const float4* xr = (const float4*)(p.in[1] + (size_t)row * 1024);
      bf16* xb = (bf16*)(ws + OFF_MEMB) + (size_t)row * 1024;
      float ss = 0.f;
#pragma unroll
      for (int i = 0; i < 4; ++i) {
        float4 v = xr[lane + 64 * i];
        ss += v.x * v.x + v.y * v.y + v.z * v.z + v.w * v.w;
        uint2 o; o.x = pack2(v.x, v.y); o.y = pack2(v.z, v.w);
        *(uint2*)(xb + (lane + 64 * i) * 4) = o;
      }
      ss = sum64(ss);
      if (lane == 0) ((float*)(ws + OFF_RMEM))[row] = rsqrtf(ss * (1.f / 1024.f) + EPS);
    } else if (it < E8) {
      int e = (it - E7) * 256 + tid;
      int pos = e >> 5, i = e & 31;
      float inv = powf(10000.f, -(float)i / 32.f);
      float ang = (float)pos * inv;
      double a = (double)ang;
      double n = rint(a * 0.15915494309189535);
      float r = (float)(a - n * 6.283185307179586);
      float2 cs; cs.x = __cosf(r); cs.y = __sinf(r);
      ((float2*)(ws + OFF_ROPE))[e] = cs;
    } else if (it < E9) {
      int lj = (it - E8) >> 4, sl = (it - E8) & 15;
      const float* pe = p.in[6] + (size_t)lj * 2048;
      const float* w = p.in[7] + (size_t)lj * 2048 * 64;
      int n = tid & 63, part = tid >> 6;
      float acc = 0.f;
      const int kb0 = sl * 128 + part * 32;
#pragma unroll 8
      for (int k = kb0; k < kb0 + 32; ++k) acc += pe[k] * w[(size_t)k * 64 + n];
      tile[tid] = acc;
      __syncthreads();
      if (tid < 64) ((float*)(ws + OFF_CB))[((it - E8)) * 64 + tid] = tile[tid] + tile[tid + 64] + tile[tid + 128] + tile[tid + 192];
      __syncthreads();
    } else {
      if (tid < 2) {
        const float* lf = p.in[9] + tid * 128;
        float s1 = 0.f, s2 = 0.f;
        for (int i = 0; i < 32; ++i) { s1 += lf[i] * lf[32 + i]; s2 += lf[64 + i] * lf[96 + i]; }
        float li = 0.8f - 0.6f * expf(-0.3f * (float)tid);
        ((float*)(ws + OFF_LAM))[tid] = expf(s1) - expf(s2) + li;
      }
    }
  }
}

template <int CH>
DI void gemm_tile(const bf16* __restrict__ Ab, long lda, long kcs, const bf16* __restrict__ Bb, long ldb, int nk, char* smem) {
  const int tid = opq(threadIdx.x), lane = tid & 63, wv = tid >> 6, half = lane >> 5, l31 = lane & 31;
  const int wm = wv >> 1, wn = wv & 1;
  bf16* As = (bf16*)smem;
  bf16* Bs = (bf16*)(smem + 36864);
  const int lrow = tid >> 3, lcol = (tid & 7) * 8;
  const bf16* ag = Ab + (long)lrow * lda + lcol;
  const bf16* bg = Bb + (long)lrow * ldb + lcol;
  f32x16 acc[2][2];
#pragma unroll
  for (int a = 0; a < 2; ++a)
#pragma unroll
    for (int b = 0; b < 2; ++b)
#pragma unroll
      for (int i = 0; i < 16; ++i) acc[a][b][i] = 0.f;
#define GCOMPUTE(BUF) do { \
    const bf16* as_ = As + (BUF) * 128 * 72 + (wm * 64 + l31) * 72 + half * 8; \
    const bf16* bs_ = Bs + (BUF) * 128 * 72 + (wn * 64 + l31) * 72 + half * 8; \
    bf16x8 fa[2][2], fb[2][2]; \
    fa[0][0] = *(const bf16x8*)(as_); fa[0][1] = *(const bf16x8*)(as_ + 32 * 72); \
    fb[0][0] = *(const bf16x8*)(bs_); fb[0][1] = *(const bf16x8*)(bs_ + 32 * 72); \
    _Pragma("unroll") for (int kc = 0; kc < 4; ++kc) { \
      if (kc < 3) { \
        fa[(kc + 1) & 1][0] = *(const bf16x8*)(as_ + (kc + 1) * 16); fa[(kc + 1) & 1][1] = *(const bf16x8*)(as_ + 32 * 72 + (kc + 1) * 16); \
        fb[(kc + 1) & 1][0] = *(const bf16x8*)(bs_ + (kc + 1) * 16); fb[(kc + 1) & 1][1] = *(const bf16x8*)(bs_ + 32 * 72 + (kc + 1) * 16); \
      } \
      _Pragma("unroll") for (int ni = 0; ni < 2; ++ni) \
        _Pragma("unroll") for (int mi = 0; mi < 2; ++mi) acc[ni][mi] = MFMA(fb[kc & 1][ni], fa[kc & 1][mi], acc[ni][mi]); \
    } } while (0)
  for (int c0 = 0; c0 < nk; c0 += CH) {
    u32x4 rs[2][8];
    const bf16* agc = ag + (long)c0 * kcs;
    const bf16* bgc = bg + (long)c0 * 64;
#pragma unroll
    for (int i = 0; i < 4; ++i) {
      rs[0][i] = *(const u32x4*)(agc + (long)(32 * i) * lda);
      rs[0][4 + i] = *(const u32x4*)(bgc + (long)(32 * i) * ldb);
    }
#pragma unroll
    for (int i = 0; i < 4; ++i) {
      *(u32x4*)(As + (lrow + 32 * i) * 72 + lcol) = rs[0][i];
      *(u32x4*)(Bs + (lrow + 32 * i) * 72 + lcol) = rs[0][4 + i];
    }
    if (CH > 1) {
#pragma unroll
      for (int i = 0; i < 4; ++i) {
        GLD16(rs[1][i], agc + (long)(32 * i) * lda + kcs);
        GLD16(rs[1][4 + i], bgc + (long)(32 * i) * ldb + 64);
      }
    }
    __syncthreads();
#pragma unroll
    for (int t = 0; t < CH; ++t) {
      const int bufc = t & 1;
      if (t + 2 < CH) {
#pragma unroll
        for (int i = 0; i < 4; ++i) {
          GLD16(rs[t & 1][i], agc + (long)(32 * i) * lda + (long)(t + 2) * kcs);
          GLD16(rs[t & 1][4 + i], bgc + (long)(32 * i) * ldb + (long)(t + 2) * 64);
        }
      }
      GCOMPUTE(bufc);
      if (t + 1 < CH) {
        u32x4(&rr)[8] = rs[(t + 1) & 1];
        if (t + 2 < CH) asm volatile("s_waitcnt vmcnt(8)" : "+v"(rr[0]), "+v"(rr[1]), "+v"(rr[2]), "+v"(rr[3]), "+v"(rr[4]), "+v"(rr[5]), "+v"(rr[6]), "+v"(rr[7]) :: "memory");
        else asm volatile("s_waitcnt vmcnt(0)" : "+v"(rr[0]), "+v"(rr[1]), "+v"(rr[2]), "+v"(rr[3]), "+v"(rr[4]), "+v"(rr[5]), "+v"(rr[6]), "+v"(rr[7]) :: "memory");
        bf16* ad = As + (bufc ^ 1) * 128 * 72; bf16* bd = Bs + (bufc ^ 1) * 128 * 72;
#pragma unroll
        for (int i = 0; i < 4; ++i) {
          *(u32x4*)(ad + (lrow + 32 * i) * 72 + lcol) = rr[i];
          *(u32x4*)(bd + (lrow + 32 * i) * 72 + lcol) = rr[4 + i];
        }
      }
      __syncthreads();
    }
  }
#undef GCOMPUTE
  float* Cs = (float*)smem;
#pragma unroll
  for (int ni = 0; ni < 2; ++ni)
#pragma unroll
    for (int mi = 0; mi < 2; ++mi)
#pragma unroll
      for (int g = 0; g < 4; ++g) {
        float4 v; v.x = acc[ni][mi][4 * g]; v.y = acc[ni][mi][4 * g + 1]; v.z = acc[ni][mi][4 * g + 2]; v.w = acc[ni][mi][4 * g + 3];
        *(float4*)(Cs + (wm * 64 + mi * 32 + l31) * 132 + wn * 64 + ni * 32 + 8 * g + 4 * half) = v;
      }
  __syncthreads();
}

enum { EPI_PLAIN = 0, EPI_RS8 = 1, EPI_RS1 = 2, EPI_OUT = 3 };
DI void gemm_epi(int mode, char* smem, bf16* __restrict__ Cb, long ldc, int row0, const float* __restrict__ rs,
                 const float* __restrict__ xres, float* __restrict__ xout, bf16* __restrict__ xbout, float* __restrict__ ssqout, int ntile) {
  const float* Cs = (const float*)smem;
  const int tid = opq(threadIdx.x);
#pragma unroll 2
  for (int it = 0; it < 8; ++it) {
    const int idx = it * 256 + tid;
    const int r = idx >> 4, ch = idx & 15;
    float4 v0 = *(const float4*)(Cs + r * 132 + ch * 8);
    float4 v1 = *(const float4*)(Cs + r * 132 + ch * 8 + 4);
    const long grow = row0 + r;
    if (mode == EPI_OUT) {
      const float4* xr = (const float4*)(xres + grow * 1024 + ntile * 128 + ch * 8);
      float4 x0 = xr[0], x1 = xr[1];
      v0.x += x0.x; v0.y += x0.y; v0.z += x0.z; v0.w += x0.w;
      v1.x += x1.x; v1.y += x1.y; v1.z += x1.z; v1.w += x1.w;
      float4* xo = (float4*)(xout + grow * 1024 + ntile * 128 + ch * 8);
      xo[0] = v0; xo[1] = v1;
      if (xbout) {
        float ss = v0.x * v0.x + v0.y * v0.y + v0.z * v0.z + v0.w * v0.w + v1.x * v1.x + v1.y * v1.y + v1.z * v1.z + v1.w * v1.w;
        ss = sum16(ss);
        if (ch == 0) ssqout[grow * 8 + ntile] = ss;
        uint4 o; o.x = pack2(v0.x, v0.y); o.y = pack2(v0.z, v0.w); o.z = pack2(v1.x, v1.y); o.w = pack2(v1.z, v1.w);
        *(uint4*)(xbout + grow * 1024 + ntile * 128 + ch * 8) = o;
      }
    } else {
      float sc = 1.f;
      if (mode == EPI_RS8) {
        const float4* q = (const float4*)(rs + grow * 8);
        float4 a = q[0], b = q[1];
        sc = rsqrtf((a.x + a.y + a.z + a.w + b.x + b.y + b.z + b.w) * (1.f / 1024.f) + EPS);
      } else if (mode == EPI_RS1) sc = rs[grow];
      uint4 o; o.x = pack2(v0.x * sc, v0.y * sc); o.y = pack2(v0.z * sc, v0.w * sc); o.z = pack2(v1.x * sc, v1.y * sc); o.w = pack2(v1.z * sc, v1.w * sc);
      *(uint4*)(Cb + grow * ldc + ntile * 128 + ch * 8) = o;
    }
  }
  __syncthreads();
}

DI void gemm_big(const bf16* __restrict__ Ab, long lda, const bf16* __restrict__ Bb, long ldb, int nk, char* smem, int mode,
                 bf16* __restrict__ Cb, long ldc, int row0, const float* __restrict__ rs, const float* __restrict__ xres,
                 float* __restrict__ xout, bf16* __restrict__ xbout, float* __restrict__ ssqout, int ntile) {
  const int tid = opq(threadIdx.x), lane = tid & 63, wv = tid >> 6, half = lane >> 5, l31 = lane & 31;
  const int wm = wv >> 1, wn = wv & 1;
  bf16* As = (bf16*)smem;
  bf16* Bs = (bf16*)(smem + 36864);
  const int lrow = tid >> 3, lcol = (tid & 7) * 8;
  const bf16* ag = Ab + (long)lrow * lda + lcol;
  const bf16* bg = Bb + (long)lrow * ldb + lcol;
  u32x4 ra[8], rb[4];
  f32x16 acc[2][4];
#pragma unroll
  for (int a = 0; a < 2; ++a)
#pragma unroll
    for (int b = 0; b < 4; ++b)
#pragma unroll
      for (int i = 0; i < 16; ++i) acc[a][b][i] = 0.f;
#pragma unroll
  for (int i = 0; i < 8; ++i) ra[i] = *(const u32x4*)(ag + (long)(32 * i) * lda);
#pragma unroll
  for (int i = 0; i < 4; ++i) rb[i] = *(const u32x4*)(bg + (long)(32 * i) * ldb);
#pragma unroll
  for (int i = 0; i < 8; ++i) *(u32x4*)(As + (lrow + 32 * i) * 72 + lcol) = ra[i];
#pragma unroll
  for (int i = 0; i < 4; ++i) *(u32x4*)(Bs + (lrow + 32 * i) * 72 + lcol) = rb[i];
  __syncthreads();
  for (int ks = 0; ks < nk; ++ks) {
    const bool more = ks + 1 < nk;
    if (more) {
#pragma unroll
      for (int i = 0; i < 8; ++i) GLD16(ra[i], ag + (long)(32 * i) * lda + (long)(ks + 1) * 64);
#pragma unroll
      for (int i = 0; i < 4; ++i) GLD16(rb[i], bg + (long)(32 * i) * ldb + (long)(ks + 1) * 64);
    }
    const bf16* as_ = As + (wm * 128 + l31) * 72 + half * 8;
    const bf16* bs_ = Bs + (wn * 64 + l31) * 72 + half * 8;
#pragma unroll
    for (int kc = 0; kc < 4; ++kc) {
      bf16x8 fa[4], fb[2];
#pragma unroll
      for (int mi = 0; mi < 4; ++mi) fa[mi] = *(const bf16x8*)(as_ + mi * 32 * 72 + kc * 16);
#pragma unroll
      for (int ni = 0; ni < 2; ++ni) fb[ni] = *(const bf16x8*)(bs_ + ni * 32 * 72 + kc * 16);
#pragma unroll
      for (int ni = 0; ni < 2; ++ni)
#pragma unroll
        for (int mi = 0; mi < 4; ++mi) acc[ni][mi] = MFMA(fb[ni], fa[mi], acc[ni][mi]);
    }
    __syncthreads();
    if (more) {
      asm volatile("s_waitcnt vmcnt(0)" : "+v"(ra[0]), "+v"(ra[1]), "+v"(ra[2]), "+v"(ra[3]), "+v"(ra[4]), "+v"(ra[5]), "+v"(ra[6]), "+v"(ra[7]),
                   "+v"(rb[0]), "+v"(rb[1]), "+v"(rb[2]), "+v"(rb[3]) :: "memory");
#pragma unroll
      for (int i = 0; i < 8; ++i) *(u32x4*)(As + (lrow + 32 * i) * 72 + lcol) = ra[i];
#pragma unroll
      for (int i = 0; i < 4; ++i) *(u32x4*)(Bs + (lrow + 32 * i) * 72 + lcol) = rb[i];
      __syncthreads();
    }
  }
  float* Cs = (float*)smem;
#pragma unroll
  for (int h = 0; h < 2; ++h) {
    if (wm == h) {
#pragma unroll
      for (int ni = 0; ni < 2; ++ni)
#pragma unroll
        for (int mi = 0; mi < 4; ++mi)
#pragma unroll
          for (int g = 0; g < 4; ++g) {
            float4 v; v.x = acc[ni][mi][4 * g]; v.y = acc[ni][mi][4 * g + 1]; v.z = acc[ni][mi][4 * g + 2]; v.w = acc[ni][mi][4 * g + 3];
            *(float4*)(Cs + (mi * 32 + l31) * 132 + wn * 64 + ni * 32 + 8 * g + 4 * half) = v;
          }
    }
    __syncthreads();
    gemm_epi(mode, smem, Cb, ldc, row0 + h * 128, rs, xres, xout, xbout, ssqout, ntile);
  }
}

enum { AM_NONE = 0, AM_CAUSAL = 1, AM_WIN = 2, AM_CMP = 3, AM_SLC = 4 };

template <int DK>
DI void attn_core(const bf16* __restrict__ Kp, long kstride, const bf16* __restrict__ Vp, long vstride, uint32_t tilemask,
                  int mode, int qpos, uint32_t sel, const bf16x8 (&Qf)[DK / 16], f32x16 (&O)[2], float& m_out, float& l_out, char* smem) {
  constexpr int KST = DK + 8;
  constexpr int CPR = DK / 8;
  constexpr int NCH = CPR / 4;
  bf16* Ks = (bf16*)smem;
  bf16* VTs = (bf16*)(smem + SM_VT);
  const int tid = opq(threadIdx.x), lane = tid & 63, half = lane >> 5, l31 = lane & 31;
#pragma unroll
  for (int i = 0; i < 16; ++i) { O[0][i] = 0.f; O[1][i] = 0.f; }
  float l = 0.f;
  const int qw0 = __builtin_amdgcn_readfirstlane(qpos - l31);
  const bool causal_like = (mode == AM_CAUSAL || mode == AM_WIN || mode == AM_SLC);
  int klo = 0, khi = 0x7fffffff;
  if (mode == AM_CAUSAL || mode == AM_SLC) khi = qpos;
  else if (mode == AM_WIN) { khi = qpos; klo = qpos - 511; }
  else if (mode == AM_CMP) khi = (qpos - 31) >> 4;
  u32x4 rk0, rk1, rk2, rv0, rv1;
  rk0 = rk1 = rk2 = (u32x4){0u, 0u, 0u, 0u};
  const int vkp = tid & 31, vcc = tid >> 5;
  const int vcol = (vkp >> 3) * 16 + (((vkp & 1) | ((vkp & 2) << 1) | ((vkp & 4) >> 1)) * 2);
  const int c0 = tid, c1 = tid + 256, c2_ = tid + 512;
  const int kr0 = c0 / CPR, kc0 = (c0 % CPR) * 8, kr1 = c1 / CPR, kc1 = (c1 % CPR) * 8, kr2 = c2_ / CPR, kc2 = (c2_ % CPR) * 8;
#define GLOAD(KT) do { \
    GLD16(rk0, Kp + (long)((KT) * 64 + kr0) * kstride + kc0); \
    if constexpr (NCH > 1) GLD16(rk1, Kp + (long)((KT) * 64 + kr1) * kstride + kc1); \
    if constexpr (NCH > 2) GLD16(rk2, Kp + (long)((KT) * 64 + kr2) * kstride + kc2); \
    GLD16(rv0, Vp + (long)((KT) * 64 + 2 * vkp) * vstride + vcc * 8); \
    GLD16(rv1, Vp + (long)((KT) * 64 + 2 * vkp + 1) * vstride + vcc * 8); } while (0)
#define LSTORE(BUF) do { asm volatile("s_waitcnt vmcnt(0)" : "+v"(rk0), "+v"(rk1), "+v"(rk2), "+v"(rv0), "+v"(rv1) :: "memory"); \
    *(u32x4*)(Ks + ((BUF) * 64 + kr0) * KST + kc0) = rk0; \
    if constexpr (NCH > 1) *(u32x4*)(Ks + ((BUF) * 64 + kr1) * KST + kc1) = rk1; \
    if constexpr (NCH > 2) *(u32x4*)(Ks + ((BUF) * 64 + kr2) * KST + kc2) = rk2; \
    bf16* vd = VTs + ((BUF) * 64 + vcc * 8) * 72 + vcol; \
    *(uint32_t*)(vd + 0 * 72) = (rv0.x & 0xffffu) | (rv1.x << 16); \
    *(uint32_t*)(vd + 1 * 72) = (rv0.x >> 16) | (rv1.x & 0xffff0000u); \
    *(uint32_t*)(vd + 2 * 72) = (rv0.y & 0xffffu) | (rv1.y << 16); \
    *(uint32_t*)(vd + 3 * 72) = (rv0.y >> 16) | (rv1.y & 0xffff0000u); \
    *(uint32_t*)(vd + 4 * 72) = (rv0.z & 0xffffu) | (rv1.z << 16); \
    *(uint32_t*)(vd + 5 * 72) = (rv0.z >> 16) | (rv1.z & 0xffff0000u); \
    *(uint32_t*)(vd + 6 * 72) = (rv0.w & 0xffffu) | (rv1.w << 16); \
    *(uint32_t*)(vd + 7 * 72) = (rv0.w >> 16) | (rv1.w & 0xffff0000u); } while (0)
  uint32_t rem = tilemask;
  int kt = __ffs(rem) - 1; rem &= rem - 1;
  GLOAD(kt);
#pragma unroll
  for (int kc = 0; kc < DK / 16; ++kc) asm volatile("" ::"v"(Qf[kc]));
  __syncthreads();
  LSTORE(0);
  __syncthreads();
  int buf = 0;
  while (true) {
    int ktn = -1;
    if (rem) { ktn = __ffs(rem) - 1; rem &= rem - 1; GLOAD(ktn); }
    const bool wave_active = !(causal_like && kt * 64 > qw0 + 31);
    if (wave_active) {
    f32x16 Sx[2];
#pragma unroll
    for (int kb = 0; kb < 2; ++kb) {
      bf16x8 Kf[DK / 16];
#pragma unroll
      for (int kc = 0; kc < DK / 16; ++kc) Kf[kc] = *(const bf16x8*)(Ks + (buf * 64 + kb * 32 + l31) * KST + kc * 16 + half * 8);
      __builtin_amdgcn_sched_barrier(0);
#pragma unroll
      for (int i = 0; i < 16; ++i) Sx[kb][i] = 0.f;
#pragma unroll
      for (int kc = 0; kc < DK / 16; ++kc) Sx[kb] = MFMA(Kf[kc], Qf[kc], Sx[kb]);
    }
    bf16x8 Vf[2][2][2];
#pragma unroll
    for (int kb = 0; kb < 2; ++kb)
#pragma unroll
      for (int c2 = 0; c2 < 2; ++c2)
#pragma unroll
        for (int dvb = 0; dvb < 2; ++dvb)
          Vf[kb][c2][dvb] = *(const bf16x8*)(VTs + (buf * 64 + dvb * 32 + l31) * 72 + (kb * 2 + c2) * 16 + half * 8);
    __builtin_amdgcn_sched_barrier(0);
    bool need_mask = false;
    if (mode == AM_CAUSAL) need_mask = kt * 64 + 63 > qw0;
    else if (mode == AM_WIN) need_mask = (kt * 64 + 63 > qw0) || (kt * 64 < qw0 + 31 - 511);
    else if (mode == AM_CMP) need_mask = true;
    else if (mode == AM_SLC) need_mask = (kt * 64 + 63 > qw0) || (__ballot(!((sel >> kt) & 1u)) != 0ull);
    int khe = khi;
    if (mode == AM_SLC && !((sel >> kt) & 1u)) khe = -1;
    const int kbase = kt * 64 + half * 4;
#pragma unroll
    for (int kb = 0; kb < 2; ++kb) {
      if (need_mask) {
#pragma unroll
        for (int i = 0; i < 16; ++i) {
          const int key = kbase + kb * 32 + (i >> 2) * 8 + (i & 3);
          Sx[kb][i] = (key >= klo && key <= khe) ? Sx[kb][i] : -1e30f;
        }
      }
      float ps = 0.f;
#pragma unroll
      for (int i = 0; i < 16; ++i) { float pv = fexp2(Sx[kb][i]); Sx[kb][i] = pv; ps += pv; }
      l += ps;
#pragma unroll
      for (int c2 = 0; c2 < 2; ++c2) {
        uint4 pw;
        pw.x = pack2(Sx[kb][8 * c2 + 0], Sx[kb][8 * c2 + 1]); pw.y = pack2(Sx[kb][8 * c2 + 2], Sx[kb][8 * c2 + 3]);
        pw.z = pack2(Sx[kb][8 * c2 + 4], Sx[kb][8 * c2 + 5]); pw.w = pack2(Sx[kb][8 * c2 + 6], Sx[kb][8 * c2 + 7]);
        const bf16x8 pf = __builtin_bit_cast(bf16x8, pw);
#pragma unroll
        for (int dvb = 0; dvb < 2; ++dvb) O[dvb] = MFMA(Vf[kb][c2][dvb], pf, O[dvb]);
      }
      __builtin_amdgcn_sched_barrier(0);
    }
    }
    if (ktn < 0) break;
    LSTORE(buf ^ 1);
    __syncthreads();
    buf ^= 1; kt = ktn;
  }
  l_out = l + shx(l, 32);
  m_out = 0.f;
#undef GLOAD
#undef LSTORE
}

template <int DK>
DI void attn_core_dual(const bf16* __restrict__ Kp, long kstride, const bf16* __restrict__ Vp, long vstride, uint32_t tilemask,
                  int mode, int qpos, uint32_t sel, const bf16x8 (&Qf)[DK / 16], f32x16 (&O)[2], f32x16 (&O2)[2], float& l_out, float& l2_out, char* smem) {
  constexpr int KST = DK + 8;
  constexpr int CPR = DK / 8;
  constexpr int NCH = CPR / 4;
  bf16* Ks = (bf16*)smem;
  bf16* VTs = (bf16*)(smem + SM_VT);
  const int tid = opq(threadIdx.x), lane = tid & 63, half = lane >> 5, l31 = lane & 31;
#pragma unroll
  for (int i = 0; i < 16; ++i) { O[0][i] = 0.f; O[1][i] = 0.f; O2[0][i] = 0.f; O2[1][i] = 0.f; }
  float l = 0.f, l2 = 0.f;
  const int qw0 = __builtin_amdgcn_readfirstlane(qpos - l31);
  const bool causal_like = (mode == AM_CAUSAL || mode == AM_WIN || mode == AM_SLC);
  int klo = 0, khi = 0x7fffffff;
  if (mode == AM_CAUSAL || mode == AM_SLC) khi = qpos;
  else if (mode == AM_WIN) { khi = qpos; klo = qpos - 511; }
  else if (mode == AM_CMP) khi = (qpos - 31) >> 4;
  u32x4 rk0, rk1, rk2, rv0, rv1;
  rk0 = rk1 = rk2 = (u32x4){0u, 0u, 0u, 0u};
  const int vkp = tid & 31, vcc = tid >> 5;
  const int vcol = (vkp >> 3) * 16 + (((vkp & 1) | ((vkp & 2) << 1) | ((vkp & 4) >> 1)) * 2);
  const int c0 = tid, c1 = tid + 256, c2_ = tid + 512;
  const int kr0 = c0 / CPR, kc0 = (c0 % CPR) * 8, kr1 = c1 / CPR, kc1 = (c1 % CPR) * 8, kr2 = c2_ / CPR, kc2 = (c2_ % CPR) * 8;
#define GLOAD(KT) do { \
    GLD16(rk0, Kp + (long)((KT) * 64 + kr0) * kstride + kc0); \
    if constexpr (NCH > 1) GLD16(rk1, Kp + (long)((KT) * 64 + kr1) * kstride + kc1); \
    if constexpr (NCH > 2) GLD16(rk2, Kp + (long)((KT) * 64 + kr2) * kstride + kc2); \
    GLD16(rv0, Vp + (long)((KT) * 64 + 2 * vkp) * vstride + vcc * 8); \
    GLD16(rv1, Vp + (long)((KT) * 64 + 2 * vkp + 1) * vstride + vcc * 8); } while (0)
#define LSTORE(BUF) do { asm volatile("s_waitcnt vmcnt(0)" : "+v"(rk0), "+v"(rk1), "+v"(rv0), "+v"(rv1) :: "memory"); \
    *(u32x4*)(Ks + ((BUF) * 64 + kr0) * KST + kc0) = rk0; \
    if constexpr (NCH > 1) *(u32x4*)(Ks + ((BUF) * 64 + kr1) * KST + kc1) = rk1; \
    if constexpr (NCH > 2) *(u32x4*)(Ks + ((BUF) * 64 + kr2) * KST + kc2) = rk2; \
    bf16* vd = VTs + ((BUF) * 64 + vcc * 8) * 72 + vcol; \
    *(uint32_t*)(vd + 0 * 72) = (rv0.x & 0xffffu) | (rv1.x << 16); \
    *(uint32_t*)(vd + 1 * 72) = (rv0.x >> 16) | (rv1.x & 0xffff0000u); \
    *(uint32_t*)(vd + 2 * 72) = (rv0.y & 0xffffu) | (rv1.y << 16); \
    *(uint32_t*)(vd + 3 * 72) = (rv0.y >> 16) | (rv1.y & 0xffff0000u); \
    *(uint32_t*)(vd + 4 * 72) = (rv0.z & 0xffffu) | (rv1.z << 16); \
    *(uint32_t*)(vd + 5 * 72) = (rv0.z >> 16) | (rv1.z & 0xffff0000u); \
    *(uint32_t*)(vd + 6 * 72) = (rv0.w & 0xffffu) | (rv1.w << 16); \
    *(uint32_t*)(vd + 7 * 72) = (rv0.w >> 16) | (rv1.w & 0xffff0000u); } while (0)
  uint32_t rem = tilemask;
  int kt = __ffs(rem) - 1; rem &= rem - 1;
  GLOAD(kt);
#pragma unroll
  for (int kc = 0; kc < DK / 16; ++kc) asm volatile("" ::"v"(Qf[kc]));
  __syncthreads();
  LSTORE(0);
  __syncthreads();
  int buf = 0;
  while (true) {
    int ktn = -1;
    if (rem) { ktn = __ffs(rem) - 1; rem &= rem - 1; GLOAD(ktn); }
    const bool wave_active = !(causal_like && kt * 64 > qw0 + 31);
    if (wave_active) {
    const bool need_mask = kt * 64 + 63 > qw0;
    const int kbase = kt * 64 + half * 4;
#pragma unroll
    for (int mp = 0; mp < 2; ++mp) {
      f32x16 Sx[2];
#pragma unroll
      for (int kb = 0; kb < 2; ++kb) {
        bf16x8 k0 = *(const bf16x8*)(Ks + (buf * 64 + kb * 32 + l31) * KST + (2 * mp) * 16 + half * 8);
        bf16x8 k1 = *(const bf16x8*)(Ks + (buf * 64 + kb * 32 + l31) * KST + (2 * mp + 1) * 16 + half * 8);
#pragma unroll
        for (int i = 0; i < 16; ++i) Sx[kb][i] = 0.f;
        Sx[kb] = MFMA(k0, Qf[2 * mp], Sx[kb]);
        Sx[kb] = MFMA(k1, Qf[2 * mp + 1], Sx[kb]);
      }
#pragma unroll
      for (int kb = 0; kb < 2; ++kb) {
        if (need_mask) {
#pragma unroll
          for (int i = 0; i < 16; ++i) {
            const int key = kbase + kb * 32 + (i >> 2) * 8 + (i & 3);
            Sx[kb][i] = (key <= khi) ? Sx[kb][i] : -1e30f;
          }
        }
        bf16x8 Vf[2][2];
#pragma unroll
        for (int c2 = 0; c2 < 2; ++c2)
#pragma unroll
          for (int dvb = 0; dvb < 2; ++dvb)
            Vf[c2][dvb] = *(const bf16x8*)(VTs + (buf * 64 + dvb * 32 + l31) * 72 + (kb * 2 + c2) * 16 + half * 8);
        float ps = 0.f;
#pragma unroll
        for (int i = 0; i < 16; ++i) { float pv = fexp2(Sx[kb][i]); Sx[kb][i] = pv; ps += pv; }
        if (mp == 0) l += ps; else l2 += ps;
#pragma unroll
        for (int c2 = 0; c2 < 2; ++c2) {
          uint4 pw;
          pw.x = pack2(Sx[kb][8 * c2 + 0], Sx[kb][8 * c2 + 1]); pw.y = pack2(Sx[kb][8 * c2 + 2], Sx[kb][8 * c2 + 3]);
          pw.z = pack2(Sx[kb][8 * c2 + 4], Sx[kb][8 * c2 + 5]); pw.w = pack2(Sx[kb][8 * c2 + 6], Sx[kb][8 * c2 + 7]);
          const bf16x8 pf = __builtin_bit_cast(bf16x8, pw);
#pragma unroll
          for (int dvb = 0; dvb < 2; ++dvb) {
            if (mp == 0) O[dvb] = MFMA(Vf[c2][dvb], pf, O[dvb]); else O2[dvb] = MFMA(Vf[c2][dvb], pf, O2[dvb]);
          }
        }
        __builtin_amdgcn_sched_barrier(0);
      }
    }
    }
    if (ktn < 0) break;
    LSTORE(buf ^ 1);
    __syncthreads();
    buf ^= 1; kt = ktn;
  }
  l_out = l + shx(l, 32);
  l2_out = l2 + shx(l2, 32);
#undef GLOAD
#undef LSTORE
}

template <int DK>
DI void load_q(const bf16* __restrict__ Qrow, bf16x8 (&Qf)[DK / 16]) {
  const int half = (opq(threadIdx.x) & 63) >> 5;
#pragma unroll
  for (int kc = 0; kc < DK / 16; ++kc) Qf[kc] = *(const bf16x8*)(Qrow + kc * 16 + half * 8);
}

DI void vec64(bool active, const bf16* src, const float* bias, int nbias, bf16* dst, const float* gain, const float2* rp, float scale, int j) {
  float a0 = 0.f, a1 = 0.f, b0 = 0.f, b1 = 0.f;
  if (active) {
    uint32_t lo = *(const uint32_t*)(src + 2 * j), hi = *(const uint32_t*)(src + 32 + 2 * j);
    a0 = bflo(lo); a1 = bfhi(lo); b0 = bflo(hi); b1 = bfhi(hi);
    for (int sidx = 0; sidx < nbias; ++sidx) {
      const float* bb = bias + sidx * 64;
      a0 += bb[2 * j]; a1 += bb[2 * j + 1]; b0 += bb[32 + 2 * j]; b1 += bb[33 + 2 * j];
    }
  }
  float ss = a0 * a0 + a1 * a1 + b0 * b0 + b1 * b1;
  ss = sum16(ss);
  const float r = rsqrtf(ss * (1.f / 64.f) + EPS);
  if (active) {
    a0 *= r * gain[2 * j]; a1 *= r * gain[2 * j + 1]; b0 *= r * gain[32 + 2 * j]; b1 *= r * gain[33 + 2 * j];
    if (rp) {
      const float2 c0 = rp[2 * j], c1 = rp[2 * j + 1];
      const float t0 = a0 * c0.x - b0 * c0.y, u0 = b0 * c0.x + a0 * c0.y;
      const float t1 = a1 * c1.x - b1 * c1.y, u1 = b1 * c1.x + a1 * c1.y;
      a0 = t0; b0 = u0; a1 = t1; b1 = u1;
    }
    *(uint32_t*)(dst + 2 * j) = pack2(a0 * scale, a1 * scale);
    *(uint32_t*)(dst + 32 + 2 * j) = pack2(b0 * scale, b1 * scale);
  }
}
template <int G>
DI void nr4(uint32_t lo, uint32_t hi, float invn, float g0, float g1, float g2, float g3, bool rope, float2 c0, float2 c1, float scale,
            uint32_t& olo, uint32_t& ohi) {
  float a0 = bflo(lo), a1 = bfhi(lo), b0 = bflo(hi), b1 = bfhi(hi);
  float ss = a0 * a0 + a1 * a1 + b0 * b0 + b1 * b1;
  ss = (G == 16) ? sum16(ss) : sum8(ss);
  const float r = rsqrtf(ss * invn + EPS);
  a0 *= r * g0; a1 *= r * g1; b0 *= r * g2; b1 *= r * g3;
  if (rope) {
    const float t0 = a0 * c0.x - b0 * c0.y, u0 = b0 * c0.x + a0 * c0.y;
    const float t1 = a1 * c1.x - b1 * c1.y, u1 = b1 * c1.x + a1 * c1.y;
    a0 = t0; b0 = u0; a1 = t1; b1 = u1;
  }
  olo = pack2(a0 * scale, a1 * scale); ohi = pack2(b0 * scale, b1 * scale);
}

struct PrepR {
  uint32_t q_lo, q_hi, p2_lo, p2_hi, p3_lo, p3_hi, dq_lo, dq_hi, dk_lo, dk_hi, glv, ckw, uqa, uqb, kra, krb;
  uint2 cw, nw, kw2, vw;
  float2 c0, c1, e0, e1;
};
struct PrepG {
  float gq0, gq1, gq2, gq3, h0, h1, h2, h3, m0, m1, m2, m3, dq0, dq1, dq2, dq3, dk0, dk1, dk2, dk3;
  float mgq0, mgq1, mgq2, mgq3, mgq4, mgq5, mgk0, mgk1, mgk2, mgk3, mgk4, mgk5;
};
DI void prep_load(char* ws, int t, int lane, PrepR& R) {
  const int j16 = lane & 15, g16 = lane >> 4, j8 = lane & 7, g8 = lane >> 3;
  const int s = t & 2047;
  const bf16* ur = (const bf16*)(ws + OFF_U) + (size_t)t * NP;
  const float2* rp = (const float2*)(ws + OFF_ROPE) + s * 32;
  const int col2 = g16 == 0 ? C_KS : (g16 == 1 ? C_KW : C_MQ + (g16 - 2) * 64);
  const int col3 = C_MQ + (2 + (g16 & 1)) * 64;
  const bf16* uq = (const bf16*)(ws + OFF_UQ + (size_t)(t >> 11) * SLAB) + (size_t)s * 384 + g16 * 96;
  const bf16* uk = (const bf16*)(ws + OFF_UKV + (size_t)(t >> 11) * SLAB) + (size_t)s * 512 + g16 * 128;
  R.q_lo = *(const uint32_t*)(ur + C_NQ + g16 * 64 + 2 * j16); R.q_hi = *(const uint32_t*)(ur + C_NQ + g16 * 64 + 32 + 2 * j16);
  R.p2_lo = *(const uint32_t*)(ur + col2 + 2 * j16); R.p2_hi = *(const uint32_t*)(ur + col2 + 32 + 2 * j16);
  R.p3_lo = *(const uint32_t*)(ur + col3 + 2 * j16); R.p3_hi = *(const uint32_t*)(ur + col3 + 32 + 2 * j16);
  R.dq_lo = *(const uint32_t*)(ur + C_DQ + g8 * 32 + 2 * j8); R.dq_hi = *(const uint32_t*)(ur + C_DQ + g8 * 32 + 16 + 2 * j8);
  R.dk_lo = *(const uint32_t*)(ur + C_DK + g8 * 32 + 2 * j8); R.dk_hi = *(const uint32_t*)(ur + C_DK + g8 * 32 + 16 + 2 * j8);
  R.glv = ur[C_GL + (lane < 12 ? lane : 0)];
  R.cw = *(const uint2*)(ur + C_CQ + lane * 4);
  R.ckw = *(const uint32_t*)(ur + C_CKV + lane * 2);
  R.nw = *(const uint2*)(uq + 4 * j16);
  R.uqa = uq[64 + j16]; R.uqb = uq[80 + j16];
  R.kw2 = *(const uint2*)(uk + 4 * j16);
  R.vw = *(const uint2*)(uk + 64 + 4 * j16);
  R.kra = ur[C_KR + j16]; R.krb = ur[C_KR + 16 + j16];
  R.c0 = rp[2 * j16]; R.c1 = rp[2 * j16 + 1];
  R.e0 = rp[4 * j8]; R.e1 = rp[4 * j8 + 2];
}
DI void prep_fin(char* ws, int t, int lane, const PrepR& R, const PrepG& G) {
  const int j16 = lane & 15, g16 = lane >> 4, j8 = lane & 7, g8 = lane >> 3;
  const float qs64 = 0.125f * LOG2E, qs32 = 0.17677669529663687f * LOG2E, qs96 = 0.10206207261596577f * LOG2E;
  const int b = t >> 11, s = t & 2047;
  bf16* ur = (bf16*)(ws + OFF_U) + (size_t)t * NP;
  const int col2 = g16 == 0 ? C_KS : (g16 == 1 ? C_KW : C_MQ + (g16 - 2) * 64);
  const int col3 = C_MQ + (2 + (g16 & 1)) * 64;
  const float2 c0 = R.c0, c1 = R.c1, e0 = R.e0, e1 = R.e1;
  uint32_t olo, ohi;
  nr4<16>(R.q_lo, R.q_hi, 1.f / 64.f, G.gq0, G.gq1, G.gq2, G.gq3, true, c0, c1, qs64, olo, ohi);
  *(uint32_t*)(ur + C_NQ + g16 * 64 + 2 * j16) = olo; *(uint32_t*)(ur + C_NQ + g16 * 64 + 32 + 2 * j16) = ohi;
  nr4<16>(R.p2_lo, R.p2_hi, 1.f / 64.f, G.h0, G.h1, G.h2, G.h3, g16 < 2, c0, c1, g16 < 2 ? 1.f : qs64, olo, ohi);
  *(uint32_t*)(ur + col2 + 2 * j16) = olo; *(uint32_t*)(ur + col2 + 32 + 2 * j16) = ohi;
  nr4<16>(R.p3_lo, R.p3_hi, 1.f / 64.f, G.m0, G.m1, G.m2, G.m3, false, c0, c1, qs64, olo, ohi);
  if (g16 < 2) { *(uint32_t*)(ur + col3 + 2 * j16) = olo; *(uint32_t*)(ur + col3 + 32 + 2 * j16) = ohi; }
  nr4<8>(R.dq_lo, R.dq_hi, 1.f / 32.f, G.dq0, G.dq1, G.dq2, G.dq3, true, e0, e1, qs32, olo, ohi);
  *(uint32_t*)(ur + C_DQ + g8 * 32 + 2 * j8) = olo; *(uint32_t*)(ur + C_DQ + g8 * 32 + 16 + 2 * j8) = ohi;
  nr4<8>(R.dk_lo, R.dk_hi, 1.f / 32.f, G.dk0, G.dk1, G.dk2, G.dk3, true, e0, e1, 1.f, olo, ohi);
  *(uint32_t*)(ur + C_DK + g8 * 32 + 2 * j8) = olo; *(uint32_t*)(ur + C_DK + g8 * 32 + 16 + 2 * j8) = ohi;
  if (lane < 12) ((float*)(ws + OFF_GT))[(size_t)t * 12 + lane] = sigmoidf_(bf2f(R.glv));
  float sq, skv;
  {
    float c0f = bflo(R.cw.x), c1f = bfhi(R.cw.x), c2f = bflo(R.cw.y), c3f = bfhi(R.cw.y);
    float ss = c0f * c0f + c1f * c1f + c2f * c2f + c3f * c3f;
    float d0 = bflo(R.ckw), d1 = bfhi(R.ckw);
    float s2 = d0 * d0 + d1 * d1;
    ss = sum64(ss); s2 = sum64(s2);
    sq = rsqrtf(ss * (1.f / 256.f) + EPS);
    skv = rsqrtf(s2 * (1.f / 128.f) + EPS);
  }
  {
    const int h = g16, j = j16;
    float n0 = bflo(R.nw.x) * sq, n1 = bfhi(R.nw.x) * sq, n2 = bflo(R.nw.y) * sq, n3 = bfhi(R.nw.y) * sq;
    float ra = bf2f(R.uqa) * sq, rb = bf2f(R.uqb) * sq;
    float r1 = ra * c0.x - rb * c0.y, r2 = rb * c0.x + ra * c0.y;
    float ss = n0 * n0 + n1 * n1 + n2 * n2 + n3 * n3 + r1 * r1 + r2 * r2;
    ss = sum16(ss);
    float r = rsqrtf(ss * (1.f / 96.f) + EPS) * qs96;
    bf16* qd = (bf16*)(ws + OFF_QM) + ((size_t)(b * 4 + h) * S + s) * 96;
    uint2 o; o.x = pack2(n0 * r * G.mgq0, n1 * r * G.mgq1); o.y = pack2(n2 * r * G.mgq2, n3 * r * G.mgq3);
    *(uint2*)(qd + 4 * j) = o;
    qd[64 + j] = f2bf(r1 * r * G.mgq4);
    qd[80 + j] = f2bf(r2 * r * G.mgq5);
    float k0 = bflo(R.kw2.x) * skv, k1 = bfhi(R.kw2.x) * skv, k2 = bflo(R.kw2.y) * skv, k3 = bfhi(R.kw2.y) * skv;
    float ka = bf2f(R.kra), kb = bf2f(R.krb);
    float kr1 = ka * c0.x - kb * c0.y, kr2 = kb * c0.x + ka * c0.y;
    float s3 = k0 * k0 + k1 * k1 + k2 * k2 + k3 * k3 + kr1 * kr1 + kr2 * kr2;
    s3 = sum16(s3);
    float rk_ = rsqrtf(s3 * (1.f / 96.f) + EPS);
    bf16* kd = (bf16*)(ws + OFF_KM) + ((size_t)(b * 4 + h) * S + s) * 96;
    uint2 o2; o2.x = pack2(k0 * rk_ * G.mgk0, k1 * rk_ * G.mgk1); o2.y = pack2(k2 * rk_ * G.mgk2, k3 * rk_ * G.mgk3);
    *(uint2*)(kd + 4 * j) = o2;
    kd[64 + j] = f2bf(kr1 * rk_ * G.mgk4);
    kd[80 + j] = f2bf(kr2 * rk_ * G.mgk5);
    uint2 o3; o3.x = pack2(bflo(R.vw.x) * skv, bfhi(R.vw.x) * skv); o3.y = pack2(bflo(R.vw.y) * skv, bfhi(R.vw.y) * skv);
    *(uint2*)((bf16*)(ws + OFF_MV) + ((size_t)(b * 4 + h) * S + s) * 64 + 4 * j) = o3;
  }
}

DI void prep_phase(const Params& p, int layer) {
  const int tid = opq(threadIdx.x), lane = tid & 63, wv = tid >> 6;
  char* ws = opqp(p.ws);
  const float2* rope = (const float2*)(ws + OFF_ROPE);
  const float* nsa_g = p.in[5] + layer * 256;
  const float* diff_g = p.in[8] + layer * 64;
  const float* mla_g = p.in[15] + layer * 192;
  const float* mem_g = p.in[18] + layer * 128;
  constexpr int N_TOK = T / 4, N_MEMT = TM / 4, N_CMP = 1024 / 4;
  const int j16 = lane & 15, g16 = lane >> 4, j8 = lane & 7;
  PrepG G;
  G.gq0 = nsa_g[2 * j16]; G.gq1 = nsa_g[2 * j16 + 1]; G.gq2 = nsa_g[32 + 2 * j16]; G.gq3 = nsa_g[33 + 2 * j16];
  const float* g2p = g16 == 0 ? nsa_g + 128 : (g16 == 1 ? nsa_g + 192 : mem_g);
  G.h0 = g2p[2 * j16]; G.h1 = g2p[2 * j16 + 1]; G.h2 = g2p[32 + 2 * j16]; G.h3 = g2p[33 + 2 * j16];
  G.m0 = mem_g[2 * j16]; G.m1 = mem_g[2 * j16 + 1]; G.m2 = mem_g[32 + 2 * j16]; G.m3 = mem_g[33 + 2 * j16];
  G.dq0 = diff_g[2 * j8]; G.dq1 = diff_g[2 * j8 + 1]; G.dq2 = diff_g[16 + 2 * j8]; G.dq3 = diff_g[17 + 2 * j8];
  G.dk0 = diff_g[32 + 2 * j8]; G.dk1 = diff_g[33 + 2 * j8]; G.dk2 = diff_g[48 + 2 * j8]; G.dk3 = diff_g[49 + 2 * j8];
  G.mgq0 = mla_g[4 * j16]; G.mgq1 = mla_g[4 * j16 + 1]; G.mgq2 = mla_g[4 * j16 + 2]; G.mgq3 = mla_g[4 * j16 + 3];
  G.mgq4 = mla_g[64 + j16]; G.mgq5 = mla_g[80 + j16];
  G.mgk0 = mla_g[96 + 4 * j16]; G.mgk1 = mla_g[96 + 4 * j16 + 1]; G.mgk2 = mla_g[96 + 4 * j16 + 2]; G.mgk3 = mla_g[96 + 4 * j16 + 3];
  G.mgk4 = mla_g[96 + 64 + j16]; G.mgk5 = mla_g[96 + 80 + j16];
  const int xcd = blockIdx.x & 7, rk = blockIdx.x >> 3, nrk = gridDim.x >> 3;
  for (int i = rk; i < 512; i += 2 * nrk) {
    const int it = xcd * 512 + i;
    const bool has2 = i + nrk < 512;
    const int it2 = has2 ? it + nrk : it;
    const int tA = it * 4 + wv, tB = it2 * 4 + wv;
    PrepR A, B;
    prep_load(ws, tA, lane, A);
    prep_load(ws, tB, lane, B);
    prep_fin(ws, tA, lane, A, G);
    if (has2) prep_fin(ws, tB, lane, B, G);
  }
  for (int i = rk; i < 96; i += nrk) {
    const int it = i < 64 ? N_TOK + xcd * 64 + i : N_TOK + N_MEMT + xcd * 32 + (i - 64);
    if (false) {
    } else if (it < N_TOK + N_MEMT) {
      const int t = (it - N_TOK) * 4 + wv;
      const int b = t >> 8, mi = t & 255;
      const bf16* kr = (const bf16*)(ws + OFF_KMEMRAW) + (size_t)t * 512;
      const int h = lane >> 4;
      uint2 vw = *(const uint2*)(kr + 256 + lane * 4);
      vec64(true, kr + h * 64, nullptr, 0, (bf16*)(ws + OFF_MK) + ((size_t)(b * 4 + h) * ML + mi) * 64, mem_g + 64, nullptr, 1.f, j16);
      *(uint2*)((bf16*)(ws + OFF_MVV) + ((size_t)(b * 4 + h) * ML + mi) * 64 + j16 * 4) = vw;
    } else {
      const int r = (it - N_TOK - N_MEMT) * 4 + wv;
      const int n = r & 127;
      const bf16* kraw = (const bf16*)(ws + OFF_CMPRAW) + (size_t)r * 128;
      const bf16* vraw = (const bf16*)(ws + OFF_CMPRAW) + (size_t)(1024 + r) * 128;
      const float* cbk = (const float*)(ws + OFF_CB) + (size_t)(layer * 2 + 0) * 16 * 64;
      const float* cbv = (const float*)(ws + OFF_CB) + (size_t)(layer * 2 + 1) * 16 * 64;
      bf16* kd = (bf16*)(ws + OFF_KCN) + (size_t)r * 64;
      bf16* vd = (bf16*)(ws + OFF_VCN) + (size_t)r * 64;
      if (n < 127) {
        const int pos = 16 * n + 31;
        float bv = 0.f;
#pragma unroll
        for (int sidx = 0; sidx < 16; ++sidx) bv += cbv[sidx * 64 + lane];
        const float vv = bf2f(vraw[lane]) + bv;
        vec64(lane < 16, kraw, cbk, 16, kd, nsa_g + 64, rope + pos * 32, 1.f, lane & 15);
        vd[lane] = f2bf(vv);
      } else {
        kd[lane] = 0; vd[lane] = 0;
      }
    }
  }
}

DI void st4(bf16* dst, float a, float b, float c, float d) { uint2 o; o.x = pack2(a, b); o.y = pack2(c, d); *(uint2*)dst = o; }

DI void attn_phaseA(const Params& p, int layer, char* smem, int* ctr) {
  char* ws = opqp(p.ws);
  bf16* u = (bf16*)(ws + OFF_U);
  bf16* y = (bf16*)(ws + OFF_Y);
  const float* gt = (const float*)(ws + OFF_GT);
  int* s_item = (int*)(smem + SM_MISC);
  const int xcd = blockIdx.x & 7;
  while (true) {
    __syncthreads();
    if (threadIdx.x == 0) *s_item = atomicAdd(ctr + 24 + xcd, 1);
    __syncthreads();
    const int item = *s_item;
    if (item >= 16) break;
    {
      const int tid = opq(threadIdx.x), lane = tid & 63, wv = tid >> 6, half = lane >> 5, l31 = lane & 31;
      const int i2 = item;
      const int qb = 15 - i2, b = xcd;
      const int q0 = qb * 128, qpos = q0 + wv * 32 + l31;
      const size_t t = (size_t)b * S + qpos;
      const bf16* ub = u + (size_t)b * S * NP;
      const bf16* kc = (const bf16*)(ws + OFF_KCN) + (size_t)b * 128 * 64;
      const bf16* vc = (const bf16*)(ws + OFF_VCN) + (size_t)b * 128 * 64;
      const uint32_t tm = (q0 + 127 >= 16 * 64 + 31) ? 3u : 1u;
      float* scl = (float*)(smem + SM_SC) + wv * 32 * 33;
#pragma unroll
      for (int g = 0; g < 16; ++g) scl[l31 * 33 + 2 * g + half] = 0.f;
      const int khi = (qpos - 31) >> 4;
#pragma unroll 1
      for (int h = 0; h < 4; ++h) {
        f32x16 O[2]; float mm, ll;
        bf16x8 Qf[4];
        load_q<64>(ub + (size_t)qpos * NP + C_NQ + h * 64, Qf);
        attn_core<64>(kc, 64, vc, 64, tm, AM_CMP, qpos, 0u, Qf, O, mm, ll, smem);
        const float inv = ll > 0.f ? 1.f / ll : 0.f;
        const float sc = inv * gt[t * 12 + h];
        bf16* od = (bf16*)(ws + OFF_OCMP) + t * 256 + h * 64;
#pragma unroll
        for (int dvb = 0; dvb < 2; ++dvb)
#pragma unroll
          for (int g = 0; g < 4; ++g)
            st4(od + dvb * 32 + 8 * g + 4 * half, O[dvb][4 * g] * sc, O[dvb][4 * g + 1] * sc, O[dvb][4 * g + 2] * sc, O[dvb][4 * g + 3] * sc);
        const float mu = mm < -1e29f ? 0.f : mm;
        const bf16* Ks = (const bf16*)smem;
        float Aa[16], Cc[16];
#pragma unroll
        for (int g = 0; g < 16; ++g) { Aa[g] = 0.f; Cc[g] = 0.f; }
#pragma unroll
        for (int kt = 0; kt < 2; ++kt) {
          if (tm & (1u << kt)) {
#pragma unroll
            for (int kb = 0; kb < 2; ++kb) {
              f32x16 Sx;
#pragma unroll
              for (int i = 0; i < 16; ++i) Sx[i] = 0.f;
#pragma unroll
              for (int kcx = 0; kcx < 4; ++kcx) {
                bf16x8 a = *(const bf16x8*)(Ks + (kt * 64 + kb * 32 + l31) * 72 + kcx * 16 + half * 8);
                Sx = MFMA(a, Qf[kcx], Sx);
              }
#pragma unroll
              for (int gg = 0; gg < 4; ++gg) {
                float pv[4];
#pragma unroll
                for (int e = 0; e < 4; ++e) {
                  const int key = kt * 64 + kb * 32 + gg * 8 + half * 4 + e;
                  pv[e] = key <= khi ? fexp2(Sx[gg * 4 + e] - mu) * inv : 0.f;
                }
                Aa[kt * 8 + kb * 4 + gg] += pv[0] + 2.f * (pv[1] + pv[2] + pv[3]);
                Cc[kt * 8 + kb * 4 + gg] += pv[0];
              }
            }
          }
        }
        {
          float rc[16];
#pragma unroll
          for (int g = 0; g < 16; ++g) rc[g] = shx(Cc[g], 32);
#pragma unroll
          for (int g = 0; g < 16; ++g) {
            const float nx = half == 0 ? rc[g] : (g < 15 ? rc[g < 15 ? g + 1 : 15] : 0.f);
            scl[l31 * 33 + 2 * g + half] += Aa[g] + nx;
          }
        }
      }
      __syncthreads();
      {
        float sv[32];
        const int cur = qpos >> 6;
#pragma unroll
        for (int j = 0; j < 32; ++j) {
          float v = scl[l31 * 33 + j];
          const bool forced = (j == 0) || (j == cur) || (j == cur - 1);
          sv[j] = j > cur ? -1e30f : (forced ? 1e30f : v);
        }
        uint32_t bits = 0;
#pragma unroll 1
        for (int jj = 0; jj < 16; ++jj) {
          const int j = half * 16 + jj;
          float sj = scl[l31 * 33 + j];
          const bool fj = (j == 0) || (j == cur) || (j == cur - 1);
          sj = j > cur ? -1e30f : (fj ? 1e30f : sj);
          int rank = 0;
#pragma unroll
          for (int i = 0; i < 32; ++i) rank += (sv[i] > sj || (sv[i] == sj && i < j)) ? 1 : 0;
          if (rank < 16) bits |= 1u << j;
        }
        bits |= (uint32_t)__shfl_xor((int)bits, 32);
        if (half == 0) ((uint32_t*)(ws + OFF_SEL))[t] = bits;
      }
      wg_publish((unsigned*)(ws + OFF_FLAG) + layer * 1024 + (b * 16 + qb) * 8);
    }
  }
  while (true) {
    __syncthreads();
    if (threadIdx.x == 0) *s_item = atomicAdd(ctr + 16 + xcd, 1);
    __syncthreads();
    const int item = *s_item;
    if (item >= 128) break;
    {
      const int tid = opq(threadIdx.x), lane = tid & 63, wv = tid >> 6, half = lane >> 5, l31 = lane & 31;
      const int i2 = item;
      const int ismem = i2 >> 6, r = i2 & 63, qb = 15 - (r >> 2), b = xcd, h = r & 3;
      const int q0 = qb * 128, qpos = q0 + wv * 32 + l31;
      const size_t t = (size_t)b * S + qpos;
      const bf16* ub = u + (size_t)b * S * NP;
      f32x16 O[2]; float mm, ll;
      bf16x8 Qf[4];
      if (!ismem) {
        load_q<64>(ub + (size_t)qpos * NP + C_NQ + h * 64, Qf);
        const int kt0 = q0 >= 512 ? (q0 - 512) / 64 : 0, kt1 = 2 * qb + 2;
        const uint32_t hi = kt1 >= 32 ? 0xffffffffu : ((1u << kt1) - 1u);
        const uint32_t tm = hi & ~((1u << kt0) - 1u);
        attn_core<64>(ub + C_KW, NP, ub + C_VW, NP, tm, AM_WIN, qpos, 0u, Qf, O, mm, ll, smem);
        const float sc = (ll > 0.f ? 1.f / ll : 0.f) * gt[t * 12 + 8 + h];
        bf16* od = (bf16*)(ws + OFF_OWIN) + t * 256 + h * 64;
#pragma unroll
        for (int dvb = 0; dvb < 2; ++dvb)
#pragma unroll
          for (int g = 0; g < 4; ++g)
            st4(od + dvb * 32 + 8 * g + 4 * half, O[dvb][4 * g] * sc, O[dvb][4 * g + 1] * sc, O[dvb][4 * g + 2] * sc, O[dvb][4 * g + 3] * sc);
        wg_publish((unsigned*)(ws + OFF_FLAG) + layer * 1024 + (b * 16 + qb) * 8 + 1 + h);
      } else {
        load_q<64>(ub + (size_t)qpos * NP + C_MQ + h * 64, Qf);
        attn_core<64>((const bf16*)(ws + OFF_MK) + (size_t)(b * 4 + h) * ML * 64, 64, (const bf16*)(ws + OFF_MVV) + (size_t)(b * 4 + h) * ML * 64, 64,
                      0xfu, AM_NONE, qpos, 0u, Qf, O, mm, ll, smem);
        const float inv = ll > 0.f ? 1.f / ll : 0.f;
#pragma unroll
        for (int dvb = 0; dvb < 2; ++dvb)
#pragma unroll
          for (int g = 0; g < 4; ++g) {
            const int dv = dvb * 32 + 8 * g + 4 * half;
            uint2 zw = *(const uint2*)(u + t * NP + C_MEZ + h * 64 + dv);
            st4(y + t * 1024 + 768 + h * 64 + dv, O[dvb][4 * g] * inv * siluf_(bflo(zw.x)), O[dvb][4 * g + 1] * inv * siluf_(bfhi(zw.x)),
                O[dvb][4 * g + 2] * inv * siluf_(bflo(zw.y)), O[dvb][4 * g + 3] * inv * siluf_(bfhi(zw.y)));
          }
      }
    }
  }
  while (true) {
    __syncthreads();
    if (threadIdx.x == 0) *s_item = atomicAdd(ctr + xcd, 1);
    __syncthreads();
    const int item = *s_item;
    if (item >= 64) break;
    {
      const int tid = opq(threadIdx.x), lane = tid & 63, wv = tid >> 6, half = lane >> 5, l31 = lane & 31;
      const int qb = 15 - (item >> 2), b = xcd, h = item & 3;
      const int q0 = qb * 128, qpos = q0 + wv * 32 + l31;
      const size_t t = (size_t)b * S + qpos;
      const uint32_t tm = (qb == 15) ? 0xffffffffu : ((1u << (2 * qb + 2)) - 1u);
      f32x16 O[2]; float mm, ll;
        bf16x8 Qf[6];
        const bf16* qm = (const bf16*)(ws + OFF_QM) + (size_t)(b * 4 + h) * S * 96;
        load_q<96>(qm + (size_t)qpos * 96, Qf);
        attn_core<96>((const bf16*)(ws + OFF_KM) + (size_t)(b * 4 + h) * S * 96, 96,
                      (const bf16*)(ws + OFF_MV) + (size_t)(b * 4 + h) * S * 64, 64, tm, AM_CAUSAL, qpos, 0u, Qf, O, mm, ll, smem);
        const float inv = ll > 0.f ? 1.f / ll : 0.f;
#pragma unroll
        for (int dvb = 0; dvb < 2; ++dvb)
#pragma unroll
          for (int g = 0; g < 4; ++g) {
            const int dv = dvb * 32 + 8 * g + 4 * half;
            uint2 zw = *(const uint2*)(u + t * NP + C_MZ + h * 64 + dv);
            st4(y + t * 1024 + 512 + h * 64 + dv, O[dvb][4 * g] * inv * siluf_(bflo(zw.x)), O[dvb][4 * g + 1] * inv * siluf_(bfhi(zw.x)),
                O[dvb][4 * g + 2] * inv * siluf_(bflo(zw.y)), O[dvb][4 * g + 3] * inv * siluf_(bfhi(zw.y)));
          }
    }
  }
  while (true) {
    __syncthreads();
    if (threadIdx.x == 0) *s_item = atomicAdd(ctr + 8 + xcd, 1);
    __syncthreads();
    const int item = *s_item;
    if (item >= 64) break;
    {
      const int tid = opq(threadIdx.x), lane = tid & 63, wv = tid >> 6, half = lane >> 5, l31 = lane & 31;
      const int qb = 15 - (item >> 2), b = xcd, h = item & 3;
      const int q0 = qb * 128, qpos = q0 + wv * 32 + l31;
      const size_t t = (size_t)b * S + qpos;
      const uint32_t tm = (qb == 15) ? 0xffffffffu : ((1u << (2 * qb + 2)) - 1u);
      f32x16 O[2]; float mm, ll;
        f32x16 O1[2];
        const bf16* ub = u + (size_t)b * S * NP;
        {
          bf16x8 Qf[4];
          float l1, l2;
          load_q<64>(ub + (size_t)qpos * NP + C_DQ + h * 64, Qf);
          attn_core_dual<64>(ub + C_DK + h * 64, NP, ub + C_DV + h * 64, NP, tm, AM_CAUSAL, qpos, 0u, Qf, O1, O, l1, l2, smem);
          const float inv1 = l1 > 0.f ? 1.f / l1 : 0.f, inv = l2 > 0.f ? 1.f / l2 : 0.f;
#pragma unroll
          for (int i = 0; i < 16; ++i) { O1[0][i] *= inv1; O1[1][i] *= inv1; }
          {
            const float lam = ((const float*)(ws + OFF_LAM))[layer];
            float ss = 0.f;
#pragma unroll
            for (int i = 0; i < 16; ++i) {
              O1[0][i] -= lam * O[0][i] * inv; O1[1][i] -= lam * O[1][i] * inv;
              ss += O1[0][i] * O1[0][i] + O1[1][i] * O1[1][i];
            }
            ss += shx(ss, 32);
            const float li = opq(layer) == 0 ? 0.2f : 0.35550907f;
            const float r = rsqrtf(ss * (1.f / 64.f) + EPS) * (1.f - li);
            const float* sg = p.in[10] + layer * 64;
#pragma unroll
            for (int dvb = 0; dvb < 2; ++dvb)
#pragma unroll
              for (int g = 0; g < 4; ++g) {
                const int dv = dvb * 32 + 8 * g + 4 * half;
                uint2 zw = *(const uint2*)(u + t * NP + C_DZ + h * 64 + dv);
                st4(y + t * 1024 + 256 + h * 64 + dv, O1[dvb][4 * g] * r * sg[dv] * siluf_(bflo(zw.x)),
                    O1[dvb][4 * g + 1] * r * sg[dv + 1] * siluf_(bfhi(zw.x)), O1[dvb][4 * g + 2] * r * sg[dv + 2] * siluf_(bflo(zw.y)),
                    O1[dvb][4 * g + 3] * r * sg[dv + 3] * siluf_(bfhi(zw.y)));
              }
          }
        }
    }
  }
}

DI void attn_phaseB(const Params& p, int layer, char* smem, int* ctr) {
  const int tid = opq(threadIdx.x), lane = tid & 63, wv = tid >> 6, half = lane >> 5, l31 = lane & 31;
  char* ws = opqp(p.ws);
  bf16* u = (bf16*)(ws + OFF_U);
  bf16* y = (bf16*)(ws + OFF_Y);
  const float* gt = (const float*)(ws + OFF_GT);
  int* s_item = (int*)(smem + SM_MISC);
  uint32_t* s_or = (uint32_t*)(smem + SM_MISC + 16);
  const int xcd = blockIdx.x & 7;
  while (true) {
    __syncthreads();
    if (tid == 0) { *s_item = atomicAdd(ctr + xcd, 1); *s_or = 0u; }
    __syncthreads();
    const int item = *s_item;
    if (item >= 64) break;
    const int qb = 15 - (item >> 2), b = xcd, h = item & 3;
    const int q0 = qb * 128, qpos = q0 + wv * 32 + l31;
    const size_t t = (size_t)b * S + qpos;
    const bf16* ub = u + (size_t)b * S * NP;
    wg_wait2((unsigned*)(ws + OFF_FLAG) + layer * 1024 + (b * 16 + qb) * 8, (unsigned*)(ws + OFF_FLAG) + layer * 1024 + (b * 16 + qb) * 8 + 1 + h);
    const uint32_t sel = ((const uint32_t*)(ws + OFF_SEL))[t];
    const uint32_t causal = (qb == 15) ? 0xffffffffu : ((1u << (2 * qb + 2)) - 1u);
    if (half == 0) atomicOr(s_or, sel);
    __syncthreads();
    const uint32_t tm = (*s_or & causal) | 1u;
    f32x16 O[2]; float mm, ll;
    bf16x8 Qf[4];
    load_q<64>(ub + (size_t)qpos * NP + C_NQ + h * 64, Qf);
    attn_core<64>(ub + C_KS, NP, ub + C_VS, NP, tm, AM_SLC, qpos, sel, Qf, O, mm, ll, smem);
    const float sc = (ll > 0.f ? 1.f / ll : 0.f) * gt[t * 12 + 4 + h];
    const bf16* oc = (const bf16*)(ws + OFF_OCMP) + t * 256 + h * 64;
    const bf16* ow = (const bf16*)(ws + OFF_OWIN) + t * 256 + h * 64;
#pragma unroll
    for (int dvb = 0; dvb < 2; ++dvb)
#pragma unroll
      for (int g = 0; g < 4; ++g) {
        const int dv = dvb * 32 + 8 * g + 4 * half;
        uint2 zw = *(const uint2*)(u + t * NP + C_NZ + h * 64 + dv);
        uint2 cw = *(const uint2*)(oc + dv);
        uint2 ww = *(const uint2*)(ow + dv);
        st4(y + t * 1024 + h * 64 + dv, (O[dvb][4 * g] * sc + bflo(cw.x) + bflo(ww.x)) * siluf_(bflo(zw.x)),
            (O[dvb][4 * g + 1] * sc + bfhi(cw.x) + bfhi(ww.x)) * siluf_(bfhi(zw.x)),
            (O[dvb][4 * g + 2] * sc + bflo(cw.y) + bflo(ww.y)) * siluf_(bflo(zw.y)),
            (O[dvb][4 * g + 3] * sc + bfhi(cw.y) + bfhi(ww.y)) * siluf_(bfhi(zw.y)));
      }
  }
  (void)layer;
}

__global__ void __launch_bounds__(256, 2) fwd_megakernel(Params p) {
  __shared__ __attribute__((aligned(16))) char smem[SMEM_BYTES];
  cg::grid_group grid = cg::this_grid();
  char* ws = opqp(p.ws);
  int* ctrs = (int*)(ws + OFF_CTR);
  __shared__ uint4 xb_words;
  if (threadIdx.x == 0) xb_words = make_uint4(0u, 0u, 0u, 0u);
  __syncthreads();
  XcdBarrier xb = xcd_barrier_post((unsigned*)(ws + OFF_BAR), (volatile LAS unsigned*)&xb_words);
  phase0(p, smem);
  if (p.out == nullptr) grid.sync();
  xcd_barrier(xb);
#define PBAR(K) xcd_barrier(xb)
  for (int layer = 0; layer < 2; ++layer) {
    bf16* u = (bf16*)(ws + OFF_U);
    {
      const bf16* xbp = (const bf16*)(ws + OFF_XB);
      const bf16* wi = (const bf16*)(ws + OFF_WI + layer * SZ_WI);
      const int xcd = blockIdx.x & 7, rk = blockIdx.x >> 3, nrk = gridDim.x >> 3;
      for (int q = rk; q < 216; q += nrk) {
        if (q < 192) {
          const int mt = xcd * 8 + (q & 7), nt = q >> 3;
          gemm_big(xbp + (size_t)mt * 256 * 1024, 1024, wi + (size_t)nt * 128 * 1024, 1024, 16, smem, EPI_RS8, u, NP, mt * 256,
                   (const float*)(ws + OFF_SSQ), nullptr, nullptr, nullptr, nullptr, nt);
        } else if (q < 208) {
          const int mt = xcd * 16 + (q - 192), nt = 24;
          gemm_tile<16>(xbp + (size_t)mt * 128 * 1024, 1024, 64, wi + (size_t)nt * 128 * 1024, 1024, 16, smem);
          gemm_epi(EPI_RS8, smem, u, NP, mt * 128, (const float*)(ws + OFF_SSQ), nullptr, nullptr, nullptr, nullptr, nt);
        } else {
          const int i = xcd * 8 + (q - 208), mt = i >> 2, nt = i & 3;
          gemm_tile<16>((const bf16*)(ws + OFF_MEMB) + (size_t)mt * 128 * 1024, 1024, 64,
                    (const bf16*)(ws + OFF_WMEM + layer * SZ_WMEM) + (size_t)nt * 128 * 1024, 1024, 16, smem);
          gemm_epi(EPI_RS1, smem, (bf16*)(ws + OFF_KMEMRAW), 512, mt * 128, (const float*)(ws + OFF_RMEM), nullptr, nullptr, nullptr, nullptr, nt);
        }
      }
    }
    PBAR(0);
    {
      const int xcd = blockIdx.x & 7, rk = blockIdx.x >> 3, nrk = gridDim.x >> 3;
      for (int q = rk; q < 58; q += nrk) {
        if (q < 2) {
          const int j = q, b = xcd;
          gemm_tile<16>(u + (size_t)b * S * NP + (j ? C_VC : C_KC), 16 * NP, NP, (const bf16*)(ws + OFF_WCMP + (layer * 2 + j) * SZ_WCMP), 2048, 32, smem);
          gemm_epi(EPI_PLAIN, smem, (bf16*)(ws + OFF_CMPRAW) + (size_t)j * 1024 * 128, 128, b * 128, nullptr, nullptr, nullptr, nullptr, nullptr, 0);
        } else if (q < 26) {
          const int i = q - 2, ml = i / 3, nt = i % 3, mt = xcd * 8 + ml;
          gemm_big(u + (size_t)mt * 256 * NP + C_CQ, NP, (const bf16*)(ws + OFF_WUQ + layer * SZ_WUQ) + (size_t)nt * 128 * 256, 256, 4, smem, EPI_PLAIN,
                   (bf16*)(ws + OFF_UQ + (size_t)xcd * SLAB), 384, ml * 256, nullptr, nullptr, nullptr, nullptr, nullptr, nt);
        } else {
          const int i = q - 26, ml = i >> 2, nt = i & 3, mt = xcd * 8 + ml;
          gemm_big(u + (size_t)mt * 256 * NP + C_CKV, NP, (const bf16*)(ws + OFF_WUKV + layer * SZ_WUKV) + (size_t)nt * 128 * 128, 128, 2, smem, EPI_PLAIN,
                   (bf16*)(ws + OFF_UKV + (size_t)xcd * SLAB), 512, ml * 256, nullptr, nullptr, nullptr, nullptr, nullptr, nt);
        }
      }
    }
    PBAR(1);
    prep_phase(p, layer);
    PBAR(2);
    attn_phaseA(p, layer, smem, ctrs + layer * 64);
    attn_phaseB(p, layer, smem, ctrs + layer * 64 + 32);
    PBAR(3);
    {
      const bf16* yb = (const bf16*)(ws + OFF_Y);
      const bf16* wo = (const bf16*)(ws + OFF_WO + layer * SZ_WO);
      const float* xres = layer == 0 ? p.in[0] : p.out;
      const int xcd = blockIdx.x & 7, rk = blockIdx.x >> 3, nrk = gridDim.x >> 3;
      for (int q = rk; q < 64; q += nrk) {
        const int mt = xcd * 8 + (q & 7), nt = q >> 3;
        gemm_big(yb + (size_t)mt * 256 * 1024, 1024, wo + (size_t)nt * 128 * 1024, 1024, 16, smem, EPI_OUT, nullptr, 0, mt * 256, nullptr, xres, p.out,
                 layer == 0 ? (bf16*)(ws + OFF_XB) : nullptr, (float*)(ws + OFF_SSQ), nt);
      }
    }
    if (layer == 0) PBAR(4);
  }
}

extern "C" void kernel_launch(void* const* d_in, const int* in_sizes, int n_in, void* d_out, int out_size, void* d_ws, size_t ws_size,
                              hipStream_t stream) {
  static int grid_blocks = 0;
  if (!grid_blocks) {
    int dev = 0, cus = 0, per_cu = 0;
    hipGetDevice(&dev);
    hipDeviceGetAttribute(&cus, hipDeviceAttributeMultiprocessorCount, dev);
    hipOccupancyMaxActiveBlocksPerMultiprocessor(&per_cu, fwd_megakernel, 256, 0);
    if (per_cu > 2) per_cu = 2;
    grid_blocks = (cus * per_cu) & ~7;
  }
  if (ws_size < WS_TOTAL) { fprintf(stderr, "workspace too small: %zu < %zu\n", ws_size, (size_t)WS_TOTAL); return; }
  Params p{};
  for (int i = 0; i < 19; ++i) p.in[i] = (const float*)d_in[i];
  p.out = (float*)d_out;
  p.ws = (char*)d_ws;
  hipMemsetAsync((char*)d_ws + OFF_CTR, 0, 1024 + 16384 + 8192 + 2048, stream);
  void* args[] = {&p};
  hipError_t e = hipLaunchCooperativeKernel((void*)fwd_megakernel, dim3(grid_blocks), dim3(256), args, 0, stream);
  if (e != hipSuccess) fprintf(stderr, "cooperative launch failed: %s (grid %d)\n", hipGetErrorString(e), grid_blocks);
}
```

```cpp
#include <hip/hip_runtime.h>
#include <hip/hip_cooperative_groups.h>
#include <stdint.h>
#include <cstdio>
namespace cg = cooperative_groups;

typedef unsigned short bf16;
using bf16x8 = __attribute__((ext_vector_type(8))) short;
using f32x16 = __attribute__((ext_vector_type(16))) float;
typedef __bf16 hbf2 __attribute__((ext_vector_type(2)));
typedef float hf2 __attribute__((ext_vector_type(2)));
typedef uint32_t u32x4 __attribute__((ext_vector_type(4)));
#define GLD16(dst, ptr) asm volatile("global_load_dwordx4 %0, %1, off" : "=&v"(dst) : "v"(ptr) : "memory")
#define WAIT_VM0() asm volatile("s_waitcnt vmcnt(0)" ::: "memory")
#define DI __device__ __forceinline__
#define MFMA(a, b, c) __builtin_amdgcn_mfma_f32_32x32x16_bf16((a), (b), (c), 0, 0, 0)

constexpr int Bn = 8, S = 2048, T = 16384, D = 1024, NP = 3200, ML = 256, TM = 2048;
constexpr float EPS = 1e-6f;
constexpr float LOG2E = 1.4426950408889634f;
constexpr int C_NQ = 0, C_KC = 256, C_VC = 320, C_KS = 384, C_VS = 448, C_KW = 512, C_VW = 576, C_NZ = 640,
              C_DQ = 896, C_DK = 1152, C_DV = 1408, C_DZ = 1664, C_CQ = 1920, C_CKV = 2176, C_KR = 2304,
              C_MZ = 2336, C_MQ = 2592, C_MEZ = 2848, C_GL = 3104;
constexpr size_t SZ_WI = (size_t)NP * 1024 * 2, SZ_WO = 1024 * 1024 * 2, SZ_WUQ = 384 * 256 * 2, SZ_WUKV = 512 * 128 * 2,
                 SZ_WMEM = 512 * 1024 * 2, SZ_WCMP = 128 * 2048 * 2;
constexpr size_t OFF_WI = 0;
constexpr size_t OFF_WO = OFF_WI + 2 * SZ_WI;
constexpr size_t OFF_WUQ = OFF_WO + 2 * SZ_WO;
constexpr size_t OFF_WUKV = OFF_WUQ + 2 * SZ_WUQ;
constexpr size_t OFF_WMEM = OFF_WUKV + 2 * SZ_WUKV;
constexpr size_t OFF_WCMP = OFF_WMEM + 2 * SZ_WMEM;
constexpr size_t OFF_CB = OFF_WCMP + 4 * SZ_WCMP;
constexpr size_t OFF_LAM = OFF_CB + 16384;
constexpr size_t OFF_CTR = OFF_LAM + 256;
constexpr size_t OFF_BAR = OFF_CTR + 1024;
constexpr size_t OFF_FLAG = OFF_BAR + 16384;
constexpr size_t OFF_PCNT = OFF_FLAG + 8192;
constexpr size_t OFF_ROPE = OFF_PCNT + 2048;
constexpr size_t OFF_SSQ = OFF_ROPE + 2048 * 32 * 8;
constexpr size_t OFF_RMEM = OFF_SSQ + (size_t)T * 8 * 4;
constexpr size_t OFF_MEMB = OFF_RMEM + 2048 * 4;
constexpr size_t OFF_XB = OFF_MEMB + (size_t)TM * 1024 * 2;
constexpr size_t OFF_U = OFF_XB + (size_t)T * 1024 * 2;
constexpr size_t OFF_R1 = OFF_U + (size_t)T * NP * 2;
constexpr size_t SLAB = (size_t)S * 1024 * 2;
constexpr size_t OFF_UQ = OFF_R1;
constexpr size_t OFF_UKV = OFF_R1 + (size_t)S * 384 * 2;
constexpr size_t OFF_Y = OFF_R1;
constexpr size_t OFF_QM = OFF_R1 + (size_t)T * 1024 * 2;
constexpr size_t OFF_KM = OFF_QM + (size_t)T * 384 * 2;
constexpr size_t OFF_MV = OFF_KM + (size_t)T * 384 * 2;
constexpr size_t OFF_KMEMRAW = OFF_MV + (size_t)T * 256 * 2;
constexpr size_t OFF_MK = OFF_KMEMRAW + (size_t)TM * 512 * 2;
constexpr size_t OFF_MVV = OFF_MK + (size_t)TM * 256 * 2;
constexpr size_t OFF_CMPRAW = OFF_MVV + (size_t)TM * 256 * 2;
constexpr size_t OFF_KCN = OFF_CMPRAW + 2 * 1024 * 128 * 2;
constexpr size_t OFF_VCN = OFF_KCN + 8 * 128 * 64 * 2;
constexpr size_t OFF_GT = OFF_VCN + 8 * 128 * 64 * 2;
constexpr size_t OFF_OCMP = OFF_GT + (size_t)T * 12 * 4;
constexpr size_t OFF_OWIN = OFF_OCMP + (size_t)T * 256 * 2;
constexpr size_t OFF_SEL = OFF_OWIN + (size_t)T * 256 * 2;
constexpr size_t WS_TOTAL = OFF_SEL + (size_t)T * 4;

constexpr int SMEM_BYTES = 73728;
constexpr int SM_VT = 2 * 64 * 104 * 2;
constexpr int SM_SC = SM_VT + 2 * 64 * 72 * 2;
constexpr int SM_MISC = SM_SC + 4 * 32 * 33 * 4;

struct Params {
  const float* in[19];
  float* out;
  char* ws;
};

DI int opq(int v) { asm volatile("" : "+v"(v)); return v; }
DI char* opqp(char* q) { size_t z = 0; asm volatile("" : "+s"(z)); return q + z; }
DI float bf2f(uint32_t v) { return __uint_as_float(v << 16); }
DI float bflo(uint32_t w) { return __uint_as_float(w << 16); }
DI float bfhi(uint32_t w) { return __uint_as_float(w & 0xffff0000u); }
DI uint32_t pack2(float a, float b) { hf2 f = {a, b}; hbf2 r = __builtin_convertvector(f, hbf2); return __builtin_bit_cast(uint32_t, r); }
DI bf16 f2bf(float a) { return (bf16)(pack2(a, 0.f) & 0xffffu); }
DI float fexp2(float x) { return __builtin_amdgcn_exp2f(x); }
DI float sigmoidf_(float x) { return __builtin_amdgcn_rcpf(1.f + fexp2(-LOG2E * x)); }
DI float siluf_(float x) { return x * __builtin_amdgcn_rcpf(1.f + fexp2(-LOG2E * x)); }
DI float shx(float v, int m) { return __shfl_xor(v, m); }
DI float dppf(float v, int ctrl_sel) {
  int x = __builtin_bit_cast(int, v), r;
  if (ctrl_sel == 0) r = __builtin_amdgcn_mov_dpp(x, 0xB1, 0xF, 0xF, true);
  else if (ctrl_sel == 1) r = __builtin_amdgcn_mov_dpp(x, 0x4E, 0xF, 0xF, true);
  else if (ctrl_sel == 2) r = __builtin_amdgcn_mov_dpp(x, 0x141, 0xF, 0xF, true);
  else r = __builtin_amdgcn_mov_dpp(x, 0x140, 0xF, 0xF, true);
  return __builtin_bit_cast(float, r);
}
DI float sum8(float v) { v += dppf(v, 0); v += dppf(v, 1); v += dppf(v, 2); return v; }
DI float sum16(float v) { v = sum8(v); v += dppf(v, 3); return v; }
DI float sum64(float v) { v = sum16(v); v += shx(v, 16); v += shx(v, 32); return v; }


#define XB_TMO      128
#define XB_XCNT(j)  (256  + 64 * (j))
#define XB_XSUB(j)  (1280 + 64 * (j))
#define XB_XGEN(j)  (2304 + 64 * (j))
#define XB_TOP      3328
#define XB_TOPGEN   3392
#define XB_SPIN_CAP (1u << 22)
#define LAS __attribute__((address_space(3)))
DI unsigned xb_ld(unsigned* p) { return __hip_atomic_load(p, __ATOMIC_RELAXED, __HIP_MEMORY_SCOPE_AGENT); }
DI unsigned xb_add(unsigned* p, unsigned v) { return __hip_atomic_fetch_add(p, v, __ATOMIC_RELAXED, __HIP_MEMORY_SCOPE_AGENT); }
DI unsigned xb_xcc_id() { return (unsigned)__builtin_amdgcn_readfirstlane((int)(__builtin_amdgcn_s_getreg((3 << 11) | 20) & 0xFu)); }
#define XB_SPIN(cond, bar) do { unsigned _sp = 0; while (cond) { __builtin_amdgcn_s_sleep(1); \
    if ((++_sp & 255u) == 0u) { if (xb_ld(&(bar)[XB_TMO])) break; if (_sp > XB_SPIN_CAP) { atomicAdd(&(bar)[XB_TMO], 1u); break; } } } } while (0)
struct XcdBarrier { unsigned* bar; unsigned x; volatile LAS unsigned* st; };
DI XcdBarrier xcd_barrier_post(unsigned* bar, volatile LAS unsigned* st) {
  XcdBarrier b; b.bar = bar; b.x = xb_xcc_id(); b.st = st;
  if (threadIdx.x == 0) (void)xb_add(&bar[XB_XCNT(b.x)], 1u);
  return b;
}
DI void xcd_barrier_complete(unsigned* bar, unsigned x, unsigned& nloc, unsigned& nx) {
  const unsigned G = gridDim.x * gridDim.y * gridDim.z;
  unsigned sum, cnt, mine, sp = 0u;
  for (;;) {
    sum = 0u; cnt = 0u; mine = 0u;
#pragma unroll
    for (unsigned j = 0; j < 16; ++j) { const unsigned c = xb_ld(&bar[XB_XCNT(j)]); sum += c; cnt += (c > 0u) ? 1u : 0u; mine = (j == x) ? c : mine; }
    if (sum == G) break;
    __builtin_amdgcn_s_sleep(1);
    if ((++sp & 255u) == 0u) { if (xb_ld(&bar[XB_TMO])) break; if (sp > XB_SPIN_CAP) { atomicAdd(&bar[XB_TMO], 1u); break; } }
  }
  nloc = mine > 0u ? mine : 1u; nx = cnt > 0u ? cnt : 1u;
}
DI void xcd_barrier(const XcdBarrier& b) {
  asm volatile("s_waitcnt vmcnt(0)" ::: "memory");
  __syncthreads();
  if (threadIdx.x == 0) {
    unsigned* bar = b.bar;
    const unsigned bx = xb_xcc_id();
    __builtin_amdgcn_s_waitcnt(0);
    unsigned nloc = b.st[0], nx = b.st[1];
    if (nloc == 0u) { xcd_barrier_complete(bar, bx, nloc, nx); b.st[0] = nloc; b.st[1] = nx; }
    const unsigned old = xb_add(&bar[XB_XSUB(bx)], 1u);
    const unsigned gen = old / nloc;
    if (old + 1u == (gen + 1u) * nloc) {
      __builtin_amdgcn_fence(__ATOMIC_RELEASE, "agent");
      asm volatile("s_waitcnt vmcnt(0)" ::: "memory");
      const unsigned og = xb_add(&bar[XB_TOP], 1u);
      const unsigned tg = og / nx;
      if (og + 1u == (tg + 1u) * nx) xb_add(&bar[XB_TOPGEN], 1u);
      else XB_SPIN(xb_ld(&bar[XB_TOPGEN]) == tg, bar);
      __builtin_amdgcn_fence(__ATOMIC_ACQUIRE, "agent");
      xb_add(&bar[XB_XGEN(bx)], 1u);
      asm volatile("s_waitcnt vmcnt(0)" ::: "memory");
    } else {
      XB_SPIN(xb_ld(&bar[XB_XGEN(bx)]) == gen, bar);
      __builtin_amdgcn_fence(__ATOMIC_ACQUIRE, "agent");
      asm volatile("s_waitcnt vmcnt(0)" ::: "memory");
    }
  }
  __syncthreads();
}

DI void part_barrier(unsigned* cnt, unsigned target) {
  asm volatile("s_waitcnt vmcnt(0)" ::: "memory");
  __syncthreads();
  if (threadIdx.x == 0) {
    __builtin_amdgcn_s_waitcnt(0);
    __builtin_amdgcn_fence(__ATOMIC_RELEASE, "agent");
    asm volatile("s_waitcnt vmcnt(0)" ::: "memory");
    xb_add(cnt, 1u);
    unsigned sp = 0;
    while (xb_ld(cnt) < target) { __builtin_amdgcn_s_sleep(1); if (++sp > (1u << 24)) break; }
    __builtin_amdgcn_fence(__ATOMIC_ACQUIRE, "agent");
    asm volatile("s_waitcnt vmcnt(0)" ::: "memory");
  }
  __syncthreads();
}

DI void wg_publish(unsigned* flag) {
  asm volatile("s_waitcnt vmcnt(0)" ::: "memory");
  __syncthreads();
  if (threadIdx.x == 0) {
    __builtin_amdgcn_fence(__ATOMIC_RELEASE, "agent");
    asm volatile("s_waitcnt vmcnt(0)" ::: "memory");
    xb_add(flag, 1u);
  }
}
DI void wg_wait2(unsigned* f0, unsigned* f1) {
  if (threadIdx.x == 0) {
    unsigned sp = 0;
    while (xb_ld(f0) < 1u || xb_ld(f1) < 1u) { __builtin_amdgcn_s_sleep(2); if (++sp > (1u << 22)) break; }
    __builtin_amdgcn_fence(__ATOMIC_ACQUIRE, "agent");
    asm volatile("s_waitcnt vmcnt(0)" ::: "memory");
  }
  __syncthreads();
}

DI int win_orig(int n) { return n < 640 ? n : (n < 3104 ? n + 12 : (n < 3116 ? n - 3104 + 640 : -1)); }

DI void convT_tile(const float* __restrict__ src, int Nsrc, const float* __restrict__ gain, bf16* __restrict__ dst, int K,
                   int k0, int n0, int mapmode, float* tile) {
  const int tid = opq(threadIdx.x);
  {
    const int nn = tid & 63, kk = tid >> 6;
    const int n = n0 + nn;
    const int on = mapmode == 1 ? win_orig(n) : (n < Nsrc ? n : -1);
    float v[16];
#pragma unroll
    for (int it = 0; it < 16; ++it) {
      const int k = k0 + kk + 4 * it;
      v[it] = 0.f;
      if (on >= 0) v[it] = src[(size_t)k * Nsrc + on];
    }
    if (gain) {
#pragma unroll
      for (int it = 0; it < 16; ++it) v[it] *= gain[k0 + kk + 4 * it];
    }
#pragma unroll
    for (int it = 0; it < 16; ++it) tile[(kk + 4 * it) * 65 + nn] = v[it];
  }
  __syncthreads();
  {
    const int k8 = (tid & 7) * 8, nb = tid >> 3;
#pragma unroll
    for (int it = 0; it < 2; ++it) {
      const int n = nb + 32 * it;
      uint4 o;
      o.x = pack2(tile[(k8 + 0) * 65 + n], tile[(k8 + 1) * 65 + n]);
      o.y = pack2(tile[(k8 + 2) * 65 + n], tile[(k8 + 3) * 65 + n]);
      o.z = pack2(tile[(k8 + 4) * 65 + n], tile[(k8 + 5) * 65 + n]);
      o.w = pack2(tile[(k8 + 6) * 65 + n], tile[(k8 + 7) * 65 + n]);
      *(uint4*)(dst + (size_t)(n0 + n) * K + k0 + k8) = o;
    }
  }
  __syncthreads();
}

DI void phase0(const Params& p, char* smem) {
  const int tid = opq(threadIdx.x), lane = tid & 63, wv = tid >> 6;
  float* tile = (float*)smem;
  char* ws = opqp(p.ws);
  constexpr int N_WI = 2 * 50 * 16, N_WO = 2 * 16 * 16, N_WUQ = 2 * 6 * 4, N_WUKV = 2 * 8 * 2, N_WMEM = 2 * 8 * 16,
                N_WCMP = 4 * 2 * 32, N_X = T / 4, N_MEM = TM / 4, N_ROPE = 256, N_CB = 64, N_LAM = 1;
  constexpr int E0 = N_WI, E1 = E0 + N_WO, E2 = E1 + N_WUQ, E3 = E2 + N_WUKV, E4 = E3 + N_WMEM, E5 = E4 + N_WCMP,
                E6 = E5 + N_X, E7 = E6 + N_MEM, E8 = E7 + N_ROPE, E9 = E8 + N_CB, E10 = E9 + N_LAM;
  for (int it = blockIdx.x; it < E10; it += gridDim.x) {
    if (it < E0) {
      int l = it / 800, r = it % 800, nt = r / 16, kt = r % 16;
      convT_tile(p.in[3] + (size_t)l * 1024 * 3116, 3116, p.in[2] + l * 1024, (bf16*)(ws + OFF_WI + l * SZ_WI), 1024, kt * 64, nt * 64, 1, tile);
    } else if (it < E1) {
      int i = it - E0; int l = i / 256, r = i % 256, nt = r / 16, kt = r % 16;
      convT_tile(p.in[4] + (size_t)l * 1024 * 1024, 1024, nullptr, (bf16*)(ws + OFF_WO + l * SZ_WO), 1024, kt * 64, nt * 64, 0, tile);
    } else if (it < E2) {
      int i = it - E1; int l = i / 24, r = i % 24, nt = r / 4, kt = r % 4;
      convT_tile(p.in[13] + (size_t)l * 256 * 384, 384, p.in[11] + l * 256, (bf16*)(ws + OFF_WUQ + l * SZ_WUQ), 256, kt * 64, nt * 64, 0, tile);
    } else if (it < E3) {
      int i = it - E2; int l = i / 16, r = i % 16, nt = r / 2, kt = r % 2;
      convT_tile(p.in[14] + (size_t)l * 128 * 512, 512, p.in[12] + l * 128, (bf16*)(ws + OFF_WUKV + l * SZ_WUKV), 128, kt * 64, nt * 64, 0, tile);
    } else if (it < E4) {
      int i = it - E3; int l = i / 128, r = i % 128, nt = r / 16, kt = r % 16;
      convT_tile(p.in[17] + (size_t)l * 1024 * 512, 512, p.in[16] + l * 1024, (bf16*)(ws + OFF_WMEM + l * SZ_WMEM), 1024, kt * 64, nt * 64, 0, tile);
    } else if (it < E5) {
      int i = it - E4; int lj = i / 64, r = i % 64, nt = r / 32, kt = r % 32;
      convT_tile(p.in[7] + (size_t)lj * 2048 * 64, 64, nullptr, (bf16*)(ws + OFF_WCMP + lj * SZ_WCMP), 2048, kt * 64, nt * 64, 0, tile);
    } else if (it < E6) {
      int row = (it - E5) * 4 + wv;
      const float4* xr = (const float4*)(p.in[0] + (size_t)row * 1024);
      bf16* xb = (bf16*)(ws + OFF_XB) + (size_t)row * 1024;
      float ss = 0.f;
#pragma unroll
      for (int i = 0; i < 4; ++i) {
        float4 v = xr[lane + 64 * i];
        ss += v.x * v.x + v.y * v.y + v.z * v.z + v.w * v.w;
        uint2 o; o.x = pack2(v.x, v.y); o.y = pack2(v.z, v.w);
        *(uint2*)(xb + (lane + 64 * i) * 4) = o;
      }
      ss = sum64(ss);
      float* sq = (float*)(ws + OFF_SSQ) + (size_t)row * 8;
      if (lane < 8) sq[lane] = lane == 0 ? ss : 0.f;
    } else if (it < E7) {
      int row = (it - E6) * 4 + wv;
      const float4* xr = (const float4*)(p.in[1] + (size_t)row * 1024);
      bf16* xb = (bf16*)(ws + OFF_MEMB) + (size_t)row * 1024;
      float ss = 0.f;
#pragma unroll
      for (int i = 0; i < 4; ++i) {
        float4 v = xr[lane + 64 * i];
        ss += v.x * v.x + v.y * v.y + v.z * v.z + v.w * v.w;
        uint2 o; o.x = pack2(v.x, v.y); o.y = pack2(v.z, v.w);
        *(uint2*)(xb + (lane + 64 * i) * 4) = o;
      }
      ss = sum64(ss);
      if (lane == 0) ((float*)(ws + OFF_RMEM))[row] = rsqrtf(ss * (1.f / 1024.f) + EPS);
    } else if (it < E8) {
      int e = (it - E7) * 256 + tid;
      int pos = e >> 5, i = e & 31;
      float inv = powf(10000.f, -(float)i / 32.f);
      float ang = (float)pos * inv;
      double a = (double)ang;
      double n = rint(a * 0.15915494309189535);
      float r = (float)(a - n * 6.283185307179586);
      float2 cs; cs.x = __cosf(r); cs.y = __sinf(r);
      ((float2*)(ws + OFF_ROPE))[e] = cs;
    } else if (it < E9) {
      int lj = (it - E8) >> 4, sl = (it - E8) & 15;
      const float* pe = p.in[6] + (size_t)lj * 2048;
      const float* w = p.in[7] + (size_t)lj * 2048 * 64;
      int n = tid & 63, part = tid >> 6;
      float acc = 0.f;
      const int kb0 = sl * 128 + part * 32;
#pragma unroll 8
      for (int k = kb0; k < kb0 + 32; ++k) acc += pe[k] * w[(size_t)k * 64 + n];
      tile[tid] = acc;
      __syncthreads();
      if (tid < 64) ((float*)(ws + OFF_CB))[((it - E8)) * 64 + tid] = tile[tid] + tile[tid + 64] + tile[tid + 128] + tile[tid + 192];
      __syncthreads();
    } else {
      if (tid < 2) {
        const float* lf = p.in[9] + tid * 128;
        float s1 = 0.f, s2 = 0.f;
        for (int i = 0; i < 32; ++i) { s1 += lf[i] * lf[32 + i]; s2 += lf[64 + i] * lf[96 + i]; }
        float li = 0.8f - 0.6f * expf(-0.3f * (float)tid);
        ((float*)(ws + OFF_LAM))[tid] = expf(s1) - expf(s2) + li;
      }
    }
  }
}

template <int CH>
DI void gemm_tile(const bf16* __restrict__ Ab, long lda, long kcs, const bf16* __restrict__ Bb, long ldb, int nk, char* smem) {
  const int tid = opq(threadIdx.x), lane = tid & 63, wv = tid >> 6, half = lane >> 5, l31 = lane & 31;
  const int wm = wv >> 1, wn = wv & 1;
  bf16* As = (bf16*)smem;
  bf16* Bs = (bf16*)(smem + 36864);
  const int lrow = tid >> 3, lcol = (tid & 7) * 8;
  const bf16* ag = Ab + (long)lrow * lda + lcol;
  const bf16* bg = Bb + (long)lrow * ldb + lcol;
  f32x16 acc[2][2];
#pragma unroll
  for (int a = 0; a < 2; ++a)
#pragma unroll
    for (int b = 0; b < 2; ++b)
#pragma unroll
      for (int i = 0; i < 16; ++i) acc[a][b][i] = 0.f;
#define GCOMPUTE(BUF) do { \
    const bf16* as_ = As + (BUF) * 128 * 72 + (wm * 64 + l31) * 72 + half * 8; \
    const bf16* bs_ = Bs + (BUF) * 128 * 72 + (wn * 64 + l31) * 72 + half * 8; \
    bf16x8 fa[2][2], fb[2][2]; \
    fa[0][0] = *(const bf16x8*)(as_); fa[0][1] = *(const bf16x8*)(as_ + 32 * 72); \
    fb[0][0] = *(const bf16x8*)(bs_); fb[0][1] = *(const bf16x8*)(bs_ + 32 * 72); \
    _Pragma("unroll") for (int kc = 0; kc < 4; ++kc) { \
      if (kc < 3) { \
        fa[(kc + 1) & 1][0] = *(const bf16x8*)(as_ + (kc + 1) * 16); fa[(kc + 1) & 1][1] = *(const bf16x8*)(as_ + 32 * 72 + (kc + 1) * 16); \
        fb[(kc + 1) & 1][0] = *(const bf16x8*)(bs_ + (kc + 1) * 16); fb[(kc + 1) & 1][1] = *(const bf16x8*)(bs_ + 32 * 72 + (kc + 1) * 16); \
      } \
      _Pragma("unroll") for (int ni = 0; ni < 2; ++ni) \
        _Pragma("unroll") for (int mi = 0; mi < 2; ++mi) acc[ni][mi] = MFMA(fb[kc & 1][ni], fa[kc & 1][mi], acc[ni][mi]); \
    } } while (0)
  for (int c0 = 0; c0 < nk; c0 += CH) {
    u32x4 rs[2][8];
    const bf16* agc = ag + (long)c0 * kcs;
    const bf16* bgc = bg + (long)c0 * 64;
#pragma unroll
    for (int i = 0; i < 4; ++i) {
      rs[0][i] = *(const u32x4*)(agc + (long)(32 * i) * lda);
      rs[0][4 + i] = *(const u32x4*)(bgc + (long)(32 * i) * ldb);
    }
#pragma unroll
    for (int i = 0; i < 4; ++i) {
      *(u32x4*)(As + (lrow + 32 * i) * 72 + lcol) = rs[0][i];
      *(u32x4*)(Bs + (lrow + 32 * i) * 72 + lcol) = rs[0][4 + i];
    }
    if (CH > 1) {
#pragma unroll
      for (int i = 0; i < 4; ++i) {
        GLD16(rs[1][i], agc + (long)(32 * i) * lda + kcs);
        GLD16(rs[1][4 + i], bgc + (long)(32 * i) * ldb + 64);
      }
    }
    __syncthreads();
#pragma unroll
    for (int t = 0; t < CH; ++t) {
      const int bufc = t & 1;
      if (t + 2 < CH) {
#pragma unroll
        for (int i = 0; i < 4; ++i) {
          GLD16(rs[t & 1][i], agc + (long)(32 * i) * lda + (long)(t + 2) * kcs);
          GLD16(rs[t & 1][4 + i], bgc + (long)(32 * i) * ldb + (long)(t + 2) * 64);
        }
      }
      GCOMPUTE(bufc);
      if (t + 1 < CH) {
        u32x4(&rr)[8] = rs[(t + 1) & 1];
        if (t + 2 < CH) asm volatile("s_waitcnt vmcnt(8)" : "+v"(rr[0]), "+v"(rr[1]), "+v"(rr[2]), "+v"(rr[3]), "+v"(rr[4]), "+v"(rr[5]), "+v"(rr[6]), "+v"(rr[7]) :: "memory");
        else asm volatile("s_waitcnt vmcnt(0)" : "+v"(rr[0]), "+v"(rr[1]), "+v"(rr[2]), "+v"(rr[3]), "+v"(rr[4]), "+v"(rr[5]), "+v"(rr[6]), "+v"(rr[7]) :: "memory");
        bf16* ad = As + (bufc ^ 1) * 128 * 72; bf16* bd = Bs + (bufc ^ 1) * 128 * 72;
#pragma unroll
        for (int i = 0; i < 4; ++i) {
          *(u32x4*)(ad + (lrow + 32 * i) * 72 + lcol) = rr[i];
          *(u32x4*)(bd + (lrow + 32 * i) * 72 + lcol) = rr[4 + i];
        }
      }
      __syncthreads();
    }
  }
#undef GCOMPUTE
  float* Cs = (float*)smem;
#pragma unroll
  for (int ni = 0; ni < 2; ++ni)
#pragma unroll
    for (int mi = 0; mi < 2; ++mi)
#pragma unroll
      for (int g = 0; g < 4; ++g) {
        float4 v; v.x = acc[ni][mi][4 * g]; v.y = acc[ni][mi][4 * g + 1]; v.z = acc[ni][mi][4 * g + 2]; v.w = acc[ni][mi][4 * g + 3];
        *(float4*)(Cs + (wm * 64 + mi * 32 + l31) * 132 + wn * 64 + ni * 32 + 8 * g + 4 * half) = v;
      }
  __syncthreads();
}

enum { EPI_PLAIN = 0, EPI_RS8 = 1, EPI_RS1 = 2, EPI_OUT = 3 };
DI void gemm_epi(int mode, char* smem, bf16* __restrict__ Cb, long ldc, int row0, const float* __restrict__ rs,
                 const float* __restrict__ xres, float* __restrict__ xout, bf16* __restrict__ xbout, float* __restrict__ ssqout, int ntile) {
  const float* Cs = (const float*)smem;
  const int tid = opq(threadIdx.x);
#pragma unroll 2
  for (int it = 0; it < 8; ++it) {
    const int idx = it * 256 + tid;
    const int r = idx >> 4, ch = idx & 15;
    float4 v0 = *(const float4*)(Cs + r * 132 + ch * 8);
    float4 v1 = *(const float4*)(Cs + r * 132 + ch * 8 + 4);
    const long grow = row0 + r;
    if (mode == EPI_OUT) {
      if (xres) {
        const float4* xr = (const float4*)(xres + grow * 1024 + ntile * 128 + ch * 8);
        float4 x0 = xr[0], x1 = xr[1];
        v0.x += x0.x; v0.y += x0.y; v0.z += x0.z; v0.w += x0.w;
        v1.x += x1.x; v1.y += x1.y; v1.z += x1.z; v1.w += x1.w;
      } else {
        const uint4 xw = *(const uint4*)(Cb + grow * 1024 + ntile * 128 + ch * 8);
        v0.x += bflo(xw.x); v0.y += bfhi(xw.x); v0.z += bflo(xw.y); v0.w += bfhi(xw.y);
        v1.x += bflo(xw.z); v1.y += bfhi(xw.z); v1.z += bflo(xw.w); v1.w += bfhi(xw.w);
      }
      if (xout) {
        float4* xo = (float4*)(xout + grow * 1024 + ntile * 128 + ch * 8);
        xo[0] = v0; xo[1] = v1;
      }
      if (xbout) {
        float ss = v0.x * v0.x + v0.y * v0.y + v0.z * v0.z + v0.w * v0.w + v1.x * v1.x + v1.y * v1.y + v1.z * v1.z + v1.w * v1.w;
        ss = sum16(ss);
        if (ch == 0) ssqout[grow * 8 + ntile] = ss;
        uint4 o; o.x = pack2(v0.x, v0.y); o.y = pack2(v0.z, v0.w); o.z = pack2(v1.x, v1.y); o.w = pack2(v1.z, v1.w);
        *(uint4*)(xbout + grow * 1024 + ntile * 128 + ch * 8) = o;
      }
    } else {
      float sc = 1.f;
      if (mode == EPI_RS8) {
        const float4* q = (const float4*)(rs + grow * 8);
        float4 a = q[0], b = q[1];
        sc = rsqrtf((a.x + a.y + a.z + a.w + b.x + b.y + b.z + b.w) * (1.f / 1024.f) + EPS);
      } else if (mode == EPI_RS1) sc = rs[grow];
      uint4 o; o.x = pack2(v0.x * sc, v0.y * sc); o.y = pack2(v0.z * sc, v0.w * sc); o.z = pack2(v1.x * sc, v1.y * sc); o.w = pack2(v1.z * sc, v1.w * sc);
      *(uint4*)(Cb + grow * ldc + ntile * 128 + ch * 8) = o;
    }
  }
  __syncthreads();
}

DI void gemm_big(const bf16* __restrict__ Ab, long lda, const bf16* __restrict__ Bb, long ldb, int nk, char* smem, int mode,
                 bf16* __restrict__ Cb, long ldc, int row0, const float* __restrict__ rs, const float* __restrict__ xres,
                 float* __restrict__ xout, bf16* __restrict__ xbout, float* __restrict__ ssqout, int ntile) {
  const int tid = opq(threadIdx.x), lane = tid & 63, wv = tid >> 6, half = lane >> 5, l31 = lane & 31;
  const int wm = wv >> 1, wn = wv & 1;
  bf16* As = (bf16*)smem;
  bf16* Bs = (bf16*)(smem + 36864);
  const int lrow = tid >> 3, lcol = (tid & 7) * 8;
  const bf16* ag = Ab + (long)lrow * lda + lcol;
  const bf16* bg = Bb + (long)lrow * ldb + lcol;
  u32x4 ra[8], rb[4];
  f32x16 acc[2][4];
#pragma unroll
  for (int a = 0; a < 2; ++a)
#pragma unroll
    for (int b = 0; b < 4; ++b)
#pragma unroll
      for (int i = 0; i < 16; ++i) acc[a][b][i] = 0.f;
#pragma unroll
  for (int i = 0; i < 8; ++i) ra[i] = *(const u32x4*)(ag + (long)(32 * i) * lda);
#pragma unroll
  for (int i = 0; i < 4; ++i) rb[i] = *(const u32x4*)(bg + (long)(32 * i) * ldb);
#pragma unroll
  for (int i = 0; i < 8; ++i) *(u32x4*)(As + (lrow + 32 * i) * 72 + lcol) = ra[i];
#pragma unroll
  for (int i = 0; i < 4; ++i) *(u32x4*)(Bs + (lrow + 32 * i) * 72 + lcol) = rb[i];
  __syncthreads();
  for (int ks = 0; ks < nk; ++ks) {
    const bool more = ks + 1 < nk;
    if (more) {
#pragma unroll
      for (int i = 0; i < 8; ++i) GLD16(ra[i], ag + (long)(32 * i) * lda + (long)(ks + 1) * 64);
#pragma unroll
      for (int i = 0; i < 4; ++i) GLD16(rb[i], bg + (long)(32 * i) * ldb + (long)(ks + 1) * 64);
    }
    const bf16* as_ = As + (wm * 128 + l31) * 72 + half * 8;
    const bf16* bs_ = Bs + (wn * 64 + l31) * 72 + half * 8;
#pragma unroll
    for (int kc = 0; kc < 4; ++kc) {
      bf16x8 fa[4], fb[2];
#pragma unroll
      for (int mi = 0; mi < 4; ++mi) fa[mi] = *(const bf16x8*)(as_ + mi * 32 * 72 + kc * 16);
#pragma unroll
      for (int ni = 0; ni < 2; ++ni) fb[ni] = *(const bf16x8*)(bs_ + ni * 32 * 72 + kc * 16);
#pragma unroll
      for (int ni = 0; ni < 2; ++ni)
#pragma unroll
        for (int mi = 0; mi < 4; ++mi) acc[ni][mi] = MFMA(fb[ni], fa[mi], acc[ni][mi]);
    }
    __syncthreads();
    if (more) {
      asm volatile("s_waitcnt vmcnt(0)" : "+v"(ra[0]), "+v"(ra[1]), "+v"(ra[2]), "+v"(ra[3]), "+v"(ra[4]), "+v"(ra[5]), "+v"(ra[6]), "+v"(ra[7]),
                   "+v"(rb[0]), "+v"(rb[1]), "+v"(rb[2]), "+v"(rb[3]) :: "memory");
#pragma unroll
      for (int i = 0; i < 8; ++i) *(u32x4*)(As + (lrow + 32 * i) * 72 + lcol) = ra[i];
#pragma unroll
      for (int i = 0; i < 4; ++i) *(u32x4*)(Bs + (lrow + 32 * i) * 72 + lcol) = rb[i];
      __syncthreads();
    }
  }
  float* Cs = (float*)smem;
#pragma unroll
  for (int h = 0; h < 2; ++h) {
    if (wm == h) {
#pragma unroll
      for (int ni = 0; ni < 2; ++ni)
#pragma unroll
        for (int mi = 0; mi < 4; ++mi)
#pragma unroll
          for (int g = 0; g < 4; ++g) {
            float4 v; v.x = acc[ni][mi][4 * g]; v.y = acc[ni][mi][4 * g + 1]; v.z = acc[ni][mi][4 * g + 2]; v.w = acc[ni][mi][4 * g + 3];
            *(float4*)(Cs + (mi * 32 + l31) * 132 + wn * 64 + ni * 32 + 8 * g + 4 * half) = v;
          }
    }
    __syncthreads();
    gemm_epi(mode, smem, Cb, ldc, row0 + h * 128, rs, xres, xout, xbout, ssqout, ntile);
  }
}

enum { AM_NONE = 0, AM_CAUSAL = 1, AM_WIN = 2, AM_CMP = 3, AM_SLC = 4 };

template <int DK>
DI void attn_core(const bf16* __restrict__ Kp, long kstride, const bf16* __restrict__ Vp, long vstride, uint32_t tilemask,
                  int mode, int qpos, uint32_t sel, const bf16x8 (&Qf)[DK / 16], f32x16 (&O)[2], float& m_out, float& l_out, char* smem) {
  constexpr int KST = DK + 8;
  constexpr int CPR = DK / 8;
  constexpr int NCH = CPR / 4;
  bf16* Ks = (bf16*)smem;
  bf16* VTs = (bf16*)(smem + SM_VT);
  const int tid = opq(threadIdx.x), lane = tid & 63, half = lane >> 5, l31 = lane & 31;
#pragma unroll
  for (int i = 0; i < 16; ++i) { O[0][i] = 0.f; O[1][i] = 0.f; }
  float l = 0.f;
  const int qw0 = __builtin_amdgcn_readfirstlane(qpos - l31);
  const bool causal_like = (mode == AM_CAUSAL || mode == AM_WIN || mode == AM_SLC);
  int klo = 0, khi = 0x7fffffff;
  if (mode == AM_CAUSAL || mode == AM_SLC) khi = qpos;
  else if (mode == AM_WIN) { khi = qpos; klo = qpos - 511; }
  else if (mode == AM_CMP) khi = (qpos - 31) >> 4;
  u32x4 rk0, rk1, rk2, rv0, rv1;
  rk0 = rk1 = rk2 = (u32x4){0u, 0u, 0u, 0u};
  const int vkp = tid & 31, vcc = tid >> 5;
  const int vcol = (vkp >> 3) * 16 + (((vkp & 1) | ((vkp & 2) << 1) | ((vkp & 4) >> 1)) * 2);
  const int c0 = tid, c1 = tid + 256, c2_ = tid + 512;
  const int kr0 = c0 / CPR, kc0 = (c0 % CPR) * 8, kr1 = c1 / CPR, kc1 = (c1 % CPR) * 8, kr2 = c2_ / CPR, kc2 = (c2_ % CPR) * 8;
#define GLOAD(KT) do { \
    GLD16(rk0, Kp + (long)((KT) * 64 + kr0) * kstride + kc0); \
    if constexpr (NCH > 1) GLD16(rk1, Kp + (long)((KT) * 64 + kr1) * kstride + kc1); \
    if constexpr (NCH > 2) GLD16(rk2, Kp + (long)((KT) * 64 + kr2) * kstride + kc2); \
    GLD16(rv0, Vp + (long)((KT) * 64 + 2 * vkp) * vstride + vcc * 8); \
    GLD16(rv1, Vp + (long)((KT) * 64 + 2 * vkp + 1) * vstride + vcc * 8); } while (0)
#define LSTORE(BUF) do { asm volatile("s_waitcnt vmcnt(0)" : "+v"(rk0), "+v"(rk1), "+v"(rk2), "+v"(rv0), "+v"(rv1) :: "memory"); \
    *(u32x4*)(Ks + ((BUF) * 64 + kr0) * KST + kc0) = rk0; \
    if constexpr (NCH > 1) *(u32x4*)(Ks + ((BUF) * 64 + kr1) * KST + kc1) = rk1; \
    if constexpr (NCH > 2) *(u32x4*)(Ks + ((BUF) * 64 + kr2) * KST + kc2) = rk2; \
    bf16* vd = VTs + ((BUF) * 64 + vcc * 8) * 72 + vcol; \
    *(uint32_t*)(vd + 0 * 72) = (rv0.x & 0xffffu) | (rv1.x << 16); \
    *(uint32_t*)(vd + 1 * 72) = (rv0.x >> 16) | (rv1.x & 0xffff0000u); \
    *(uint32_t*)(vd + 2 * 72) = (rv0.y & 0xffffu) | (rv1.y << 16); \
    *(uint32_t*)(vd + 3 * 72) = (rv0.y >> 16) | (rv1.y & 0xffff0000u); \
    *(uint32_t*)(vd + 4 * 72) = (rv0.z & 0xffffu) | (rv1.z << 16); \
    *(uint32_t*)(vd + 5 * 72) = (rv0.z >> 16) | (rv1.z & 0xffff0000u); \
    *(uint32_t*)(vd + 6 * 72) = (rv0.w & 0xffffu) | (rv1.w << 16); \
    *(uint32_t*)(vd + 7 * 72) = (rv0.w >> 16) | (rv1.w & 0xffff0000u); } while (0)
  uint32_t rem = tilemask;
  int kt = __ffs(rem) - 1; rem &= rem - 1;
  GLOAD(kt);
#pragma unroll
  for (int kc = 0; kc < DK / 16; ++kc) asm volatile("" ::"v"(Qf[kc]));
  __syncthreads();
  LSTORE(0);
  __syncthreads();
  int buf = 0;
  while (true) {
    int ktn = -1;
    if (rem) { ktn = __ffs(rem) - 1; rem &= rem - 1; GLOAD(ktn); }
    const bool wave_active = !(causal_like && kt * 64 > qw0 + 31);
    if (wave_active) {
    f32x16 Sx[2];
#pragma unroll
    for (int kb = 0; kb < 2; ++kb) {
      bf16x8 Kf[DK / 16];
#pragma unroll
      for (int kc = 0; kc < DK / 16; ++kc) Kf[kc] = *(const bf16x8*)(Ks + (buf * 64 + kb * 32 + l31) * KST + kc * 16 + half * 8);
      __builtin_amdgcn_sched_barrier(0);
#pragma unroll
      for (int i = 0; i < 16; ++i) Sx[kb][i] = 0.f;
#pragma unroll
      for (int kc = 0; kc < DK / 16; ++kc) Sx[kb] = MFMA(Kf[kc], Qf[kc], Sx[kb]);
    }
    bf16x8 Vf[2][2][2];
#pragma unroll
    for (int kb = 0; kb < 2; ++kb)
#pragma unroll
      for (int c2 = 0; c2 < 2; ++c2)
#pragma unroll
        for (int dvb = 0; dvb < 2; ++dvb)
          Vf[kb][c2][dvb] = *(const bf16x8*)(VTs + (buf * 64 + dvb * 32 + l31) * 72 + (kb * 2 + c2) * 16 + half * 8);
    __builtin_amdgcn_sched_barrier(0);
    bool need_mask = false;
    if (mode == AM_CAUSAL) need_mask = kt * 64 + 63 > qw0;
    else if (mode == AM_WIN) need_mask = (kt * 64 + 63 > qw0) || (kt * 64 < qw0 + 31 - 511);
    else if (mode == AM_CMP) need_mask = true;
    else if (mode == AM_SLC) need_mask = (kt * 64 + 63 > qw0) || (__ballot(!((sel >> kt) & 1u)) != 0ull);
    int khe = khi;
    if (mode == AM_SLC && !((sel >> kt) & 1u)) khe = -1;
    const int kbase = kt * 64 + half * 4;
#pragma unroll
    for (int kb = 0; kb < 2; ++kb) {
      if (need_mask) {
#pragma unroll
        for (int i = 0; i < 16; ++i) {
          const int key = kbase + kb * 32 + (i >> 2) * 8 + (i & 3);
          Sx[kb][i] = (key >= klo && key <= khe) ? Sx[kb][i] : -1e30f;
        }
      }
      float ps = 0.f;
#pragma unroll
      for (int i = 0; i < 16; ++i) { float pv = fexp2(Sx[kb][i]); Sx[kb][i] = pv; ps += pv; }
      l += ps;
#pragma unroll
      for (int c2 = 0; c2 < 2; ++c2) {
        uint4 pw;
        pw.x = pack2(Sx[kb][8 * c2 + 0], Sx[kb][8 * c2 + 1]); pw.y = pack2(Sx[kb][8 * c2 + 2], Sx[kb][8 * c2 + 3]);
        pw.z = pack2(Sx[kb][8 * c2 + 4], Sx[kb][8 * c2 + 5]); pw.w = pack2(Sx[kb][8 * c2 + 6], Sx[kb][8 * c2 + 7]);
        const bf16x8 pf = __builtin_bit_cast(bf16x8, pw);
#pragma unroll
        for (int dvb = 0; dvb < 2; ++dvb) O[dvb] = MFMA(Vf[kb][c2][dvb], pf, O[dvb]);
      }
      __builtin_amdgcn_sched_barrier(0);
    }
    }
    if (ktn < 0) break;
    LSTORE(buf ^ 1);
    __syncthreads();
    buf ^= 1; kt = ktn;
  }
  l_out = l + shx(l, 32);
  m_out = 0.f;
#undef GLOAD
#undef LSTORE
}

template <int DK>
DI void attn_core_dual(const bf16* __restrict__ Kp, long kstride, const bf16* __restrict__ Vp, long vstride, uint32_t tilemask,
                  int mode, int qpos, uint32_t sel, const bf16x8 (&Qf)[DK / 16], f32x16 (&O)[2], f32x16 (&O2)[2], float& l_out, float& l2_out, char* smem) {
  constexpr int KST = DK + 8;
  constexpr int CPR = DK / 8;
  constexpr int NCH = CPR / 4;
  bf16* Ks = (bf16*)smem;
  bf16* VTs = (bf16*)(smem + SM_VT);
  const int tid = opq(threadIdx.x), lane = tid & 63, half = lane >> 5, l31 = lane & 31;
#pragma unroll
  for (int i = 0; i < 16; ++i) { O[0][i] = 0.f; O[1][i] = 0.f; O2[0][i] = 0.f; O2[1][i] = 0.f; }
  float l = 0.f, l2 = 0.f;
  const int qw0 = __builtin_amdgcn_readfirstlane(qpos - l31);
  const bool causal_like = (mode == AM_CAUSAL || mode == AM_WIN || mode == AM_SLC);
  int klo = 0, khi = 0x7fffffff;
  if (mode == AM_CAUSAL || mode == AM_SLC) khi = qpos;
  else if (mode == AM_WIN) { khi = qpos; klo = qpos - 511; }
  else if (mode == AM_CMP) khi = (qpos - 31) >> 4;
  u32x4 rk0, rk1, rk2, rv0, rv1;
  rk0 = rk1 = rk2 = (u32x4){0u, 0u, 0u, 0u};
  const int vkp = tid & 31, vcc = tid >> 5;
  const int vcol = (vkp >> 3) * 16 + (((vkp & 1) | ((vkp & 2) << 1) | ((vkp & 4) >> 1)) * 2);
  const int c0 = tid, c1 = tid + 256, c2_ = tid + 512;
  const int kr0 = c0 / CPR, kc0 = (c0 % CPR) * 8, kr1 = c1 / CPR, kc1 = (c1 % CPR) * 8, kr2 = c2_ / CPR, kc2 = (c2_ % CPR) * 8;
#define GLOAD(KT) do { \
    GLD16(rk0, Kp + (long)((KT) * 64 + kr0) * kstride + kc0); \
    if constexpr (NCH > 1) GLD16(rk1, Kp + (long)((KT) * 64 + kr1) * kstride + kc1); \
    if constexpr (NCH > 2) GLD16(rk2, Kp + (long)((KT) * 64 + kr2) * kstride + kc2); \
    GLD16(rv0, Vp + (long)((KT) * 64 + 2 * vkp) * vstride + vcc * 8); \
    GLD16(rv1, Vp + (long)((KT) * 64 + 2 * vkp + 1) * vstride + vcc * 8); } while (0)
#define LSTORE(BUF) do { asm volatile("s_waitcnt vmcnt(0)" : "+v"(rk0), "+v"(rk1), "+v"(rv0), "+v"(rv1) :: "memory"); \
    *(u32x4*)(Ks + ((BUF) * 64 + kr0) * KST + kc0) = rk0; \
    if constexpr (NCH > 1) *(u32x4*)(Ks + ((BUF) * 64 + kr1) * KST + kc1) = rk1; \
    if constexpr (NCH > 2) *(u32x4*)(Ks + ((BUF) * 64 + kr2) * KST + kc2) = rk2; \
    bf16* vd = VTs + ((BUF) * 64 + vcc * 8) * 72 + vcol; \
    *(uint32_t*)(vd + 0 * 72) = (rv0.x & 0xffffu) | (rv1.x << 16); \
    *(uint32_t*)(vd + 1 * 72) = (rv0.x >> 16) | (rv1.x & 0xffff0000u); \
    *(uint32_t*)(vd + 2 * 72) = (rv0.y & 0xffffu) | (rv1.y << 16); \
    *(uint32_t*)(vd + 3 * 72) = (rv0.y >> 16) | (rv1.y & 0xffff0000u); \
    *(uint32_t*)(vd + 4 * 72) = (rv0.z & 0xffffu) | (rv1.z << 16); \
    *(uint32_t*)(vd + 5 * 72) = (rv0.z >> 16) | (rv1.z & 0xffff0000u); \
    *(uint32_t*)(vd + 6 * 72) = (rv0.w & 0xffffu) | (rv1.w << 16); \
    *(uint32_t*)(vd + 7 * 72) = (rv0.w >> 16) | (rv1.w & 0xffff0000u); } while (0)
  uint32_t rem = tilemask;
  int kt = __ffs(rem) - 1; rem &= rem - 1;
  GLOAD(kt);
#pragma unroll
  for (int kc = 0; kc < DK / 16; ++kc) asm volatile("" ::"v"(Qf[kc]));
  __syncthreads();
  LSTORE(0);
  __syncthreads();
  int buf = 0;
  while (true) {
    int ktn = -1;
    if (rem) { ktn = __ffs(rem) - 1; rem &= rem - 1; GLOAD(ktn); }
    const bool wave_active = !(causal_like && kt * 64 > qw0 + 31);
    if (wave_active) {
    const bool need_mask = kt * 64 + 63 > qw0;
    const int kbase = kt * 64 + half * 4;
#pragma unroll
    for (int mp = 0; mp < 2; ++mp) {
      f32x16 Sx[2];
#pragma unroll
      for (int kb = 0; kb < 2; ++kb) {
        bf16x8 k0 = *(const bf16x8*)(Ks + (buf * 64 + kb * 32 + l31) * KST + (2 * mp) * 16 + half * 8);
        bf16x8 k1 = *(const bf16x8*)(Ks + (buf * 64 + kb * 32 + l31) * KST + (2 * mp + 1) * 16 + half * 8);
#pragma unroll
        for (int i = 0; i < 16; ++i) Sx[kb][i] = 0.f;
        Sx[kb] = MFMA(k0, Qf[2 * mp], Sx[kb]);
        Sx[kb] = MFMA(k1, Qf[2 * mp + 1], Sx[kb]);
      }
#pragma unroll
      for (int kb = 0; kb < 2; ++kb) {
        if (need_mask) {
#pragma unroll
          for (int i = 0; i < 16; ++i) {
            const int key = kbase + kb * 32 + (i >> 2) * 8 + (i & 3);
            Sx[kb][i] = (key <= khi) ? Sx[kb][i] : -1e30f;
          }
        }
        bf16x8 Vf[2][2];
#pragma unroll
        for (int c2 = 0; c2 < 2; ++c2)
#pragma unroll
          for (int dvb = 0; dvb < 2; ++dvb)
            Vf[c2][dvb] = *(const bf16x8*)(VTs + (buf * 64 + dvb * 32 + l31) * 72 + (kb * 2 + c2) * 16 + half * 8);
        float ps = 0.f;
#pragma unroll
        for (int i = 0; i < 16; ++i) { float pv = fexp2(Sx[kb][i]); Sx[kb][i] = pv; ps += pv; }
        if (mp == 0) l += ps; else l2 += ps;
#pragma unroll
        for (int c2 = 0; c2 < 2; ++c2) {
          uint4 pw;
          pw.x = pack2(Sx[kb][8 * c2 + 0], Sx[kb][8 * c2 + 1]); pw.y = pack2(Sx[kb][8 * c2 + 2], Sx[kb][8 * c2 + 3]);
          pw.z = pack2(Sx[kb][8 * c2 + 4], Sx[kb][8 * c2 + 5]); pw.w = pack2(Sx[kb][8 * c2 + 6], Sx[kb][8 * c2 + 7]);
          const bf16x8 pf = __builtin_bit_cast(bf16x8, pw);
#pragma unroll
          for (int dvb = 0; dvb < 2; ++dvb) {
            if (mp == 0) O[dvb] = MFMA(Vf[c2][dvb], pf, O[dvb]); else O2[dvb] = MFMA(Vf[c2][dvb], pf, O2[dvb]);
          }
        }
        __builtin_amdgcn_sched_barrier(0);
      }
    }
    }
    if (ktn < 0) break;
    LSTORE(buf ^ 1);
    __syncthreads();
    buf ^= 1; kt = ktn;
  }
  l_out = l + shx(l, 32);
  l2_out = l2 + shx(l2, 32);
#undef GLOAD
#undef LSTORE
}

template <int DK>
DI void load_q(const bf16* __restrict__ Qrow, bf16x8 (&Qf)[DK / 16]) {
  const int half = (opq(threadIdx.x) & 63) >> 5;
#pragma unroll
  for (int kc = 0; kc < DK / 16; ++kc) Qf[kc] = *(const bf16x8*)(Qrow + kc * 16 + half * 8);
}

DI void vec64(bool active, const bf16* src, const float* bias, int nbias, bf16* dst, const float* gain, const float2* rp, float scale, int j) {
  float a0 = 0.f, a1 = 0.f, b0 = 0.f, b1 = 0.f;
  if (active) {
    uint32_t lo = *(const uint32_t*)(src + 2 * j), hi = *(const uint32_t*)(src + 32 + 2 * j);
    a0 = bflo(lo); a1 = bfhi(lo); b0 = bflo(hi); b1 = bfhi(hi);
    for (int sidx = 0; sidx < nbias; ++sidx) {
      const float* bb = bias + sidx * 64;
      a0 += bb[2 * j]; a1 += bb[2 * j + 1]; b0 += bb[32 + 2 * j]; b1 += bb[33 + 2 * j];
    }
  }
  float ss = a0 * a0 + a1 * a1 + b0 * b0 + b1 * b1;
  ss = sum16(ss);
  const float r = rsqrtf(ss * (1.f / 64.f) + EPS);
  if (active) {
    a0 *= r * gain[2 * j]; a1 *= r * gain[2 * j + 1]; b0 *= r * gain[32 + 2 * j]; b1 *= r * gain[33 + 2 * j];
    if (rp) {
      const float2 c0 = rp[2 * j], c1 = rp[2 * j + 1];
      const float t0 = a0 * c0.x - b0 * c0.y, u0 = b0 * c0.x + a0 * c0.y;
      const float t1 = a1 * c1.x - b1 * c1.y, u1 = b1 * c1.x + a1 * c1.y;
      a0 = t0; b0 = u0; a1 = t1; b1 = u1;
    }
    *(uint32_t*)(dst + 2 * j) = pack2(a0 * scale, a1 * scale);
    *(uint32_t*)(dst + 32 + 2 * j) = pack2(b0 * scale, b1 * scale);
  }
}
template <int G>
DI void nr4(uint32_t lo, uint32_t hi, float invn, float g0, float g1, float g2, float g3, bool rope, float2 c0, float2 c1, float scale,
            uint32_t& olo, uint32_t& ohi) {
  float a0 = bflo(lo), a1 = bfhi(lo), b0 = bflo(hi), b1 = bfhi(hi);
  float ss = a0 * a0 + a1 * a1 + b0 * b0 + b1 * b1;
  ss = (G == 16) ? sum16(ss) : sum8(ss);
  const float r = rsqrtf(ss * invn + EPS);
  a0 *= r * g0; a1 *= r * g1; b0 *= r * g2; b1 *= r * g3;
  if (rope) {
    const float t0 = a0 * c0.x - b0 * c0.y, u0 = b0 * c0.x + a0 * c0.y;
    const float t1 = a1 * c1.x - b1 * c1.y, u1 = b1 * c1.x + a1 * c1.y;
    a0 = t0; b0 = u0; a1 = t1; b1 = u1;
  }
  olo = pack2(a0 * scale, a1 * scale); ohi = pack2(b0 * scale, b1 * scale);
}

struct PrepR {
  uint32_t q_lo, q_hi, p2_lo, p2_hi, p3_lo, p3_hi, dq_lo, dq_hi, dk_lo, dk_hi, glv, ckw, uqa, uqb, kra, krb;
  uint2 cw, nw, kw2, vw;
  float2 c0, c1, e0, e1;
};
struct PrepG {
  float gq0, gq1, gq2, gq3, h0, h1, h2, h3, m0, m1, m2, m3, dq0, dq1, dq2, dq3, dk0, dk1, dk2, dk3;
  float mgq0, mgq1, mgq2, mgq3, mgq4, mgq5, mgk0, mgk1, mgk2, mgk3, mgk4, mgk5;
};
DI void prep_load(char* ws, int t, int lane, PrepR& R) {
  const int j16 = lane & 15, g16 = lane >> 4, j8 = lane & 7, g8 = lane >> 3;
  const int s = t & 2047;
  const bf16* ur = (const bf16*)(ws + OFF_U) + (size_t)t * NP;
  const float2* rp = (const float2*)(ws + OFF_ROPE) + s * 32;
  const int col2 = g16 == 0 ? C_KS : (g16 == 1 ? C_KW : C_MQ + (g16 - 2) * 64);
  const int col3 = C_MQ + (2 + (g16 & 1)) * 64;
  const bf16* uq = (const bf16*)(ws + OFF_UQ + (size_t)(t >> 11) * SLAB) + (size_t)s * 384 + g16 * 96;
  const bf16* uk = (const bf16*)(ws + OFF_UKV + (size_t)(t >> 11) * SLAB) + (size_t)s * 512 + g16 * 128;
  R.q_lo = *(const uint32_t*)(ur + C_NQ + g16 * 64 + 2 * j16); R.q_hi = *(const uint32_t*)(ur + C_NQ + g16 * 64 + 32 + 2 * j16);
  R.p2_lo = *(const uint32_t*)(ur + col2 + 2 * j16); R.p2_hi = *(const uint32_t*)(ur + col2 + 32 + 2 * j16);
  R.p3_lo = *(const uint32_t*)(ur + col3 + 2 * j16); R.p3_hi = *(const uint32_t*)(ur + col3 + 32 + 2 * j16);
  R.dq_lo = *(const uint32_t*)(ur + C_DQ + g8 * 32 + 2 * j8); R.dq_hi = *(const uint32_t*)(ur + C_DQ + g8 * 32 + 16 + 2 * j8);
  R.dk_lo = *(const uint32_t*)(ur + C_DK + g8 * 32 + 2 * j8); R.dk_hi = *(const uint32_t*)(ur + C_DK + g8 * 32 + 16 + 2 * j8);
  R.glv = ur[C_GL + (lane < 12 ? lane : 0)];
  R.cw = *(const uint2*)(ur + C_CQ + lane * 4);
  R.ckw = *(const uint32_t*)(ur + C_CKV + lane * 2);
  R.nw = *(const uint2*)(uq + 4 * j16);
  R.uqa = uq[64 + j16]; R.uqb = uq[80 + j16];
  R.kw2 = *(const uint2*)(uk + 4 * j16);
  R.vw = *(const uint2*)(uk + 64 + 4 * j16);
  R.kra = ur[C_KR + j16]; R.krb = ur[C_KR + 16 + j16];
  R.c0 = rp[2 * j16]; R.c1 = rp[2 * j16 + 1];
  R.e0 = rp[4 * j8]; R.e1 = rp[4 * j8 + 2];
}
DI void prep_fin(char* ws, int t, int lane, const PrepR& R, const PrepG& G) {
  const int j16 = lane & 15, g16 = lane >> 4, j8 = lane & 7, g8 = lane >> 3;
  const float qs64 = 0.125f * LOG2E, qs32 = 0.17677669529663687f * LOG2E, qs96 = 0.10206207261596577f * LOG2E;
  const int b = t >> 11, s = t & 2047;
  bf16* ur = (bf16*)(ws + OFF_U) + (size_t)t * NP;
  const int col2 = g16 == 0 ? C_KS : (g16 == 1 ? C_KW : C_MQ + (g16 - 2) * 64);
  const int col3 = C_MQ + (2 + (g16 & 1)) * 64;
  const float2 c0 = R.c0, c1 = R.c1, e0 = R.e0, e1 = R.e1;
  uint32_t olo, ohi;
  nr4<16>(R.q_lo, R.q_hi, 1.f / 64.f, G.gq0, G.gq1, G.gq2, G.gq3, true, c0, c1, qs64, olo, ohi);
  *(uint32_t*)(ur + C_NQ + g16 * 64 + 2 * j16) = olo; *(uint32_t*)(ur + C_NQ + g16 * 64 + 32 + 2 * j16) = ohi;
  nr4<16>(R.p2_lo, R.p2_hi, 1.f / 64.f, G.h0, G.h1, G.h2, G.h3, g16 < 2, c0, c1, g16 < 2 ? 1.f : qs64, olo, ohi);
  *(uint32_t*)(ur + col2 + 2 * j16) = olo; *(uint32_t*)(ur + col2 + 32 + 2 * j16) = ohi;
  nr4<16>(R.p3_lo, R.p3_hi, 1.f / 64.f, G.m0, G.m1, G.m2, G.m3, false, c0, c1, qs64, olo, ohi);
  if (g16 < 2) { *(uint32_t*)(ur + col3 + 2 * j16) = olo; *(uint32_t*)(ur + col3 + 32 + 2 * j16) = ohi; }
  nr4<8>(R.dq_lo, R.dq_hi, 1.f / 32.f, G.dq0, G.dq1, G.dq2, G.dq3, true, e0, e1, qs32, olo, ohi);
  *(uint32_t*)(ur + C_DQ + g8 * 32 + 2 * j8) = olo; *(uint32_t*)(ur + C_DQ + g8 * 32 + 16 + 2 * j8) = ohi;
  nr4<8>(R.dk_lo, R.dk_hi, 1.f / 32.f, G.dk0, G.dk1, G.dk2, G.dk3, true, e0, e1, 1.f, olo, ohi);
  *(uint32_t*)(ur + C_DK + g8 * 32 + 2 * j8) = olo; *(uint32_t*)(ur + C_DK + g8 * 32 + 16 + 2 * j8) = ohi;
  if (lane < 12) ((float*)(ws + OFF_GT))[(size_t)t * 12 + lane] = sigmoidf_(bf2f(R.glv));
  float sq, skv;
  {
    float c0f = bflo(R.cw.x), c1f = bfhi(R.cw.x), c2f = bflo(R.cw.y), c3f = bfhi(R.cw.y);
    float ss = c0f * c0f + c1f * c1f + c2f * c2f + c3f * c3f;
    float d0 = bflo(R.ckw), d1 = bfhi(R.ckw);
    float s2 = d0 * d0 + d1 * d1;
    ss = sum64(ss); s2 = sum64(s2);
    sq = rsqrtf(ss * (1.f / 256.f) + EPS);
    skv = rsqrtf(s2 * (1.f / 128.f) + EPS);
  }
  {
    const int h = g16, j = j16;
    float n0 = bflo(R.nw.x) * sq, n1 = bfhi(R.nw.x) * sq, n2 = bflo(R.nw.y) * sq, n3 = bfhi(R.nw.y) * sq;
    float ra = bf2f(R.uqa) * sq, rb = bf2f(R.uqb) * sq;
    float r1 = ra * c0.x - rb * c0.y, r2 = rb * c0.x + ra * c0.y;
    float ss = n0 * n0 + n1 * n1 + n2 * n2 + n3 * n3 + r1 * r1 + r2 * r2;
    ss = sum16(ss);
    float r = rsqrtf(ss * (1.f / 96.f) + EPS) * qs96;
    bf16* qd = (bf16*)(ws + OFF_QM) + ((size_t)(b * 4 + h) * S + s) * 96;
    uint2 o; o.x = pack2(n0 * r * G.mgq0, n1 * r * G.mgq1); o.y = pack2(n2 * r * G.mgq2, n3 * r * G.mgq3);
    *(uint2*)(qd + 4 * j) = o;
    qd[64 + j] = f2bf(r1 * r * G.mgq4);
    qd[80 + j] = f2bf(r2 * r * G.mgq5);
    float k0 = bflo(R.kw2.x) * skv, k1 = bfhi(R.kw2.x) * skv, k2 = bflo(R.kw2.y) * skv, k3 = bfhi(R.kw2.y) * skv;
    float ka = bf2f(R.kra), kb = bf2f(R.krb);
    float kr1 = ka * c0.x - kb * c0.y, kr2 = kb * c0.x + ka * c0.y;
    float s3 = k0 * k0 + k1 * k1 + k2 * k2 + k3 * k3 + kr1 * kr1 + kr2 * kr2;
    s3 = sum16(s3);
    float rk_ = rsqrtf(s3 * (1.f / 96.f) + EPS);
    bf16* kd = (bf16*)(ws + OFF_KM) + ((size_t)(b * 4 + h) * S + s) * 96;
    uint2 o2; o2.x = pack2(k0 * rk_ * G.mgk0, k1 * rk_ * G.mgk1); o2.y = pack2(k2 * rk_ * G.mgk2, k3 * rk_ * G.mgk3);
    *(uint2*)(kd + 4 * j) = o2;
    kd[64 + j] = f2bf(kr1 * rk_ * G.mgk4);
    kd[80 + j] = f2bf(kr2 * rk_ * G.mgk5);
    uint2 o3; o3.x = pack2(bflo(R.vw.x) * skv, bfhi(R.vw.x) * skv); o3.y = pack2(bflo(R.vw.y) * skv, bfhi(R.vw.y) * skv);
    *(uint2*)((bf16*)(ws + OFF_MV) + ((size_t)(b * 4 + h) * S + s) * 64 + 4 * j) = o3;
  }
}

DI void prep_phase(const Params& p, int layer) {
  const int tid = opq(threadIdx.x), lane = tid & 63, wv = tid >> 6;
  char* ws = opqp(p.ws);
  const float2* rope = (const float2*)(ws + OFF_ROPE);
  const float* nsa_g = p.in[5] + layer * 256;
  const float* diff_g = p.in[8] + layer * 64;
  const float* mla_g = p.in[15] + layer * 192;
  const float* mem_g = p.in[18] + layer * 128;
  constexpr int N_TOK = T / 4, N_MEMT = TM / 4, N_CMP = 1024 / 4;
  const int j16 = lane & 15, g16 = lane >> 4, j8 = lane & 7;
  PrepG G;
  G.gq0 = nsa_g[2 * j16]; G.gq1 = nsa_g[2 * j16 + 1]; G.gq2 = nsa_g[32 + 2 * j16]; G.gq3 = nsa_g[33 + 2 * j16];
  const float* g2p = g16 == 0 ? nsa_g + 128 : (g16 == 1 ? nsa_g + 192 : mem_g);
  G.h0 = g2p[2 * j16]; G.h1 = g2p[2 * j16 + 1]; G.h2 = g2p[32 + 2 * j16]; G.h3 = g2p[33 + 2 * j16];
  G.m0 = mem_g[2 * j16]; G.m1 = mem_g[2 * j16 + 1]; G.m2 = mem_g[32 + 2 * j16]; G.m3 = mem_g[33 + 2 * j16];
  G.dq0 = diff_g[2 * j8]; G.dq1 = diff_g[2 * j8 + 1]; G.dq2 = diff_g[16 + 2 * j8]; G.dq3 = diff_g[17 + 2 * j8];
  G.dk0 = diff_g[32 + 2 * j8]; G.dk1 = diff_g[33 + 2 * j8]; G.dk2 = diff_g[48 + 2 * j8]; G.dk3 = diff_g[49 + 2 * j8];
  G.mgq0 = mla_g[4 * j16]; G.mgq1 = mla_g[4 * j16 + 1]; G.mgq2 = mla_g[4 * j16 + 2]; G.mgq3 = mla_g[4 * j16 + 3];
  G.mgq4 = mla_g[64 + j16]; G.mgq5 = mla_g[80 + j16];
  G.mgk0 = mla_g[96 + 4 * j16]; G.mgk1 = mla_g[96 + 4 * j16 + 1]; G.mgk2 = mla_g[96 + 4 * j16 + 2]; G.mgk3 = mla_g[96 + 4 * j16 + 3];
  G.mgk4 = mla_g[96 + 64 + j16]; G.mgk5 = mla_g[96 + 80 + j16];
  const int xcd = blockIdx.x & 7, rk = blockIdx.x >> 3, nrk = gridDim.x >> 3;
  for (int i = rk; i < 512; i += 2 * nrk) {
    const int it = xcd * 512 + i;
    const bool has2 = i + nrk < 512;
    const int it2 = has2 ? it + nrk : it;
    const int tA = it * 4 + wv, tB = it2 * 4 + wv;
    PrepR A, B;
    prep_load(ws, tA, lane, A);
    prep_load(ws, tB, lane, B);
    prep_fin(ws, tA, lane, A, G);
    if (has2) prep_fin(ws, tB, lane, B, G);
  }
  for (int i = rk; i < 96; i += nrk) {
    const int it = i < 64 ? N_TOK + xcd * 64 + i : N_TOK + N_MEMT + xcd * 32 + (i - 64);
    if (false) {
    } else if (it < N_TOK + N_MEMT) {
      const int t = (it - N_TOK) * 4 + wv;
      const int b = t >> 8, mi = t & 255;
      const bf16* kr = (const bf16*)(ws + OFF_KMEMRAW) + (size_t)t * 512;
      const int h = lane >> 4;
      uint2 vw = *(const uint2*)(kr + 256 + lane * 4);
      vec64(true, kr + h * 64, nullptr, 0, (bf16*)(ws + OFF_MK) + ((size_t)(b * 4 + h) * ML + mi) * 64, mem_g + 64, nullptr, 1.f, j16);
      *(uint2*)((bf16*)(ws + OFF_MVV) + ((size_t)(b * 4 + h) * ML + mi) * 64 + j16 * 4) = vw;
    } else {
      const int r = (it - N_TOK - N_MEMT) * 4 + wv;
      const int n = r & 127;
      const bf16* kraw = (const bf16*)(ws + OFF_CMPRAW) + (size_t)r * 128;
      const bf16* vraw = (const bf16*)(ws + OFF_CMPRAW) + (size_t)(1024 + r) * 128;
      const float* cbk = (const float*)(ws + OFF_CB) + (size_t)(layer * 2 + 0) * 16 * 64;
      const float* cbv = (const float*)(ws + OFF_CB) + (size_t)(layer * 2 + 1) * 16 * 64;
      bf16* kd = (bf16*)(ws + OFF_KCN) + (size_t)r * 64;
      bf16* vd = (bf16*)(ws + OFF_VCN) + (size_t)r * 64;
      if (n < 127) {
        const int pos = 16 * n + 31;
        float bv = 0.f;
#pragma unroll
        for (int sidx = 0; sidx < 16; ++sidx) bv += cbv[sidx * 64 + lane];
        const float vv = bf2f(vraw[lane]) + bv;
        vec64(lane < 16, kraw, cbk, 16, kd, nsa_g + 64, rope + pos * 32, 1.f, lane & 15);
        vd[lane] = f2bf(vv);
      } else {
        kd[lane] = 0; vd[lane] = 0;
      }
    }
  }
}

DI void st4(bf16* dst, float a, float b, float c, float d) { uint2 o; o.x = pack2(a, b); o.y = pack2(c, d); *(uint2*)dst = o; }

DI void attn_phaseA(const Params& p, int layer, char* smem, int* ctr) {
  char* ws = opqp(p.ws);
  bf16* u = (bf16*)(ws + OFF_U);
  bf16* y = (bf16*)(ws + OFF_Y);
  const float* gt = (const float*)(ws + OFF_GT);
  int* s_item = (int*)(smem + SM_MISC);
  const int xcd = blockIdx.x & 7;
  while (true) {
    __syncthreads();
    if (threadIdx.x == 0) *s_item = atomicAdd(ctr + 24 + xcd, 1);
    __syncthreads();
    const int item = *s_item;
    if (item >= 16) break;
    {
      const int tid = opq(threadIdx.x), lane = tid & 63, wv = tid >> 6, half = lane >> 5, l31 = lane & 31;
      const int i2 = item;
      const int qb = 15 - i2, b = xcd;
      const int q0 = qb * 128, qpos = q0 + wv * 32 + l31;
      const size_t t = (size_t)b * S + qpos;
      const bf16* ub = u + (size_t)b * S * NP;
      const bf16* kc = (const bf16*)(ws + OFF_KCN) + (size_t)b * 128 * 64;
      const bf16* vc = (const bf16*)(ws + OFF_VCN) + (size_t)b * 128 * 64;
      const uint32_t tm = (q0 + 127 >= 16 * 64 + 31) ? 3u : 1u;
      float* scl = (float*)(smem + SM_SC) + wv * 32 * 33;
#pragma unroll
      for (int g = 0; g < 16; ++g) scl[l31 * 33 + 2 * g + half] = 0.f;
      const int khi = (qpos - 31) >> 4;
#pragma unroll 1
      for (int h = 0; h < 4; ++h) {
        f32x16 O[2]; float mm, ll;
        bf16x8 Qf[4];
        load_q<64>(ub + (size_t)qpos * NP + C_NQ + h * 64, Qf);
        attn_core<64>(kc, 64, vc, 64, tm, AM_CMP, qpos, 0u, Qf, O, mm, ll, smem);
        const float inv = ll > 0.f ? 1.f / ll : 0.f;
        const float sc = inv * gt[t * 12 + h];
        bf16* od = (bf16*)(ws + OFF_OCMP) + t * 256 + h * 64;
#pragma unroll
        for (int dvb = 0; dvb < 2; ++dvb)
#pragma unroll
          for (int g = 0; g < 4; ++g)
            st4(od + dvb * 32 + 8 * g + 4 * half, O[dvb][4 * g] * sc, O[dvb][4 * g + 1] * sc, O[dvb][4 * g + 2] * sc, O[dvb][4 * g + 3] * sc);
        const float mu = mm < -1e29f ? 0.f : mm;
        const bf16* Ks = (const bf16*)smem;
        float Aa[16], Cc[16];
#pragma unroll
        for (int g = 0; g < 16; ++g) { Aa[g] = 0.f; Cc[g] = 0.f; }
#pragma unroll
        for (int kt = 0; kt < 2; ++kt) {
          if (tm & (1u << kt)) {
#pragma unroll
            for (int kb = 0; kb < 2; ++kb) {
              f32x16 Sx;
#pragma unroll
              for (int i = 0; i < 16; ++i) Sx[i] = 0.f;
#pragma unroll
              for (int kcx = 0; kcx < 4; ++kcx) {
                bf16x8 a = *(const bf16x8*)(Ks + (kt * 64 + kb * 32 + l31) * 72 + kcx * 16 + half * 8);
                Sx = MFMA(a, Qf[kcx], Sx);
              }
#pragma unroll
              for (int gg = 0; gg < 4; ++gg) {
                float pv[4];
#pragma unroll
                for (int e = 0; e < 4; ++e) {
                  const int key = kt * 64 + kb * 32 + gg * 8 + half * 4 + e;
                  pv[e] = key <= khi ? fexp2(Sx[gg * 4 + e] - mu) * inv : 0.f;
                }
                Aa[kt * 8 + kb * 4 + gg] += pv[0] + 2.f * (pv[1] + pv[2] + pv[3]);
                Cc[kt * 8 + kb * 4 + gg] += pv[0];
              }
            }
          }
        }
        {
          float rc[16];
#pragma unroll
          for (int g = 0; g < 16; ++g) rc[g] = shx(Cc[g], 32);
#pragma unroll
          for (int g = 0; g < 16; ++g) {
            const float nx = half == 0 ? rc[g] : (g < 15 ? rc[g < 15 ? g + 1 : 15] : 0.f);
            scl[l31 * 33 + 2 * g + half] += Aa[g] + nx;
          }
        }
      }
      __syncthreads();
      {
        float sv[32];
        const int cur = qpos >> 6;
#pragma unroll
        for (int j = 0; j < 32; ++j) {
          float v = scl[l31 * 33 + j];
          const bool forced = (j == 0) || (j == cur) || (j == cur - 1);
          sv[j] = j > cur ? -1e30f : (forced ? 1e30f : v);
        }
        uint32_t bits = 0;
#pragma unroll 1
        for (int jj = 0; jj < 16; ++jj) {
          const int j = half * 16 + jj;
          float sj = scl[l31 * 33 + j];
          const bool fj = (j == 0) || (j == cur) || (j == cur - 1);
          sj = j > cur ? -1e30f : (fj ? 1e30f : sj);
          int rank = 0;
#pragma unroll
          for (int i = 0; i < 32; ++i) rank += (sv[i] > sj || (sv[i] == sj && i < j)) ? 1 : 0;
          if (rank < 16) bits |= 1u << j;
        }
        bits |= (uint32_t)__shfl_xor((int)bits, 32);
        if (half == 0) ((uint32_t*)(ws + OFF_SEL))[t] = bits;
      }
      wg_publish((unsigned*)(ws + OFF_FLAG) + layer * 1024 + (b * 16 + qb) * 8);
    }
  }
  while (true) {
    __syncthreads();
    if (threadIdx.x == 0) *s_item = atomicAdd(ctr + 16 + xcd, 1);
    __syncthreads();
    const int item = *s_item;
    if (item >= 128) break;
    {
      const int tid = opq(threadIdx.x), lane = tid & 63, wv = tid >> 6, half = lane >> 5, l31 = lane & 31;
      const int i2 = item;
      const int ismem = i2 >> 6, r = i2 & 63, qb = 15 - (r >> 2), b = xcd, h = r & 3;
      const int q0 = qb * 128, qpos = q0 + wv * 32 + l31;
      const size_t t = (size_t)b * S + qpos;
      const bf16* ub = u + (size_t)b * S * NP;
      f32x16 O[2]; float mm, ll;
      bf16x8 Qf[4];
      if (!ismem) {
        load_q<64>(ub + (size_t)qpos * NP + C_NQ + h * 64, Qf);
        const int kt0 = q0 >= 512 ? (q0 - 512) / 64 : 0, kt1 = 2 * qb + 2;
        const uint32_t hi = kt1 >= 32 ? 0xffffffffu : ((1u << kt1) - 1u);
        const uint32_t tm = hi & ~((1u << kt0) - 1u);
        attn_core<64>(ub + C_KW, NP, ub + C_VW, NP, tm, AM_WIN, qpos, 0u, Qf, O, mm, ll, smem);
        const float sc = (ll > 0.f ? 1.f / ll : 0.f) * gt[t * 12 + 8 + h];
        bf16* od = (bf16*)(ws + OFF_OWIN) + t * 256 + h * 64;
#pragma unroll
        for (int dvb = 0; dvb < 2; ++dvb)
#pragma unroll
          for (int g = 0; g < 4; ++g)
            st4(od + dvb * 32 + 8 * g + 4 * half, O[dvb][4 * g] * sc, O[dvb][4 * g + 1] * sc, O[dvb][4 * g + 2] * sc, O[dvb][4 * g + 3] * sc);
        wg_publish((unsigned*)(ws + OFF_FLAG) + layer * 1024 + (b * 16 + qb) * 8 + 1 + h);
      } else {
        load_q<64>(ub + (size_t)qpos * NP + C_MQ + h * 64, Qf);
        attn_core<64>((const bf16*)(ws + OFF_MK) + (size_t)(b * 4 + h) * ML * 64, 64, (const bf16*)(ws + OFF_MVV) + (size_t)(b * 4 + h) * ML * 64, 64,
                      0xfu, AM_NONE, qpos, 0u, Qf, O, mm, ll, smem);
        const float inv = ll > 0.f ? 1.f / ll : 0.f;
#pragma unroll
        for (int dvb = 0; dvb < 2; ++dvb)
#pragma unroll
          for (int g = 0; g < 4; ++g) {
            const int dv = dvb * 32 + 8 * g + 4 * half;
            uint2 zw = *(const uint2*)(u + t * NP + C_MEZ + h * 64 + dv);
            st4(y + t * 1024 + 768 + h * 64 + dv, O[dvb][4 * g] * inv * siluf_(bflo(zw.x)), O[dvb][4 * g + 1] * inv * siluf_(bfhi(zw.x)),
                O[dvb][4 * g + 2] * inv * siluf_(bflo(zw.y)), O[dvb][4 * g + 3] * inv * siluf_(bfhi(zw.y)));
          }
      }
    }
  }
  while (true) {
    __syncthreads();
    if (threadIdx.x == 0) *s_item = atomicAdd(ctr + xcd, 1);
    __syncthreads();
    const int item = *s_item;
    if (item >= 64) break;
    {
      const int tid = opq(threadIdx.x), lane = tid & 63, wv = tid >> 6, half = lane >> 5, l31 = lane & 31;
      const int qb = 15 - (item >> 2), b = xcd, h = item & 3;
      const int q0 = qb * 128, qpos = q0 + wv * 32 + l31;
      const size_t t = (size_t)b * S + qpos;
      const uint32_t tm = (qb == 15) ? 0xffffffffu : ((1u << (2 * qb + 2)) - 1u);
      f32x16 O[2]; float mm, ll;
        bf16x8 Qf[6];
        const bf16* qm = (const bf16*)(ws + OFF_QM) + (size_t)(b * 4 + h) * S * 96;
        load_q<96>(qm + (size_t)qpos * 96, Qf);
        attn_core<96>((const bf16*)(ws + OFF_KM) + (size_t)(b * 4 + h) * S * 96, 96,
                      (const bf16*)(ws + OFF_MV) + (size_t)(b * 4 + h) * S * 64, 64, tm, AM_CAUSAL, qpos, 0u, Qf, O, mm, ll, smem);
        const float inv = ll > 0.f ? 1.f / ll : 0.f;
#pragma unroll
        for (int dvb = 0; dvb < 2; ++dvb)
#pragma unroll
          for (int g = 0; g < 4; ++g) {
            const int dv = dvb * 32 + 8 * g + 4 * half;
            uint2 zw = *(const uint2*)(u + t * NP + C_MZ + h * 64 + dv);
            st4(y + t * 1024 + 512 + h * 64 + dv, O[dvb][4 * g] * inv * siluf_(bflo(zw.x)), O[dvb][4 * g + 1] * inv * siluf_(bfhi(zw.x)),
                O[dvb][4 * g + 2] * inv * siluf_(bflo(zw.y)), O[dvb][4 * g + 3] * inv * siluf_(bfhi(zw.y)));
          }
    }
  }
  while (true) {
    __syncthreads();
    if (threadIdx.x == 0) *s_item = atomicAdd(ctr + 8 + xcd, 1);
    __syncthreads();
    const int item = *s_item;
    if (item >= 64) break;
    {
      const int tid = opq(threadIdx.x), lane = tid & 63, wv = tid >> 6, half = lane >> 5, l31 = lane & 31;
      const int qb = 15 - (item >> 2), b = xcd, h = item & 3;
      const int q0 = qb * 128, qpos = q0 + wv * 32 + l31;
      const size_t t = (size_t)b * S + qpos;
      const uint32_t tm = (qb == 15) ? 0xffffffffu : ((1u << (2 * qb + 2)) - 1u);
      f32x16 O[2]; float mm, ll;
        f32x16 O1[2];
        const bf16* ub = u + (size_t)b * S * NP;
        {
          bf16x8 Qf[4];
          float l1, l2;
          load_q<64>(ub + (size_t)qpos * NP + C_DQ + h * 64, Qf);
          attn_core_dual<64>(ub + C_DK + h * 64, NP, ub + C_DV + h * 64, NP, tm, AM_CAUSAL, qpos, 0u, Qf, O1, O, l1, l2, smem);
          const float inv1 = l1 > 0.f ? 1.f / l1 : 0.f, inv = l2 > 0.f ? 1.f / l2 : 0.f;
#pragma unroll
          for (int i = 0; i < 16; ++i) { O1[0][i] *= inv1; O1[1][i] *= inv1; }
          {
            const float lam = ((const float*)(ws + OFF_LAM))[layer];
            float ss = 0.f;
#pragma unroll
            for (int i = 0; i < 16; ++i) {
              O1[0][i] -= lam * O[0][i] * inv; O1[1][i] -= lam * O[1][i] * inv;
              ss += O1[0][i] * O1[0][i] + O1[1][i] * O1[1][i];
            }
            ss += shx(ss, 32);
            const float li = opq(layer) == 0 ? 0.2f : 0.35550907f;
            const float r = rsqrtf(ss * (1.f / 64.f) + EPS) * (1.f - li);
            const float* sg = p.in[10] + layer * 64;
#pragma unroll
            for (int dvb = 0; dvb < 2; ++dvb)
#pragma unroll
              for (int g = 0; g < 4; ++g) {
                const int dv = dvb * 32 + 8 * g + 4 * half;
                uint2 zw = *(const uint2*)(u + t * NP + C_DZ + h * 64 + dv);
                st4(y + t * 1024 + 256 + h * 64 + dv, O1[dvb][4 * g] * r * sg[dv] * siluf_(bflo(zw.x)),
                    O1[dvb][4 * g + 1] * r * sg[dv + 1] * siluf_(bfhi(zw.x)), O1[dvb][4 * g + 2] * r * sg[dv + 2] * siluf_(bflo(zw.y)),
                    O1[dvb][4 * g + 3] * r * sg[dv + 3] * siluf_(bfhi(zw.y)));
              }
          }
        }
    }
  }
}

DI void attn_phaseB(const Params& p, int layer, char* smem, int* ctr) {
  const int tid = opq(threadIdx.x), lane = tid & 63, wv = tid >> 6, half = lane >> 5, l31 = lane & 31;
  char* ws = opqp(p.ws);
  bf16* u = (bf16*)(ws + OFF_U);
  bf16* y = (bf16*)(ws + OFF_Y);
  const float* gt = (const float*)(ws + OFF_GT);
  int* s_item = (int*)(smem + SM_MISC);
  uint32_t* s_or = (uint32_t*)(smem + SM_MISC + 16);
  const int xcd = blockIdx.x & 7;
  while (true) {
    __syncthreads();
    if (tid == 0) { *s_item = atomicAdd(ctr + xcd, 1); *s_or = 0u; }
    __syncthreads();
    const int item = *s_item;
    if (item >= 64) break;
    const int qb = 15 - (item >> 2), b = xcd, h = item & 3;
    const int q0 = qb * 128, qpos = q0 + wv * 32 + l31;
    const size_t t = (size_t)b * S + qpos;
    const bf16* ub = u + (size_t)b * S * NP;
    wg_wait2((unsigned*)(ws + OFF_FLAG) + layer * 1024 + (b * 16 + qb) * 8, (unsigned*)(ws + OFF_FLAG) + layer * 1024 + (b * 16 + qb) * 8 + 1 + h);
    const uint32_t sel = ((const uint32_t*)(ws + OFF_SEL))[t];
    const uint32_t causal = (qb == 15) ? 0xffffffffu : ((1u << (2 * qb + 2)) - 1u);
    if (half == 0) atomicOr(s_or, sel);
    __syncthreads();
    const uint32_t tm = (*s_or & causal) | 1u;
    f32x16 O[2]; float mm, ll;
    bf16x8 Qf[4];
    load_q<64>(ub + (size_t)qpos * NP + C_NQ + h * 64, Qf);
    attn_core<64>(ub + C_KS, NP, ub + C_VS, NP, tm, AM_SLC, qpos, sel, Qf, O, mm, ll, smem);
    const float sc = (ll > 0.f ? 1.f / ll : 0.f) * gt[t * 12 + 4 + h];
    const bf16* oc = (const bf16*)(ws + OFF_OCMP) + t * 256 + h * 64;
    const bf16* ow = (const bf16*)(ws + OFF_OWIN) + t * 256 + h * 64;
#pragma unroll
    for (int dvb = 0; dvb < 2; ++dvb)
#pragma unroll
      for (int g = 0; g < 4; ++g) {
        const int dv = dvb * 32 + 8 * g + 4 * half;
        uint2 zw = *(const uint2*)(u + t * NP + C_NZ + h * 64 + dv);
        uint2 cw = *(const uint2*)(oc + dv);
        uint2 ww = *(const uint2*)(ow + dv);
        st4(y + t * 1024 + h * 64 + dv, (O[dvb][4 * g] * sc + bflo(cw.x) + bflo(ww.x)) * siluf_(bflo(zw.x)),
            (O[dvb][4 * g + 1] * sc + bfhi(cw.x) + bfhi(ww.x)) * siluf_(bfhi(zw.x)),
            (O[dvb][4 * g + 2] * sc + bflo(cw.y) + bflo(ww.y)) * siluf_(bflo(zw.y)),
            (O[dvb][4 * g + 3] * sc + bfhi(cw.y) + bfhi(ww.y)) * siluf_(bfhi(zw.y)));
      }
  }
  (void)layer;
}

__global__ void __launch_bounds__(256, 2) fwd_megakernel(Params p) {
  __shared__ __attribute__((aligned(16))) char smem[SMEM_BYTES];
  cg::grid_group grid = cg::this_grid();
  char* ws = opqp(p.ws);
  int* ctrs = (int*)(ws + OFF_CTR);
  __shared__ uint4 xb_words;
  if (threadIdx.x == 0) xb_words = make_uint4(0u, 0u, 0u, 0u);
  __syncthreads();
  XcdBarrier xb = xcd_barrier_post((unsigned*)(ws + OFF_BAR), (volatile LAS unsigned*)&xb_words);
  phase0(p, smem);
  if (p.out == nullptr) grid.sync();
  xcd_barrier(xb);
#define PBAR(K) xcd_barrier(xb)
  for (int layer = 0; layer < 2; ++layer) {
    bf16* u = (bf16*)(ws + OFF_U);
    {
      const bf16* xbp = (const bf16*)(ws + OFF_XB);
      const bf16* wi = (const bf16*)(ws + OFF_WI + layer * SZ_WI);
      const int xcd = blockIdx.x & 7, rk = blockIdx.x >> 3, nrk = gridDim.x >> 3;
      for (int q = rk; q < 216; q += nrk) {
        if (q < 192) {
          const int mt = xcd * 8 + (q & 7), nt = q >> 3;
          gemm_big(xbp + (size_t)mt * 256 * 1024, 1024, wi + (size_t)nt * 128 * 1024, 1024, 16, smem, EPI_RS8, u, NP, mt * 256,
                   (const float*)(ws + OFF_SSQ), nullptr, nullptr, nullptr, nullptr, nt);
        } else if (q < 208) {
          const int mt = xcd * 16 + (q - 192), nt = 24;
          gemm_tile<16>(xbp + (size_t)mt * 128 * 1024, 1024, 64, wi + (size_t)nt * 128 * 1024, 1024, 16, smem);
          gemm_epi(EPI_RS8, smem, u, NP, mt * 128, (const float*)(ws + OFF_SSQ), nullptr, nullptr, nullptr, nullptr, nt);
        } else {
          const int i = xcd * 8 + (q - 208), mt = i >> 2, nt = i & 3;
          gemm_tile<16>((const bf16*)(ws + OFF_MEMB) + (size_t)mt * 128 * 1024, 1024, 64,
                    (const bf16*)(ws + OFF_WMEM + layer * SZ_WMEM) + (size_t)nt * 128 * 1024, 1024, 16, smem);
          gemm_epi(EPI_RS1, smem, (bf16*)(ws + OFF_KMEMRAW), 512, mt * 128, (const float*)(ws + OFF_RMEM), nullptr, nullptr, nullptr, nullptr, nt);
        }
      }
    }
    PBAR(0);
    {
      const int xcd = blockIdx.x & 7, rk = blockIdx.x >> 3, nrk = gridDim.x >> 3;
      for (int q = rk; q < 58; q += nrk) {
        if (q < 2) {
          const int j = q, b = xcd;
          gemm_tile<16>(u + (size_t)b * S * NP + (j ? C_VC : C_KC), 16 * NP, NP, (const bf16*)(ws + OFF_WCMP + (layer * 2 + j) * SZ_WCMP), 2048, 32, smem);
          gemm_epi(EPI_PLAIN, smem, (bf16*)(ws + OFF_CMPRAW) + (size_t)j * 1024 * 128, 128, b * 128, nullptr, nullptr, nullptr, nullptr, nullptr, 0);
        } else if (q < 26) {
          const int i = q - 2, ml = i / 3, nt = i % 3, mt = xcd * 8 + ml;
          gemm_big(u + (size_t)mt * 256 * NP + C_CQ, NP, (const bf16*)(ws + OFF_WUQ + layer * SZ_WUQ) + (size_t)nt * 128 * 256, 256, 4, smem, EPI_PLAIN,
                   (bf16*)(ws + OFF_UQ + (size_t)xcd * SLAB), 384, ml * 256, nullptr, nullptr, nullptr, nullptr, nullptr, nt);
        } else {
          const int i = q - 26, ml = i >> 2, nt = i & 3, mt = xcd * 8 + ml;
          gemm_big(u + (size_t)mt * 256 * NP + C_CKV, NP, (const bf16*)(ws + OFF_WUKV + layer * SZ_WUKV) + (size_t)nt * 128 * 128, 128, 2, smem, EPI_PLAIN,
                   (bf16*)(ws + OFF_UKV + (size_t)xcd * SLAB), 512, ml * 256, nullptr, nullptr, nullptr, nullptr, nullptr, nt);
        }
      }
    }
    PBAR(1);
    prep_phase(p, layer);
    PBAR(2);
    attn_phaseA(p, layer, smem, ctrs + layer * 64);
    attn_phaseB(p, layer, smem, ctrs + layer * 64 + 32);
    PBAR(3);
    {
      const bf16* yb = (const bf16*)(ws + OFF_Y);
      const bf16* wo = (const bf16*)(ws + OFF_WO + layer * SZ_WO);
      const float* xres = layer == 0 ? p.in[0] : nullptr;
      const int xcd = blockIdx.x & 7, rk = blockIdx.x >> 3, nrk = gridDim.x >> 3;
      for (int q = rk; q < 64; q += nrk) {
        const int mt = xcd * 8 + (q & 7), nt = q >> 3;
        gemm_big(yb + (size_t)mt * 256 * 1024, 1024, wo + (size_t)nt * 128 * 1024, 1024, 16, smem, EPI_OUT, (bf16*)(ws + OFF_XB), 0, mt * 256, nullptr, xres, layer == 0 ? nullptr : p.out,
                 layer == 0 ? (bf16*)(ws + OFF_XB) : nullptr, (float*)(ws + OFF_SSQ), nt);
      }
    }
    if (layer == 0) PBAR(4);
  }
}

extern "C" void kernel_launch(void* const* d_in, const int* in_sizes, int n_in, void* d_out, int out_size, void* d_ws, size_t ws_size,
                              hipStream_t stream) {
  static int grid_blocks = 0;
  if (!grid_blocks) {
    int dev = 0, cus = 0, per_cu = 0;
    hipGetDevice(&dev);
    hipDeviceGetAttribute(&cus, hipDeviceAttributeMultiprocessorCount, dev);
    hipOccupancyMaxActiveBlocksPerMultiprocessor(&per_cu, fwd_megakernel, 256, 0);
    if (per_cu > 2) per_cu = 2;
    grid_blocks = (cus * per_cu) & ~7;
  }
  if (ws_size < WS_TOTAL) { fprintf(stderr, "workspace too small: %zu < %zu\n", ws_size, (size_t)WS_TOTAL); return; }
  Params p{};
  for (int i = 0; i < 19; ++i) p.in[i] = (const float*)d_in[i];
  p.out = (float*)d_out;
  p.ws = (char*)d_ws;
  hipMemsetAsync((char*)d_ws + OFF_CTR, 0, 1024 + 16384 + 8192 + 2048, stream);
  void* args[] = {&p};
  hipError_t e = hipLaunchCooperativeKernel((void*)fwd_megakernel, dim3(grid_blocks), dim3(256), args, 0, stream);
  if (e != hipSuccess) fprintf(stderr, "cooperative launch failed: %s (grid %d)\n", hipGetErrorString(e), grid_blocks);
}
```

```cpp
#include <hip/hip_runtime.h>
#include <hip/hip_cooperative_groups.h>
#include <stdint.h>
#include <cstdio>
namespace cg = cooperative_groups;

typedef unsigned short bf16;
using bf16x8 = __attribute__((ext_vector_type(8))) short;
using f32x16 = __attribute__((ext_vector_type(16))) float;
typedef __bf16 hbf2 __attribute__((ext_vector_type(2)));
typedef float hf2 __attribute__((ext_vector_type(2)));
typedef uint32_t u32x4 __attribute__((ext_vector_type(4)));
#define GLD16(dst, ptr) asm volatile("global_load_dwordx4 %0, %1, off" : "=&v"(dst) : "v"(ptr) : "memory")
#define WAIT_VM0() asm volatile("s_waitcnt vmcnt(0)" ::: "memory")
#define DI __device__ __forceinline__
#define MFMA(a, b, c) __builtin_amdgcn_mfma_f32_32x32x16_bf16((a), (b), (c), 0, 0, 0)

constexpr int Bn = 8, S = 2048, T = 16384, D = 1024, NP = 3200, ML = 256, TM = 2048;
constexpr float EPS = 1e-6f;
constexpr float LOG2E = 1.4426950408889634f;
constexpr int C_NQ = 0, C_KC = 256, C_VC = 320, C_KS = 384, C_VS = 448, C_KW = 512, C_VW = 576, C_NZ = 640,
              C_DQ = 896, C_DK = 1152, C_DV = 1408, C_DZ = 1664, C_CQ = 1920, C_CKV = 2176, C_KR = 2304,
              C_MZ = 2336, C_MQ = 2592, C_MEZ = 2848, C_GL = 3104;
constexpr size_t SZ_WI = (size_t)NP * 1024 * 2, SZ_WO = 1024 * 1024 * 2, SZ_WUQ = 384 * 256 * 2, SZ_WUKV = 512 * 128 * 2,
                 SZ_WMEM = 512 * 1024 * 2, SZ_WCMP = 128 * 2048 * 2;
constexpr size_t OFF_WI = 0;
constexpr size_t OFF_WO = OFF_WI + 2 * SZ_WI;
constexpr size_t OFF_WUQ = OFF_WO + 2 * SZ_WO;
constexpr size_t OFF_WUKV = OFF_WUQ + 2 * SZ_WUQ;
constexpr size_t OFF_WMEM = OFF_WUKV + 2 * SZ_WUKV;
constexpr size_t OFF_WCMP = OFF_WMEM + 2 * SZ_WMEM;
constexpr size_t OFF_CB = OFF_WCMP + 4 * SZ_WCMP;
constexpr size_t OFF_LAM = OFF_CB + 16384;
constexpr size_t OFF_CTR = OFF_LAM + 256;
constexpr size_t OFF_BAR = OFF_CTR + 1024;
constexpr size_t OFF_FLAG = OFF_BAR + 16384;
constexpr size_t OFF_PCNT = OFF_FLAG + 8192;
constexpr size_t OFF_ROPE = OFF_PCNT + 2048;
constexpr size_t OFF_SSQ = OFF_ROPE + 2048 * 32 * 8;
constexpr size_t OFF_RMEM = OFF_SSQ + (size_t)T * 8 * 4;
constexpr size_t OFF_MEMB = OFF_RMEM + 2048 * 4;
constexpr size_t OFF_XB = OFF_MEMB + (size_t)TM * 1024 * 2;
constexpr size_t OFF_U = OFF_XB + (size_t)T * 1024 * 2;
constexpr size_t OFF_R1 = OFF_U + (size_t)T * NP * 2;
constexpr size_t SLAB = (size_t)S * 1024 * 2;
constexpr size_t OFF_UQ = OFF_R1;
constexpr size_t OFF_UKV = OFF_R1 + (size_t)S * 384 * 2;
constexpr size_t OFF_Y = OFF_R1;
constexpr size_t OFF_QM = OFF_R1 + (size_t)T * 1024 * 2;
constexpr size_t OFF_KM = OFF_QM + (size_t)T * 384 * 2;
constexpr size_t OFF_MV = OFF_KM + (size_t)T * 384 * 2;
constexpr size_t OFF_KMEMRAW = OFF_MV + (size_t)T * 256 * 2;
constexpr size_t OFF_MK = OFF_KMEMRAW + (size_t)TM * 512 * 2;
constexpr size_t OFF_MVV = OFF_MK + (size_t)TM * 256 * 2;
constexpr size_t OFF_CMPRAW = OFF_MVV + (size_t)TM * 256 * 2;
constexpr size_t OFF_KCN = OFF_CMPRAW + 2 * 1024 * 128 * 2;
constexpr size_t OFF_VCN = OFF_KCN + 8 * 128 * 64 * 2;
constexpr size_t OFF_GT = OFF_VCN + 8 * 128 * 64 * 2;
constexpr size_t OFF_OCMP = OFF_GT + (size_t)T * 12 * 4;
constexpr size_t OFF_OWIN = OFF_OCMP + (size_t)T * 256 * 2;
constexpr size_t OFF_SEL = OFF_OWIN + (size_t)T * 256 * 2;
constexpr size_t WS_TOTAL = OFF_SEL + (size_t)T * 4;

constexpr int SMEM_BYTES = 73728;
constexpr int SM_VT = 2 * 64 * 104 * 2;
constexpr int SM_SC = SM_VT + 2 * 64 * 72 * 2;
constexpr int SM_MISC = SM_SC + 4 * 32 * 33 * 4;

struct Params {
  const float* in[19];
  float* out;
  char* ws;
};

DI int opq(int v) { asm volatile("" : "+v"(v)); return v; }
DI char* opqp(char* q) { size_t z = 0; asm volatile("" : "+s"(z)); return q + z; }
DI float bf2f(uint32_t v) { return __uint_as_float(v << 16); }
DI float bflo(uint32_t w) { return __uint_as_float(w << 16); }
DI float bfhi(uint32_t w) { return __uint_as_float(w & 0xffff0000u); }
DI uint32_t pack2(float a, float b) { hf2 f = {a, b}; hbf2 r = __builtin_convertvector(f, hbf2); return __builtin_bit_cast(uint32_t, r); }
DI bf16 f2bf(float a) { return (bf16)(pack2(a, 0.f) & 0xffffu); }
DI float fexp2(float x) { return __builtin_amdgcn_exp2f(x); }
DI float sigmoidf_(float x) { return __builtin_amdgcn_rcpf(1.f + fexp2(-LOG2E * x)); }
DI float siluf_(float x) { return x * __builtin_amdgcn_rcpf(1.f + fexp2(-LOG2E * x)); }
DI float shx(float v, int m) { return __shfl_xor(v, m); }
DI float dppf(float v, int ctrl_sel) {
  int x = __builtin_bit_cast(int, v), r;
  if (ctrl_sel == 0) r = __builtin_amdgcn_mov_dpp(x, 0xB1, 0xF, 0xF, true);
  else if (ctrl_sel == 1) r = __builtin_amdgcn_mov_dpp(x, 0x4E, 0xF, 0xF, true);
  else if (ctrl_sel == 2) r = __builtin_amdgcn_mov_dpp(x, 0x141, 0xF, 0xF, true);
  else r = __builtin_amdgcn_mov_dpp(x, 0x140, 0xF, 0xF, true);
  return __builtin_bit_cast(float, r);
}
DI float sum8(float v) { v += dppf(v, 0); v += dppf(v, 1); v += dppf(v, 2); return v; }
DI float sum16(float v) { v = sum8(v); v += dppf(v, 3); return v; }
DI float sum64(float v) { v = sum16(v); v += shx(v, 16); v += shx(v, 32); return v; }


#define XB_TMO      128
#define XB_XCNT(j)  (256  + 64 * (j))
#define XB_XSUB(j)  (1280 + 64 * (j))
#define XB_XGEN(j)  (2304 + 64 * (j))
#define XB_TOP      3328
#define XB_TOPGEN   3392
#define XB_SPIN_CAP (1u << 22)
#define LAS __attribute__((address_space(3)))
DI unsigned xb_ld(unsigned* p) { return __hip_atomic_load(p, __ATOMIC_RELAXED, __HIP_MEMORY_SCOPE_AGENT); }
DI unsigned xb_add(unsigned* p, unsigned v) { return __hip_atomic_fetch_add(p, v, __ATOMIC_RELAXED, __HIP_MEMORY_SCOPE_AGENT); }
DI unsigned xb_xcc_id() { return (unsigned)__builtin_amdgcn_readfirstlane((int)(__builtin_amdgcn_s_getreg((3 << 11) | 20) & 0xFu)); }
#define XB_SPIN(cond, bar) do { unsigned _sp = 0; while (cond) { __builtin_amdgcn_s_sleep(1); \
    if ((++_sp & 255u) == 0u) { if (xb_ld(&(bar)[XB_TMO])) break; if (_sp > XB_SPIN_CAP) { atomicAdd(&(bar)[XB_TMO], 1u); break; } } } } while (0)
struct XcdBarrier { unsigned* bar; unsigned x; volatile LAS unsigned* st; };
DI XcdBarrier xcd_barrier_post(unsigned* bar, volatile LAS unsigned* st) {
  XcdBarrier b; b.bar = bar; b.x = xb_xcc_id(); b.st = st;
  if (threadIdx.x == 0) (void)xb_add(&bar[XB_XCNT(b.x)], 1u);
  return b;
}
DI void xcd_barrier_complete(unsigned* bar, unsigned x, unsigned& nloc, unsigned& nx) {
  const unsigned G = gridDim.x * gridDim.y * gridDim.z;
  unsigned sum, cnt, mine, sp = 0u;
  for (;;) {
    sum = 0u; cnt = 0u; mine = 0u;
#pragma unroll
    for (unsigned j = 0; j < 16; ++j) { const unsigned c = xb_ld(&bar[XB_XCNT(j)]); sum += c; cnt += (c > 0u) ? 1u : 0u; mine = (j == x) ? c : mine; }
    if (sum == G) break;
    __builtin_amdgcn_s_sleep(1);
    if ((++sp & 255u) == 0u) { if (xb_ld(&bar[XB_TMO])) break; if (sp > XB_SPIN_CAP) { atomicAdd(&bar[XB_TMO], 1u); break; } }
  }
  nloc = mine > 0u ? mine : 1u; nx = cnt > 0u ? cnt : 1u;
}
DI void xcd_barrier(const XcdBarrier& b) {
  asm volatile("s_waitcnt vmcnt(0)" ::: "memory");
  __syncthreads();
  if (threadIdx.x == 0) {
    unsigned* bar = b.bar;
    const unsigned bx = xb_xcc_id();
    __builtin_amdgcn_s_waitcnt(0);
    unsigned nloc = b.st[0], nx = b.st[1];
    if (nloc == 0u) { xcd_barrier_complete(bar, bx, nloc, nx); b.st[0] = nloc; b.st[1] = nx; }
    const unsigned old = xb_add(&bar[XB_XSUB(bx)], 1u);
    const unsigned gen = old / nloc;
    if (old + 1u == (gen + 1u) * nloc) {
      __builtin_amdgcn_fence(__ATOMIC_RELEASE, "agent");
      asm volatile("s_waitcnt vmcnt(0)" ::: "memory");
      const unsigned og = xb_add(&bar[XB_TOP], 1u);
      const unsigned tg = og / nx;
      if (og + 1u == (tg + 1u) * nx) xb_add(&bar[XB_TOPGEN], 1u);
      else XB_SPIN(xb_ld(&bar[XB_TOPGEN]) == tg, bar);
      __builtin_amdgcn_fence(__ATOMIC_ACQUIRE, "agent");
      xb_add(&bar[XB_XGEN(bx)], 1u);
      asm volatile("s_waitcnt vmcnt(0)" ::: "memory");
    } else {
      XB_SPIN(xb_ld(&bar[XB_XGEN(bx)]) == gen, bar);
      __builtin_amdgcn_fence(__ATOMIC_ACQUIRE, "agent");
      asm volatile("s_waitcnt vmcnt(0)" ::: "memory");
    }
  }
  __syncthreads();
}

DI void part_barrier(unsigned* cnt, unsigned target) {
  asm volatile("s_waitcnt vmcnt(0)" ::: "memory");
  __syncthreads();
  if (threadIdx.x == 0) {
    __builtin_amdgcn_s_waitcnt(0);
    __builtin_amdgcn_fence(__ATOMIC_RELEASE, "agent");
    asm volatile("s_waitcnt vmcnt(0)" ::: "memory");
    xb_add(cnt, 1u);
    unsigned sp = 0;
    while (xb_ld(cnt) < target) { __builtin_amdgcn_s_sleep(1); if (++sp > (1u << 24)) break; }
    __builtin_amdgcn_fence(__ATOMIC_ACQUIRE, "agent");
    asm volatile("s_waitcnt vmcnt(0)" ::: "memory");
  }
  __syncthreads();
}

DI void wg_publish(unsigned* flag) {
  asm volatile("s_waitcnt vmcnt(0)" ::: "memory");
  __syncthreads();
  if (threadIdx.x == 0) {
    __builtin_amdgcn_fence(__ATOMIC_RELEASE, "agent");
    asm volatile("s_waitcnt vmcnt(0)" ::: "memory");
    xb_add(flag, 1u);
  }
}
DI void wg_wait2(unsigned* f0, unsigned* f1) {
  if (threadIdx.x == 0) {
    unsigned sp = 0;
    while (xb_ld(f0) < 1u || xb_ld(f1) < 1u) { __builtin_amdgcn_s_sleep(2); if (++sp > (1u << 22)) break; }
    __builtin_amdgcn_fence(__ATOMIC_ACQUIRE, "agent");
    asm volatile("s_waitcnt vmcnt(0)" ::: "memory");
  }
  __syncthreads();
}

DI int win_orig(int n) { return n < 640 ? n : (n < 3104 ? n + 12 : (n < 3116 ? n - 3104 + 640 : -1)); }

DI void convT_tile(const float* __restrict__ src, int Nsrc, const float* __restrict__ gain, bf16* __restrict__ dst, int K,
                   int k0, int n0, int mapmode, float* tile) {
  const int tid = opq(threadIdx.x);
  {
    const int nn = tid & 63, kk = tid >> 6;
    const int n = n0 + nn;
    const int on = mapmode == 1 ? win_orig(n) : (n < Nsrc ? n : -1);
    float v[16];
#pragma unroll
    for (int it = 0; it < 16; ++it) {
      const int k = k0 + kk + 4 * it;
      v[it] = 0.f;
      if (on >= 0) v[it] = src[(size_t)k * Nsrc + on];
    }
    if (gain) {
#pragma unroll
      for (int it = 0; it < 16; ++it) v[it] *= gain[k0 + kk + 4 * it];
    }
#pragma unroll
    for (int it = 0; it < 16; ++it) tile[(kk + 4 * it) * 65 + nn] = v[it];
  }
  __syncthreads();
  {
    const int k8 = (tid & 7) * 8, nb = tid >> 3;
#pragma unroll
    for (int it = 0; it < 2; ++it) {
      const int n = nb + 32 * it;
      uint4 o;
      o.x = pack2(tile[(k8 + 0) * 65 + n], tile[(k8 + 1) * 65 + n]);
      o.y = pack2(tile[(k8 + 2) * 65 + n], tile[(k8 + 3) * 65 + n]);
      o.z = pack2(tile[(k8 + 4) * 65 + n], tile[(k8 + 5) * 65 + n]);
      o.w = pack2(tile[(k8 + 6) * 65 + n], tile[(k8 + 7) * 65 + n]);
      *(uint4*)(dst + (size_t)(n0 + n) * K + k0 + k8) = o;
    }
  }
  __syncthreads();
}

DI void phase0(const Params& p, char* smem) {
  const int tid = opq(threadIdx.x), lane = tid & 63, wv = tid >> 6;
  float* tile = (float*)smem;
  char* ws = opqp(p.ws);
  constexpr int N_WI = 2 * 50 * 16, N_WO = 2 * 16 * 16, N_WUQ = 2 * 6 * 4, N_WUKV = 2 * 8 * 2, N_WMEM = 2 * 8 * 16,
                N_WCMP = 4 * 2 * 32, N_X = T / 4, N_MEM = TM / 4, N_ROPE = 256, N_CB = 64, N_LAM = 1;
  constexpr int E0 = N_WI, E1 = E0 + N_WO, E2 = E1 + N_WUQ, E3 = E2 + N_WUKV, E4 = E3 + N_WMEM, E5 = E4 + N_WCMP,
                E6 = E5 + N_X, E7 = E6 + N_MEM, E8 = E7 + N_ROPE, E9 = E8 + N_CB, E10 = E9 + N_LAM;
  for (int it = blockIdx.x; it < E10; it += gridDim.x) {
    if (it < E0) {
      int l = it / 800, r = it % 800, nt = r / 16, kt = r % 16;
      convT_tile(p.in[3] + (size_t)l * 1024 * 3116, 3116, p.in[2] + l * 1024, (bf16*)(ws + OFF_WI + l * SZ_WI), 1024, kt * 64, nt * 64, 1, tile);
    } else if (it < E1) {
      int i = it - E0; int l = i / 256, r = i % 256, nt = r / 16, kt = r % 16;
      convT_tile(p.in[4] + (size_t)l * 1024 * 1024, 1024, nullptr, (bf16*)(ws + OFF_WO + l * SZ_WO), 1024, kt * 64, nt * 64, 0, tile);
    } else if (it < E2) {
      int i = it - E1; int l = i / 24, r = i % 24, nt = r / 4, kt = r % 4;
      convT_tile(p.in[13] + (size_t)l * 256 * 384, 384, p.in[11] + l * 256, (bf16*)(ws + OFF_WUQ + l * SZ_WUQ), 256, kt * 64, nt * 64, 0, tile);
    } else if (it < E3) {
      int i = it - E2; int l = i / 16, r = i % 16, nt = r / 2, kt = r % 2;
      convT_tile(p.in[14] + (size_t)l * 128 * 512, 512, p.in[12] + l * 128, (bf16*)(ws + OFF_WUKV + l * SZ_WUKV), 128, kt * 64, nt * 64, 0, tile);
    } else if (it < E4) {
      int i = it - E3; int l = i / 128, r = i % 128, nt = r / 16, kt = r % 16;
      convT_tile(p.in[17] + (size_t)l * 1024 * 512, 512, p.in[16] + l * 1024, (bf16*)(ws + OFF_WMEM + l * SZ_WMEM), 1024, kt * 64, nt * 64, 0, tile);
    } else if (it < E5) {
      int i = it - E4; int lj = i / 64, r = i % 64, nt = r / 32, kt = r % 32;
      convT_tile(p.in[7] + (size_t)lj * 2048 * 64, 64, nullptr, (bf16*)(ws + OFF_WCMP + lj * SZ_WCMP), 2048, kt * 64, nt * 64, 0, tile);
    } else if (it < E6) {
      int row = (it - E5) * 4 + wv;
      const float4* xr = (const float4*)(p.in[0] + (size_t)row * 1024);
      bf16* xb = (bf16*)(ws + OFF_XB) + (size_t)row * 1024;
      float ss = 0.f;
#pragma unroll
      for (int i = 0; i < 4; ++i) {
        float4 v = xr[lane + 64 * i];
        ss += v.x * v.x + v.y * v.y + v.z * v.z + v.w * v.w;
        uint2 o; o.x = pack2(v.x, v.y); o.y = pack2(v.z, v.w);
        *(uint2*)(xb + (lane + 64 * i) * 4) = o;
      }
      ss = sum64(ss);
      float* sq = (float*)(ws + OFF_SSQ) + (size_t)row * 8;
      if (lane < 8) sq[lane] = lane == 0 ? ss : 0.f;
    } else if (it < E7) {
      int row = (it - E6) * 4 + wv;
      const float4* xr = (const float4*)(p.in[1] + (size_t)row * 1024);
      bf16* xb = (bf16*)(ws + OFF_MEMB) + (size_t)row * 1024;
      float ss = 0.f;
#pragma unroll
      for (int i = 0; i < 4; ++i) {
        float4 v = xr[lane + 64 * i];
        ss += v.x * v.x + v.y * v.y + v.z * v.z + v.w * v.w;
        uint2 o; o.x = pack2(v.x, v.y); o.y = pack2(v.z, v.w);
        *(uint2*)(xb + (lane + 64 * i) * 4) = o;
      }
      ss = sum64(ss);
      if (lane == 0) ((float*)(ws + OFF_RMEM))[row] = rsqrtf(ss * (1.f / 1024.f) + EPS);
    } else if (it < E8) {
      int e = (it - E7) * 256 + tid;
      int pos = e >> 5, i = e & 31;
      float inv = powf(10000.f, -(float)i / 32.f);
      float ang = (float)pos * inv;
      double a = (double)ang;
      double n = rint(a * 0.15915494309189535);
      float r = (float)(a - n * 6.283185307179586);
      float2 cs; cs.x = __cosf(r); cs.y = __sinf(r);
      ((float2*)(ws + OFF_ROPE))[e] = cs;
    } else if (it < E9) {
      int lj = (it - E8) >> 4, sl = (it - E8) & 15;
      const float* pe = p.in[6] + (size_t)lj * 2048;
      const float* w = p.in[7] + (size_t)lj * 2048 * 64;
      int n = tid & 63, part = tid >> 6;
      float acc = 0.f;
      const int kb0 = sl * 128 + part * 32;
#pragma unroll 8
      for (int k = kb0; k < kb0 + 32; ++k) acc += pe[k] * w[(size_t)k * 64 + n];
      tile[tid] = acc;
      __syncthreads();
      if (tid < 64) ((float*)(ws + OFF_CB))[((it - E8)) * 64 + tid] = tile[tid] + tile[tid + 64] + tile[tid + 128] + tile[tid + 192];
      __syncthreads();
    } else {
      if (tid < 2) {
        const float* lf = p.in[9] + tid * 128;
        float s1 = 0.f, s2 = 0.f;
        for (int i = 0; i < 32; ++i) { s1 += lf[i] * lf[32 + i]; s2 += lf[64 + i] * lf[96 + i]; }
        float li = 0.8f - 0.6f * expf(-0.3f * (float)tid);
        ((float*)(ws + OFF_LAM))[tid] = expf(s1) - expf(s2) + li;
      }
    }
  }
}

template <int CH>
DI void gemm_tile(const bf16* __restrict__ Ab, long lda, long kcs, const bf16* __restrict__ Bb, long ldb, int nk, char* smem) {
  const int tid = opq(threadIdx.x), lane = tid & 63, wv = tid >> 6, half = lane >> 5, l31 = lane & 31;
  const int wm = wv >> 1, wn = wv & 1;
  bf16* As = (bf16*)smem;
  bf16* Bs = (bf16*)(smem + 36864);
  const int lrow = tid >> 3, lcol = (tid & 7) * 8;
  const bf16* ag = Ab + (long)lrow * lda + lcol;
  const bf16* bg = Bb + (long)lrow * ldb + lcol;
  f32x16 acc[2][2];
#pragma unroll
  for (int a = 0; a < 2; ++a)
#pragma unroll
    for (int b = 0; b < 2; ++b)
#pragma unroll
      for (int i = 0; i < 16; ++i) acc[a][b][i] = 0.f;
#define GCOMPUTE(BUF) do { \
    const bf16* as_ = As + (BUF) * 128 * 72 + (wm * 64 + l31) * 72 + half * 8; \
    const bf16* bs_ = Bs + (BUF) * 128 * 72 + (wn * 64 + l31) * 72 + half * 8; \
    bf16x8 fa[2][2], fb[2][2]; \
    fa[0][0] = *(const bf16x8*)(as_); fa[0][1] = *(const bf16x8*)(as_ + 32 * 72); \
    fb[0][0] = *(const bf16x8*)(bs_); fb[0][1] = *(const bf16x8*)(bs_ + 32 * 72); \
    _Pragma("unroll") for (int kc = 0; kc < 4; ++kc) { \
      if (kc < 3) { \
        fa[(kc + 1) & 1][0] = *(const bf16x8*)(as_ + (kc + 1) * 16); fa[(kc + 1) & 1][1] = *(const bf16x8*)(as_ + 32 * 72 + (kc + 1) * 16); \
        fb[(kc + 1) & 1][0] = *(const bf16x8*)(bs_ + (kc + 1) * 16); fb[(kc + 1) & 1][1] = *(const bf16x8*)(bs_ + 32 * 72 + (kc + 1) * 16); \
      } \
      _Pragma("unroll") for (int ni = 0; ni < 2; ++ni) \
        _Pragma("unroll") for (int mi = 0; mi < 2; ++mi) acc[ni][mi] = MFMA(fb[kc & 1][ni], fa[kc & 1][mi], acc[ni][mi]); \
    } } while (0)
  for (int c0 = 0; c0 < nk; c0 += CH) {
    u32x4 rs[2][8];
    const bf16* agc = ag + (long)c0 * kcs;
    const bf16* bgc = bg + (long)c0 * 64;
#pragma unroll
    for (int i = 0; i < 4; ++i) {
      rs[0][i] = *(const u32x4*)(agc + (long)(32 * i) * lda);
      rs[0][4 + i] = *(const u32x4*)(bgc + (long)(32 * i) * ldb);
    }
#pragma unroll
    for (int i = 0; i < 4; ++i) {
      *(u32x4*)(As + (lrow + 32 * i) * 72 + lcol) = rs[0][i];
      *(u32x4*)(Bs + (lrow + 32 * i) * 72 + lcol) = rs[0][4 + i];
    }
    if (CH > 1) {
#pragma unroll
      for (int i = 0; i < 4; ++i) {
        GLD16(rs[1][i], agc + (long)(32 * i) * lda + kcs);
        GLD16(rs[1][4 + i], bgc + (long)(32 * i) * ldb + 64);
      }
    }
    __syncthreads();
#pragma unroll
    for (int t = 0; t < CH; ++t) {
      const int bufc = t & 1;
      if (t + 2 < CH) {
#pragma unroll
        for (int i = 0; i < 4; ++i) {
          GLD16(rs[t & 1][i], agc + (long)(32 * i) * lda + (long)(t + 2) * kcs);
          GLD16(rs[t & 1][4 + i], bgc + (long)(32 * i) * ldb + (long)(t + 2) * 64);
        }
      }
      GCOMPUTE(bufc);
      if (t + 1 < CH) {
        u32x4(&rr)[8] = rs[(t + 1) & 1];
        if (t + 2 < CH) asm volatile("s_waitcnt vmcnt(8)" : "+v"(rr[0]), "+v"(rr[1]), "+v"(rr[2]), "+v"(rr[3]), "+v"(rr[4]), "+v"(rr[5]), "+v"(rr[6]), "+v"(rr[7]) :: "memory");
        else asm volatile("s_waitcnt vmcnt(0)" : "+v"(rr[0]), "+v"(rr[1]), "+v"(rr[2]), "+v"(rr[3]), "+v"(rr[4]), "+v"(rr[5]), "+v"(rr[6]), "+v"(rr[7]) :: "memory");
        bf16* ad = As + (bufc ^ 1) * 128 * 72; bf16* bd = Bs + (bufc ^ 1) * 128 * 72;
#pragma unroll
        for (int i = 0; i < 4; ++i) {
          *(u32x4*)(ad + (lrow + 32 * i) * 72 + lcol) = rr[i];
          *(u32x4*)(bd + (lrow + 32 * i) * 72 + lcol) = rr[4 + i];
        }
      }
      __syncthreads();
    }
  }
#undef GCOMPUTE
  float* Cs = (float*)smem;
#pragma unroll
  for (int ni = 0; ni < 2; ++ni)
#pragma unroll
    for (int mi = 0; mi < 2; ++mi)
#pragma unroll
      for (int g = 0; g < 4; ++g) {
        float4 v; v.x = acc[ni][mi][4 * g]; v.y = acc[ni][mi][4 * g + 1]; v.z = acc[ni][mi][4 * g + 2]; v.w = acc[ni][mi][4 * g + 3];
        *(float4*)(Cs + (wm * 64 + mi * 32 + l31) * 132 + wn * 64 + ni * 32 + 8 * g + 4 * half) = v;
      }
  __syncthreads();
}

enum { EPI_PLAIN = 0, EPI_RS8 = 1, EPI_RS1 = 2, EPI_OUT = 3 };
DI void gemm_epi(int mode, char* smem, bf16* __restrict__ Cb, long ldc, int row0, const float* __restrict__ rs,
                 const float* __restrict__ xres, float* __restrict__ xout, bf16* __restrict__ xbout, float* __restrict__ ssqout, int ntile) {
  const float* Cs = (const float*)smem;
  const int tid = opq(threadIdx.x);
#pragma unroll 2
  for (int it = 0; it < 8; ++it) {
    const int idx = it * 256 + tid;
    const int r = idx >> 4, ch = idx & 15;
    float4 v0 = *(const float4*)(Cs + r * 132 + ch * 8);
    float4 v1 = *(const float4*)(Cs + r * 132 + ch * 8 + 4);
    const long grow = row0 + r;
    if (mode == EPI_OUT) {
      if (xres) {
        const float4* xr = (const float4*)(xres + grow * 1024 + ntile * 128 + ch * 8);
        float4 x0 = xr[0], x1 = xr[1];
        v0.x += x0.x; v0.y += x0.y; v0.z += x0.z; v0.w += x0.w;
        v1.x += x1.x; v1.y += x1.y; v1.z += x1.z; v1.w += x1.w;
      } else {
        const uint4 xw = *(const uint4*)(Cb + grow * 1024 + ntile * 128 + ch * 8);
        v0.x += bflo(xw.x); v0.y += bfhi(xw.x); v0.z += bflo(xw.y); v0.w += bfhi(xw.y);
        v1.x += bflo(xw.z); v1.y += bfhi(xw.z); v1.z += bflo(xw.w); v1.w += bfhi(xw.w);
      }
      if (xout) {
        float4* xo = (float4*)(xout + grow * 1024 + ntile * 128 + ch * 8);
        xo[0] = v0; xo[1] = v1;
      }
      if (xbout) {
        float ss = v0.x * v0.x + v0.y * v0.y + v0.z * v0.z + v0.w * v0.w + v1.x * v1.x + v1.y * v1.y + v1.z * v1.z + v1.w * v1.w;
        ss = sum16(ss);
        if (ch == 0) ssqout[grow * 8 + ntile] = ss;
        uint4 o; o.x = pack2(v0.x, v0.y); o.y = pack2(v0.z, v0.w); o.z = pack2(v1.x, v1.y); o.w = pack2(v1.z, v1.w);
        *(uint4*)(xbout + grow * 1024 + ntile * 128 + ch * 8) = o;
      }
    } else {
      float sc = 1.f;
      if (mode == EPI_RS8) {
        const float4* q = (const float4*)(rs + grow * 8);
        float4 a = q[0], b = q[1];
        sc = rsqrtf((a.x + a.y + a.z + a.w + b.x + b.y + b.z + b.w) * (1.f / 1024.f) + EPS);
      } else if (mode == EPI_RS1) sc = rs[grow];
      uint4 o; o.x = pack2(v0.x * sc, v0.y * sc); o.y = pack2(v0.z * sc, v0.w * sc); o.z = pack2(v1.x * sc, v1.y * sc); o.w = pack2(v1.z * sc, v1.w * sc);
      *(uint4*)(Cb + grow * ldc + ntile * 128 + ch * 8) = o;
    }
  }
  __syncthreads();
}

DI void gemm_big(const bf16* __restrict__ Ab, long lda, const bf16* __restrict__ Bb, long ldb, int nk, char* smem, int mode,
                 bf16* __restrict__ Cb, long ldc, int row0, const float* __restrict__ rs, const float* __restrict__ xres,
                 float* __restrict__ xout, bf16* __restrict__ xbout, float* __restrict__ ssqout, int ntile) {
  const int tid = opq(threadIdx.x), lane = tid & 63, wv = tid >> 6, half = lane >> 5, l31 = lane & 31;
  const int wm = wv >> 1, wn = wv & 1;
  bf16* As = (bf16*)smem;
  bf16* Bs = (bf16*)(smem + 36864);
  const int lrow = tid >> 3, lcol = (tid & 7) * 8;
  const bf16* ag = Ab + (long)lrow * lda + lcol;
  const bf16* bg = Bb + (long)lrow * ldb + lcol;
  u32x4 ra[8], rb[4];
  f32x16 acc[2][4];
#pragma unroll
  for (int a = 0; a < 2; ++a)
#pragma unroll
    for (int b = 0; b < 4; ++b)
#pragma unroll
      for (int i = 0; i < 16; ++i) acc[a][b][i] = 0.f;
#pragma unroll
  for (int i = 0; i < 8; ++i) ra[i] = *(const u32x4*)(ag + (long)(32 * i) * lda);
#pragma unroll
  for (int i = 0; i < 4; ++i) rb[i] = *(const u32x4*)(bg + (long)(32 * i) * ldb);
#pragma unroll
  for (int i = 0; i < 8; ++i) *(u32x4*)(As + (lrow + 32 * i) * 72 + lcol) = ra[i];
#pragma unroll
  for (int i = 0; i < 4; ++i) *(u32x4*)(Bs + (lrow + 32 * i) * 72 + lcol) = rb[i];
  __syncthreads();
  for (int ks = 0; ks < nk; ++ks) {
    const bool more = ks + 1 < nk;
    if (more) {
#pragma unroll
      for (int i = 0; i < 8; ++i) GLD16(ra[i], ag + (long)(32 * i) * lda + (long)(ks + 1) * 64);
#pragma unroll
      for (int i = 0; i < 4; ++i) GLD16(rb[i], bg + (long)(32 * i) * ldb + (long)(ks + 1) * 64);
    }
    const bf16* as_ = As + (wm * 128 + l31) * 72 + half * 8;
    const bf16* bs_ = Bs + (wn * 64 + l31) * 72 + half * 8;
#pragma unroll
    for (int kc = 0; kc < 4; ++kc) {
      bf16x8 fa[4], fb[2];
#pragma unroll
      for (int mi = 0; mi < 4; ++mi) fa[mi] = *(const bf16x8*)(as_ + mi * 32 * 72 + kc * 16);
#pragma unroll
      for (int ni = 0; ni < 2; ++ni) fb[ni] = *(const bf16x8*)(bs_ + ni * 32 * 72 + kc * 16);
#pragma unroll
      for (int ni = 0; ni < 2; ++ni)
#pragma unroll
        for (int mi = 0; mi < 4; ++mi) acc[ni][mi] = MFMA(fb[ni], fa[mi], acc[ni][mi]);
    }
    __syncthreads();
    if (more) {
      asm volatile("s_waitcnt vmcnt(0)" : "+v"(ra[0]), "+v"(ra[1]), "+v"(ra[2]), "+v"(ra[3]), "+v"(ra[4]), "+v"(ra[5]), "+v"(ra[6]), "+v"(ra[7]),
                   "+v"(rb[0]), "+v"(rb[1]), "+v"(rb[2]), "+v"(rb[3]) :: "memory");
#pragma unroll
      for (int i = 0; i < 8; ++i) *(u32x4*)(As + (lrow + 32 * i) * 72 + lcol) = ra[i];
#pragma unroll
      for (int i = 0; i < 4; ++i) *(u32x4*)(Bs + (lrow + 32 * i) * 72 + lcol) = rb[i];
      __syncthreads();
    }
  }
  float* Cs = (float*)smem;
#pragma unroll
  for (int h = 0; h < 2; ++h) {
    if (wm == h) {
#pragma unroll
      for (int ni = 0; ni < 2; ++ni)
#pragma unroll
        for (int mi = 0; mi < 4; ++mi)
#pragma unroll
          for (int g = 0; g < 4; ++g) {
            float4 v; v.x = acc[ni][mi][4 * g]; v.y = acc[ni][mi][4 * g + 1]; v.z = acc[ni][mi][4 * g + 2]; v.w = acc[ni][mi][4 * g + 3];
            *(float4*)(Cs + (mi * 32 + l31) * 132 + wn * 64 + ni * 32 + 8 * g + 4 * half) = v;
          }
    }
    __syncthreads();
    gemm_epi(mode, smem, Cb, ldc, row0 + h * 128, rs, xres, xout, xbout, ssqout, ntile);
  }
}

enum { AM_NONE = 0, AM_CAUSAL = 1, AM_WIN = 2, AM_CMP = 3, AM_SLC = 4 };

template <int DK>
DI void attn_core(const bf16* __restrict__ Kp, long kstride, const bf16* __restrict__ Vp, long vstride, uint32_t tilemask,
                  int mode, int qpos, uint32_t sel, const bf16x8 (&Qf)[DK / 16], f32x16 (&O)[2], float& m_out, float& l_out, char* smem) {
  constexpr int KST = DK + 8;
  constexpr int CPR = DK / 8;
  constexpr int NCH = CPR / 4;
  bf16* Ks = (bf16*)smem;
  bf16* VTs = (bf16*)(smem + SM_VT);
  const int tid = opq(threadIdx.x), lane = tid & 63, half = lane >> 5, l31 = lane & 31;
#pragma unroll
  for (int i = 0; i < 16; ++i) { O[0][i] = 0.f; O[1][i] = 0.f; }
  float l = 0.f;
  const int qw0 = __builtin_amdgcn_readfirstlane(qpos - l31);
  const bool causal_like = (mode == AM_CAUSAL || mode == AM_WIN || mode == AM_SLC);
  int klo = 0, khi = 0x7fffffff;
  if (mode == AM_CAUSAL || mode == AM_SLC) khi = qpos;
  else if (mode == AM_WIN) { khi = qpos; klo = qpos - 511; }
  else if (mode == AM_CMP) khi = (qpos - 31) >> 4;
  u32x4 rk0, rk1, rk2, rv0, rv1;
  rk0 = rk1 = rk2 = (u32x4){0u, 0u, 0u, 0u};
  const int vkp = tid & 31, vcc = tid >> 5;
  const int vcol = (vkp >> 3) * 16 + (((vkp & 1) | ((vkp & 2) << 1) | ((vkp & 4) >> 1)) * 2);
  const int c0 = tid, c1 = tid + 256, c2_ = tid + 512;
  const int kr0 = c0 / CPR, kc0 = (c0 % CPR) * 8, kr1 = c1 / CPR, kc1 = (c1 % CPR) * 8, kr2 = c2_ / CPR, kc2 = (c2_ % CPR) * 8;
#define GLOAD(KT) do { \
    GLD16(rk0, Kp + (long)((KT) * 64 + kr0) * kstride + kc0); \
    if constexpr (NCH > 1) GLD16(rk1, Kp + (long)((KT) * 64 + kr1) * kstride + kc1); \
    if constexpr (NCH > 2) GLD16(rk2, Kp + (long)((KT) * 64 + kr2) * kstride + kc2); \
    GLD16(rv0, Vp + (long)((KT) * 64 + 2 * vkp) * vstride + vcc * 8); \
    GLD16(rv1, Vp + (long)((KT) * 64 + 2 * vkp + 1) * vstride + vcc * 8); } while (0)
#define LSTORE(BUF) do { asm volatile("s_waitcnt vmcnt(0)" : "+v"(rk0), "+v"(rk1), "+v"(rk2), "+v"(rv0), "+v"(rv1) :: "memory"); \
    *(u32x4*)(Ks + ((BUF) * 64 + kr0) * KST + kc0) = rk0; \
    if constexpr (NCH > 1) *(u32x4*)(Ks + ((BUF) * 64 + kr1) * KST + kc1) = rk1; \
    if constexpr (NCH > 2) *(u32x4*)(Ks + ((BUF) * 64 + kr2) * KST + kc2) = rk2; \
    bf16* vd = VTs + ((BUF) * 64 + vcc * 8) * 72 + vcol; \
    *(uint32_t*)(vd + 0 * 72) = (rv0.x & 0xffffu) | (rv1.x << 16); \
    *(uint32_t*)(vd + 1 * 72) = (rv0.x >> 16) | (rv1.x & 0xffff0000u); \
    *(uint32_t*)(vd + 2 * 72) = (rv0.y & 0xffffu) | (rv1.y << 16); \
    *(uint32_t*)(vd + 3 * 72) = (rv0.y >> 16) | (rv1.y & 0xffff0000u); \
    *(uint32_t*)(vd + 4 * 72) = (rv0.z & 0xffffu) | (rv1.z << 16); \
    *(uint32_t*)(vd + 5 * 72) = (rv0.z >> 16) | (rv1.z & 0xffff0000u); \
    *(uint32_t*)(vd + 6 * 72) = (rv0.w & 0xffffu) | (rv1.w << 16); \
    *(uint32_t*)(vd + 7 * 72) = (rv0.w >> 16) | (rv1.w & 0xffff0000u); } while (0)
  uint32_t rem = tilemask;
  int kt = __ffs(rem) - 1; rem &= rem - 1;
  GLOAD(kt);
#pragma unroll
  for (int kc = 0; kc < DK / 16; ++kc) asm volatile("" ::"v"(Qf[kc]));
  __syncthreads();
  LSTORE(0);
  __syncthreads();
  int buf = 0;
  while (true) {
    int ktn = -1;
    if (rem) { ktn = __ffs(rem) - 1; rem &= rem - 1; GLOAD(ktn); }
    const bool wave_active = !(causal_like && kt * 64 > qw0 + 31);
    if (wave_active) {
    f32x16 Sx[2];
#pragma unroll
    for (int kb = 0; kb < 2; ++kb) {
      bf16x8 Kf[DK / 16];
#pragma unroll
      for (int kc = 0; kc < DK / 16; ++kc) Kf[kc] = *(const bf16x8*)(Ks + (buf * 64 + kb * 32 + l31) * KST + kc * 16 + half * 8);
      __builtin_amdgcn_sched_barrier(0);
#pragma unroll
      for (int i = 0; i < 16; ++i) Sx[kb][i] = 0.f;
#pragma unroll
      for (int kc = 0; kc < DK / 16; ++kc) Sx[kb] = MFMA(Kf[kc], Qf[kc], Sx[kb]);
    }
    bf16x8 Vf[2][2][2];
#pragma unroll
    for (int kb = 0; kb < 2; ++kb)
#pragma unroll
      for (int c2 = 0; c2 < 2; ++c2)
#pragma unroll
        for (int dvb = 0; dvb < 2; ++dvb)
          Vf[kb][c2][dvb] = *(const bf16x8*)(VTs + (buf * 64 + dvb * 32 + l31) * 72 + (kb * 2 + c2) * 16 + half * 8);
    __builtin_amdgcn_sched_barrier(0);
    bool need_mask = false;
    if (mode == AM_CAUSAL) need_mask = kt * 64 + 63 > qw0;
    else if (mode == AM_WIN) need_mask = (kt * 64 + 63 > qw0) || (kt * 64 < qw0 + 31 - 511);
    else if (mode == AM_CMP) need_mask = true;
    else if (mode == AM_SLC) need_mask = (kt * 64 + 63 > qw0);
    const bool keep = !(mode == AM_SLC) || (((sel >> kt) & 1u) != 0u);
    int khe = khi;
    if (mode == AM_SLC && !((sel >> kt) & 1u)) khe = -1;
    const int kbase = kt * 64 + half * 4;
#pragma unroll
    for (int kb = 0; kb < 2; ++kb) {
      if (need_mask) {
#pragma unroll
        for (int i = 0; i < 16; ++i) {
          const int key = kbase + kb * 32 + (i >> 2) * 8 + (i & 3);
          Sx[kb][i] = (key >= klo && key <= khe) ? Sx[kb][i] : -1e30f;
        }
      }
      float ps = 0.f;
#pragma unroll
      for (int i = 0; i < 16; ++i) { float pv = fexp2(Sx[kb][i]); pv = keep ? pv : 0.f; Sx[kb][i] = pv; ps += pv; }
      l += ps;
#pragma unroll
      for (int c2 = 0; c2 < 2; ++c2) {
        uint4 pw;
        pw.x = pack2(Sx[kb][8 * c2 + 0], Sx[kb][8 * c2 + 1]); pw.y = pack2(Sx[kb][8 * c2 + 2], Sx[kb][8 * c2 + 3]);
        pw.z = pack2(Sx[kb][8 * c2 + 4], Sx[kb][8 * c2 + 5]); pw.w = pack2(Sx[kb][8 * c2 + 6], Sx[kb][8 * c2 + 7]);
        const bf16x8 pf = __builtin_bit_cast(bf16x8, pw);
#pragma unroll
        for (int dvb = 0; dvb < 2; ++dvb) O[dvb] = MFMA(Vf[kb][c2][dvb], pf, O[dvb]);
      }
      __builtin_amdgcn_sched_barrier(0);
    }
    }
    if (ktn < 0) break;
    LSTORE(buf ^ 1);
    __syncthreads();
    buf ^= 1; kt = ktn;
  }
  l_out = l + shx(l, 32);
  m_out = 0.f;
#undef GLOAD
#undef LSTORE
}

template <int DK>
DI void attn_core_dual(const bf16* __restrict__ Kp, long kstride, const bf16* __restrict__ Vp, long vstride, uint32_t tilemask,
                  int mode, int qpos, uint32_t sel, const bf16x8 (&Qf)[DK / 16], f32x16 (&O)[2], f32x16 (&O2)[2], float& l_out, float& l2_out, char* smem) {
  constexpr int KST = DK + 8;
  constexpr int CPR = DK / 8;
  constexpr int NCH = CPR / 4;
  bf16* Ks = (bf16*)smem;
  bf16* VTs = (bf16*)(smem + SM_VT);
  const int tid = opq(threadIdx.x), lane = tid & 63, half = lane >> 5, l31 = lane & 31;
#pragma unroll
  for (int i = 0; i < 16; ++i) { O[0][i] = 0.f; O[1][i] = 0.f; O2[0][i] = 0.f; O2[1][i] = 0.f; }
  float l = 0.f, l2 = 0.f;
  const int qw0 = __builtin_amdgcn_readfirstlane(qpos - l31);
  const bool causal_like = (mode == AM_CAUSAL || mode == AM_WIN || mode == AM_SLC);
  int klo = 0, khi = 0x7fffffff;
  if (mode == AM_CAUSAL || mode == AM_SLC) khi = qpos;
  else if (mode == AM_WIN) { khi = qpos; klo = qpos - 511; }
  else if (mode == AM_CMP) khi = (qpos - 31) >> 4;
  u32x4 rk0, rk1, rk2, rv0, rv1;
  rk0 = rk1 = rk2 = (u32x4){0u, 0u, 0u, 0u};
  const int vkp = tid & 31, vcc = tid >> 5;
  const int vcol = (vkp >> 3) * 16 + (((vkp & 1) | ((vkp & 2) << 1) | ((vkp & 4) >> 1)) * 2);
  const int c0 = tid, c1 = tid + 256, c2_ = tid + 512;
  const int kr0 = c0 / CPR, kc0 = (c0 % CPR) * 8, kr1 = c1 / CPR, kc1 = (c1 % CPR) * 8, kr2 = c2_ / CPR, kc2 = (c2_ % CPR) * 8;
#define GLOAD(KT) do { \
    GLD16(rk0, Kp + (long)((KT) * 64 + kr0) * kstride + kc0); \
    if constexpr (NCH > 1) GLD16(rk1, Kp + (long)((KT) * 64 + kr1) * kstride + kc1); \
    if constexpr (NCH > 2) GLD16(rk2, Kp + (long)((KT) * 64 + kr2) * kstride + kc2); \
    GLD16(rv0, Vp + (long)((KT) * 64 + 2 * vkp) * vstride + vcc * 8); \
    GLD16(rv1, Vp + (long)((KT) * 64 + 2 * vkp + 1) * vstride + vcc * 8); } while (0)
#define LSTORE(BUF) do { asm volatile("s_waitcnt vmcnt(0)" : "+v"(rk0), "+v"(rk1), "+v"(rv0), "+v"(rv1) :: "memory"); \
    *(u32x4*)(Ks + ((BUF) * 64 + kr0) * KST + kc0) = rk0; \
    if constexpr (NCH > 1) *(u32x4*)(Ks + ((BUF) * 64 + kr1) * KST + kc1) = rk1; \
    if constexpr (NCH > 2) *(u32x4*)(Ks + ((BUF) * 64 + kr2) * KST + kc2) = rk2; \
    bf16* vd = VTs + ((BUF) * 64 + vcc * 8) * 72 + vcol; \
    *(uint32_t*)(vd + 0 * 72) = (rv0.x & 0xffffu) | (rv1.x << 16); \
    *(uint32_t*)(vd + 1 * 72) = (rv0.x >> 16) | (rv1.x & 0xffff0000u); \
    *(uint32_t*)(vd + 2 * 72) = (rv0.y & 0xffffu) | (rv1.y << 16); \
    *(uint32_t*)(vd + 3 * 72) = (rv0.y >> 16) | (rv1.y & 0xffff0000u); \
    *(uint32_t*)(vd + 4 * 72) = (rv0.z & 0xffffu) | (rv1.z << 16); \
    *(uint32_t*)(vd + 5 * 72) = (rv0.z >> 16) | (rv1.z & 0xffff0000u); \
    *(uint32_t*)(vd + 6 * 72) = (rv0.w & 0xffffu) | (rv1.w << 16); \
    *(uint32_t*)(vd + 7 * 72) = (rv0.w >> 16) | (rv1.w & 0xffff0000u); } while (0)
  uint32_t rem = tilemask;
  int kt = __ffs(rem) - 1; rem &= rem - 1;
  GLOAD(kt);
#pragma unroll
  for (int kc = 0; kc < DK / 16; ++kc) asm volatile("" ::"v"(Qf[kc]));
  __syncthreads();
  LSTORE(0);
  __syncthreads();
  int buf = 0;
  while (true) {
    int ktn = -1;
    if (rem) { ktn = __ffs(rem) - 1; rem &= rem - 1; GLOAD(ktn); }
    const bool wave_active = !(causal_like && kt * 64 > qw0 + 31);
    if (wave_active) {
    const bool need_mask = kt * 64 + 63 > qw0;
    const int kbase = kt * 64 + half * 4;
#pragma unroll
    for (int mp = 0; mp < 2; ++mp) {
      f32x16 Sx[2];
#pragma unroll
      for (int kb = 0; kb < 2; ++kb) {
        bf16x8 k0 = *(const bf16x8*)(Ks + (buf * 64 + kb * 32 + l31) * KST + (2 * mp) * 16 + half * 8);
        bf16x8 k1 = *(const bf16x8*)(Ks + (buf * 64 + kb * 32 + l31) * KST + (2 * mp + 1) * 16 + half * 8);
#pragma unroll
        for (int i = 0; i < 16; ++i) Sx[kb][i] = 0.f;
        Sx[kb] = MFMA(k0, Qf[2 * mp], Sx[kb]);
        Sx[kb] = MFMA(k1, Qf[2 * mp + 1], Sx[kb]);
      }
#pragma unroll
      for (int kb = 0; kb < 2; ++kb) {
        if (need_mask) {
#pragma unroll
          for (int i = 0; i < 16; ++i) {
            const int key = kbase + kb * 32 + (i >> 2) * 8 + (i & 3);
            Sx[kb][i] = (key <= khi) ? Sx[kb][i] : -1e30f;
          }
        }
        bf16x8 Vf[2][2];
#pragma unroll
        for (int c2 = 0; c2 < 2; ++c2)
#pragma unroll
          for (int dvb = 0; dvb < 2; ++dvb)
            Vf[c2][dvb] = *(const bf16x8*)(VTs + (buf * 64 + dvb * 32 + l31) * 72 + (kb * 2 + c2) * 16 + half * 8);
        float ps = 0.f;
#pragma unroll
        for (int i = 0; i < 16; ++i) { float pv = fexp2(Sx[kb][i]); Sx[kb][i] = pv; ps += pv; }
        if (mp == 0) l += ps; else l2 += ps;
#pragma unroll
        for (int c2 = 0; c2 < 2; ++c2) {
          uint4 pw;
          pw.x = pack2(Sx[kb][8 * c2 + 0], Sx[kb][8 * c2 + 1]); pw.y = pack2(Sx[kb][8 * c2 + 2], Sx[kb][8 * c2 + 3]);
          pw.z = pack2(Sx[kb][8 * c2 + 4], Sx[kb][8 * c2 + 5]); pw.w = pack2(Sx[kb][8 * c2 + 6], Sx[kb][8 * c2 + 7]);
          const bf16x8 pf = __builtin_bit_cast(bf16x8, pw);
#pragma unroll
          for (int dvb = 0; dvb < 2; ++dvb) {
            if (mp == 0) O[dvb] = MFMA(Vf[c2][dvb], pf, O[dvb]); else O2[dvb] = MFMA(Vf[c2][dvb], pf, O2[dvb]);
          }
        }
        __builtin_amdgcn_sched_barrier(0);
      }
    }
    }
    if (ktn < 0) break;
    LSTORE(buf ^ 1);
    __syncthreads();
    buf ^= 1; kt = ktn;
  }
  l_out = l + shx(l, 32);
  l2_out = l2 + shx(l2, 32);
#undef GLOAD
#undef LSTORE
}

template <int DK>
DI void load_q(const bf16* __restrict__ Qrow, bf16x8 (&Qf)[DK / 16]) {
  const int half = (opq(threadIdx.x) & 63) >> 5;
#pragma unroll
  for (int kc = 0; kc < DK / 16; ++kc) Qf[kc] = *(const bf16x8*)(Qrow + kc * 16 + half * 8);
}

DI void vec64(bool active, const bf16* src, const float* bias, int nbias, bf16* dst, const float* gain, const float2* rp, float scale, int j) {
  float a0 = 0.f, a1 = 0.f, b0 = 0.f, b1 = 0.f;
  if (active) {
    uint32_t lo = *(const uint32_t*)(src + 2 * j), hi = *(const uint32_t*)(src + 32 + 2 * j);
    a0 = bflo(lo); a1 = bfhi(lo); b0 = bflo(hi); b1 = bfhi(hi);
    for (int sidx = 0; sidx < nbias; ++sidx) {
      const float* bb = bias + sidx * 64;
      a0 += bb[2 * j]; a1 += bb[2 * j + 1]; b0 += bb[32 + 2 * j]; b1 += bb[33 + 2 * j];
    }
  }
  float ss = a0 * a0 + a1 * a1 + b0 * b0 + b1 * b1;
  ss = sum16(ss);
  const float r = rsqrtf(ss * (1.f / 64.f) + EPS);
  if (active) {
    a0 *= r * gain[2 * j]; a1 *= r * gain[2 * j + 1]; b0 *= r * gain[32 + 2 * j]; b1 *= r * gain[33 + 2 * j];
    if (rp) {
      const float2 c0 = rp[2 * j], c1 = rp[2 * j + 1];
      const float t0 = a0 * c0.x - b0 * c0.y, u0 = b0 * c0.x + a0 * c0.y;
      const float t1 = a1 * c1.x - b1 * c1.y, u1 = b1 * c1.x + a1 * c1.y;
      a0 = t0; b0 = u0; a1 = t1; b1 = u1;
    }
    *(uint32_t*)(dst + 2 * j) = pack2(a0 * scale, a1 * scale);
    *(uint32_t*)(dst + 32 + 2 * j) = pack2(b0 * scale, b1 * scale);
  }
}
template <int G>
DI void nr4(uint32_t lo, uint32_t hi, float invn, float g0, float g1, float g2, float g3, bool rope, float2 c0, float2 c1, float scale,
            uint32_t& olo, uint32_t& ohi) {
  float a0 = bflo(lo), a1 = bfhi(lo), b0 = bflo(hi), b1 = bfhi(hi);
  float ss = a0 * a0 + a1 * a1 + b0 * b0 + b1 * b1;
  ss = (G == 16) ? sum16(ss) : sum8(ss);
  const float r = rsqrtf(ss * invn + EPS);
  a0 *= r * g0; a1 *= r * g1; b0 *= r * g2; b1 *= r * g3;
  if (rope) {
    const float t0 = a0 * c0.x - b0 * c0.y, u0 = b0 * c0.x + a0 * c0.y;
    const float t1 = a1 * c1.x - b1 * c1.y, u1 = b1 * c1.x + a1 * c1.y;
    a0 = t0; b0 = u0; a1 = t1; b1 = u1;
  }
  olo = pack2(a0 * scale, a1 * scale); ohi = pack2(b0 * scale, b1 * scale);
}

struct PrepR {
  uint32_t q_lo, q_hi, p2_lo, p2_hi, p3_lo, p3_hi, dq_lo, dq_hi, dk_lo, dk_hi, glv, ckw, uqa, uqb, kra, krb;
  uint2 cw, nw, kw2, vw;
  float2 c0, c1, e0, e1;
};
struct PrepG {
  float gq0, gq1, gq2, gq3, h0, h1, h2, h3, m0, m1, m2, m3, dq0, dq1, dq2, dq3, dk0, dk1, dk2, dk3;
  float mgq0, mgq1, mgq2, mgq3, mgq4, mgq5, mgk0, mgk1, mgk2, mgk3, mgk4, mgk5;
};
DI void prep_load(char* ws, int t, int lane, PrepR& R) {
  const int j16 = lane & 15, g16 = lane >> 4, j8 = lane & 7, g8 = lane >> 3;
  const int s = t & 2047;
  const bf16* ur = (const bf16*)(ws + OFF_U) + (size_t)t * NP;
  const float2* rp = (const float2*)(ws + OFF_ROPE) + s * 32;
  const int col2 = g16 == 0 ? C_KS : (g16 == 1 ? C_KW : C_MQ + (g16 - 2) * 64);
  const int col3 = C_MQ + (2 + (g16 & 1)) * 64;
  const bf16* uq = (const bf16*)(ws + OFF_UQ + (size_t)(t >> 11) * SLAB) + (size_t)s * 384 + g16 * 96;
  const bf16* uk = (const bf16*)(ws + OFF_UKV + (size_t)(t >> 11) * SLAB) + (size_t)s * 512 + g16 * 128;
  R.q_lo = *(const uint32_t*)(ur + C_NQ + g16 * 64 + 2 * j16); R.q_hi = *(const uint32_t*)(ur + C_NQ + g16 * 64 + 32 + 2 * j16);
  R.p2_lo = *(const uint32_t*)(ur + col2 + 2 * j16); R.p2_hi = *(const uint32_t*)(ur + col2 + 32 + 2 * j16);
  R.p3_lo = *(const uint32_t*)(ur + col3 + 2 * j16); R.p3_hi = *(const uint32_t*)(ur + col3 + 32 + 2 * j16);
  R.dq_lo = *(const uint32_t*)(ur + C_DQ + g8 * 32 + 2 * j8); R.dq_hi = *(const uint32_t*)(ur + C_DQ + g8 * 32 + 16 + 2 * j8);
  R.dk_lo = *(const uint32_t*)(ur + C_DK + g8 * 32 + 2 * j8); R.dk_hi = *(const uint32_t*)(ur + C_DK + g8 * 32 + 16 + 2 * j8);
  R.glv = ur[C_GL + (lane < 12 ? lane : 0)];
  R.cw = *(const uint2*)(ur + C_CQ + lane * 4);
  R.ckw = *(const uint32_t*)(ur + C_CKV + lane * 2);
  R.nw = *(const uint2*)(uq + 4 * j16);
  R.uqa = uq[64 + j16]; R.uqb = uq[80 + j16];
  R.kw2 = *(const uint2*)(uk + 4 * j16);
  R.vw = *(const uint2*)(uk + 64 + 4 * j16);
  R.kra = ur[C_KR + j16]; R.krb = ur[C_KR + 16 + j16];
  R.c0 = rp[2 * j16]; R.c1 = rp[2 * j16 + 1];
  R.e0 = rp[4 * j8]; R.e1 = rp[4 * j8 + 2];
}
DI void prep_fin(char* ws, int t, int lane, const PrepR& R, const PrepG& G) {
  const int j16 = lane & 15, g16 = lane >> 4, j8 = lane & 7, g8 = lane >> 3;
  const float qs64 = 0.125f * LOG2E, qs32 = 0.17677669529663687f * LOG2E, qs96 = 0.10206207261596577f * LOG2E;
  const int b = t >> 11, s = t & 2047;
  bf16* ur = (bf16*)(ws + OFF_U) + (size_t)t * NP;
  const int col2 = g16 == 0 ? C_KS : (g16 == 1 ? C_KW : C_MQ + (g16 - 2) * 64);
  const int col3 = C_MQ + (2 + (g16 & 1)) * 64;
  const float2 c0 = R.c0, c1 = R.c1, e0 = R.e0, e1 = R.e1;
  uint32_t olo, ohi;
  nr4<16>(R.q_lo, R.q_hi, 1.f / 64.f, G.gq0, G.gq1, G.gq2, G.gq3, true, c0, c1, qs64, olo, ohi);
  *(uint32_t*)(ur + C_NQ + g16 * 64 + 2 * j16) = olo; *(uint32_t*)(ur + C_NQ + g16 * 64 + 32 + 2 * j16) = ohi;
  nr4<16>(R.p2_lo, R.p2_hi, 1.f / 64.f, G.h0, G.h1, G.h2, G.h3, g16 < 2, c0, c1, g16 < 2 ? 1.f : qs64, olo, ohi);
  *(uint32_t*)(ur + col2 + 2 * j16) = olo; *(uint32_t*)(ur + col2 + 32 + 2 * j16) = ohi;
  nr4<16>(R.p3_lo, R.p3_hi, 1.f / 64.f, G.m0, G.m1, G.m2, G.m3, false, c0, c1, qs64, olo, ohi);
  if (g16 < 2) { *(uint32_t*)(ur + col3 + 2 * j16) = olo; *(uint32_t*)(ur + col3 + 32 + 2 * j16) = ohi; }
  nr4<8>(R.dq_lo, R.dq_hi, 1.f / 32.f, G.dq0, G.dq1, G.dq2, G.dq3, true, e0, e1, qs32, olo, ohi);
  *(uint32_t*)(ur + C_DQ + g8 * 32 + 2 * j8) = olo; *(uint32_t*)(ur + C_DQ + g8 * 32 + 16 + 2 * j8) = ohi;
  nr4<8>(R.dk_lo, R.dk_hi, 1.f / 32.f, G.dk0, G.dk1, G.dk2, G.dk3, true, e0, e1, 1.f, olo, ohi);
  *(uint32_t*)(ur + C_DK + g8 * 32 + 2 * j8) = olo; *(uint32_t*)(ur + C_DK + g8 * 32 + 16 + 2 * j8) = ohi;
  if (lane < 12) ((float*)(ws + OFF_GT))[(size_t)t * 12 + lane] = sigmoidf_(bf2f(R.glv));
  float sq, skv;
  {
    float c0f = bflo(R.cw.x), c1f = bfhi(R.cw.x), c2f = bflo(R.cw.y), c3f = bfhi(R.cw.y);
    float ss = c0f * c0f + c1f * c1f + c2f * c2f + c3f * c3f;
    float d0 = bflo(R.ckw), d1 = bfhi(R.ckw);
    float s2 = d0 * d0 + d1 * d1;
    ss = sum64(ss); s2 = sum64(s2);
    sq = rsqrtf(ss * (1.f / 256.f) + EPS);
    skv = rsqrtf(s2 * (1.f / 128.f) + EPS);
  }
  {
    const int h = g16, j = j16;
    float n0 = bflo(R.nw.x) * sq, n1 = bfhi(R.nw.x) * sq, n2 = bflo(R.nw.y) * sq, n3 = bfhi(R.nw.y) * sq;
    float ra = bf2f(R.uqa) * sq, rb = bf2f(R.uqb) * sq;
    float r1 = ra * c0.x - rb * c0.y, r2 = rb * c0.x + ra * c0.y;
    float ss = n0 * n0 + n1 * n1 + n2 * n2 + n3 * n3 + r1 * r1 + r2 * r2;
    ss = sum16(ss);
    float r = rsqrtf(ss * (1.f / 96.f) + EPS) * qs96;
    bf16* qd = (bf16*)(ws + OFF_QM) + ((size_t)(b * 4 + h) * S + s) * 96;
    uint2 o; o.x = pack2(n0 * r * G.mgq0, n1 * r * G.mgq1); o.y = pack2(n2 * r * G.mgq2, n3 * r * G.mgq3);
    *(uint2*)(qd + 4 * j) = o;
    qd[64 + j] = f2bf(r1 * r * G.mgq4);
    qd[80 + j] = f2bf(r2 * r * G.mgq5);
    float k0 = bflo(R.kw2.x) * skv, k1 = bfhi(R.kw2.x) * skv, k2 = bflo(R.kw2.y) * skv, k3 = bfhi(R.kw2.y) * skv;
    float ka = bf2f(R.kra), kb = bf2f(R.krb);
    float kr1 = ka * c0.x - kb * c0.y, kr2 = kb * c0.x + ka * c0.y;
    float s3 = k0 * k0 + k1 * k1 + k2 * k2 + k3 * k3 + kr1 * kr1 + kr2 * kr2;
    s3 = sum16(s3);
    float rk_ = rsqrtf(s3 * (1.f / 96.f) + EPS);
    bf16* kd = (bf16*)(ws + OFF_KM) + ((size_t)(b * 4 + h) * S + s) * 96;
    uint2 o2; o2.x = pack2(k0 * rk_ * G.mgk0, k1 * rk_ * G.mgk1); o2.y = pack2(k2 * rk_ * G.mgk2, k3 * rk_ * G.mgk3);
    *(uint2*)(kd + 4 * j) = o2;
    kd[64 + j] = f2bf(kr1 * rk_ * G.mgk4);
    kd[80 + j] = f2bf(kr2 * rk_ * G.mgk5);
    uint2 o3; o3.x = pack2(bflo(R.vw.x) * skv, bfhi(R.vw.x) * skv); o3.y = pack2(bflo(R.vw.y) * skv, bfhi(R.vw.y) * skv);
    *(uint2*)((bf16*)(ws + OFF_MV) + ((size_t)(b * 4 + h) * S + s) * 64 + 4 * j) = o3;
  }
}

DI void prep_phase(const Params& p, int layer) {
  const int tid = opq(threadIdx.x), lane = tid & 63, wv = tid >> 6;
  char* ws = opqp(p.ws);
  const float2* rope = (const float2*)(ws + OFF_ROPE);
  const float* nsa_g = p.in[5] + layer * 256;
  const float* diff_g = p.in[8] + layer * 64;
  const float* mla_g = p.in[15] + layer * 192;
  const float* mem_g = p.in[18] + layer * 128;
  constexpr int N_TOK = T / 4, N_MEMT = TM / 4, N_CMP = 1024 / 4;
  const int j16 = lane & 15, g16 = lane >> 4, j8 = lane & 7;
  PrepG G;
  G.gq0 = nsa_g[2 * j16]; G.gq1 = nsa_g[2 * j16 + 1]; G.gq2 = nsa_g[32 + 2 * j16]; G.gq3 = nsa_g[33 + 2 * j16];
  const float* g2p = g16 == 0 ? nsa_g + 128 : (g16 == 1 ? nsa_g + 192 : mem_g);
  G.h0 = g2p[2 * j16]; G.h1 = g2p[2 * j16 + 1]; G.h2 = g2p[32 + 2 * j16]; G.h3 = g2p[33 + 2 * j16];
  G.m0 = mem_g[2 * j16]; G.m1 = mem_g[2 * j16 + 1]; G.m2 = mem_g[32 + 2 * j16]; G.m3 = mem_g[33 + 2 * j16];
  G.dq0 = diff_g[2 * j8]; G.dq1 = diff_g[2 * j8 + 1]; G.dq2 = diff_g[16 + 2 * j8]; G.dq3 = diff_g[17 + 2 * j8];
  G.dk0 = diff_g[32 + 2 * j8]; G.dk1 = diff_g[33 + 2 * j8]; G.dk2 = diff_g[48 + 2 * j8]; G.dk3 = diff_g[49 + 2 * j8];
  G.mgq0 = mla_g[4 * j16]; G.mgq1 = mla_g[4 * j16 + 1]; G.mgq2 = mla_g[4 * j16 + 2]; G.mgq3 = mla_g[4 * j16 + 3];
  G.mgq4 = mla_g[64 + j16]; G.mgq5 = mla_g[80 + j16];
  G.mgk0 = mla_g[96 + 4 * j16]; G.mgk1 = mla_g[96 + 4 * j16 + 1]; G.mgk2 = mla_g[96 + 4 * j16 + 2]; G.mgk3 = mla_g[96 + 4 * j16 + 3];
  G.mgk4 = mla_g[96 + 64 + j16]; G.mgk5 = mla_g[96 + 80 + j16];
  const int xcd = blockIdx.x & 7, rk = blockIdx.x >> 3, nrk = gridDim.x >> 3;
  for (int i = rk; i < 512; i += 2 * nrk) {
    const int it = xcd * 512 + i;
    const bool has2 = i + nrk < 512;
    const int it2 = has2 ? it + nrk : it;
    const int tA = it * 4 + wv, tB = it2 * 4 + wv;
    PrepR A, B;
    prep_load(ws, tA, lane, A);
    prep_load(ws, tB, lane, B);
    prep_fin(ws, tA, lane, A, G);
    if (has2) prep_fin(ws, tB, lane, B, G);
  }
  for (int i = rk; i < 96; i += nrk) {
    const int it = i < 64 ? N_TOK + xcd * 64 + i : N_TOK + N_MEMT + xcd * 32 + (i - 64);
    if (false) {
    } else if (it < N_TOK + N_MEMT) {
      const int t = (it - N_TOK) * 4 + wv;
      const int b = t >> 8, mi = t & 255;
      const bf16* kr = (const bf16*)(ws + OFF_KMEMRAW) + (size_t)t * 512;
      const int h = lane >> 4;
      uint2 vw = *(const uint2*)(kr + 256 + lane * 4);
      vec64(true, kr + h * 64, nullptr, 0, (bf16*)(ws + OFF_MK) + ((size_t)(b * 4 + h) * ML + mi) * 64, mem_g + 64, nullptr, 1.f, j16);
      *(uint2*)((bf16*)(ws + OFF_MVV) + ((size_t)(b * 4 + h) * ML + mi) * 64 + j16 * 4) = vw;
    } else {
      const int r = (it - N_TOK - N_MEMT) * 4 + wv;
      const int n = r & 127;
      const bf16* kraw = (const bf16*)(ws + OFF_CMPRAW) + (size_t)r * 128;
      const bf16* vraw = (const bf16*)(ws + OFF_CMPRAW) + (size_t)(1024 + r) * 128;
      const float* cbk = (const float*)(ws + OFF_CB) + (size_t)(layer * 2 + 0) * 16 * 64;
      const float* cbv = (const float*)(ws + OFF_CB) + (size_t)(layer * 2 + 1) * 16 * 64;
      bf16* kd = (bf16*)(ws + OFF_KCN) + (size_t)r * 64;
      bf16* vd = (bf16*)(ws + OFF_VCN) + (size_t)r * 64;
      if (n < 127) {
        const int pos = 16 * n + 31;
        float bv = 0.f;
#pragma unroll
        for (int sidx = 0; sidx < 16; ++sidx) bv += cbv[sidx * 64 + lane];
        const float vv = bf2f(vraw[lane]) + bv;
        vec64(lane < 16, kraw, cbk, 16, kd, nsa_g + 64, rope + pos * 32, 1.f, lane & 15);
        vd[lane] = f2bf(vv);
      } else {
        kd[lane] = 0; vd[lane] = 0;
      }
    }
  }
}

DI void st4(bf16* dst, float a, float b, float c, float d) { uint2 o; o.x = pack2(a, b); o.y = pack2(c, d); *(uint2*)dst = o; }

DI void attn_phaseA(const Params& p, int layer, char* smem, int* ctr) {
  char* ws = opqp(p.ws);
  bf16* u = (bf16*)(ws + OFF_U);
  bf16* y = (bf16*)(ws + OFF_Y);
  const float* gt = (const float*)(ws + OFF_GT);
  int* s_item = (int*)(smem + SM_MISC);
  const int xcd = blockIdx.x & 7;
  while (true) {
    __syncthreads();
    if (threadIdx.x == 0) *s_item = atomicAdd(ctr + 24 + xcd, 1);
    __syncthreads();
    const int item = *s_item;
    if (item >= 16) break;
    {
      const int tid = opq(threadIdx.x), lane = tid & 63, wv = tid >> 6, half = lane >> 5, l31 = lane & 31;
      const int i2 = item;
      const int qb = 15 - i2, b = xcd;
      const int q0 = qb * 128, qpos = q0 + wv * 32 + l31;
      const size_t t = (size_t)b * S + qpos;
      const bf16* ub = u + (size_t)b * S * NP;
      const bf16* kc = (const bf16*)(ws + OFF_KCN) + (size_t)b * 128 * 64;
      const bf16* vc = (const bf16*)(ws + OFF_VCN) + (size_t)b * 128 * 64;
      const uint32_t tm = (q0 + 127 >= 16 * 64 + 31) ? 3u : 1u;
      float* scl = (float*)(smem + SM_SC) + wv * 32 * 33;
#pragma unroll
      for (int g = 0; g < 16; ++g) scl[l31 * 33 + 2 * g + half] = 0.f;
      const int khi = (qpos - 31) >> 4;
#pragma unroll 1
      for (int h = 0; h < 4; ++h) {
        f32x16 O[2]; float mm, ll;
        bf16x8 Qf[4];
        load_q<64>(ub + (size_t)qpos * NP + C_NQ + h * 64, Qf);
        attn_core<64>(kc, 64, vc, 64, tm, AM_CMP, qpos, 0u, Qf, O, mm, ll, smem);
        const float inv = ll > 0.f ? 1.f / ll : 0.f;
        const float sc = inv * gt[t * 12 + h];
        bf16* od = (bf16*)(ws + OFF_OCMP) + t * 256 + h * 64;
#pragma unroll
        for (int dvb = 0; dvb < 2; ++dvb)
#pragma unroll
          for (int g = 0; g < 4; ++g)
            st4(od + dvb * 32 + 8 * g + 4 * half, O[dvb][4 * g] * sc, O[dvb][4 * g + 1] * sc, O[dvb][4 * g + 2] * sc, O[dvb][4 * g + 3] * sc);
        const float mu = mm < -1e29f ? 0.f : mm;
        const bf16* Ks = (const bf16*)smem;
        float Aa[16], Cc[16];
#pragma unroll
        for (int g = 0; g < 16; ++g) { Aa[g] = 0.f; Cc[g] = 0.f; }
#pragma unroll
        for (int kt = 0; kt < 2; ++kt) {
          if (tm & (1u << kt)) {
#pragma unroll
            for (int kb = 0; kb < 2; ++kb) {
              f32x16 Sx;
#pragma unroll
              for (int i = 0; i < 16; ++i) Sx[i] = 0.f;
#pragma unroll
              for (int kcx = 0; kcx < 4; ++kcx) {
                bf16x8 a = *(const bf16x8*)(Ks + (kt * 64 + kb * 32 + l31) * 72 + kcx * 16 + half * 8);
                Sx = MFMA(a, Qf[kcx], Sx);
              }
#pragma unroll
              for (int gg = 0; gg < 4; ++gg) {
                float pv[4];
#pragma unroll
                for (int e = 0; e < 4; ++e) {
                  const int key = kt * 64 + kb * 32 + gg * 8 + half * 4 + e;
                  pv[e] = key <= khi ? fexp2(Sx[gg * 4 + e] - mu) * inv : 0.f;
                }
                Aa[kt * 8 + kb * 4 + gg] += pv[0] + 2.f * (pv[1] + pv[2] + pv[3]);
                Cc[kt * 8 + kb * 4 + gg] += pv[0];
              }
            }
          }
        }
        {
          float rc[16];
#pragma unroll
          for (int g = 0; g < 16; ++g) rc[g] = shx(Cc[g], 32);
#pragma unroll
          for (int g = 0; g < 16; ++g) {
            const float nx = half == 0 ? rc[g] : (g < 15 ? rc[g < 15 ? g + 1 : 15] : 0.f);
            scl[l31 * 33 + 2 * g + half] += Aa[g] + nx;
          }
        }
      }
      __syncthreads();
      {
        float sv[32];
        const int cur = qpos >> 6;
#pragma unroll
        for (int j = 0; j < 32; ++j) {
          float v = scl[l31 * 33 + j];
          const bool forced = (j == 0) || (j == cur) || (j == cur - 1);
          sv[j] = j > cur ? -1e30f : (forced ? 1e30f : v);
        }
        uint32_t bits = 0;
#pragma unroll 1
        for (int jj = 0; jj < 16; ++jj) {
          const int j = half * 16 + jj;
          float sj = scl[l31 * 33 + j];
          const bool fj = (j == 0) || (j == cur) || (j == cur - 1);
          sj = j > cur ? -1e30f : (fj ? 1e30f : sj);
          int rank = 0;
#pragma unroll
          for (int i = 0; i < 32; ++i) rank += (sv[i] > sj || (sv[i] == sj && i < j)) ? 1 : 0;
          if (rank < 16) bits |= 1u << j;
        }
        bits |= (uint32_t)__shfl_xor((int)bits, 32);
        if (half == 0) ((uint32_t*)(ws + OFF_SEL))[t] = bits;
      }
      wg_publish((unsigned*)(ws + OFF_FLAG) + layer * 1024 + (b * 16 + qb) * 8);
    }
  }
  while (true) {
    __syncthreads();
    if (threadIdx.x == 0) *s_item = atomicAdd(ctr + 16 + xcd, 1);
    __syncthreads();
    const int item = *s_item;
    if (item >= 128) break;
    {
      const int tid = opq(threadIdx.x), lane = tid & 63, wv = tid >> 6, half = lane >> 5, l31 = lane & 31;
      const int i2 = item;
      const int ismem = i2 >> 6, r = i2 & 63, qb = 15 - (r >> 2), b = xcd, h = r & 3;
      const int q0 = qb * 128, qpos = q0 + wv * 32 + l31;
      const size_t t = (size_t)b * S + qpos;
      const bf16* ub = u + (size_t)b * S * NP;
      f32x16 O[2]; float mm, ll;
      bf16x8 Qf[4];
      if (!ismem) {
        load_q<64>(ub + (size_t)qpos * NP + C_NQ + h * 64, Qf);
        const int kt0 = q0 >= 512 ? (q0 - 512) / 64 : 0, kt1 = 2 * qb + 2;
        const uint32_t hi = kt1 >= 32 ? 0xffffffffu : ((1u << kt1) - 1u);
        const uint32_t tm = hi & ~((1u << kt0) - 1u);
        attn_core<64>(ub + C_KW, NP, ub + C_VW, NP, tm, AM_WIN, qpos, 0u, Qf, O, mm, ll, smem);
        const float sc = (ll > 0.f ? 1.f / ll : 0.f) * gt[t * 12 + 8 + h];
        bf16* od = (bf16*)(ws + OFF_OWIN) + t * 256 + h * 64;
#pragma unroll
        for (int dvb = 0; dvb < 2; ++dvb)
#pragma unroll
          for (int g = 0; g < 4; ++g)
            st4(od + dvb * 32 + 8 * g + 4 * half, O[dvb][4 * g] * sc, O[dvb][4 * g + 1] * sc, O[dvb][4 * g + 2] * sc, O[dvb][4 * g + 3] * sc);
        wg_publish((unsigned*)(ws + OFF_FLAG) + layer * 1024 + (b * 16 + qb) * 8 + 1 + h);
      } else {
        load_q<64>(ub + (size_t)qpos * NP + C_MQ + h * 64, Qf);
        attn_core<64>((const bf16*)(ws + OFF_MK) + (size_t)(b * 4 + h) * ML * 64, 64, (const bf16*)(ws + OFF_MVV) + (size_t)(b * 4 + h) * ML * 64, 64,
                      0xfu, AM_NONE, qpos, 0u, Qf, O, mm, ll, smem);
        const float inv = ll > 0.f ? 1.f / ll : 0.f;
#pragma unroll
        for (int dvb = 0; dvb < 2; ++dvb)
#pragma unroll
          for (int g = 0; g < 4; ++g) {
            const int dv = dvb * 32 + 8 * g + 4 * half;
            uint2 zw = *(const uint2*)(u + t * NP + C_MEZ + h * 64 + dv);
            st4(y + t * 1024 + 768 + h * 64 + dv, O[dvb][4 * g] * inv * siluf_(bflo(zw.x)), O[dvb][4 * g + 1] * inv * siluf_(bfhi(zw.x)),
                O[dvb][4 * g + 2] * inv * siluf_(bflo(zw.y)), O[dvb][4 * g + 3] * inv * siluf_(bfhi(zw.y)));
          }
      }
    }
  }
  while (true) {
    __syncthreads();
    if (threadIdx.x == 0) *s_item = atomicAdd(ctr + xcd, 1);
    __syncthreads();
    const int item = *s_item;
    if (item >= 64) break;
    {
      const int tid = opq(threadIdx.x), lane = tid & 63, wv = tid >> 6, half = lane >> 5, l31 = lane & 31;
      const int qb = 15 - (item >> 2), b = xcd, h = item & 3;
      const int q0 = qb * 128, qpos = q0 + wv * 32 + l31;
      const size_t t = (size_t)b * S + qpos;
      const uint32_t tm = (qb == 15) ? 0xffffffffu : ((1u << (2 * qb + 2)) - 1u);
      f32x16 O[2]; float mm, ll;
        bf16x8 Qf[6];
        const bf16* qm = (const bf16*)(ws + OFF_QM) + (size_t)(b * 4 + h) * S * 96;
        load_q<96>(qm + (size_t)qpos * 96, Qf);
        attn_core<96>((const bf16*)(ws + OFF_KM) + (size_t)(b * 4 + h) * S * 96, 96,
                      (const bf16*)(ws + OFF_MV) + (size_t)(b * 4 + h) * S * 64, 64, tm, AM_CAUSAL, qpos, 0u, Qf, O, mm, ll, smem);
        const float inv = ll > 0.f ? 1.f / ll : 0.f;
#pragma unroll
        for (int dvb = 0; dvb < 2; ++dvb)
#pragma unroll
          for (int g = 0; g < 4; ++g) {
            const int dv = dvb * 32 + 8 * g + 4 * half;
            uint2 zw = *(const uint2*)(u + t * NP + C_MZ + h * 64 + dv);
            st4(y + t * 1024 + 512 + h * 64 + dv, O[dvb][4 * g] * inv * siluf_(bflo(zw.x)), O[dvb][4 * g + 1] * inv * siluf_(bfhi(zw.x)),
                O[dvb][4 * g + 2] * inv * siluf_(bflo(zw.y)), O[dvb][4 * g + 3] * inv * siluf_(bfhi(zw.y)));
          }
    }
  }
  while (true) {
    __syncthreads();
    if (threadIdx.x == 0) *s_item = atomicAdd(ctr + 8 + xcd, 1);
    __syncthreads();
    const int item = *s_item;
    if (item >= 64) break;
    {
      const int tid = opq(threadIdx.x), lane = tid & 63, wv = tid >> 6, half = lane >> 5, l31 = lane & 31;
      const int qb = 15 - (item >> 2), b = xcd, h = item & 3;
      const int q0 = qb * 128, qpos = q0 + wv * 32 + l31;
      const size_t t = (size_t)b * S + qpos;
      const uint32_t tm = (qb == 15) ? 0xffffffffu : ((1u << (2 * qb + 2)) - 1u);
      f32x16 O[2]; float mm, ll;
        f32x16 O1[2];
        const bf16* ub = u + (size_t)b * S * NP;
        {
          bf16x8 Qf[4];
          float l1, l2;
          load_q<64>(ub + (size_t)qpos * NP + C_DQ + h * 64, Qf);
          attn_core_dual<64>(ub + C_DK + h * 64, NP, ub + C_DV + h * 64, NP, tm, AM_CAUSAL, qpos, 0u, Qf, O1, O, l1, l2, smem);
          const float inv1 = l1 > 0.f ? 1.f / l1 : 0.f, inv = l2 > 0.f ? 1.f / l2 : 0.f;
#pragma unroll
          for (int i = 0; i < 16; ++i) { O1[0][i] *= inv1; O1[1][i] *= inv1; }
          {
            const float lam = ((const float*)(ws + OFF_LAM))[layer];
            float ss = 0.f;
#pragma unroll
            for (int i = 0; i < 16; ++i) {
              O1[0][i] -= lam * O[0][i] * inv; O1[1][i] -= lam * O[1][i] * inv;
              ss += O1[0][i] * O1[0][i] + O1[1][i] * O1[1][i];
            }
            ss += shx(ss, 32);
            const float li = opq(layer) == 0 ? 0.2f : 0.35550907f;
            const float r = rsqrtf(ss * (1.f / 64.f) + EPS) * (1.f - li);
            const float* sg = p.in[10] + layer * 64;
#pragma unroll
            for (int dvb = 0; dvb < 2; ++dvb)
#pragma unroll
              for (int g = 0; g < 4; ++g) {
                const int dv = dvb * 32 + 8 * g + 4 * half;
                uint2 zw = *(const uint2*)(u + t * NP + C_DZ + h * 64 + dv);
                st4(y + t * 1024 + 256 + h * 64 + dv, O1[dvb][4 * g] * r * sg[dv] * siluf_(bflo(zw.x)),
                    O1[dvb][4 * g + 1] * r * sg[dv + 1] * siluf_(bfhi(zw.x)), O1[dvb][4 * g + 2] * r * sg[dv + 2] * siluf_(bflo(zw.y)),
                    O1[dvb][4 * g + 3] * r * sg[dv + 3] * siluf_(bfhi(zw.y)));
              }
          }
        }
    }
  }
}

DI void attn_phaseB(const Params& p, int layer, char* smem, int* ctr) {
  const int tid = opq(threadIdx.x), lane = tid & 63, wv = tid >> 6, half = lane >> 5, l31 = lane & 31;
  char* ws = opqp(p.ws);
  bf16* u = (bf16*)(ws + OFF_U);
  bf16* y = (bf16*)(ws + OFF_Y);
  const float* gt = (const float*)(ws + OFF_GT);
  int* s_item = (int*)(smem + SM_MISC);
  uint32_t* s_or = (uint32_t*)(smem + SM_MISC + 16);
  const int xcd = blockIdx.x & 7;
  while (true) {
    __syncthreads();
    if (tid == 0) { *s_item = atomicAdd(ctr + xcd, 1); *s_or = 0u; }
    __syncthreads();
    const int item = *s_item;
    if (item >= 64) break;
    const int qb = 15 - (item >> 2), b = xcd, h = item & 3;
    const int q0 = qb * 128, qpos = q0 + wv * 32 + l31;
    const size_t t = (size_t)b * S + qpos;
    const bf16* ub = u + (size_t)b * S * NP;
    wg_wait2((unsigned*)(ws + OFF_FLAG) + layer * 1024 + (b * 16 + qb) * 8, (unsigned*)(ws + OFF_FLAG) + layer * 1024 + (b * 16 + qb) * 8 + 1 + h);
    const uint32_t sel = ((const uint32_t*)(ws + OFF_SEL))[t];
    const uint32_t causal = (qb == 15) ? 0xffffffffu : ((1u << (2 * qb + 2)) - 1u);
    if (half == 0) atomicOr(s_or, sel);
    __syncthreads();
    const uint32_t tm = (*s_or & causal) | 1u;
    f32x16 O[2]; float mm, ll;
    bf16x8 Qf[4];
    load_q<64>(ub + (size_t)qpos * NP + C_NQ + h * 64, Qf);
    attn_core<64>(ub + C_KS, NP, ub + C_VS, NP, tm, AM_SLC, qpos, sel, Qf, O, mm, ll, smem);
    const float sc = (ll > 0.f ? 1.f / ll : 0.f) * gt[t * 12 + 4 + h];
    const bf16* oc = (const bf16*)(ws + OFF_OCMP) + t * 256 + h * 64;
    const bf16* ow = (const bf16*)(ws + OFF_OWIN) + t * 256 + h * 64;
#pragma unroll
    for (int dvb = 0; dvb < 2; ++dvb)
#pragma unroll
      for (int g = 0; g < 4; ++g) {
        const int dv = dvb * 32 + 8 * g + 4 * half;
        uint2 zw = *(const uint2*)(u + t * NP + C_NZ + h * 64 + dv);
        uint2 cw = *(const uint2*)(oc + dv);
        uint2 ww = *(const uint2*)(ow + dv);
        st4(y + t * 1024 + h * 64 + dv, (O[dvb][4 * g] * sc + bflo(cw.x) + bflo(ww.x)) * siluf_(bflo(zw.x)),
            (O[dvb][4 * g + 1] * sc + bfhi(cw.x) + bfhi(ww.x)) * siluf_(bfhi(zw.x)),
            (O[dvb][4 * g + 2] * sc + bflo(cw.y) + bflo(ww.y)) * siluf_(bflo(zw.y)),
            (O[dvb][4 * g + 3] * sc + bfhi(cw.y) + bfhi(ww.y)) * siluf_(bfhi(zw.y)));
      }
  }
  (void)layer;
}

__global__ void __launch_bounds__(256, 2) fwd_megakernel(Params p) {
  __shared__ __attribute__((aligned(16))) char smem[SMEM_BYTES];
  cg::grid_group grid = cg::this_grid();
  char* ws = opqp(p.ws);
  int* ctrs = (int*)(ws + OFF_CTR);
  __shared__ uint4 xb_words;
  if (threadIdx.x == 0) xb_words = make_uint4(0u, 0u, 0u, 0u);
  __syncthreads();
  XcdBarrier xb = xcd_barrier_post((unsigned*)(ws + OFF_BAR), (volatile LAS unsigned*)&xb_words);
  phase0(p, smem);
  if (p.out == nullptr) grid.sync();
  xcd_barrier(xb);
#define PBAR(K) xcd_barrier(xb)
  for (int layer = 0; layer < 2; ++layer) {
    bf16* u = (bf16*)(ws + OFF_U);
    {
      const bf16* xbp = (const bf16*)(ws + OFF_XB);
      const bf16* wi = (const bf16*)(ws + OFF_WI + layer * SZ_WI);
      const int xcd = blockIdx.x & 7, rk = blockIdx.x >> 3, nrk = gridDim.x >> 3;
      for (int q = rk; q < 216; q += nrk) {
        if (q < 192) {
          const int mt = xcd * 8 + (q & 7), nt = q >> 3;
          gemm_big(xbp + (size_t)mt * 256 * 1024, 1024, wi + (size_t)nt * 128 * 1024, 1024, 16, smem, EPI_RS8, u, NP, mt * 256,
                   (const float*)(ws + OFF_SSQ), nullptr, nullptr, nullptr, nullptr, nt);
        } else if (q < 208) {
          const int mt = xcd * 16 + (q - 192), nt = 24;
          gemm_tile<16>(xbp + (size_t)mt * 128 * 1024, 1024, 64, wi + (size_t)nt * 128 * 1024, 1024, 16, smem);
          gemm_epi(EPI_RS8, smem, u, NP, mt * 128, (const float*)(ws + OFF_SSQ), nullptr, nullptr, nullptr, nullptr, nt);
        } else {
          const int i = xcd * 8 + (q - 208), mt = i >> 2, nt = i & 3;
          gemm_tile<16>((const bf16*)(ws + OFF_MEMB) + (size_t)mt * 128 * 1024, 1024, 64,
                    (const bf16*)(ws + OFF_WMEM + layer * SZ_WMEM) + (size_t)nt * 128 * 1024, 1024, 16, smem);
          gemm_epi(EPI_RS1, smem, (bf16*)(ws + OFF_KMEMRAW), 512, mt * 128, (const float*)(ws + OFF_RMEM), nullptr, nullptr, nullptr, nullptr, nt);
        }
      }
    }
    PBAR(0);
    {
      const int xcd = blockIdx.x & 7, rk = blockIdx.x >> 3, nrk = gridDim.x >> 3;
      for (int q = rk; q < 58; q += nrk) {
        if (q < 2) {
          const int j = q, b = xcd;
          gemm_tile<16>(u + (size_t)b * S * NP + (j ? C_VC : C_KC), 16 * NP, NP, (const bf16*)(ws + OFF_WCMP + (layer * 2 + j) * SZ_WCMP), 2048, 32, smem);
          gemm_epi(EPI_PLAIN, smem, (bf16*)(ws + OFF_CMPRAW) + (size_t)j * 1024 * 128, 128, b * 128, nullptr, nullptr, nullptr, nullptr, nullptr, 0);
        } else if (q < 26) {
          const int i = q - 2, ml = i / 3, nt = i % 3, mt = xcd * 8 + ml;
          gemm_big(u + (size_t)mt * 256 * NP + C_CQ, NP, (const bf16*)(ws + OFF_WUQ + layer * SZ_WUQ) + (size_t)nt * 128 * 256, 256, 4, smem, EPI_PLAIN,
                   (bf16*)(ws + OFF_UQ + (size_t)xcd * SLAB), 384, ml * 256, nullptr, nullptr, nullptr, nullptr, nullptr, nt);
        } else {
          const int i = q - 26, ml = i >> 2, nt = i & 3, mt = xcd * 8 + ml;
          gemm_big(u + (size_t)mt * 256 * NP + C_CKV, NP, (const bf16*)(ws + OFF_WUKV + layer * SZ_WUKV) + (size_t)nt * 128 * 128, 128, 2, smem, EPI_PLAIN,
                   (bf16*)(ws + OFF_UKV + (size_t)xcd * SLAB), 512, ml * 256, nullptr, nullptr, nullptr, nullptr, nullptr, nt);
        }
      }
    }
    PBAR(1);
    prep_phase(p, layer);
    PBAR(2);
    attn_phaseA(p, layer, smem, ctrs + layer * 64);
    attn_phaseB(p, layer, smem, ctrs + layer * 64 + 32);
    PBAR(3);
    {
      const bf16* yb = (const bf16*)(ws + OFF_Y);
      const bf16* wo = (const bf16*)(ws + OFF_WO + layer * SZ_WO);
      const float* xres = layer == 0 ? p.in[0] : nullptr;
      const int xcd = blockIdx.x & 7, rk = blockIdx.x >> 3, nrk = gridDim.x >> 3;
      for (int q = rk; q < 64; q += nrk) {
        const int mt = xcd * 8 + (q & 7), nt = q >> 3;
        gemm_big(yb + (size_t)mt * 256 * 1024, 1024, wo + (size_t)nt * 128 * 1024, 1024, 16, smem, EPI_OUT, (bf16*)(ws + OFF_XB), 0, mt * 256, nullptr, xres, layer == 0 ? nullptr : p.out,
                 layer == 0 ? (bf16*)(ws + OFF_XB) : nullptr, (float*)(ws + OFF_SSQ), nt);
      }
    }
    if (layer == 0) PBAR(4);
  }
}

extern "C" void kernel_launch(void* const* d_in, const int* in_sizes, int n_in, void* d_out, int out_size, void* d_ws, size_t ws_size,
                              hipStream_t stream) {
  static int grid_blocks = 0;
  if (!grid_blocks) {
    int dev = 0, cus = 0, per_cu = 0;
    hipGetDevice(&dev);
    hipDeviceGetAttribute(&cus, hipDeviceAttributeMultiprocessorCount, dev);
    hipOccupancyMaxActiveBlocksPerMultiprocessor(&per_cu, fwd_megakernel, 256, 0);
    if (per_cu > 2) per_cu = 2;
    grid_blocks = (cus * per_cu) & ~7;
  }
  if (ws_size < WS_TOTAL) { fprintf(stderr, "workspace too small: %zu < %zu\n", ws_size, (size_t)WS_TOTAL); return; }
  Params p{};
  for (int i = 0; i < 19; ++i) p.in[i] = (const float*)d_in[i];
  p.out = (float*)d_out;
  p.ws = (char*)d_ws;
  hipMemsetAsync((char*)d_ws + OFF_CTR, 0, 1024 + 16384 + 8192 + 2048, stream);
  void* args[] = {&p};
  hipError_t e = hipLaunchCooperativeKernel((void*)fwd_megakernel, dim3(grid_blocks), dim3(256), args, 0, stream);
  if (e != hipSuccess) fprintf(stderr, "cooperative launch failed: %s (grid %d)\n", hipGetErrorString(e), grid_blocks);
}
```

```cpp
#include <hip/hip_runtime.h>
#include <hip/hip_cooperative_groups.h>
#include <stdint.h>
#include <cstdio>
namespace cg = cooperative_groups;

typedef unsigned short bf16;
using bf16x8 = __attribute__((ext_vector_type(8))) short;
using f32x16 = __attribute__((ext_vector_type(16))) float;
typedef __bf16 hbf2 __attribute__((ext_vector_type(2)));
typedef float hf2 __attribute__((ext_vector_type(2)));
typedef uint32_t u32x4 __attribute__((ext_vector_type(4)));
#define GLD16(dst, ptr) asm volatile("global_load_dwordx4 %0, %1, off" : "=&v"(dst) : "v"(ptr) : "memory")
#define WAIT_VM0() asm volatile("s_waitcnt vmcnt(0)" ::: "memory")
#define DI __device__ __forceinline__
#define MFMA(a, b, c) __builtin_amdgcn_mfma_f32_32x32x16_bf16((a), (b), (c), 0, 0, 0)

constexpr int Bn = 8, S = 2048, T = 16384, D = 1024, NP = 3200, ML = 256, TM = 2048;
constexpr float EPS = 1e-6f;
constexpr float LOG2E = 1.4426950408889634f;
constexpr int C_NQ = 0, C_KC = 256, C_VC = 320, C_KS = 384, C_VS = 448, C_KW = 512, C_VW = 576, C_NZ = 640,
              C_DQ = 896, C_DK = 1152, C_DV = 1408, C_DZ = 1664, C_CQ = 1920, C_CKV = 2176, C_KR = 2304,
              C_MZ = 2336, C_MQ = 2592, C_MEZ = 2848, C_GL = 3104;
constexpr size_t SZ_WI = (size_t)NP * 1024 * 2, SZ_WO = 1024 * 1024 * 2, SZ_WUQ = 384 * 256 * 2, SZ_WUKV = 512 * 128 * 2,
                 SZ_WMEM = 512 * 1024 * 2, SZ_WCMP = 128 * 2048 * 2;
constexpr size_t OFF_WI = 0;
constexpr size_t OFF_WO = OFF_WI + 2 * SZ_WI;
constexpr size_t OFF_WUQ = OFF_WO + 2 * SZ_WO;
constexpr size_t OFF_WUKV = OFF_WUQ + 2 * SZ_WUQ;
constexpr size_t OFF_WMEM = OFF_WUKV + 2 * SZ_WUKV;
constexpr size_t OFF_WCMP = OFF_WMEM + 2 * SZ_WMEM;
constexpr size_t OFF_CB = OFF_WCMP + 4 * SZ_WCMP;
constexpr size_t OFF_LAM = OFF_CB + 16384;
constexpr size_t OFF_CTR = OFF_LAM + 256;
constexpr size_t OFF_BAR = OFF_CTR + 1024;
constexpr size_t OFF_FLAG = OFF_BAR + 16384;
constexpr size_t OFF_PCNT = OFF_FLAG + 8192;
constexpr size_t OFF_ROPE = OFF_PCNT + 2048;
constexpr size_t OFF_SSQ = OFF_ROPE + 2048 * 32 * 8;
constexpr size_t OFF_RMEM = OFF_SSQ + (size_t)T * 8 * 4;
constexpr size_t OFF_MEMB = OFF_RMEM + 2048 * 4;
constexpr size_t OFF_XB = OFF_MEMB + (size_t)TM * 1024 * 2;
constexpr size_t OFF_U = OFF_XB + (size_t)T * 1024 * 2;
constexpr size_t OFF_R1 = OFF_U + (size_t)T * NP * 2;
constexpr size_t SLAB = (size_t)S * 1024 * 2;
constexpr size_t OFF_UQ = OFF_R1;
constexpr size_t OFF_UKV = OFF_R1 + (size_t)S * 384 * 2;
constexpr size_t OFF_Y = OFF_R1;
constexpr size_t OFF_QM = OFF_R1 + (size_t)T * 1024 * 2;
constexpr size_t OFF_KM = OFF_QM + (size_t)T * 384 * 2;
constexpr size_t OFF_MV = OFF_KM + (size_t)T * 384 * 2;
constexpr size_t OFF_KMEMRAW = OFF_MV + (size_t)T * 256 * 2;
constexpr size_t OFF_MK = OFF_KMEMRAW + (size_t)TM * 512 * 2;
constexpr size_t OFF_MVV = OFF_MK + (size_t)TM * 256 * 2;
constexpr size_t OFF_CMPRAW = OFF_MVV + (size_t)TM * 256 * 2;
constexpr size_t OFF_KCN = OFF_CMPRAW + 8 * 1024 * 128 * 2;
constexpr size_t OFF_VCN = OFF_KCN + 8 * 128 * 64 * 2;
constexpr size_t OFF_GT = OFF_VCN + 8 * 128 * 64 * 2;
constexpr size_t OFF_OCMP = OFF_GT + (size_t)T * 12 * 4;
constexpr size_t OFF_OWIN = OFF_OCMP + (size_t)T * 256 * 2;
constexpr size_t OFF_SEL = OFF_OWIN + (size_t)T * 256 * 2;
constexpr size_t WS_TOTAL = OFF_SEL + (size_t)T * 4;

constexpr int SMEM_BYTES = 73728;
constexpr int SM_VT = 2 * 64 * 104 * 2;
constexpr int SM_SC = SM_VT + 2 * 64 * 72 * 2;
constexpr int SM_MISC = SM_SC + 4 * 32 * 33 * 4;

struct Params {
  const float* in[19];
  float* out;
  char* ws;
};

DI int opq(int v) { asm volatile("" : "+v"(v)); return v; }
DI char* opqp(char* q) { size_t z = 0; asm volatile("" : "+s"(z)); return q + z; }
DI float bf2f(uint32_t v) { return __uint_as_float(v << 16); }
DI float bflo(uint32_t w) { return __uint_as_float(w << 16); }
DI float bfhi(uint32_t w) { return __uint_as_float(w & 0xffff0000u); }
DI uint32_t pack2(float a, float b) { hf2 f = {a, b}; hbf2 r = __builtin_convertvector(f, hbf2); return __builtin_bit_cast(uint32_t, r); }
DI bf16 f2bf(float a) { return (bf16)(pack2(a, 0.f) & 0xffffu); }
DI float fexp2(float x) { return __builtin_amdgcn_exp2f(x); }
DI float sigmoidf_(float x) { return __builtin_amdgcn_rcpf(1.f + fexp2(-LOG2E * x)); }
DI float siluf_(float x) { return x * __builtin_amdgcn_rcpf(1.f + fexp2(-LOG2E * x)); }
DI float shx(float v, int m) { return __shfl_xor(v, m); }
DI float dppf(float v, int ctrl_sel) {
  int x = __builtin_bit_cast(int, v), r;
  if (ctrl_sel == 0) r = __builtin_amdgcn_mov_dpp(x, 0xB1, 0xF, 0xF, true);
  else if (ctrl_sel == 1) r = __builtin_amdgcn_mov_dpp(x, 0x4E, 0xF, 0xF, true);
  else if (ctrl_sel == 2) r = __builtin_amdgcn_mov_dpp(x, 0x141, 0xF, 0xF, true);
  else r = __builtin_amdgcn_mov_dpp(x, 0x140, 0xF, 0xF, true);
  return __builtin_bit_cast(float, r);
}
DI float sum8(float v) { v += dppf(v, 0); v += dppf(v, 1); v += dppf(v, 2); return v; }
DI float sum16(float v) { v = sum8(v); v += dppf(v, 3); return v; }
DI float sum64(float v) { v = sum16(v); v += shx(v, 16); v += shx(v, 32); return v; }


#define XB_TMO      128
#define XB_XCNT(j)  (256  + 64 * (j))
#define XB_XSUB(j)  (1280 + 64 * (j))
#define XB_XGEN(j)  (2304 + 64 * (j))
#define XB_TOP      3328
#define XB_TOPGEN   3392
#define XB_SPIN_CAP (1u << 22)
#define LAS __attribute__((address_space(3)))
DI unsigned xb_ld(unsigned* p) { return __hip_atomic_load(p, __ATOMIC_RELAXED, __HIP_MEMORY_SCOPE_AGENT); }
DI unsigned xb_add(unsigned* p, unsigned v) { return __hip_atomic_fetch_add(p, v, __ATOMIC_RELAXED, __HIP_MEMORY_SCOPE_AGENT); }
DI unsigned xb_xcc_id() { return (unsigned)__builtin_amdgcn_readfirstlane((int)(__builtin_amdgcn_s_getreg((3 << 11) | 20) & 0xFu)); }
#define XB_SPIN(cond, bar) do { unsigned _sp = 0; while (cond) { __builtin_amdgcn_s_sleep(1); \
    if ((++_sp & 255u) == 0u) { if (xb_ld(&(bar)[XB_TMO])) break; if (_sp > XB_SPIN_CAP) { atomicAdd(&(bar)[XB_TMO], 1u); break; } } } } while (0)
struct XcdBarrier { unsigned* bar; unsigned x; volatile LAS unsigned* st; };
DI XcdBarrier xcd_barrier_post(unsigned* bar, volatile LAS unsigned* st) {
  XcdBarrier b; b.bar = bar; b.x = xb_xcc_id(); b.st = st;
  if (threadIdx.x == 0) (void)xb_add(&bar[XB_XCNT(b.x)], 1u);
  return b;
}
DI void xcd_barrier_complete(unsigned* bar, unsigned x, unsigned& nloc, unsigned& nx) {
  const unsigned G = gridDim.x * gridDim.y * gridDim.z;
  unsigned sum, cnt, mine, sp = 0u;
  for (;;) {
    sum = 0u; cnt = 0u; mine = 0u;
#pragma unroll
    for (unsigned j = 0; j < 16; ++j) { const unsigned c = xb_ld(&bar[XB_XCNT(j)]); sum += c; cnt += (c > 0u) ? 1u : 0u; mine = (j == x) ? c : mine; }
    if (sum == G) break;
    __builtin_amdgcn_s_sleep(1);
    if ((++sp & 255u) == 0u) { if (xb_ld(&bar[XB_TMO])) break; if (sp > XB_SPIN_CAP) { atomicAdd(&bar[XB_TMO], 1u); break; } }
  }
  nloc = mine > 0u ? mine : 1u; nx = cnt > 0u ? cnt : 1u;
}
DI void xcd_barrier(const XcdBarrier& b) {
  asm volatile("s_waitcnt vmcnt(0)" ::: "memory");
  __syncthreads();
  if (threadIdx.x == 0) {
    unsigned* bar = b.bar;
    const unsigned bx = xb_xcc_id();
    __builtin_amdgcn_s_waitcnt(0);
    unsigned nloc = b.st[0], nx = b.st[1];
    if (nloc == 0u) { xcd_barrier_complete(bar, bx, nloc, nx); b.st[0] = nloc; b.st[1] = nx; }
    const unsigned old = xb_add(&bar[XB_XSUB(bx)], 1u);
    const unsigned gen = old / nloc;
    if (old + 1u == (gen + 1u) * nloc) {
      __builtin_amdgcn_fence(__ATOMIC_RELEASE, "agent");
      asm volatile("s_waitcnt vmcnt(0)" ::: "memory");
      const unsigned og = xb_add(&bar[XB_TOP], 1u);
      const unsigned tg = og / nx;
      if (og + 1u == (tg + 1u) * nx) xb_add(&bar[XB_TOPGEN], 1u);
      else XB_SPIN(xb_ld(&bar[XB_TOPGEN]) == tg, bar);
      __builtin_amdgcn_fence(__ATOMIC_ACQUIRE, "agent");
      xb_add(&bar[XB_XGEN(bx)], 1u);
      asm volatile("s_waitcnt vmcnt(0)" ::: "memory");
    } else {
      XB_SPIN(xb_ld(&bar[XB_XGEN(bx)]) == gen, bar);
      __builtin_amdgcn_fence(__ATOMIC_ACQUIRE, "agent");
      asm volatile("s_waitcnt vmcnt(0)" ::: "memory");
    }
  }
  __syncthreads();
}

DI void part_barrier(unsigned* cnt, unsigned target) {
  asm volatile("s_waitcnt vmcnt(0)" ::: "memory");
  __syncthreads();
  if (threadIdx.x == 0) {
    __builtin_amdgcn_s_waitcnt(0);
    __builtin_amdgcn_fence(__ATOMIC_RELEASE, "agent");
    asm volatile("s_waitcnt vmcnt(0)" ::: "memory");
    xb_add(cnt, 1u);
    unsigned sp = 0;
    while (xb_ld(cnt) < target) { __builtin_amdgcn_s_sleep(1); if (++sp > (1u << 24)) break; }
    __builtin_amdgcn_fence(__ATOMIC_ACQUIRE, "agent");
    asm volatile("s_waitcnt vmcnt(0)" ::: "memory");
  }
  __syncthreads();
}

DI void wg_publish(unsigned* flag) {
  asm volatile("s_waitcnt vmcnt(0)" ::: "memory");
  __syncthreads();
  if (threadIdx.x == 0) {
    __builtin_amdgcn_fence(__ATOMIC_RELEASE, "agent");
    asm volatile("s_waitcnt vmcnt(0)" ::: "memory");
    xb_add(flag, 1u);
  }
}
DI void wg_wait2(unsigned* f0, unsigned* f1) {
  if (threadIdx.x == 0) {
    unsigned sp = 0;
    while (xb_ld(f0) < 1u || xb_ld(f1) < 1u) { __builtin_amdgcn_s_sleep(2); if (++sp > (1u << 22)) break; }
    __builtin_amdgcn_fence(__ATOMIC_ACQUIRE, "agent");
    asm volatile("s_waitcnt vmcnt(0)" ::: "memory");
  }
  __syncthreads();
}

DI int win_orig(int n) { return n < 640 ? n : (n < 3104 ? n + 12 : (n < 3116 ? n - 3104 + 640 : -1)); }

DI void convT_tile(const float* __restrict__ src, int Nsrc, const float* __restrict__ gain, bf16* __restrict__ dst, int K,
                   int k0, int n0, int mapmode, float* tile) {
  const int tid = opq(threadIdx.x);
  {
    const int nn = tid & 63, kk = tid >> 6;
    const int n = n0 + nn;
    const int on = mapmode == 1 ? win_orig(n) : (n < Nsrc ? n : -1);
    float v[16];
#pragma unroll
    for (int it = 0; it < 16; ++it) {
      const int k = k0 + kk + 4 * it;
      v[it] = 0.f;
      if (on >= 0) v[it] = src[(size_t)k * Nsrc + on];
    }
    if (gain) {
#pragma unroll
      for (int it = 0; it < 16; ++it) v[it] *= gain[k0 + kk + 4 * it];
    }
#pragma unroll
    for (int it = 0; it < 16; ++it) tile[(kk + 4 * it) * 65 + nn] = v[it];
  }
  __syncthreads();
  {
    const int k8 = (tid & 7) * 8, nb = tid >> 3;
#pragma unroll
    for (int it = 0; it < 2; ++it) {
      const int n = nb + 32 * it;
      uint4 o;
      o.x = pack2(tile[(k8 + 0) * 65 + n], tile[(k8 + 1) * 65 + n]);
      o.y = pack2(tile[(k8 + 2) * 65 + n], tile[(k8 + 3) * 65 + n]);
      o.z = pack2(tile[(k8 + 4) * 65 + n], tile[(k8 + 5) * 65 + n]);
      o.w = pack2(tile[(k8 + 6) * 65 + n], tile[(k8 + 7) * 65 + n]);
      *(uint4*)(dst + (size_t)(n0 + n) * K + k0 + k8) = o;
    }
  }
  __syncthreads();
}

DI void phase0(const Params& p, char* smem) {
  const int tid = opq(threadIdx.x), lane = tid & 63, wv = tid >> 6;
  float* tile = (float*)smem;
  char* ws = opqp(p.ws);
  constexpr int N_WI = 2 * 50 * 16, N_WO = 2 * 16 * 16, N_WUQ = 2 * 6 * 4, N_WUKV = 2 * 8 * 2, N_WMEM = 2 * 8 * 16,
                N_WCMP = 4 * 2 * 32, N_X = T / 4, N_MEM = TM / 4, N_ROPE = 256, N_CB = 64, N_LAM = 1;
  constexpr int E0 = N_WI, E1 = E0 + N_WO, E2 = E1 + N_WUQ, E3 = E2 + N_WUKV, E4 = E3 + N_WMEM, E5 = E4 + N_WCMP,
                E6 = E5 + N_X, E7 = E6 + N_MEM, E8 = E7 + N_ROPE, E9 = E8 + N_CB, E10 = E9 + N_LAM;
  for (int it = blockIdx.x; it < E10; it += gridDim.x) {
    if (it < E0) {
      int l = it / 800, r = it % 800, nt = r / 16, kt = r % 16;
      convT_tile(p.in[3] + (size_t)l * 1024 * 3116, 3116, p.in[2] + l * 1024, (bf16*)(ws + OFF_WI + l * SZ_WI), 1024, kt * 64, nt * 64, 1, tile);
    } else if (it < E1) {
      int i = it - E0; int l = i / 256, r = i % 256, nt = r / 16, kt = r % 16;
      convT_tile(p.in[4] + (size_t)l * 1024 * 1024, 1024, nullptr, (bf16*)(ws + OFF_WO + l * SZ_WO), 1024, kt * 64, nt * 64, 0, tile);
    } else if (it < E2) {
      int i = it - E1; int l = i / 24, r = i % 24, nt = r / 4, kt = r % 4;
      convT_tile(p.in[13] + (size_t)l * 256 * 384, 384, p.in[11] + l * 256, (bf16*)(ws + OFF_WUQ + l * SZ_WUQ), 256, kt * 64, nt * 64, 0, tile);
    } else if (it < E3) {
      int i = it - E2; int l = i / 16, r = i % 16, nt = r / 2, kt = r % 2;
      convT_tile(p.in[14] + (size_t)l * 128 * 512, 512, p.in[12] + l * 128, (bf16*)(ws + OFF_WUKV + l * SZ_WUKV), 128, kt * 64, nt * 64, 0, tile);
    } else if (it < E4) {
      int i = it - E3; int l = i / 128, r = i % 128, nt = r / 16, kt = r % 16;
      convT_tile(p.in[17] + (size_t)l * 1024 * 512, 512, p.in[16] + l * 1024, (bf16*)(ws + OFF_WMEM + l * SZ_WMEM), 1024, kt * 64, nt * 64, 0, tile);
    } else if (it < E5) {
      int i = it - E4; int lj = i / 64, r = i % 64, nt = r / 32, kt = r % 32;
      convT_tile(p.in[7] + (size_t)lj * 2048 * 64, 64, nullptr, (bf16*)(ws + OFF_WCMP + lj * SZ_WCMP), 2048, kt * 64, nt * 64, 0, tile);
    } else if (it < E6) {
      int row = (it - E5) * 4 + wv;
      const float4* xr = (const float4*)(p.in[0] + (size_t)row * 1024);
      bf16* xb = (bf16*)(ws + OFF_XB) + (size_t)row * 1024;
      float ss = 0.f;
#pragma unroll
      for (int i = 0; i < 4; ++i) {
        float4 v = xr[lane + 64 * i];
        ss += v.x * v.x + v.y * v.y + v.z * v.z + v.w * v.w;
        uint2 o; o.x = pack2(v.x, v.y); o.y = pack2(v.z, v.w);
        *(uint2*)(xb + (lane + 64 * i) * 4) = o;
      }
      ss = sum64(ss);
      float* sq = (float*)(ws + OFF_SSQ) + (size_t)row * 8;
      if (lane < 8) sq[lane] = lane == 0 ? ss : 0.f;
    } else if (it < E7) {
      int row = (it - E6) * 4 + wv;
      const float4* xr = (const float4*)(p.in[1] + (size_t)row * 1024);
      bf16* xb = (bf16*)(ws + OFF_MEMB) + (size_t)row * 1024;
      float ss = 0.f;
#pragma unroll
      for (int i = 0; i < 4; ++i) {
        float4 v = xr[lane + 64 * i];
        ss += v.x * v.x + v.y * v.y + v.z * v.z + v.w * v.w;
        uint2 o; o.x = pack2(v.x, v.y); o.y = pack2(v.z, v.w);
        *(uint2*)(xb + (lane + 64 * i) * 4) = o;
      }
      ss = sum64(ss);
      if (lane == 0) ((float*)(ws + OFF_RMEM))[row] = rsqrtf(ss * (1.f / 1024.f) + EPS);
    } else if (it < E8) {
      int e = (it - E7) * 256 + tid;
      int pos = e >> 5, i = e & 31;
      float inv = powf(10000.f, -(float)i / 32.f);
      float ang = (float)pos * inv;
      double a = (double)ang;
      double n = rint(a * 0.15915494309189535);
      float r = (float)(a - n * 6.283185307179586);
      float2 cs; cs.x = __cosf(r); cs.y = __sinf(r);
      ((float2*)(ws + OFF_ROPE))[e] = cs;
    } else if (it < E9) {
      int lj = (it - E8) >> 4, sl = (it - E8) & 15;
      const float* pe = p.in[6] + (size_t)lj * 2048;
      const float* w = p.in[7] + (size_t)lj * 2048 * 64;
      int n = tid & 63, part = tid >> 6;
      float acc = 0.f;
      const int kb0 = sl * 128 + part * 32;
#pragma unroll 8
      for (int k = kb0; k < kb0 + 32; ++k) acc += pe[k] * w[(size_t)k * 64 + n];
      tile[tid] = acc;
      __syncthreads();
      if (tid < 64) ((float*)(ws + OFF_CB))[((it - E8)) * 64 + tid] = tile[tid] + tile[tid + 64] + tile[tid + 128] + tile[tid + 192];
      __syncthreads();
    } else {
      if (tid < 2) {
        const float* lf = p.in[9] + tid * 128;
        float s1 = 0.f, s2 = 0.f;
        for (int i = 0; i < 32; ++i) { s1 += lf[i] * lf[32 + i]; s2 += lf[64 + i] * lf[96 + i]; }
        float li = 0.8f - 0.6f * expf(-0.3f * (float)tid);
        ((float*)(ws + OFF_LAM))[tid] = expf(s1) - expf(s2) + li;
      }
    }
  }
}

template <int CH>
DI void gemm_tile(const bf16* __restrict__ Ab, long lda, long kcs, const bf16* __restrict__ Bb, long ldb, int nk, char* smem) {
  const int tid = opq(threadIdx.x), lane = tid & 63, wv = tid >> 6, half = lane >> 5, l31 = lane & 31;
  const int wm = wv >> 1, wn = wv & 1;
  bf16* As = (bf16*)smem;
  bf16* Bs = (bf16*)(smem + 36864);
  const int lrow = tid >> 3, lcol = (tid & 7) * 8;
  const bf16* ag = Ab + (long)lrow * lda + lcol;
  const bf16* bg = Bb + (long)lrow * ldb + lcol;
  f32x16 acc[2][2];
#pragma unroll
  for (int a = 0; a < 2; ++a)
#pragma unroll
    for (int b = 0; b < 2; ++b)
#pragma unroll
      for (int i = 0; i < 16; ++i) acc[a][b][i] = 0.f;
#define GCOMPUTE(BUF) do { \
    const bf16* as_ = As + (BUF) * 128 * 72 + (wm * 64 + l31) * 72 + half * 8; \
    const bf16* bs_ = Bs + (BUF) * 128 * 72 + (wn * 64 + l31) * 72 + half * 8; \
    bf16x8 fa[2][2], fb[2][2]; \
    fa[0][0] = *(const bf16x8*)(as_); fa[0][1] = *(const bf16x8*)(as_ + 32 * 72); \
    fb[0][0] = *(const bf16x8*)(bs_); fb[0][1] = *(const bf16x8*)(bs_ + 32 * 72); \
    _Pragma("unroll") for (int kc = 0; kc < 4; ++kc) { \
      if (kc < 3) { \
        fa[(kc + 1) & 1][0] = *(const bf16x8*)(as_ + (kc + 1) * 16); fa[(kc + 1) & 1][1] = *(const bf16x8*)(as_ + 32 * 72 + (kc + 1) * 16); \
        fb[(kc + 1) & 1][0] = *(const bf16x8*)(bs_ + (kc + 1) * 16); fb[(kc + 1) & 1][1] = *(const bf16x8*)(bs_ + 32 * 72 + (kc + 1) * 16); \
      } \
      _Pragma("unroll") for (int ni = 0; ni < 2; ++ni) \
        _Pragma("unroll") for (int mi = 0; mi < 2; ++mi) acc[ni][mi] = MFMA(fb[kc & 1][ni], fa[kc & 1][mi], acc[ni][mi]); \
    } } while (0)
  for (int c0 = 0; c0 < nk; c0 += CH) {
    u32x4 rs[2][8];
    const bf16* agc = ag + (long)c0 * kcs;
    const bf16* bgc = bg + (long)c0 * 64;
#pragma unroll
    for (int i = 0; i < 4; ++i) {
      rs[0][i] = *(const u32x4*)(agc + (long)(32 * i) * lda);
      rs[0][4 + i] = *(const u32x4*)(bgc + (long)(32 * i) * ldb);
    }
#pragma unroll
    for (int i = 0; i < 4; ++i) {
      *(u32x4*)(As + (lrow + 32 * i) * 72 + lcol) = rs[0][i];
      *(u32x4*)(Bs + (lrow + 32 * i) * 72 + lcol) = rs[0][4 + i];
    }
    if (CH > 1) {
#pragma unroll
      for (int i = 0; i < 4; ++i) {
        GLD16(rs[1][i], agc + (long)(32 * i) * lda + kcs);
        GLD16(rs[1][4 + i], bgc + (long)(32 * i) * ldb + 64);
      }
    }
    __syncthreads();
#pragma unroll
    for (int t = 0; t < CH; ++t) {
      const int bufc = t & 1;
      if (t + 2 < CH) {
#pragma unroll
        for (int i = 0; i < 4; ++i) {
          GLD16(rs[t & 1][i], agc + (long)(32 * i) * lda + (long)(t + 2) * kcs);
          GLD16(rs[t & 1][4 + i], bgc + (long)(32 * i) * ldb + (long)(t + 2) * 64);
        }
      }
      GCOMPUTE(bufc);
      if (t + 1 < CH) {
        u32x4(&rr)[8] = rs[(t + 1) & 1];
        if (t + 2 < CH) asm volatile("s_waitcnt vmcnt(8)" : "+v"(rr[0]), "+v"(rr[1]), "+v"(rr[2]), "+v"(rr[3]), "+v"(rr[4]), "+v"(rr[5]), "+v"(rr[6]), "+v"(rr[7]) :: "memory");
        else asm volatile("s_waitcnt vmcnt(0)" : "+v"(rr[0]), "+v"(rr[1]), "+v"(rr[2]), "+v"(rr[3]), "+v"(rr[4]), "+v"(rr[5]), "+v"(rr[6]), "+v"(rr[7]) :: "memory");
        bf16* ad = As + (bufc ^ 1) * 128 * 72; bf16* bd = Bs + (bufc ^ 1) * 128 * 72;
#pragma unroll
        for (int i = 0; i < 4; ++i) {
          *(u32x4*)(ad + (lrow + 32 * i) * 72 + lcol) = rr[i];
          *(u32x4*)(bd + (lrow + 32 * i) * 72 + lcol) = rr[4 + i];
        }
      }
      __syncthreads();
    }
  }
#undef GCOMPUTE
  float* Cs = (float*)smem;
#pragma unroll
  for (int ni = 0; ni < 2; ++ni)
#pragma unroll
    for (int mi = 0; mi < 2; ++mi)
#pragma unroll
      for (int g = 0; g < 4; ++g) {
        float4 v; v.x = acc[ni][mi][4 * g]; v.y = acc[ni][mi][4 * g + 1]; v.z = acc[ni][mi][4 * g + 2]; v.w = acc[ni][mi][4 * g + 3];
        *(float4*)(Cs + (wm * 64 + mi * 32 + l31) * 132 + wn * 64 + ni * 32 + 8 * g + 4 * half) = v;
      }
  __syncthreads();
}

enum { EPI_PLAIN = 0, EPI_RS8 = 1, EPI_RS1 = 2, EPI_OUT = 3 };
DI void gemm_epi(int mode, char* smem, bf16* __restrict__ Cb, long ldc, int row0, const float* __restrict__ rs,
                 const float* __restrict__ xres, float* __restrict__ xout, bf16* __restrict__ xbout, float* __restrict__ ssqout, int ntile) {
  const float* Cs = (const float*)smem;
  const int tid = opq(threadIdx.x);
#pragma unroll 2
  for (int it = 0; it < 8; ++it) {
    const int idx = it * 256 + tid;
    const int r = idx >> 4, ch = idx & 15;
    float4 v0 = *(const float4*)(Cs + r * 132 + ch * 8);
    float4 v1 = *(const float4*)(Cs + r * 132 + ch * 8 + 4);
    const long grow = row0 + r;
    if (mode == EPI_OUT) {
      if (xres) {
        const float4* xr = (const float4*)(xres + grow * 1024 + ntile * 128 + ch * 8);
        float4 x0 = xr[0], x1 = xr[1];
        v0.x += x0.x; v0.y += x0.y; v0.z += x0.z; v0.w += x0.w;
        v1.x += x1.x; v1.y += x1.y; v1.z += x1.z; v1.w += x1.w;
      } else {
        const uint4 xw = *(const uint4*)(Cb + grow * 1024 + ntile * 128 + ch * 8);
        v0.x += bflo(xw.x); v0.y += bfhi(xw.x); v0.z += bflo(xw.y); v0.w += bfhi(xw.y);
        v1.x += bflo(xw.z); v1.y += bfhi(xw.z); v1.z += bflo(xw.w); v1.w += bfhi(xw.w);
      }
      if (xout) {
        float4* xo = (float4*)(xout + grow * 1024 + ntile * 128 + ch * 8);
        xo[0] = v0; xo[1] = v1;
      }
      if (xbout) {
        float ss = v0.x * v0.x + v0.y * v0.y + v0.z * v0.z + v0.w * v0.w + v1.x * v1.x + v1.y * v1.y + v1.z * v1.z + v1.w * v1.w;
        ss = sum16(ss);
        if (ch == 0) ssqout[grow * 8 + ntile] = ss;
        uint4 o; o.x = pack2(v0.x, v0.y); o.y = pack2(v0.z, v0.w); o.z = pack2(v1.x, v1.y); o.w = pack2(v1.z, v1.w);
        *(uint4*)(xbout + grow * 1024 + ntile * 128 + ch * 8) = o;
      }
    } else {
      float sc = 1.f;
      if (mode == EPI_RS8) {
        const float4* q = (const float4*)(rs + grow * 8);
        float4 a = q[0], b = q[1];
        sc = rsqrtf((a.x + a.y + a.z + a.w + b.x + b.y + b.z + b.w) * (1.f / 1024.f) + EPS);
      } else if (mode == EPI_RS1) sc = rs[grow];
      uint4 o; o.x = pack2(v0.x * sc, v0.y * sc); o.y = pack2(v0.z * sc, v0.w * sc); o.z = pack2(v1.x * sc, v1.y * sc); o.w = pack2(v1.z * sc, v1.w * sc);
      *(uint4*)(Cb + grow * ldc + ntile * 128 + ch * 8) = o;
    }
  }
  __syncthreads();
}

DI void gemm_big(const bf16* __restrict__ Ab, long lda, const bf16* __restrict__ Bb, long ldb, int nk, char* smem, int mode,
                 bf16* __restrict__ Cb, long ldc, int row0, const float* __restrict__ rs, const float* __restrict__ xres,
                 float* __restrict__ xout, bf16* __restrict__ xbout, float* __restrict__ ssqout, int ntile) {
  const int tid = opq(threadIdx.x), lane = tid & 63, wv = tid >> 6, half = lane >> 5, l31 = lane & 31;
  const int wm = wv >> 1, wn = wv & 1;
  bf16* As = (bf16*)smem;
  bf16* Bs = (bf16*)(smem + 36864);
  const int lrow = tid >> 3, lcol = (tid & 7) * 8;
  const bf16* ag = Ab + (long)lrow * lda + lcol;
  const bf16* bg = Bb + (long)lrow * ldb + lcol;
  u32x4 ra[8], rb[4];
  f32x16 acc[2][4];
#pragma unroll
  for (int a = 0; a < 2; ++a)
#pragma unroll
    for (int b = 0; b < 4; ++b)
#pragma unroll
      for (int i = 0; i < 16; ++i) acc[a][b][i] = 0.f;
#pragma unroll
  for (int i = 0; i < 8; ++i) ra[i] = *(const u32x4*)(ag + (long)(32 * i) * lda);
#pragma unroll
  for (int i = 0; i < 4; ++i) rb[i] = *(const u32x4*)(bg + (long)(32 * i) * ldb);
#pragma unroll
  for (int i = 0; i < 8; ++i) *(u32x4*)(As + (lrow + 32 * i) * 72 + lcol) = ra[i];
#pragma unroll
  for (int i = 0; i < 4; ++i) *(u32x4*)(Bs + (lrow + 32 * i) * 72 + lcol) = rb[i];
  __syncthreads();
  for (int ks = 0; ks < nk; ++ks) {
    const bool more = ks + 1 < nk;
    if (more) {
#pragma unroll
      for (int i = 0; i < 8; ++i) GLD16(ra[i], ag + (long)(32 * i) * lda + (long)(ks + 1) * 64);
#pragma unroll
      for (int i = 0; i < 4; ++i) GLD16(rb[i], bg + (long)(32 * i) * ldb + (long)(ks + 1) * 64);
    }
    const bf16* as_ = As + (wm * 128 + l31) * 72 + half * 8;
    const bf16* bs_ = Bs + (wn * 64 + l31) * 72 + half * 8;
#pragma unroll
    for (int kc = 0; kc < 4; ++kc) {
      bf16x8 fa[4], fb[2];
#pragma unroll
      for (int mi = 0; mi < 4; ++mi) fa[mi] = *(const bf16x8*)(as_ + mi * 32 * 72 + kc * 16);
#pragma unroll
      for (int ni = 0; ni < 2; ++ni) fb[ni] = *(const bf16x8*)(bs_ + ni * 32 * 72 + kc * 16);
#pragma unroll
      for (int ni = 0; ni < 2; ++ni)
#pragma unroll
        for (int mi = 0; mi < 4; ++mi) acc[ni][mi] = MFMA(fb[ni], fa[mi], acc[ni][mi]);
    }
    __syncthreads();
    if (more) {
      asm volatile("s_waitcnt vmcnt(0)" : "+v"(ra[0]), "+v"(ra[1]), "+v"(ra[2]), "+v"(ra[3]), "+v"(ra[4]), "+v"(ra[5]), "+v"(ra[6]), "+v"(ra[7]),
                   "+v"(rb[0]), "+v"(rb[1]), "+v"(rb[2]), "+v"(rb[3]) :: "memory");
#pragma unroll
      for (int i = 0; i < 8; ++i) *(u32x4*)(As + (lrow + 32 * i) * 72 + lcol) = ra[i];
#pragma unroll
      for (int i = 0; i < 4; ++i) *(u32x4*)(Bs + (lrow + 32 * i) * 72 + lcol) = rb[i];
      __syncthreads();
    }
  }
  float* Cs = (float*)smem;
#pragma unroll
  for (int h = 0; h < 2; ++h) {
    if (wm == h) {
#pragma unroll
      for (int ni = 0; ni < 2; ++ni)
#pragma unroll
        for (int mi = 0; mi < 4; ++mi)
#pragma unroll
          for (int g = 0; g < 4; ++g) {
            float4 v; v.x = acc[ni][mi][4 * g]; v.y = acc[ni][mi][4 * g + 1]; v.z = acc[ni][mi][4 * g + 2]; v.w = acc[ni][mi][4 * g + 3];
            *(float4*)(Cs + (mi * 32 + l31) * 132 + wn * 64 + ni * 32 + 8 * g + 4 * half) = v;
          }
    }
    __syncthreads();
    gemm_epi(mode, smem, Cb, ldc, row0 + h * 128, rs, xres, xout, xbout, ssqout, ntile);
  }
}

enum { AM_NONE = 0, AM_CAUSAL = 1, AM_WIN = 2, AM_CMP = 3, AM_SLC = 4 };

template <int DK>
DI void attn_core(const bf16* __restrict__ Kp, long kstride, const bf16* __restrict__ Vp, long vstride, uint32_t tilemask,
                  int mode, int qpos, uint32_t sel, const bf16x8 (&Qf)[DK / 16], f32x16 (&O)[2], float& m_out, float& l_out, char* smem) {
  constexpr int KST = DK + 8;
  constexpr int CPR = DK / 8;
  constexpr int NCH = CPR / 4;
  bf16* Ks = (bf16*)smem;
  bf16* VTs = (bf16*)(smem + SM_VT);
  const int tid = opq(threadIdx.x), lane = tid & 63, half = lane >> 5, l31 = lane & 31;
#pragma unroll
  for (int i = 0; i < 16; ++i) { O[0][i] = 0.f; O[1][i] = 0.f; }
  float l = 0.f;
  const int qw0 = __builtin_amdgcn_readfirstlane(qpos - l31);
  const bool causal_like = (mode == AM_CAUSAL || mode == AM_WIN || mode == AM_SLC);
  int klo = 0, khi = 0x7fffffff;
  if (mode == AM_CAUSAL || mode == AM_SLC) khi = qpos;
  else if (mode == AM_WIN) { khi = qpos; klo = qpos - 511; }
  else if (mode == AM_CMP) khi = (qpos - 31) >> 4;
  u32x4 rk0, rk1, rk2, rv0, rv1;
  rk0 = rk1 = rk2 = (u32x4){0u, 0u, 0u, 0u};
  const int vkp = tid & 31, vcc = tid >> 5;
  const int vcol = (vkp >> 3) * 16 + (((vkp & 1) | ((vkp & 2) << 1) | ((vkp & 4) >> 1)) * 2);
  const int c0 = tid, c1 = tid + 256, c2_ = tid + 512;
  const int kr0 = c0 / CPR, kc0 = (c0 % CPR) * 8, kr1 = c1 / CPR, kc1 = (c1 % CPR) * 8, kr2 = c2_ / CPR, kc2 = (c2_ % CPR) * 8;
#define GLOAD(KT) do { \
    GLD16(rk0, Kp + (long)((KT) * 64 + kr0) * kstride + kc0); \
    if constexpr (NCH > 1) GLD16(rk1, Kp + (long)((KT) * 64 + kr1) * kstride + kc1); \
    if constexpr (NCH > 2) GLD16(rk2, Kp + (long)((KT) * 64 + kr2) * kstride + kc2); \
    GLD16(rv0, Vp + (long)((KT) * 64 + 2 * vkp) * vstride + vcc * 8); \
    GLD16(rv1, Vp + (long)((KT) * 64 + 2 * vkp + 1) * vstride + vcc * 8); } while (0)
#define LSTORE(BUF) do { asm volatile("s_waitcnt vmcnt(0)" : "+v"(rk0), "+v"(rk1), "+v"(rk2), "+v"(rv0), "+v"(rv1) :: "memory"); \
    *(u32x4*)(Ks + ((BUF) * 64 + kr0) * KST + kc0) = rk0; \
    if constexpr (NCH > 1) *(u32x4*)(Ks + ((BUF) * 64 + kr1) * KST + kc1) = rk1; \
    if constexpr (NCH > 2) *(u32x4*)(Ks + ((BUF) * 64 + kr2) * KST + kc2) = rk2; \
    bf16* vd = VTs + ((BUF) * 64 + vcc * 8) * 72 + vcol; \
    *(uint32_t*)(vd + 0 * 72) = (rv0.x & 0xffffu) | (rv1.x << 16); \
    *(uint32_t*)(vd + 1 * 72) = (rv0.x >> 16) | (rv1.x & 0xffff0000u); \
    *(uint32_t*)(vd + 2 * 72) = (rv0.y & 0xffffu) | (rv1.y << 16); \
    *(uint32_t*)(vd + 3 * 72) = (rv0.y >> 16) | (rv1.y & 0xffff0000u); \
    *(uint32_t*)(vd + 4 * 72) = (rv0.z & 0xffffu) | (rv1.z << 16); \
    *(uint32_t*)(vd + 5 * 72) = (rv0.z >> 16) | (rv1.z & 0xffff0000u); \
    *(uint32_t*)(vd + 6 * 72) = (rv0.w & 0xffffu) | (rv1.w << 16); \
    *(uint32_t*)(vd + 7 * 72) = (rv0.w >> 16) | (rv1.w & 0xffff0000u); } while (0)
  uint32_t rem = tilemask;
  int kt = __ffs(rem) - 1; rem &= rem - 1;
  GLOAD(kt);
#pragma unroll
  for (int kc = 0; kc < DK / 16; ++kc) asm volatile("" ::"v"(Qf[kc]));
  __syncthreads();
  LSTORE(0);
  __syncthreads();
  int buf = 0;
  while (true) {
    int ktn = -1;
    if (rem) { ktn = __ffs(rem) - 1; rem &= rem - 1; GLOAD(ktn); }
    const bool wave_active = !(causal_like && kt * 64 > qw0 + 31);
    if (wave_active) {
    f32x16 Sx[2];
#pragma unroll
    for (int kb = 0; kb < 2; ++kb) {
      bf16x8 Kf[DK / 16];
#pragma unroll
      for (int kc = 0; kc < DK / 16; ++kc) Kf[kc] = *(const bf16x8*)(Ks + (buf * 64 + kb * 32 + l31) * KST + kc * 16 + half * 8);
      __builtin_amdgcn_sched_barrier(0);
#pragma unroll
      for (int i = 0; i < 16; ++i) Sx[kb][i] = 0.f;
#pragma unroll
      for (int kc = 0; kc < DK / 16; ++kc) Sx[kb] = MFMA(Kf[kc], Qf[kc], Sx[kb]);
    }
    bf16x8 Vf[2][2][2];
#pragma unroll
    for (int kb = 0; kb < 2; ++kb)
#pragma unroll
      for (int c2 = 0; c2 < 2; ++c2)
#pragma unroll
        for (int dvb = 0; dvb < 2; ++dvb)
          Vf[kb][c2][dvb] = *(const bf16x8*)(VTs + (buf * 64 + dvb * 32 + l31) * 72 + (kb * 2 + c2) * 16 + half * 8);
    __builtin_amdgcn_sched_barrier(0);
    bool need_mask = false;
    if (mode == AM_CAUSAL) need_mask = kt * 64 + 63 > qw0;
    else if (mode == AM_WIN) need_mask = (kt * 64 + 63 > qw0) || (kt * 64 < qw0 + 31 - 511);
    else if (mode == AM_CMP) need_mask = true;
    else if (mode == AM_SLC) need_mask = (kt * 64 + 63 > qw0);
    const bool keep = !(mode == AM_SLC) || (((sel >> kt) & 1u) != 0u);
    int khe = khi;
    if (mode == AM_SLC && !((sel >> kt) & 1u)) khe = -1;
    const int kbase = kt * 64 + half * 4;
#pragma unroll
    for (int kb = 0; kb < 2; ++kb) {
      if (need_mask) {
#pragma unroll
        for (int i = 0; i < 16; ++i) {
          const int key = kbase + kb * 32 + (i >> 2) * 8 + (i & 3);
          Sx[kb][i] = (key >= klo && key <= khe) ? Sx[kb][i] : -1e30f;
        }
      }
      float ps = 0.f;
#pragma unroll
      for (int i = 0; i < 16; ++i) { float pv = fexp2(Sx[kb][i]); pv = keep ? pv : 0.f; Sx[kb][i] = pv; ps += pv; }
      l += ps;
#pragma unroll
      for (int c2 = 0; c2 < 2; ++c2) {
        uint4 pw;
        pw.x = pack2(Sx[kb][8 * c2 + 0], Sx[kb][8 * c2 + 1]); pw.y = pack2(Sx[kb][8 * c2 + 2], Sx[kb][8 * c2 + 3]);
        pw.z = pack2(Sx[kb][8 * c2 + 4], Sx[kb][8 * c2 + 5]); pw.w = pack2(Sx[kb][8 * c2 + 6], Sx[kb][8 * c2 + 7]);
        const bf16x8 pf = __builtin_bit_cast(bf16x8, pw);
#pragma unroll
        for (int dvb = 0; dvb < 2; ++dvb) O[dvb] = MFMA(Vf[kb][c2][dvb], pf, O[dvb]);
      }
      __builtin_amdgcn_sched_barrier(0);
    }
    }
    if (ktn < 0) break;
    LSTORE(buf ^ 1);
    __syncthreads();
    buf ^= 1; kt = ktn;
  }
  l_out = l + shx(l, 32);
  m_out = 0.f;
#undef GLOAD
#undef LSTORE
}

template <int DK>
DI void attn_core_dual(const bf16* __restrict__ Kp, long kstride, const bf16* __restrict__ Vp, long vstride, uint32_t tilemask,
                  int mode, int qpos, uint32_t sel, const bf16x8 (&Qf)[DK / 16], f32x16 (&O)[2], f32x16 (&O2)[2], float& l_out, float& l2_out, char* smem) {
  constexpr int KST = DK + 8;
  constexpr int CPR = DK / 8;
  constexpr int NCH = CPR / 4;
  bf16* Ks = (bf16*)smem;
  bf16* VTs = (bf16*)(smem + SM_VT);
  const int tid = opq(threadIdx.x), lane = tid & 63, half = lane >> 5, l31 = lane & 31;
#pragma unroll
  for (int i = 0; i < 16; ++i) { O[0][i] = 0.f; O[1][i] = 0.f; O2[0][i] = 0.f; O2[1][i] = 0.f; }
  float l = 0.f, l2 = 0.f;
  const int qw0 = __builtin_amdgcn_readfirstlane(qpos - l31);
  const bool causal_like = (mode == AM_CAUSAL || mode == AM_WIN || mode == AM_SLC);
  int klo = 0, khi = 0x7fffffff;
  if (mode == AM_CAUSAL || mode == AM_SLC) khi = qpos;
  else if (mode == AM_WIN) { khi = qpos; klo = qpos - 511; }
  else if (mode == AM_CMP) khi = (qpos - 31) >> 4;
  u32x4 rk0, rk1, rk2, rv0, rv1;
  rk0 = rk1 = rk2 = (u32x4){0u, 0u, 0u, 0u};
  const int vkp = tid & 31, vcc = tid >> 5;
  const int vcol = (vkp >> 3) * 16 + (((vkp & 1) | ((vkp & 2) << 1) | ((vkp & 4) >> 1)) * 2);
  const int c0 = tid, c1 = tid + 256, c2_ = tid + 512;
  const int kr0 = c0 / CPR, kc0 = (c0 % CPR) * 8, kr1 = c1 / CPR, kc1 = (c1 % CPR) * 8, kr2 = c2_ / CPR, kc2 = (c2_ % CPR) * 8;
#define GLOAD(KT) do { \
    GLD16(rk0, Kp + (long)((KT) * 64 + kr0) * kstride + kc0); \
    if constexpr (NCH > 1) GLD16(rk1, Kp + (long)((KT) * 64 + kr1) * kstride + kc1); \
    if constexpr (NCH > 2) GLD16(rk2, Kp + (long)((KT) * 64 + kr2) * kstride + kc2); \
    GLD16(rv0, Vp + (long)((KT) * 64 + 2 * vkp) * vstride + vcc * 8); \
    GLD16(rv1, Vp + (long)((KT) * 64 + 2 * vkp + 1) * vstride + vcc * 8); } while (0)
#define LSTORE(BUF) do { asm volatile("s_waitcnt vmcnt(0)" : "+v"(rk0), "+v"(rk1), "+v"(rv0), "+v"(rv1) :: "memory"); \
    *(u32x4*)(Ks + ((BUF) * 64 + kr0) * KST + kc0) = rk0; \
    if constexpr (NCH > 1) *(u32x4*)(Ks + ((BUF) * 64 + kr1) * KST + kc1) = rk1; \
    if constexpr (NCH > 2) *(u32x4*)(Ks + ((BUF) * 64 + kr2) * KST + kc2) = rk2; \
    bf16* vd = VTs + ((BUF) * 64 + vcc * 8) * 72 + vcol; \
    *(uint32_t*)(vd + 0 * 72) = (rv0.x & 0xffffu) | (rv1.x << 16); \
    *(uint32_t*)(vd + 1 * 72) = (rv0.x >> 16) | (rv1.x & 0xffff0000u); \
    *(uint32_t*)(vd + 2 * 72) = (rv0.y & 0xffffu) | (rv1.y << 16); \
    *(uint32_t*)(vd + 3 * 72) = (rv0.y >> 16) | (rv1.y & 0xffff0000u); \
    *(uint32_t*)(vd + 4 * 72) = (rv0.z & 0xffffu) | (rv1.z << 16); \
    *(uint32_t*)(vd + 5 * 72) = (rv0.z >> 16) | (rv1.z & 0xffff0000u); \
    *(uint32_t*)(vd + 6 * 72) = (rv0.w & 0xffffu) | (rv1.w << 16); \
    *(uint32_t*)(vd + 7 * 72) = (rv0.w >> 16) | (rv1.w & 0xffff0000u); } while (0)
  uint32_t rem = tilemask;
  int kt = __ffs(rem) - 1; rem &= rem - 1;
  GLOAD(kt);
#pragma unroll
  for (int kc = 0; kc < DK / 16; ++kc) asm volatile("" ::"v"(Qf[kc]));
  __syncthreads();
  LSTORE(0);
  __syncthreads();
  int buf = 0;
  while (true) {
    int ktn = -1;
    if (rem) { ktn = __ffs(rem) - 1; rem &= rem - 1; GLOAD(ktn); }
    const bool wave_active = !(causal_like && kt * 64 > qw0 + 31);
    if (wave_active) {
    const bool need_mask = kt * 64 + 63 > qw0;
    const int kbase = kt * 64 + half * 4;
#pragma unroll
    for (int mp = 0; mp < 2; ++mp) {
      f32x16 Sx[2];
#pragma unroll
      for (int kb = 0; kb < 2; ++kb) {
        bf16x8 k0 = *(const bf16x8*)(Ks + (buf * 64 + kb * 32 + l31) * KST + (2 * mp) * 16 + half * 8);
        bf16x8 k1 = *(const bf16x8*)(Ks + (buf * 64 + kb * 32 + l31) * KST + (2 * mp + 1) * 16 + half * 8);
#pragma unroll
        for (int i = 0; i < 16; ++i) Sx[kb][i] = 0.f;
        Sx[kb] = MFMA(k0, Qf[2 * mp], Sx[kb]);
        Sx[kb] = MFMA(k1, Qf[2 * mp + 1], Sx[kb]);
      }
#pragma unroll
      for (int kb = 0; kb < 2; ++kb) {
        if (need_mask) {
#pragma unroll
          for (int i = 0; i < 16; ++i) {
            const int key = kbase + kb * 32 + (i >> 2) * 8 + (i & 3);
            Sx[kb][i] = (key <= khi) ? Sx[kb][i] : -1e30f;
          }
        }
        bf16x8 Vf[2][2];
#pragma unroll
        for (int c2 = 0; c2 < 2; ++c2)
#pragma unroll
          for (int dvb = 0; dvb < 2; ++dvb)
            Vf[c2][dvb] = *(const bf16x8*)(VTs + (buf * 64 + dvb * 32 + l31) * 72 + (kb * 2 + c2) * 16 + half * 8);
        float ps = 0.f;
#pragma unroll
        for (int i = 0; i < 16; ++i) { float pv = fexp2(Sx[kb][i]); Sx[kb][i] = pv; ps += pv; }
        if (mp == 0) l += ps; else l2 += ps;
#pragma unroll
        for (int c2 = 0; c2 < 2; ++c2) {
          uint4 pw;
          pw.x = pack2(Sx[kb][8 * c2 + 0], Sx[kb][8 * c2 + 1]); pw.y = pack2(Sx[kb][8 * c2 + 2], Sx[kb][8 * c2 + 3]);
          pw.z = pack2(Sx[kb][8 * c2 + 4], Sx[kb][8 * c2 + 5]); pw.w = pack2(Sx[kb][8 * c2 + 6], Sx[kb][8 * c2 + 7]);
          const bf16x8 pf = __builtin_bit_cast(bf16x8, pw);
#pragma unroll
          for (int dvb = 0; dvb < 2; ++dvb) {
            if (mp == 0) O[dvb] = MFMA(Vf[c2][dvb], pf, O[dvb]); else O2[dvb] = MFMA(Vf[c2][dvb], pf, O2[dvb]);
          }
        }
        __builtin_amdgcn_sched_barrier(0);
      }
    }
    }
    if (ktn < 0) break;
    LSTORE(buf ^ 1);
    __syncthreads();
    buf ^= 1; kt = ktn;
  }
  l_out = l + shx(l, 32);
  l2_out = l2 + shx(l2, 32);
#undef GLOAD
#undef LSTORE
}

template <int DK>
DI void load_q(const bf16* __restrict__ Qrow, bf16x8 (&Qf)[DK / 16]) {
  const int half = (opq(threadIdx.x) & 63) >> 5;
#pragma unroll
  for (int kc = 0; kc < DK / 16; ++kc) Qf[kc] = *(const bf16x8*)(Qrow + kc * 16 + half * 8);
}

DI void vec64(bool active, const bf16* src, const float* bias, int nbias, bf16* dst, const float* gain, const float2* rp, float scale, int j, const bf16* src2 = nullptr) {
  float a0 = 0.f, a1 = 0.f, b0 = 0.f, b1 = 0.f;
  if (active) {
    uint32_t lo = *(const uint32_t*)(src + 2 * j), hi = *(const uint32_t*)(src + 32 + 2 * j);
    a0 = bflo(lo); a1 = bfhi(lo); b0 = bflo(hi); b1 = bfhi(hi);
    if (src2) {
#pragma unroll
      for (int q = 0; q < 3; ++q) {
        const bf16* sq_ = src2 + (size_t)q * 2 * 1024 * 128;
        lo = *(const uint32_t*)(sq_ + 2 * j); hi = *(const uint32_t*)(sq_ + 32 + 2 * j); a0 += bflo(lo); a1 += bfhi(lo); b0 += bflo(hi); b1 += bfhi(hi);
      }
    }
    for (int sidx = 0; sidx < nbias; ++sidx) {
      const float* bb = bias + sidx * 64;
      a0 += bb[2 * j]; a1 += bb[2 * j + 1]; b0 += bb[32 + 2 * j]; b1 += bb[33 + 2 * j];
    }
  }
  float ss = a0 * a0 + a1 * a1 + b0 * b0 + b1 * b1;
  ss = sum16(ss);
  const float r = rsqrtf(ss * (1.f / 64.f) + EPS);
  if (active) {
    a0 *= r * gain[2 * j]; a1 *= r * gain[2 * j + 1]; b0 *= r * gain[32 + 2 * j]; b1 *= r * gain[33 + 2 * j];
    if (rp) {
      const float2 c0 = rp[2 * j], c1 = rp[2 * j + 1];
      const float t0 = a0 * c0.x - b0 * c0.y, u0 = b0 * c0.x + a0 * c0.y;
      const float t1 = a1 * c1.x - b1 * c1.y, u1 = b1 * c1.x + a1 * c1.y;
      a0 = t0; b0 = u0; a1 = t1; b1 = u1;
    }
    *(uint32_t*)(dst + 2 * j) = pack2(a0 * scale, a1 * scale);
    *(uint32_t*)(dst + 32 + 2 * j) = pack2(b0 * scale, b1 * scale);
  }
}
template <int G>
DI void nr4(uint32_t lo, uint32_t hi, float invn, float g0, float g1, float g2, float g3, bool rope, float2 c0, float2 c1, float scale,
            uint32_t& olo, uint32_t& ohi) {
  float a0 = bflo(lo), a1 = bfhi(lo), b0 = bflo(hi), b1 = bfhi(hi);
  float ss = a0 * a0 + a1 * a1 + b0 * b0 + b1 * b1;
  ss = (G == 16) ? sum16(ss) : sum8(ss);
  const float r = rsqrtf(ss * invn + EPS);
  a0 *= r * g0; a1 *= r * g1; b0 *= r * g2; b1 *= r * g3;
  if (rope) {
    const float t0 = a0 * c0.x - b0 * c0.y, u0 = b0 * c0.x + a0 * c0.y;
    const float t1 = a1 * c1.x - b1 * c1.y, u1 = b1 * c1.x + a1 * c1.y;
    a0 = t0; b0 = u0; a1 = t1; b1 = u1;
  }
  olo = pack2(a0 * scale, a1 * scale); ohi = pack2(b0 * scale, b1 * scale);
}

struct PrepR {
  uint32_t q_lo, q_hi, p2_lo, p2_hi, p3_lo, p3_hi, dq_lo, dq_hi, dk_lo, dk_hi, glv, ckw, uqa, uqb, kra, krb;
  uint2 cw, nw, kw2, vw;
  float2 c0, c1, e0, e1;
};
struct PrepG {
  float gq0, gq1, gq2, gq3, h0, h1, h2, h3, m0, m1, m2, m3, dq0, dq1, dq2, dq3, dk0, dk1, dk2, dk3;
  float mgq0, mgq1, mgq2, mgq3, mgq4, mgq5, mgk0, mgk1, mgk2, mgk3, mgk4, mgk5;
};
DI void prep_load(char* ws, int t, int lane, PrepR& R) {
  const int j16 = lane & 15, g16 = lane >> 4, j8 = lane & 7, g8 = lane >> 3;
  const int s = t & 2047;
  const bf16* ur = (const bf16*)(ws + OFF_U) + (size_t)t * NP;
  const float2* rp = (const float2*)(ws + OFF_ROPE) + s * 32;
  const int col2 = g16 == 0 ? C_KS : (g16 == 1 ? C_KW : C_MQ + (g16 - 2) * 64);
  const int col3 = C_MQ + (2 + (g16 & 1)) * 64;
  const bf16* uq = (const bf16*)(ws + OFF_UQ + (size_t)(t >> 11) * SLAB) + (size_t)s * 384 + g16 * 96;
  const bf16* uk = (const bf16*)(ws + OFF_UKV + (size_t)(t >> 11) * SLAB) + (size_t)s * 512 + g16 * 128;
  R.q_lo = *(const uint32_t*)(ur + C_NQ + g16 * 64 + 2 * j16); R.q_hi = *(const uint32_t*)(ur + C_NQ + g16 * 64 + 32 + 2 * j16);
  R.p2_lo = *(const uint32_t*)(ur + col2 + 2 * j16); R.p2_hi = *(const uint32_t*)(ur + col2 + 32 + 2 * j16);
  R.p3_lo = *(const uint32_t*)(ur + col3 + 2 * j16); R.p3_hi = *(const uint32_t*)(ur + col3 + 32 + 2 * j16);
  R.dq_lo = *(const uint32_t*)(ur + C_DQ + g8 * 32 + 2 * j8); R.dq_hi = *(const uint32_t*)(ur + C_DQ + g8 * 32 + 16 + 2 * j8);
  R.dk_lo = *(const uint32_t*)(ur + C_DK + g8 * 32 + 2 * j8); R.dk_hi = *(const uint32_t*)(ur + C_DK + g8 * 32 + 16 + 2 * j8);
  R.glv = ur[C_GL + (lane < 12 ? lane : 0)];
  R.cw = *(const uint2*)(ur + C_CQ + lane * 4);
  R.ckw = *(const uint32_t*)(ur + C_CKV + lane * 2);
  R.nw = *(const uint2*)(uq + 4 * j16);
  R.uqa = uq[64 + j16]; R.uqb = uq[80 + j16];
  R.kw2 = *(const uint2*)(uk + 4 * j16);
  R.vw = *(const uint2*)(uk + 64 + 4 * j16);
  R.kra = ur[C_KR + j16]; R.krb = ur[C_KR + 16 + j16];
  R.c0 = rp[2 * j16]; R.c1 = rp[2 * j16 + 1];
  R.e0 = rp[4 * j8]; R.e1 = rp[4 * j8 + 2];
}
DI void prep_fin(char* ws, int t, int lane, const PrepR& R, const PrepG& G) {
  const int j16 = lane & 15, g16 = lane >> 4, j8 = lane & 7, g8 = lane >> 3;
  const float qs64 = 0.125f * LOG2E, qs32 = 0.17677669529663687f * LOG2E, qs96 = 0.10206207261596577f * LOG2E;
  const int b = t >> 11, s = t & 2047;
  bf16* ur = (bf16*)(ws + OFF_U) + (size_t)t * NP;
  const int col2 = g16 == 0 ? C_KS : (g16 == 1 ? C_KW : C_MQ + (g16 - 2) * 64);
  const int col3 = C_MQ + (2 + (g16 & 1)) * 64;
  const float2 c0 = R.c0, c1 = R.c1, e0 = R.e0, e1 = R.e1;
  uint32_t olo, ohi;
  nr4<16>(R.q_lo, R.q_hi, 1.f / 64.f, G.gq0, G.gq1, G.gq2, G.gq3, true, c0, c1, qs64, olo, ohi);
  *(uint32_t*)(ur + C_NQ + g16 * 64 + 2 * j16) = olo; *(uint32_t*)(ur + C_NQ + g16 * 64 + 32 + 2 * j16) = ohi;
  nr4<16>(R.p2_lo, R.p2_hi, 1.f / 64.f, G.h0, G.h1, G.h2, G.h3, g16 < 2, c0, c1, g16 < 2 ? 1.f : qs64, olo, ohi);
  *(uint32_t*)(ur + col2 + 2 * j16) = olo; *(uint32_t*)(ur + col2 + 32 + 2 * j16) = ohi;
  nr4<16>(R.p3_lo, R.p3_hi, 1.f / 64.f, G.m0, G.m1, G.m2, G.m3, false, c0, c1, qs64, olo, ohi);
  if (g16 < 2) { *(uint32_t*)(ur + col3 + 2 * j16) = olo; *(uint32_t*)(ur + col3 + 32 + 2 * j16) = ohi; }
  nr4<8>(R.dq_lo, R.dq_hi, 1.f / 32.f, G.dq0, G.dq1, G.dq2, G.dq3, true, e0, e1, qs32, olo, ohi);
  *(uint32_t*)(ur + C_DQ + g8 * 32 + 2 * j8) = olo; *(uint32_t*)(ur + C_DQ + g8 * 32 + 16 + 2 * j8) = ohi;
  nr4<8>(R.dk_lo, R.dk_hi, 1.f / 32.f, G.dk0, G.dk1, G.dk2, G.dk3, true, e0, e1, 1.f, olo, ohi);
  *(uint32_t*)(ur + C_DK + g8 * 32 + 2 * j8) = olo; *(uint32_t*)(ur + C_DK + g8 * 32 + 16 + 2 * j8) = ohi;
  if (lane < 12) ((float*)(ws + OFF_GT))[(size_t)t * 12 + lane] = sigmoidf_(bf2f(R.glv));
  float sq, skv;
  {
    float c0f = bflo(R.cw.x), c1f = bfhi(R.cw.x), c2f = bflo(R.cw.y), c3f = bfhi(R.cw.y);
    float ss = c0f * c0f + c1f * c1f + c2f * c2f + c3f * c3f;
    float d0 = bflo(R.ckw), d1 = bfhi(R.ckw);
    float s2 = d0 * d0 + d1 * d1;
    ss = sum64(ss); s2 = sum64(s2);
    sq = rsqrtf(ss * (1.f / 256.f) + EPS);
    skv = rsqrtf(s2 * (1.f / 128.f) + EPS);
  }
  {
    const int h = g16, j = j16;
    float n0 = bflo(R.nw.x) * sq, n1 = bfhi(R.nw.x) * sq, n2 = bflo(R.nw.y) * sq, n3 = bfhi(R.nw.y) * sq;
    float ra = bf2f(R.uqa) * sq, rb = bf2f(R.uqb) * sq;
    float r1 = ra * c0.x - rb * c0.y, r2 = rb * c0.x + ra * c0.y;
    float ss = n0 * n0 + n1 * n1 + n2 * n2 + n3 * n3 + r1 * r1 + r2 * r2;
    ss = sum16(ss);
    float r = rsqrtf(ss * (1.f / 96.f) + EPS) * qs96;
    bf16* qd = (bf16*)(ws + OFF_QM) + ((size_t)(b * 4 + h) * S + s) * 96;
    uint2 o; o.x = pack2(n0 * r * G.mgq0, n1 * r * G.mgq1); o.y = pack2(n2 * r * G.mgq2, n3 * r * G.mgq3);
    *(uint2*)(qd + 4 * j) = o;
    qd[64 + j] = f2bf(r1 * r * G.mgq4);
    qd[80 + j] = f2bf(r2 * r * G.mgq5);
    float k0 = bflo(R.kw2.x) * skv, k1 = bfhi(R.kw2.x) * skv, k2 = bflo(R.kw2.y) * skv, k3 = bfhi(R.kw2.y) * skv;
    float ka = bf2f(R.kra), kb = bf2f(R.krb);
    float kr1 = ka * c0.x - kb * c0.y, kr2 = kb * c0.x + ka * c0.y;
    float s3 = k0 * k0 + k1 * k1 + k2 * k2 + k3 * k3 + kr1 * kr1 + kr2 * kr2;
    s3 = sum16(s3);
    float rk_ = rsqrtf(s3 * (1.f / 96.f) + EPS);
    bf16* kd = (bf16*)(ws + OFF_KM) + ((size_t)(b * 4 + h) * S + s) * 96;
    uint2 o2; o2.x = pack2(k0 * rk_ * G.mgk0, k1 * rk_ * G.mgk1); o2.y = pack2(k2 * rk_ * G.mgk2, k3 * rk_ * G.mgk3);
    *(uint2*)(kd + 4 * j) = o2;
    kd[64 + j] = f2bf(kr1 * rk_ * G.mgk4);
    kd[80 + j] = f2bf(kr2 * rk_ * G.mgk5);
    uint2 o3; o3.x = pack2(bflo(R.vw.x) * skv, bfhi(R.vw.x) * skv); o3.y = pack2(bflo(R.vw.y) * skv, bfhi(R.vw.y) * skv);
    *(uint2*)((bf16*)(ws + OFF_MV) + ((size_t)(b * 4 + h) * S + s) * 64 + 4 * j) = o3;
  }
}

DI void prep_phase(const Params& p, int layer) {
  const int tid = opq(threadIdx.x), lane = tid & 63, wv = tid >> 6;
  char* ws = opqp(p.ws);
  const float2* rope = (const float2*)(ws + OFF_ROPE);
  const float* nsa_g = p.in[5] + layer * 256;
  const float* diff_g = p.in[8] + layer * 64;
  const float* mla_g = p.in[15] + layer * 192;
  const float* mem_g = p.in[18] + layer * 128;
  constexpr int N_TOK = T / 4, N_MEMT = TM / 4, N_CMP = 1024 / 4;
  const int j16 = lane & 15, g16 = lane >> 4, j8 = lane & 7;
  PrepG G;
  G.gq0 = nsa_g[2 * j16]; G.gq1 = nsa_g[2 * j16 + 1]; G.gq2 = nsa_g[32 + 2 * j16]; G.gq3 = nsa_g[33 + 2 * j16];
  const float* g2p = g16 == 0 ? nsa_g + 128 : (g16 == 1 ? nsa_g + 192 : mem_g);
  G.h0 = g2p[2 * j16]; G.h1 = g2p[2 * j16 + 1]; G.h2 = g2p[32 + 2 * j16]; G.h3 = g2p[33 + 2 * j16];
  G.m0 = mem_g[2 * j16]; G.m1 = mem_g[2 * j16 + 1]; G.m2 = mem_g[32 + 2 * j16]; G.m3 = mem_g[33 + 2 * j16];
  G.dq0 = diff_g[2 * j8]; G.dq1 = diff_g[2 * j8 + 1]; G.dq2 = diff_g[16 + 2 * j8]; G.dq3 = diff_g[17 + 2 * j8];
  G.dk0 = diff_g[32 + 2 * j8]; G.dk1 = diff_g[33 + 2 * j8]; G.dk2 = diff_g[48 + 2 * j8]; G.dk3 = diff_g[49 + 2 * j8];
  G.mgq0 = mla_g[4 * j16]; G.mgq1 = mla_g[4 * j16 + 1]; G.mgq2 = mla_g[4 * j16 + 2]; G.mgq3 = mla_g[4 * j16 + 3];
  G.mgq4 = mla_g[64 + j16]; G.mgq5 = mla_g[80 + j16];
  G.mgk0 = mla_g[96 + 4 * j16]; G.mgk1 = mla_g[96 + 4 * j16 + 1]; G.mgk2 = mla_g[96 + 4 * j16 + 2]; G.mgk3 = mla_g[96 + 4 * j16 + 3];
  G.mgk4 = mla_g[96 + 64 + j16]; G.mgk5 = mla_g[96 + 80 + j16];
  const int xcd = blockIdx.x & 7, rk = blockIdx.x >> 3, nrk = gridDim.x >> 3;
  for (int i = rk; i < 512; i += 2 * nrk) {
    const int it = xcd * 512 + i;
    const bool has2 = i + nrk < 512;
    const int it2 = has2 ? it + nrk : it;
    const int tA = it * 4 + wv, tB = it2 * 4 + wv;
    PrepR A, B;
    prep_load(ws, tA, lane, A);
    prep_load(ws, tB, lane, B);
    prep_fin(ws, tA, lane, A, G);
    if (has2) prep_fin(ws, tB, lane, B, G);
  }
  for (int i = rk; i < 96; i += nrk) {
    const int it = i < 64 ? N_TOK + xcd * 64 + i : N_TOK + N_MEMT + xcd * 32 + (i - 64);
    if (false) {
    } else if (it < N_TOK + N_MEMT) {
      const int t = (it - N_TOK) * 4 + wv;
      const int b = t >> 8, mi = t & 255;
      const bf16* kr = (const bf16*)(ws + OFF_KMEMRAW) + (size_t)t * 512;
      const int h = lane >> 4;
      uint2 vw = *(const uint2*)(kr + 256 + lane * 4);
      vec64(true, kr + h * 64, nullptr, 0, (bf16*)(ws + OFF_MK) + ((size_t)(b * 4 + h) * ML + mi) * 64, mem_g + 64, nullptr, 1.f, j16);
      *(uint2*)((bf16*)(ws + OFF_MVV) + ((size_t)(b * 4 + h) * ML + mi) * 64 + j16 * 4) = vw;
    } else {
      const int r = (it - N_TOK - N_MEMT) * 4 + wv;
      const int n = r & 127;
      const bf16* kraw = (const bf16*)(ws + OFF_CMPRAW) + (size_t)r * 128;
      const bf16* vraw = (const bf16*)(ws + OFF_CMPRAW) + (size_t)(1024 + r) * 128;
      const float* cbk = (const float*)(ws + OFF_CB) + (size_t)(layer * 2 + 0) * 16 * 64;
      const float* cbv = (const float*)(ws + OFF_CB) + (size_t)(layer * 2 + 1) * 16 * 64;
      bf16* kd = (bf16*)(ws + OFF_KCN) + (size_t)r * 64;
      bf16* vd = (bf16*)(ws + OFF_VCN) + (size_t)r * 64;
      if (n < 127) {
        const int pos = 16 * n + 31;
        float bv = 0.f;
#pragma unroll
        for (int sidx = 0; sidx < 16; ++sidx) bv += cbv[sidx * 64 + lane];
        const float vv = bf2f(vraw[lane]) + bf2f(vraw[(size_t)2 * 1024 * 128 + lane]) + bf2f(vraw[(size_t)4 * 1024 * 128 + lane]) + bf2f(vraw[(size_t)6 * 1024 * 128 + lane]) + bv;
        vec64(lane < 16, kraw, cbk, 16, kd, nsa_g + 64, rope + pos * 32, 1.f, lane & 15, kraw + (size_t)2 * 1024 * 128);
        vd[lane] = f2bf(vv);
      } else {
        kd[lane] = 0; vd[lane] = 0;
      }
    }
  }
}

DI void st4(bf16* dst, float a, float b, float c, float d) { uint2 o; o.x = pack2(a, b); o.y = pack2(c, d); *(uint2*)dst = o; }

DI void attn_phaseA(const Params& p, int layer, char* smem, int* ctr) {
  char* ws = opqp(p.ws);
  bf16* u = (bf16*)(ws + OFF_U);
  bf16* y = (bf16*)(ws + OFF_Y);
  const float* gt = (const float*)(ws + OFF_GT);
  int* s_item = (int*)(smem + SM_MISC);
  const int xcd = blockIdx.x & 7;
  while (true) {
    __syncthreads();
    if (threadIdx.x == 0) *s_item = atomicAdd(ctr + 24 + xcd, 1);
    __syncthreads();
    const int item = *s_item;
    if (item >= 16) break;
    {
      const int tid = opq(threadIdx.x), lane = tid & 63, wv = tid >> 6, half = lane >> 5, l31 = lane & 31;
      const int i2 = item;
      const int qb = 15 - i2, b = xcd;
      const int q0 = qb * 128, qpos = q0 + wv * 32 + l31;
      const size_t t = (size_t)b * S + qpos;
      const bf16* ub = u + (size_t)b * S * NP;
      const bf16* kc = (const bf16*)(ws + OFF_KCN) + (size_t)b * 128 * 64;
      const bf16* vc = (const bf16*)(ws + OFF_VCN) + (size_t)b * 128 * 64;
      const uint32_t tm = (q0 + 127 >= 16 * 64 + 31) ? 3u : 1u;
      float* scl = (float*)(smem + SM_SC) + wv * 32 * 33;
#pragma unroll
      for (int g = 0; g < 16; ++g) scl[l31 * 33 + 2 * g + half] = 0.f;
      const int khi = (qpos - 31) >> 4;
#pragma unroll 1
      for (int h = 0; h < 4; ++h) {
        f32x16 O[2]; float mm, ll;
        bf16x8 Qf[4];
        load_q<64>(ub + (size_t)qpos * NP + C_NQ + h * 64, Qf);
        attn_core<64>(kc, 64, vc, 64, tm, AM_CMP, qpos, 0u, Qf, O, mm, ll, smem);
        const float inv = ll > 0.f ? 1.f / ll : 0.f;
        const float sc = inv * gt[t * 12 + h];
        bf16* od = (bf16*)(ws + OFF_OCMP) + t * 256 + h * 64;
#pragma unroll
        for (int dvb = 0; dvb < 2; ++dvb)
#pragma unroll
          for (int g = 0; g < 4; ++g)
            st4(od + dvb * 32 + 8 * g + 4 * half, O[dvb][4 * g] * sc, O[dvb][4 * g + 1] * sc, O[dvb][4 * g + 2] * sc, O[dvb][4 * g + 3] * sc);
        const float mu = mm < -1e29f ? 0.f : mm;
        const bf16* Ks = (const bf16*)smem;
        float Aa[16], Cc[16];
#pragma unroll
        for (int g = 0; g < 16; ++g) { Aa[g] = 0.f; Cc[g] = 0.f; }
#pragma unroll
        for (int kt = 0; kt < 2; ++kt) {
          if (tm & (1u << kt)) {
#pragma unroll
            for (int kb = 0; kb < 2; ++kb) {
              f32x16 Sx;
#pragma unroll
              for (int i = 0; i < 16; ++i) Sx[i] = 0.f;
#pragma unroll
              for (int kcx = 0; kcx < 4; ++kcx) {
                bf16x8 a = *(const bf16x8*)(Ks + (kt * 64 + kb * 32 + l31) * 72 + kcx * 16 + half * 8);
                Sx = MFMA(a, Qf[kcx], Sx);
              }
#pragma unroll
              for (int gg = 0; gg < 4; ++gg) {
                float pv[4];
#pragma unroll
                for (int e = 0; e < 4; ++e) {
                  const int key = kt * 64 + kb * 32 + gg * 8 + half * 4 + e;
                  pv[e] = key <= khi ? fexp2(Sx[gg * 4 + e] - mu) * inv : 0.f;
                }
                Aa[kt * 8 + kb * 4 + gg] += pv[0] + 2.f * (pv[1] + pv[2] + pv[3]);
                Cc[kt * 8 + kb * 4 + gg] += pv[0];
              }
            }
          }
        }
        {
          float rc[16];
#pragma unroll
          for (int g = 0; g < 16; ++g) rc[g] = shx(Cc[g], 32);
#pragma unroll
          for (int g = 0; g < 16; ++g) {
            const float nx = half == 0 ? rc[g] : (g < 15 ? rc[g < 15 ? g + 1 : 15] : 0.f);
            scl[l31 * 33 + 2 * g + half] += Aa[g] + nx;
          }
        }
      }
      __syncthreads();
      {
        float sv[32];
        const int cur = qpos >> 6;
#pragma unroll
        for (int j = 0; j < 32; ++j) {
          float v = scl[l31 * 33 + j];
          const bool forced = (j == 0) || (j == cur) || (j == cur - 1);
          sv[j] = j > cur ? -1e30f : (forced ? 1e30f : v);
        }
        uint32_t bits = 0;
#pragma unroll 1
        for (int jj = 0; jj < 16; ++jj) {
          const int j = half * 16 + jj;
          float sj = scl[l31 * 33 + j];
          const bool fj = (j == 0) || (j == cur) || (j == cur - 1);
          sj = j > cur ? -1e30f : (fj ? 1e30f : sj);
          int rank = 0;
#pragma unroll
          for (int i = 0; i < 32; ++i) rank += (sv[i] > sj || (sv[i] == sj && i < j)) ? 1 : 0;
          if (rank < 16) bits |= 1u << j;
        }
        bits |= (uint32_t)__shfl_xor((int)bits, 32);
        if (half == 0) ((uint32_t*)(ws + OFF_SEL))[t] = bits;
      }
      wg_publish((unsigned*)(ws + OFF_FLAG) + layer * 1024 + (b * 16 + qb) * 8);
    }
  }
  while (true) {
    __syncthreads();
    if (threadIdx.x == 0) *s_item = atomicAdd(ctr + 16 + xcd, 1);
    __syncthreads();
    const int item = *s_item;
    if (item >= 128) break;
    {
      const int tid = opq(threadIdx.x), lane = tid & 63, wv = tid >> 6, half = lane >> 5, l31 = lane & 31;
      const int i2 = item;
      const int ismem = i2 >> 6, r = i2 & 63, qb = 15 - (r >> 2), b = xcd, h = r & 3;
      const int q0 = qb * 128, qpos = q0 + wv * 32 + l31;
      const size_t t = (size_t)b * S + qpos;
      const bf16* ub = u + (size_t)b * S * NP;
      f32x16 O[2]; float mm, ll;
      bf16x8 Qf[4];
      if (!ismem) {
        load_q<64>(ub + (size_t)qpos * NP + C_NQ + h * 64, Qf);
        const int kt0 = q0 >= 512 ? (q0 - 512) / 64 : 0, kt1 = 2 * qb + 2;
        const uint32_t hi = kt1 >= 32 ? 0xffffffffu : ((1u << kt1) - 1u);
        const uint32_t tm = hi & ~((1u << kt0) - 1u);
        attn_core<64>(ub + C_KW, NP, ub + C_VW, NP, tm, AM_WIN, qpos, 0u, Qf, O, mm, ll, smem);
        const float sc = (ll > 0.f ? 1.f / ll : 0.f) * gt[t * 12 + 8 + h];
        bf16* od = (bf16*)(ws + OFF_OWIN) + t * 256 + h * 64;
#pragma unroll
        for (int dvb = 0; dvb < 2; ++dvb)
#pragma unroll
          for (int g = 0; g < 4; ++g)
            st4(od + dvb * 32 + 8 * g + 4 * half, O[dvb][4 * g] * sc, O[dvb][4 * g + 1] * sc, O[dvb][4 * g + 2] * sc, O[dvb][4 * g + 3] * sc);
        wg_publish((unsigned*)(ws + OFF_FLAG) + layer * 1024 + (b * 16 + qb) * 8 + 1 + h);
      } else {
        load_q<64>(ub + (size_t)qpos * NP + C_MQ + h * 64, Qf);
        attn_core<64>((const bf16*)(ws + OFF_MK) + (size_t)(b * 4 + h) * ML * 64, 64, (const bf16*)(ws + OFF_MVV) + (size_t)(b * 4 + h) * ML * 64, 64,
                      0xfu, AM_NONE, qpos, 0u, Qf, O, mm, ll, smem);
        const float inv = ll > 0.f ? 1.f / ll : 0.f;
#pragma unroll
        for (int dvb = 0; dvb < 2; ++dvb)
#pragma unroll
          for (int g = 0; g < 4; ++g) {
            const int dv = dvb * 32 + 8 * g + 4 * half;
            uint2 zw = *(const uint2*)(u + t * NP + C_MEZ + h * 64 + dv);
            st4(y + t * 1024 + 768 + h * 64 + dv, O[dvb][4 * g] * inv * siluf_(bflo(zw.x)), O[dvb][4 * g + 1] * inv * siluf_(bfhi(zw.x)),
                O[dvb][4 * g + 2] * inv * siluf_(bflo(zw.y)), O[dvb][4 * g + 3] * inv * siluf_(bfhi(zw.y)));
          }
      }
    }
  }
  while (true) {
    __syncthreads();
    if (threadIdx.x == 0) *s_item = atomicAdd(ctr + xcd, 1);
    __syncthreads();
    const int item = *s_item;
    if (item >= 64) break;
    {
      const int tid = opq(threadIdx.x), lane = tid & 63, wv = tid >> 6, half = lane >> 5, l31 = lane & 31;
      const int qb = 15 - (item >> 2), b = xcd, h = item & 3;
      const int q0 = qb * 128, qpos = q0 + wv * 32 + l31;
      const size_t t = (size_t)b * S + qpos;
      const uint32_t tm = (qb == 15) ? 0xffffffffu : ((1u << (2 * qb + 2)) - 1u);
      f32x16 O[2]; float mm, ll;
        bf16x8 Qf[6];
        const bf16* qm = (const bf16*)(ws + OFF_QM) + (size_t)(b * 4 + h) * S * 96;
        load_q<96>(qm + (size_t)qpos * 96, Qf);
        attn_core<96>((const bf16*)(ws + OFF_KM) + (size_t)(b * 4 + h) * S * 96, 96,
                      (const bf16*)(ws + OFF_MV) + (size_t)(b * 4 + h) * S * 64, 64, tm, AM_CAUSAL, qpos, 0u, Qf, O, mm, ll, smem);
        const float inv = ll > 0.f ? 1.f / ll : 0.f;
#pragma unroll
        for (int dvb = 0; dvb < 2; ++dvb)
#pragma unroll
          for (int g = 0; g < 4; ++g) {
            const int dv = dvb * 32 + 8 * g + 4 * half;
            uint2 zw = *(const uint2*)(u + t * NP + C_MZ + h * 64 + dv);
            st4(y + t * 1024 + 512 + h * 64 + dv, O[dvb][4 * g] * inv * siluf_(bflo(zw.x)), O[dvb][4 * g + 1] * inv * siluf_(bfhi(zw.x)),
                O[dvb][4 * g + 2] * inv * siluf_(bflo(zw.y)), O[dvb][4 * g + 3] * inv * siluf_(bfhi(zw.y)));
          }
    }
  }
  while (true) {
    __syncthreads();
    if (threadIdx.x == 0) *s_item = atomicAdd(ctr + 8 + xcd, 1);
    __syncthreads();
    const int item = *s_item;
    if (item >= 64) break;
    {
      const int tid = opq(threadIdx.x), lane = tid & 63, wv = tid >> 6, half = lane >> 5, l31 = lane & 31;
      const int qb = 15 - (item >> 2), b = xcd, h = item & 3;
      const int q0 = qb * 128, qpos = q0 + wv * 32 + l31;
      const size_t t = (size_t)b * S + qpos;
      const uint32_t tm = (qb == 15) ? 0xffffffffu : ((1u << (2 * qb + 2)) - 1u);
      f32x16 O[2]; float mm, ll;
        f32x16 O1[2];
        const bf16* ub = u + (size_t)b * S * NP;
        {
          bf16x8 Qf[4];
          float l1, l2;
          load_q<64>(ub + (size_t)qpos * NP + C_DQ + h * 64, Qf);
          attn_core_dual<64>(ub + C_DK + h * 64, NP, ub + C_DV + h * 64, NP, tm, AM_CAUSAL, qpos, 0u, Qf, O1, O, l1, l2, smem);
          const float inv1 = l1 > 0.f ? 1.f / l1 : 0.f, inv = l2 > 0.f ? 1.f / l2 : 0.f;
#pragma unroll
          for (int i = 0; i < 16; ++i) { O1[0][i] *= inv1; O1[1][i] *= inv1; }
          {
            const float lam = ((const float*)(ws + OFF_LAM))[layer];
            float ss = 0.f;
#pragma unroll
            for (int i = 0; i < 16; ++i) {
              O1[0][i] -= lam * O[0][i] * inv; O1[1][i] -= lam * O[1][i] * inv;
              ss += O1[0][i] * O1[0][i] + O1[1][i] * O1[1][i];
            }
            ss += shx(ss, 32);
            const float li = opq(layer) == 0 ? 0.2f : 0.35550907f;
            const float r = rsqrtf(ss * (1.f / 64.f) + EPS) * (1.f - li);
            const float* sg = p.in[10] + layer * 64;
#pragma unroll
            for (int dvb = 0; dvb < 2; ++dvb)
#pragma unroll
              for (int g = 0; g < 4; ++g) {
                const int dv = dvb * 32 + 8 * g + 4 * half;
                uint2 zw = *(const uint2*)(u + t * NP + C_DZ + h * 64 + dv);
                st4(y + t * 1024 + 256 + h * 64 + dv, O1[dvb][4 * g] * r * sg[dv] * siluf_(bflo(zw.x)),
                    O1[dvb][4 * g + 1] * r * sg[dv + 1] * siluf_(bfhi(zw.x)), O1[dvb][4 * g + 2] * r * sg[dv + 2] * siluf_(bflo(zw.y)),
                    O1[dvb][4 * g + 3] * r * sg[dv + 3] * siluf_(bfhi(zw.y)));
              }
          }
        }
    }
  }
}

DI void attn_phaseB(const Params& p, int layer, char* smem, int* ctr) {
  const int tid = opq(threadIdx.x), lane = tid & 63, wv = tid >> 6, half = lane >> 5, l31 = lane & 31;
  char* ws = opqp(p.ws);
  bf16* u = (bf16*)(ws + OFF_U);
  bf16* y = (bf16*)(ws + OFF_Y);
  const float* gt = (const float*)(ws + OFF_GT);
  int* s_item = (int*)(smem + SM_MISC);
  uint32_t* s_or = (uint32_t*)(smem + SM_MISC + 16);
  const int xcd = blockIdx.x & 7;
  while (true) {
    __syncthreads();
    if (tid == 0) { *s_item = atomicAdd(ctr + xcd, 1); *s_or = 0u; }
    __syncthreads();
    const int item = *s_item;
    if (item >= 64) break;
    const int qb = 15 - (item >> 2), b = xcd, h = item & 3;
    const int q0 = qb * 128, qpos = q0 + wv * 32 + l31;
    const size_t t = (size_t)b * S + qpos;
    const bf16* ub = u + (size_t)b * S * NP;
    wg_wait2((unsigned*)(ws + OFF_FLAG) + layer * 1024 + (b * 16 + qb) * 8, (unsigned*)(ws + OFF_FLAG) + layer * 1024 + (b * 16 + qb) * 8 + 1 + h);
    const uint32_t sel = ((const uint32_t*)(ws + OFF_SEL))[t];
    const uint32_t causal = (qb == 15) ? 0xffffffffu : ((1u << (2 * qb + 2)) - 1u);
    if (half == 0) atomicOr(s_or, sel);
    __syncthreads();
    const uint32_t tm = (*s_or & causal) | 1u;
    f32x16 O[2]; float mm, ll;
    bf16x8 Qf[4];
    load_q<64>(ub + (size_t)qpos * NP + C_NQ + h * 64, Qf);
    attn_core<64>(ub + C_KS, NP, ub + C_VS, NP, tm, AM_SLC, qpos, sel, Qf, O, mm, ll, smem);
    const float sc = (ll > 0.f ? 1.f / ll : 0.f) * gt[t * 12 + 4 + h];
    const bf16* oc = (const bf16*)(ws + OFF_OCMP) + t * 256 + h * 64;
    const bf16* ow = (const bf16*)(ws + OFF_OWIN) + t * 256 + h * 64;
#pragma unroll
    for (int dvb = 0; dvb < 2; ++dvb)
#pragma unroll
      for (int g = 0; g < 4; ++g) {
        const int dv = dvb * 32 + 8 * g + 4 * half;
        uint2 zw = *(const uint2*)(u + t * NP + C_NZ + h * 64 + dv);
        uint2 cw = *(const uint2*)(oc + dv);
        uint2 ww = *(const uint2*)(ow + dv);
        st4(y + t * 1024 + h * 64 + dv, (O[dvb][4 * g] * sc + bflo(cw.x) + bflo(ww.x)) * siluf_(bflo(zw.x)),
            (O[dvb][4 * g + 1] * sc + bfhi(cw.x) + bfhi(ww.x)) * siluf_(bfhi(zw.x)),
            (O[dvb][4 * g + 2] * sc + bflo(cw.y) + bflo(ww.y)) * siluf_(bflo(zw.y)),
            (O[dvb][4 * g + 3] * sc + bfhi(cw.y) + bfhi(ww.y)) * siluf_(bfhi(zw.y)));
      }
  }
  (void)layer;
}

__global__ void __launch_bounds__(256, 2) fwd_megakernel(Params p) {
  __shared__ __attribute__((aligned(16))) char smem[SMEM_BYTES];
  cg::grid_group grid = cg::this_grid();
  char* ws = opqp(p.ws);
  int* ctrs = (int*)(ws + OFF_CTR);
  __shared__ uint4 xb_words;
  if (threadIdx.x == 0) xb_words = make_uint4(0u, 0u, 0u, 0u);
  __syncthreads();
  XcdBarrier xb = xcd_barrier_post((unsigned*)(ws + OFF_BAR), (volatile LAS unsigned*)&xb_words);
  phase0(p, smem);
  if (p.out == nullptr) grid.sync();
  xcd_barrier(xb);
#define PBAR(K) xcd_barrier(xb)
  for (int layer = 0; layer < 2; ++layer) {
    bf16* u = (bf16*)(ws + OFF_U);
    {
      const bf16* xbp = (const bf16*)(ws + OFF_XB);
      const bf16* wi = (const bf16*)(ws + OFF_WI + layer * SZ_WI);
      const int xcd = blockIdx.x & 7, rk = blockIdx.x >> 3, nrk = gridDim.x >> 3;
      for (int q = rk; q < 216; q += nrk) {
        if (q < 192) {
          const int mt = xcd * 8 + (q & 7), nt = q >> 3;
          gemm_big(xbp + (size_t)mt * 256 * 1024, 1024, wi + (size_t)nt * 128 * 1024, 1024, 16, smem, EPI_RS8, u, NP, mt * 256,
                   (const float*)(ws + OFF_SSQ), nullptr, nullptr, nullptr, nullptr, nt);
        } else if (q < 208) {
          const int mt = xcd * 16 + (q - 192), nt = 24;
          gemm_tile<16>(xbp + (size_t)mt * 128 * 1024, 1024, 64, wi + (size_t)nt * 128 * 1024, 1024, 16, smem);
          gemm_epi(EPI_RS8, smem, u, NP, mt * 128, (const float*)(ws + OFF_SSQ), nullptr, nullptr, nullptr, nullptr, nt);
        } else {
          const int i = xcd * 8 + (q - 208), mt = i >> 2, nt = i & 3;
          gemm_tile<16>((const bf16*)(ws + OFF_MEMB) + (size_t)mt * 128 * 1024, 1024, 64,
                    (const bf16*)(ws + OFF_WMEM + layer * SZ_WMEM) + (size_t)nt * 128 * 1024, 1024, 16, smem);
          gemm_epi(EPI_RS1, smem, (bf16*)(ws + OFF_KMEMRAW), 512, mt * 128, (const float*)(ws + OFF_RMEM), nullptr, nullptr, nullptr, nullptr, nt);
        }
      }
    }
    PBAR(0);
    {
      const int xcd = blockIdx.x & 7, rk = blockIdx.x >> 3, nrk = gridDim.x >> 3;
      for (int q = rk; q < 64; q += nrk) {
        if (q < 8) {
          const int j = q >> 2, kh = q & 3, b = xcd;
          gemm_tile<8>(u + (size_t)b * S * NP + (j ? C_VC : C_KC) + (size_t)kh * 8 * NP, 16 * NP, NP,
                       (const bf16*)(ws + OFF_WCMP + (layer * 2 + j) * SZ_WCMP) + kh * 512, 2048, 8, smem);
          gemm_epi(EPI_PLAIN, smem, (bf16*)(ws + OFF_CMPRAW) + (size_t)(kh * 2 + j) * 1024 * 128, 128, b * 128, nullptr, nullptr, nullptr, nullptr, nullptr, 0);
        } else if (q < 32) {
          const int i = q - 8, ml = i / 3, nt = i % 3, mt = xcd * 8 + ml;
          gemm_big(u + (size_t)mt * 256 * NP + C_CQ, NP, (const bf16*)(ws + OFF_WUQ + layer * SZ_WUQ) + (size_t)nt * 128 * 256, 256, 4, smem, EPI_PLAIN,
                   (bf16*)(ws + OFF_UQ + (size_t)xcd * SLAB), 384, ml * 256, nullptr, nullptr, nullptr, nullptr, nullptr, nt);
        } else {
          const int i = q - 32, ml = i >> 2, nt = i & 3, mt = xcd * 8 + ml;
          gemm_big(u + (size_t)mt * 256 * NP + C_CKV, NP, (const bf16*)(ws + OFF_WUKV + layer * SZ_WUKV) + (size_t)nt * 128 * 128, 128, 2, smem, EPI_PLAIN,
                   (bf16*)(ws + OFF_UKV + (size_t)xcd * SLAB), 512, ml * 256, nullptr, nullptr, nullptr, nullptr, nullptr, nt);
        }
      }
    }
    PBAR(1);
    prep_phase(p, layer);
    PBAR(2);
    attn_phaseA(p, layer, smem, ctrs + layer * 64);
    attn_phaseB(p, layer, smem, ctrs + layer * 64 + 32);
    PBAR(3);
    {
      const bf16* yb = (const bf16*)(ws + OFF_Y);
      const bf16* wo = (const bf16*)(ws + OFF_WO + layer * SZ_WO);
      const float* xres = layer == 0 ? p.in[0] : nullptr;
      const int xcd = blockIdx.x & 7, rk = blockIdx.x >> 3, nrk = gridDim.x >> 3;
      for (int q = rk; q < 64; q += nrk) {
        const int mt = xcd * 8 + (q & 7), nt = q >> 3;
        gemm_big(yb + (size_t)mt * 256 * 1024, 1024, wo + (size_t)nt * 128 * 1024, 1024, 16, smem, EPI_OUT, (bf16*)(ws + OFF_XB), 0, mt * 256, nullptr, xres, layer == 0 ? nullptr : p.out,
                 layer == 0 ? (bf16*)(ws + OFF_XB) : nullptr, (float*)(ws + OFF_SSQ), nt);
      }
    }
    if (layer == 0) PBAR(4);
  }
}

extern "C" void kernel_launch(void* const* d_in, const int* in_sizes, int n_in, void* d_out, int out_size, void* d_ws, size_t ws_size,
                              hipStream_t stream) {
  static int grid_blocks = 0;
  if (!grid_blocks) {
    int dev = 0, cus = 0, per_cu = 0;
    hipGetDevice(&dev);
    hipDeviceGetAttribute(&cus, hipDeviceAttributeMultiprocessorCount, dev);
    hipOccupancyMaxActiveBlocksPerMultiprocessor(&per_cu, fwd_megakernel, 256, 0);
    if (per_cu > 2) per_cu = 2;
    grid_blocks = (cus * per_cu) & ~7;
  }
  if (ws_size < WS_TOTAL) { fprintf(stderr, "workspace too small: %zu < %zu\n", ws_size, (size_t)WS_TOTAL); return; }
  Params p{};
  for (int i = 0; i < 19; ++i) p.in[i] = (const float*)d_in[i];
  p.out = (float*)d_out;
  p.ws = (char*)d_ws;
  hipMemsetAsync((char*)d_ws + OFF_CTR, 0, 1024 + 16384 + 8192 + 2048, stream);
  void* args[] = {&p};
  hipError_t e = hipLaunchCooperativeKernel((void*)fwd_megakernel, dim3(grid_blocks), dim3(256), args, 0, stream);
  if (e != hipSuccess) fprintf(stderr, "cooperative launch failed: %s (grid %d)\n", hipGetErrorString(e), grid_blocks);
}
```

```cpp
#include <hip/hip_runtime.h>
#include <hip/hip_cooperative_groups.h>
#include <stdint.h>
#include <cstdio>
namespace cg = cooperative_groups;

typedef unsigned short bf16;
using bf16x8 = __attribute__((ext_vector_type(8))) short;
using f32x16 = __attribute__((ext_vector_type(16))) float;
typedef __bf16 hbf2 __attribute__((ext_vector_type(2)));
typedef float hf2 __attribute__((ext_vector_type(2)));
typedef uint32_t u32x4 __attribute__((ext_vector_type(4)));
#define GLD16(dst, ptr) asm volatile("global_load_dwordx4 %0, %1, off" : "=&v"(dst) : "v"(ptr) : "memory")
#define WAIT_VM0() asm volatile("s_waitcnt vmcnt(0)" ::: "memory")
#define DI __device__ __forceinline__
#define MFMA(a, b, c) __builtin_amdgcn_mfma_f32_32x32x16_bf16((a), (b), (c), 0, 0, 0)

constexpr int Bn = 8, S = 2048, T = 16384, D = 1024, NP = 3200, ML = 256, TM = 2048;
constexpr float EPS = 1e-6f;
constexpr float LOG2E = 1.4426950408889634f;
constexpr int C_NQ = 0, C_KC = 256, C_VC = 320, C_KS = 384, C_VS = 448, C_KW = 512, C_VW = 576, C_NZ = 640,
              C_DQ = 896, C_DK = 1152, C_DV = 1408, C_DZ = 1664, C_CQ = 1920, C_CKV = 2176, C_KR = 2304,
              C_MZ = 2336, C_MQ = 2592, C_MEZ = 2848, C_GL = 3104;
constexpr size_t SZ_WI = (size_t)NP * 1024 * 2, SZ_WO = 1024 * 1024 * 2, SZ_WUQ = 384 * 256 * 2, SZ_WUKV = 512 * 128 * 2,
                 SZ_WMEM = 512 * 1024 * 2, SZ_WCMP = 128 * 2048 * 2;
constexpr size_t OFF_WI = 0;
constexpr size_t OFF_WO = OFF_WI + 2 * SZ_WI;
constexpr size_t OFF_WUQ = OFF_WO + 2 * SZ_WO;
constexpr size_t OFF_WUKV = OFF_WUQ + 2 * SZ_WUQ;
constexpr size_t OFF_WMEM = OFF_WUKV + 2 * SZ_WUKV;
constexpr size_t OFF_WCMP = OFF_WMEM + 2 * SZ_WMEM;
constexpr size_t OFF_CB = OFF_WCMP + 4 * SZ_WCMP;
constexpr size_t OFF_LAM = OFF_CB + 16384;
constexpr size_t OFF_CTR = OFF_LAM + 256;
constexpr size_t OFF_BAR = OFF_CTR + 1024;
constexpr size_t OFF_FLAG = OFF_BAR + 16384;
constexpr size_t OFF_PCNT = OFF_FLAG + 8192;
constexpr size_t OFF_ROPE = OFF_PCNT + 2048;
constexpr size_t OFF_SSQ = OFF_ROPE + 2048 * 32 * 8;
constexpr size_t OFF_RMEM = OFF_SSQ + (size_t)T * 8 * 4;
constexpr size_t OFF_MEMB = OFF_RMEM + 2048 * 4;
constexpr size_t OFF_XB = OFF_MEMB + (size_t)TM * 1024 * 2;
constexpr size_t OFF_U = OFF_XB + (size_t)T * 1024 * 2;
constexpr size_t OFF_R1 = OFF_U + (size_t)T * NP * 2;
constexpr size_t SLAB = (size_t)S * 1024 * 2;
constexpr size_t OFF_UQ = OFF_R1;
constexpr size_t OFF_UKV = OFF_R1 + (size_t)S * 384 * 2;
constexpr size_t OFF_Y = OFF_R1;
constexpr size_t OFF_QM = OFF_R1 + (size_t)T * 1024 * 2;
constexpr size_t OFF_KM = OFF_QM + (size_t)T * 384 * 2;
constexpr size_t OFF_MV = OFF_KM + (size_t)T * 384 * 2;
constexpr size_t OFF_KMEMRAW = OFF_MV + (size_t)T * 256 * 2;
constexpr size_t OFF_MK = OFF_KMEMRAW + (size_t)TM * 512 * 2;
constexpr size_t OFF_MVV = OFF_MK + (size_t)TM * 256 * 2;
constexpr size_t OFF_CMPRAW = OFF_MVV + (size_t)TM * 256 * 2;
constexpr size_t OFF_KCN = OFF_CMPRAW + 8 * 1024 * 128 * 2;
constexpr size_t OFF_VCN = OFF_KCN + 8 * 128 * 64 * 2;
constexpr size_t OFF_GT = OFF_VCN + 8 * 128 * 64 * 2;
constexpr size_t OFF_OCMP = OFF_GT + (size_t)T * 12 * 4;
constexpr size_t OFF_OWIN = OFF_OCMP + (size_t)T * 256 * 2;
constexpr size_t OFF_SEL = OFF_OWIN + (size_t)T * 256 * 2;
constexpr size_t WS_TOTAL = OFF_SEL + (size_t)T * 4;

constexpr int SMEM_BYTES = 73728;
constexpr int SM_VT = 2 * 64 * 104 * 2;
constexpr int SM_SC = SM_VT + 2 * 64 * 72 * 2;
constexpr int SM_MISC = SM_SC + 4 * 32 * 33 * 4;

struct Params {
  const float* in[19];
  float* out;
  char* ws;
};

DI int opq(int v) { asm volatile("" : "+v"(v)); return v; }
DI char* opqp(char* q) { size_t z = 0; asm volatile("" : "+s"(z)); return q + z; }
DI float bf2f(uint32_t v) { return __uint_as_float(v << 16); }
DI float bflo(uint32_t w) { return __uint_as_float(w << 16); }
DI float bfhi(uint32_t w) { return __uint_as_float(w & 0xffff0000u); }
DI uint32_t pack2(float a, float b) { hf2 f = {a, b}; hbf2 r = __builtin_convertvector(f, hbf2); return __builtin_bit_cast(uint32_t, r); }
DI bf16 f2bf(float a) { return (bf16)(pack2(a, 0.f) & 0xffffu); }
DI float fexp2(float x) { return __builtin_amdgcn_exp2f(x); }
DI float sigmoidf_(float x) { return __builtin_amdgcn_rcpf(1.f + fexp2(-LOG2E * x)); }
DI float siluf_(float x) { return x * __builtin_amdgcn_rcpf(1.f + fexp2(-LOG2E * x)); }
DI float shx(float v, int m) { return __shfl_xor(v, m); }
DI float dppf(float v, int ctrl_sel) {
  int x = __builtin_bit_cast(int, v), r;
  if (ctrl_sel == 0) r = __builtin_amdgcn_mov_dpp(x, 0xB1, 0xF, 0xF, true);
  else if (ctrl_sel == 1) r = __builtin_amdgcn_mov_dpp(x, 0x4E, 0xF, 0xF, true);
  else if (ctrl_sel == 2) r = __builtin_amdgcn_mov_dpp(x, 0x141, 0xF, 0xF, true);
  else r = __builtin_amdgcn_mov_dpp(x, 0x140, 0xF, 0xF, true);
  return __builtin_bit_cast(float, r);
}
DI float sum8(float v) { v += dppf(v, 0); v += dppf(v, 1); v += dppf(v, 2); return v; }
DI float sum16(float v) { v = sum8(v); v += dppf(v, 3); return v; }
DI float sum64(float v) { v = sum16(v); v += shx(v, 16); v += shx(v, 32); return v; }


#define XB_TMO      128
#define XB_XCNT(j)  (256  + 64 * (j))
#define XB_XSUB(j)  (1280 + 64 * (j))
#define XB_XGEN(j)  (2304 + 64 * (j))
#define XB_TOP      3328
#define XB_TOPGEN   3392
#define XB_SPIN_CAP (1u << 22)
#define LAS __attribute__((address_space(3)))
DI unsigned xb_ld(unsigned* p) { return __hip_atomic_load(p, __ATOMIC_RELAXED, __HIP_MEMORY_SCOPE_AGENT); }
DI unsigned xb_add(unsigned* p, unsigned v) { return __hip_atomic_fetch_add(p, v, __ATOMIC_RELAXED, __HIP_MEMORY_SCOPE_AGENT); }
DI unsigned xb_xcc_id() { return (unsigned)__builtin_amdgcn_readfirstlane((int)(__builtin_amdgcn_s_getreg((3 << 11) | 20) & 0xFu)); }
#define XB_SPIN(cond, bar) do { unsigned _sp = 0; while (cond) { __builtin_amdgcn_s_sleep(1); \
    if ((++_sp & 255u) == 0u) { if (xb_ld(&(bar)[XB_TMO])) break; if (_sp > XB_SPIN_CAP) { atomicAdd(&(bar)[XB_TMO], 1u); break; } } } } while (0)
struct XcdBarrier { unsigned* bar; unsigned x; volatile LAS unsigned* st; };
DI XcdBarrier xcd_barrier_post(unsigned* bar, volatile LAS unsigned* st) {
  XcdBarrier b; b.bar = bar; b.x = xb_xcc_id(); b.st = st;
  if (threadIdx.x == 0) (void)xb_add(&bar[XB_XCNT(b.x)], 1u);
  return b;
}
DI void xcd_barrier_complete(unsigned* bar, unsigned x, unsigned& nloc, unsigned& nx) {
  const unsigned G = gridDim.x * gridDim.y * gridDim.z;
  unsigned sum, cnt, mine, sp = 0u;
  for (;;) {
    sum = 0u; cnt = 0u; mine = 0u;
#pragma unroll
    for (unsigned j = 0; j < 16; ++j) { const unsigned c = xb_ld(&bar[XB_XCNT(j)]); sum += c; cnt += (c > 0u) ? 1u : 0u; mine = (j == x) ? c : mine; }
    if (sum == G) break;
    __builtin_amdgcn_s_sleep(1);
    if ((++sp & 255u) == 0u) { if (xb_ld(&bar[XB_TMO])) break; if (sp > XB_SPIN_CAP) { atomicAdd(&bar[XB_TMO], 1u); break; } }
  }
  nloc = mine > 0u ? mine : 1u; nx = cnt > 0u ? cnt : 1u;
}
DI void xcd_barrier(const XcdBarrier& b) {
  asm volatile("s_waitcnt vmcnt(0)" ::: "memory");
  __syncthreads();
  if (threadIdx.x == 0) {
    unsigned* bar = b.bar;
    const unsigned bx = xb_xcc_id();
    __builtin_amdgcn_s_waitcnt(0);
    unsigned nloc = b.st[0], nx = b.st[1];
    if (nloc == 0u) { xcd_barrier_complete(bar, bx, nloc, nx); b.st[0] = nloc; b.st[1] = nx; }
    const unsigned old = xb_add(&bar[XB_XSUB(bx)], 1u);
    const unsigned gen = old / nloc;
    if (old + 1u == (gen + 1u) * nloc) {
      __builtin_amdgcn_fence(__ATOMIC_RELEASE, "agent");
      asm volatile("s_waitcnt vmcnt(0)" ::: "memory");
      const unsigned og = xb_add(&bar[XB_TOP], 1u);
      const unsigned tg = og / nx;
      if (og + 1u == (tg + 1u) * nx) xb_add(&bar[XB_TOPGEN], 1u);
      else XB_SPIN(xb_ld(&bar[XB_TOPGEN]) == tg, bar);
      __builtin_amdgcn_fence(__ATOMIC_ACQUIRE, "agent");
      xb_add(&bar[XB_XGEN(bx)], 1u);
      asm volatile("s_waitcnt vmcnt(0)" ::: "memory");
    } else {
      XB_SPIN(xb_ld(&bar[XB_XGEN(bx)]) == gen, bar);
      __builtin_amdgcn_fence(__ATOMIC_ACQUIRE, "agent");
      asm volatile("s_waitcnt vmcnt(0)" ::: "memory");
    }
  }
  __syncthreads();
}

DI void part_barrier(unsigned* cnt, unsigned target) {
  asm volatile("s_waitcnt vmcnt(0)" ::: "memory");
  __syncthreads();
  if (threadIdx.x == 0) {
    __builtin_amdgcn_s_waitcnt(0);
    __builtin_amdgcn_fence(__ATOMIC_RELEASE, "agent");
    asm volatile("s_waitcnt vmcnt(0)" ::: "memory");
    xb_add(cnt, 1u);
    unsigned sp = 0;
    while (xb_ld(cnt) < target) { __builtin_amdgcn_s_sleep(1); if (++sp > (1u << 24)) break; }
    __builtin_amdgcn_fence(__ATOMIC_ACQUIRE, "agent");
    asm volatile("s_waitcnt vmcnt(0)" ::: "memory");
  }
  __syncthreads();
}

DI void wg_publish(unsigned* flag) {
  asm volatile("s_waitcnt vmcnt(0)" ::: "memory");
  __syncthreads();
  if (threadIdx.x == 0) {
    __builtin_amdgcn_fence(__ATOMIC_RELEASE, "agent");
    asm volatile("s_waitcnt vmcnt(0)" ::: "memory");
    xb_add(flag, 1u);
  }
}
DI void wg_wait2(unsigned* f0, unsigned* f1) {
  if (threadIdx.x == 0) {
    unsigned sp = 0;
    while (xb_ld(f0) < 1u || xb_ld(f1) < 1u) { __builtin_amdgcn_s_sleep(2); if (++sp > (1u << 22)) break; }
    __builtin_amdgcn_fence(__ATOMIC_ACQUIRE, "agent");
    asm volatile("s_waitcnt vmcnt(0)" ::: "memory");
  }
  __syncthreads();
}

DI int win_orig(int n) { return n < 640 ? n : (n < 3104 ? n + 12 : (n < 3116 ? n - 3104 + 640 : -1)); }

DI void convT_tile(const float* __restrict__ src, int Nsrc, const float* __restrict__ gain, bf16* __restrict__ dst, int K,
                   int k0, int n0, int mapmode, float* tile) {
  const int tid = opq(threadIdx.x);
  {
    const int nn = tid & 63, kk = tid >> 6;
    const int n = n0 + nn;
    const int on = mapmode == 1 ? win_orig(n) : (n < Nsrc ? n : -1);
    float v[16];
#pragma unroll
    for (int it = 0; it < 16; ++it) {
      const int k = k0 + kk + 4 * it;
      v[it] = 0.f;
      if (on >= 0) v[it] = src[(size_t)k * Nsrc + on];
    }
    if (gain) {
#pragma unroll
      for (int it = 0; it < 16; ++it) v[it] *= gain[k0 + kk + 4 * it];
    }
#pragma unroll
    for (int it = 0; it < 16; ++it) tile[(kk + 4 * it) * 65 + nn] = v[it];
  }
  __syncthreads();
  {
    const int k8 = (tid & 7) * 8, nb = tid >> 3;
#pragma unroll
    for (int it = 0; it < 2; ++it) {
      const int n = nb + 32 * it;
      uint4 o;
      o.x = pack2(tile[(k8 + 0) * 65 + n], tile[(k8 + 1) * 65 + n]);
      o.y = pack2(tile[(k8 + 2) * 65 + n], tile[(k8 + 3) * 65 + n]);
      o.z = pack2(tile[(k8 + 4) * 65 + n], tile[(k8 + 5) * 65 + n]);
      o.w = pack2(tile[(k8 + 6) * 65 + n], tile[(k8 + 7) * 65 + n]);
      *(uint4*)(dst + (size_t)(n0 + n) * K + k0 + k8) = o;
    }
  }
  __syncthreads();
}

DI void phase0(const Params& p, char* smem) {
  const int tid = opq(threadIdx.x), lane = tid & 63, wv = tid >> 6;
  float* tile = (float*)smem;
  char* ws = opqp(p.ws);
  constexpr int N_WI = 2 * 50 * 16, N_WO = 2 * 16 * 16, N_WUQ = 2 * 6 * 4, N_WUKV = 2 * 8 * 2, N_WMEM = 2 * 8 * 16,
                N_WCMP = 4 * 2 * 32, N_X = T / 4, N_MEM = TM / 4, N_ROPE = 256, N_CB = 64, N_LAM = 1;
  constexpr int E0 = N_WI, E1 = E0 + N_WO, E2 = E1 + N_WUQ, E3 = E2 + N_WUKV, E4 = E3 + N_WMEM, E5 = E4 + N_WCMP,
                E6 = E5 + N_X, E7 = E6 + N_MEM, E8 = E7 + N_ROPE, E9 = E8 + N_CB, E10 = E9 + N_LAM;
  for (int it = blockIdx.x; it < E10; it += gridDim.x) {
    if (it < E0) {
      int l = it / 800, r = it % 800, nt = r / 16, kt = r % 16;
      convT_tile(p.in[3] + (size_t)l * 1024 * 3116, 3116, p.in[2] + l * 1024, (bf16*)(ws + OFF_WI + l * SZ_WI), 1024, kt * 64, nt * 64, 1, tile);
    } else if (it < E1) {
      int i = it - E0; int l = i / 256, r = i % 256, nt = r / 16, kt = r % 16;
      convT_tile(p.in[4] + (size_t)l * 1024 * 1024, 1024, nullptr, (bf16*)(ws + OFF_WO + l * SZ_WO), 1024, kt * 64, nt * 64, 0, tile);
    } else if (it < E2) {
      int i = it - E1; int l = i / 24, r = i % 24, nt = r / 4, kt = r % 4;
      convT_tile(p.in[13] + (size_t)l * 256 * 384, 384, p.in[11] + l * 256, (bf16*)(ws + OFF_WUQ + l * SZ_WUQ), 256, kt * 64, nt * 64, 0, tile);
    } else if (it < E3) {
      int i = it - E2; int l = i / 16, r = i % 16, nt = r / 2, kt = r % 2;
      convT_tile(p.in[14] + (size_t)l * 128 * 512, 512, p.in[12] + l * 128, (bf16*)(ws + OFF_WUKV + l * SZ_WUKV), 128, kt * 64, nt * 64, 0, tile);
    } else if (it < E4) {
      int i = it - E3; int l = i / 128, r = i % 128, nt = r / 16, kt = r % 16;
      convT_tile(p.in[17] + (size_t)l * 1024 * 512, 512, p.in[16] + l * 1024, (bf16*)(ws + OFF_WMEM + l * SZ_WMEM), 1024, kt * 64, nt * 64, 0, tile);
    } else if (it < E5) {
      int i = it - E4; int lj = i / 64, r = i % 64, nt = r / 32, kt = r % 32;
      convT_tile(p.in[7] + (size_t)lj * 2048 * 64, 64, nullptr, (bf16*)(ws + OFF_WCMP + lj * SZ_WCMP), 2048, kt * 64, nt * 64, 0, tile);
    } else if (it < E6) {
      int row = (it - E5) * 4 + wv;
      const float4* xr = (const float4*)(p.in[0] + (size_t)row * 1024);
      bf16* xb = (bf16*)(ws + OFF_XB) + (size_t)row * 1024;
      float ss = 0.f;
#pragma unroll
      for (int i = 0; i < 4; ++i) {
        float4 v = xr[lane + 64 * i];
        ss += v.x * v.x + v.y * v.y + v.z * v.z + v.w * v.w;
        uint2 o; o.x = pack2(v.x, v.y); o.y = pack2(v.z, v.w);
        *(uint2*)(xb + (lane + 64 * i) * 4) = o;
      }
      ss = sum64(ss);
      float* sq = (float*)(ws + OFF_SSQ) + (size_t)row * 8;
      if (lane < 8) sq[lane] = lane == 0 ? ss : 0.f;
    } else if (it < E7) {
      int row = (it - E6) * 4 + wv;
      const float4* xr = (const float4*)(p.in[1] + (size_t)row * 1024);
      bf16* xb = (bf16*)(ws + OFF_MEMB) + (size_t)row * 1024;
      float ss = 0.f;
#pragma unroll
      for (int i = 0; i < 4; ++i) {
        float4 v = xr[lane + 64 * i];
        ss += v.x * v.x + v.y * v.y + v.z * v.z + v.w * v.w;
        uint2 o; o.x = pack2(v.x, v.y); o.y = pack2(v.z, v.w);
        *(uint2*)(xb + (lane + 64 * i) * 4) = o;
      }
      ss = sum64(ss);
      if (lane == 0) ((float*)(ws + OFF_RMEM))[row] = rsqrtf(ss * (1.f / 1024.f) + EPS);
    } else if (it < E8) {
      int e = (it - E7) * 256 + tid;
      int pos = e >> 5, i = e & 31;
      float inv = powf(10000.f, -(float)i / 32.f);
      float ang = (float)pos * inv;
      double a = (double)ang;
      double n = rint(a * 0.15915494309189535);
      float r = (float)(a - n * 6.283185307179586);
      float2 cs; cs.x = __cosf(r); cs.y = __sinf(r);
      ((float2*)(ws + OFF_ROPE))[e] = cs;
    } else if (it < E9) {
      int lj = (it - E8) >> 4, sl = (it - E8) & 15;
      const float* pe = p.in[6] + (size_t)lj * 2048;
      const float* w = p.in[7] + (size_t)lj * 2048 * 64;
      int n = tid & 63, part = tid >> 6;
      float acc = 0.f;
      const int kb0 = sl * 128 + part * 32;
#pragma unroll 8
      for (int k = kb0; k < kb0 + 32; ++k) acc += pe[k] * w[(size_t)k * 64 + n];
      tile[tid] = acc;
      __syncthreads();
      if (tid < 64) ((float*)(ws + OFF_CB))[((it - E8)) * 64 + tid] = tile[tid] + tile[tid + 64] + tile[tid + 128] + tile[tid + 192];
      __syncthreads();
    } else {
      if (tid < 2) {
        const float* lf = p.in[9] + tid * 128;
        float s1 = 0.f, s2 = 0.f;
        for (int i = 0; i < 32; ++i) { s1 += lf[i] * lf[32 + i]; s2 += lf[64 + i] * lf[96 + i]; }
        float li = 0.8f - 0.6f * expf(-0.3f * (float)tid);
        ((float*)(ws + OFF_LAM))[tid] = expf(s1) - expf(s2) + li;
      }
    }
  }
}

template <int CH>
DI void gemm_tile(const bf16* __restrict__ Ab, long lda, long kcs, const bf16* __restrict__ Bb, long ldb, int nk, char* smem) {
  const int tid = opq(threadIdx.x), lane = tid & 63, wv = tid >> 6, half = lane >> 5, l31 = lane & 31;
  const int wm = wv >> 1, wn = wv & 1;
  bf16* As = (bf16*)smem;
  bf16* Bs = (bf16*)(smem + 36864);
  const int lrow = tid >> 3, lcol = (tid & 7) * 8;
  const bf16* ag = Ab + (long)lrow * lda + lcol;
  const bf16* bg = Bb + (long)lrow * ldb + lcol;
  f32x16 acc[2][2];
#pragma unroll
  for (int a = 0; a < 2; ++a)
#pragma unroll
    for (int b = 0; b < 2; ++b)
#pragma unroll
      for (int i = 0; i < 16; ++i) acc[a][b][i] = 0.f;
#define GCOMPUTE(BUF) do { \
    const bf16* as_ = As + (BUF) * 128 * 72 + (wm * 64 + l31) * 72 + half * 8; \
    const bf16* bs_ = Bs + (BUF) * 128 * 72 + (wn * 64 + l31) * 72 + half * 8; \
    bf16x8 fa[2][2], fb[2][2]; \
    fa[0][0] = *(const bf16x8*)(as_); fa[0][1] = *(const bf16x8*)(as_ + 32 * 72); \
    fb[0][0] = *(const bf16x8*)(bs_); fb[0][1] = *(const bf16x8*)(bs_ + 32 * 72); \
    _Pragma("unroll") for (int kc = 0; kc < 4; ++kc) { \
      if (kc < 3) { \
        fa[(kc + 1) & 1][0] = *(const bf16x8*)(as_ + (kc + 1) * 16); fa[(kc + 1) & 1][1] = *(const bf16x8*)(as_ + 32 * 72 + (kc + 1) * 16); \
        fb[(kc + 1) & 1][0] = *(const bf16x8*)(bs_ + (kc + 1) * 16); fb[(kc + 1) & 1][1] = *(const bf16x8*)(bs_ + 32 * 72 + (kc + 1) * 16); \
      } \
      _Pragma("unroll") for (int ni = 0; ni < 2; ++ni) \
        _Pragma("unroll") for (int mi = 0; mi < 2; ++mi) acc[ni][mi] = MFMA(fb[kc & 1][ni], fa[kc & 1][mi], acc[ni][mi]); \
    } } while (0)
  for (int c0 = 0; c0 < nk; c0 += CH) {
    u32x4 rs[2][8];
    const bf16* agc = ag + (long)c0 * kcs;
    const bf16* bgc = bg + (long)c0 * 64;
#pragma unroll
    for (int i = 0; i < 4; ++i) {
      rs[0][i] = *(const u32x4*)(agc + (long)(32 * i) * lda);
      rs[0][4 + i] = *(const u32x4*)(bgc + (long)(32 * i) * ldb);
    }
#pragma unroll
    for (int i = 0; i < 4; ++i) {
      *(u32x4*)(As + (lrow + 32 * i) * 72 + lcol) = rs[0][i];
      *(u32x4*)(Bs + (lrow + 32 * i) * 72 + lcol) = rs[0][4 + i];
    }
    if (CH > 1) {
#pragma unroll
      for (int i = 0; i < 4; ++i) {
        GLD16(rs[1][i], agc + (long)(32 * i) * lda + kcs);
        GLD16(rs[1][4 + i], bgc + (long)(32 * i) * ldb + 64);
      }
    }
    __syncthreads();
#pragma unroll
    for (int t = 0; t < CH; ++t) {
      const int bufc = t & 1;
      if (t + 2 < CH) {
#pragma unroll
        for (int i = 0; i < 4; ++i) {
          GLD16(rs[t & 1][i], agc + (long)(32 * i) * lda + (long)(t + 2) * kcs);
          GLD16(rs[t & 1][4 + i], bgc + (long)(32 * i) * ldb + (long)(t + 2) * 64);
        }
      }
      GCOMPUTE(bufc);
      if (t + 1 < CH) {
        u32x4(&rr)[8] = rs[(t + 1) & 1];
        if (t + 2 < CH) asm volatile("s_waitcnt vmcnt(8)" : "+v"(rr[0]), "+v"(rr[1]), "+v"(rr[2]), "+v"(rr[3]), "+v"(rr[4]), "+v"(rr[5]), "+v"(rr[6]), "+v"(rr[7]) :: "memory");
        else asm volatile("s_waitcnt vmcnt(0)" : "+v"(rr[0]), "+v"(rr[1]), "+v"(rr[2]), "+v"(rr[3]), "+v"(rr[4]), "+v"(rr[5]), "+v"(rr[6]), "+v"(rr[7]) :: "memory");
        bf16* ad = As + (bufc ^ 1) * 128 * 72; bf16* bd = Bs + (bufc ^ 1) * 128 * 72;
#pragma unroll
        for (int i = 0; i < 4; ++i) {
          *(u32x4*)(ad + (lrow + 32 * i) * 72 + lcol) = rr[i];
          *(u32x4*)(bd + (lrow + 32 * i) * 72 + lcol) = rr[4 + i];
        }
      }
      __syncthreads();
    }
  }
#undef GCOMPUTE
  float* Cs = (float*)smem;
#pragma unroll
  for (int ni = 0; ni < 2; ++ni)
#pragma unroll
    for (int mi = 0; mi < 2; ++mi)
#pragma unroll
      for (int g = 0; g < 4; ++g) {
        float4 v; v.x = acc[ni][mi][4 * g]; v.y = acc[ni][mi][4 * g + 1]; v.z = acc[ni][mi][4 * g + 2]; v.w = acc[ni][mi][4 * g + 3];
        *(float4*)(Cs + (wm * 64 + mi * 32 + l31) * 132 + wn * 64 + ni * 32 + 8 * g + 4 * half) = v;
      }
  __syncthreads();
}

enum { EPI_PLAIN = 0, EPI_RS8 = 1, EPI_RS1 = 2, EPI_OUT = 3 };
DI void gemm_epi(int mode, char* smem, bf16* __restrict__ Cb, long ldc, int row0, const float* __restrict__ rs,
                 const float* __restrict__ xres, float* __restrict__ xout, bf16* __restrict__ xbout, float* __restrict__ ssqout, int ntile) {
  const float* Cs = (const float*)smem;
  const int tid = opq(threadIdx.x);
#pragma unroll 2
  for (int it = 0; it < 8; ++it) {
    const int idx = it * 256 + tid;
    const int r = idx >> 4, ch = idx & 15;
    float4 v0 = *(const float4*)(Cs + r * 132 + ch * 8);
    float4 v1 = *(const float4*)(Cs + r * 132 + ch * 8 + 4);
    const long grow = row0 + r;
    if (mode == EPI_OUT) {
      if (xres) {
        const float4* xr = (const float4*)(xres + grow * 1024 + ntile * 128 + ch * 8);
        float4 x0 = xr[0], x1 = xr[1];
        v0.x += x0.x; v0.y += x0.y; v0.z += x0.z; v0.w += x0.w;
        v1.x += x1.x; v1.y += x1.y; v1.z += x1.z; v1.w += x1.w;
      } else {
        const uint4 xw = *(const uint4*)(Cb + grow * 1024 + ntile * 128 + ch * 8);
        v0.x += bflo(xw.x); v0.y += bfhi(xw.x); v0.z += bflo(xw.y); v0.w += bfhi(xw.y);
        v1.x += bflo(xw.z); v1.y += bfhi(xw.z); v1.z += bflo(xw.w); v1.w += bfhi(xw.w);
      }
      if (xout) {
        float4* xo = (float4*)(xout + grow * 1024 + ntile * 128 + ch * 8);
        xo[0] = v0; xo[1] = v1;
      }
      if (xbout) {
        float ss = v0.x * v0.x + v0.y * v0.y + v0.z * v0.z + v0.w * v0.w + v1.x * v1.x + v1.y * v1.y + v1.z * v1.z + v1.w * v1.w;
        ss = sum16(ss);
        if (ch == 0) ssqout[grow * 8 + ntile] = ss;
        uint4 o; o.x = pack2(v0.x, v0.y); o.y = pack2(v0.z, v0.w); o.z = pack2(v1.x, v1.y); o.w = pack2(v1.z, v1.w);
        *(uint4*)(xbout + grow * 1024 + ntile * 128 + ch * 8) = o;
      }
    } else {
      float sc = 1.f;
      if (mode == EPI_RS8) {
        const float4* q = (const float4*)(rs + grow * 8);
        float4 a = q[0], b = q[1];
        sc = rsqrtf((a.x + a.y + a.z + a.w + b.x + b.y + b.z + b.w) * (1.f / 1024.f) + EPS);
      } else if (mode == EPI_RS1) sc = rs[grow];
      uint4 o; o.x = pack2(v0.x * sc, v0.y * sc); o.y = pack2(v0.z * sc, v0.w * sc); o.z = pack2(v1.x * sc, v1.y * sc); o.w = pack2(v1.z * sc, v1.w * sc);
      *(uint4*)(Cb + grow * ldc + ntile * 128 + ch * 8) = o;
    }
  }
  __syncthreads();
}

DI void gemm_big(const bf16* __restrict__ Ab, long lda, const bf16* __restrict__ Bb, long ldb, int nk, char* smem, int mode,
                 bf16* __restrict__ Cb, long ldc, int row0, const float* __restrict__ rs, const float* __restrict__ xres,
                 float* __restrict__ xout, bf16* __restrict__ xbout, float* __restrict__ ssqout, int ntile) {
  const int tid = opq(threadIdx.x), lane = tid & 63, wv = tid >> 6, half = lane >> 5, l31 = lane & 31;
  const int wm = wv >> 1, wn = wv & 1;
  bf16* As = (bf16*)smem;
  bf16* Bs = (bf16*)(smem + 36864);
  const int lrow = tid >> 3, lcol = (tid & 7) * 8;
  const bf16* ag = Ab + (long)lrow * lda + lcol;
  const bf16* bg = Bb + (long)lrow * ldb + lcol;
  u32x4 ra[8], rb[4];
  f32x16 acc[2][4];
#pragma unroll
  for (int a = 0; a < 2; ++a)
#pragma unroll
    for (int b = 0; b < 4; ++b)
#pragma unroll
      for (int i = 0; i < 16; ++i) acc[a][b][i] = 0.f;
#pragma unroll
  for (int i = 0; i < 8; ++i) ra[i] = *(const u32x4*)(ag + (long)(32 * i) * lda);
#pragma unroll
  for (int i = 0; i < 4; ++i) rb[i] = *(const u32x4*)(bg + (long)(32 * i) * ldb);
#pragma unroll
  for (int i = 0; i < 8; ++i) *(u32x4*)(As + (lrow + 32 * i) * 72 + lcol) = ra[i];
#pragma unroll
  for (int i = 0; i < 4; ++i) *(u32x4*)(Bs + (lrow + 32 * i) * 72 + lcol) = rb[i];
  __syncthreads();
  for (int ks = 0; ks < nk; ++ks) {
    const bool more = ks + 1 < nk;
    if (more) {
#pragma unroll
      for (int i = 0; i < 8; ++i) GLD16(ra[i], ag + (long)(32 * i) * lda + (long)(ks + 1) * 64);
#pragma unroll
      for (int i = 0; i < 4; ++i) GLD16(rb[i], bg + (long)(32 * i) * ldb + (long)(ks + 1) * 64);
    }
    const bf16* as_ = As + (wm * 128 + l31) * 72 + half * 8;
    const bf16* bs_ = Bs + (wn * 64 + l31) * 72 + half * 8;
#pragma unroll
    for (int kc = 0; kc < 4; ++kc) {
      bf16x8 fa[4], fb[2];
#pragma unroll
      for (int mi = 0; mi < 4; ++mi) fa[mi] = *(const bf16x8*)(as_ + mi * 32 * 72 + kc * 16);
#pragma unroll
      for (int ni = 0; ni < 2; ++ni) fb[ni] = *(const bf16x8*)(bs_ + ni * 32 * 72 + kc * 16);
#pragma unroll
      for (int ni = 0; ni < 2; ++ni)
#pragma unroll
        for (int mi = 0; mi < 4; ++mi) acc[ni][mi] = MFMA(fb[ni], fa[mi], acc[ni][mi]);
    }
    __syncthreads();
    if (more) {
      asm volatile("s_waitcnt vmcnt(0)" : "+v"(ra[0]), "+v"(ra[1]), "+v"(ra[2]), "+v"(ra[3]), "+v"(ra[4]), "+v"(ra[5]), "+v"(ra[6]), "+v"(ra[7]),
                   "+v"(rb[0]), "+v"(rb[1]), "+v"(rb[2]), "+v"(rb[3]) :: "memory");
#pragma unroll
      for (int i = 0; i < 8; ++i) *(u32x4*)(As + (lrow + 32 * i) * 72 + lcol) = ra[i];
#pragma unroll
      for (int i = 0; i < 4; ++i) *(u32x4*)(Bs + (lrow + 32 * i) * 72 + lcol) = rb[i];
      __syncthreads();
    }
  }
  float* Cs = (float*)smem;
#pragma unroll
  for (int h = 0; h < 2; ++h) {
    if (wm == h) {
#pragma unroll
      for (int ni = 0; ni < 2; ++ni)
#pragma unroll
        for (int mi = 0; mi < 4; ++mi)
#pragma unroll
          for (int g = 0; g < 4; ++g) {
            float4 v; v.x = acc[ni][mi][4 * g]; v.y = acc[ni][mi][4 * g + 1]; v.z = acc[ni][mi][4 * g + 2]; v.w = acc[ni][mi][4 * g + 3];
            *(float4*)(Cs + (mi * 32 + l31) * 132 + wn * 64 + ni * 32 + 8 * g + 4 * half) = v;
          }
    }
    __syncthreads();
    gemm_epi(mode, smem, Cb, ldc, row0 + h * 128, rs, xres, xout, xbout, ssqout, ntile);
  }
}

enum { AM_NONE = 0, AM_CAUSAL = 1, AM_WIN = 2, AM_CMP = 3, AM_SLC = 4 };

template <int DK>
DI void attn_core(const bf16* __restrict__ Kp, long kstride, const bf16* __restrict__ Vp, long vstride, uint32_t tilemask,
                  int mode, int qpos, uint32_t sel, const bf16x8 (&Qf)[DK / 16], f32x16 (&O)[2], float& m_out, float& l_out, char* smem) {
  constexpr int KST = DK + 8;
  constexpr int CPR = DK / 8;
  constexpr int NCH = CPR / 4;
  bf16* Ks = (bf16*)smem;
  bf16* VTs = (bf16*)(smem + SM_VT);
  const int tid = opq(threadIdx.x), lane = tid & 63, half = lane >> 5, l31 = lane & 31;
#pragma unroll
  for (int i = 0; i < 16; ++i) { O[0][i] = 0.f; O[1][i] = 0.f; }
  float l = 0.f;
  const int qw0 = __builtin_amdgcn_readfirstlane(qpos - l31);
  const bool causal_like = (mode == AM_CAUSAL || mode == AM_WIN || mode == AM_SLC);
  int klo = 0, khi = 0x7fffffff;
  if (mode == AM_CAUSAL || mode == AM_SLC) khi = qpos;
  else if (mode == AM_WIN) { khi = qpos; klo = qpos - 511; }
  else if (mode == AM_CMP) khi = (qpos - 31) >> 4;
  u32x4 rk0, rk1, rk2, rv0, rv1;
  rk0 = rk1 = rk2 = (u32x4){0u, 0u, 0u, 0u};
  const int vkp = tid & 31, vcc = tid >> 5;
  const int vcol = (vkp >> 3) * 16 + (((vkp & 1) | ((vkp & 2) << 1) | ((vkp & 4) >> 1)) * 2);
  const int c0 = tid, c1 = tid + 256, c2_ = tid + 512;
  const int kr0 = c0 / CPR, kc0 = (c0 % CPR) * 8, kr1 = c1 / CPR, kc1 = (c1 % CPR) * 8, kr2 = c2_ / CPR, kc2 = (c2_ % CPR) * 8;
#define GLOAD(KT) do { \
    GLD16(rk0, Kp + (long)((KT) * 64 + kr0) * kstride + kc0); \
    if constexpr (NCH > 1) GLD16(rk1, Kp + (long)((KT) * 64 + kr1) * kstride + kc1); \
    if constexpr (NCH > 2) GLD16(rk2, Kp + (long)((KT) * 64 + kr2) * kstride + kc2); \
    GLD16(rv0, Vp + (long)((KT) * 64 + 2 * vkp) * vstride + vcc * 8); \
    GLD16(rv1, Vp + (long)((KT) * 64 + 2 * vkp + 1) * vstride + vcc * 8); } while (0)
#define LSTORE(BUF) do { asm volatile("s_waitcnt vmcnt(0)" : "+v"(rk0), "+v"(rk1), "+v"(rk2), "+v"(rv0), "+v"(rv1) :: "memory"); \
    *(u32x4*)(Ks + ((BUF) * 64 + kr0) * KST + kc0) = rk0; \
    if constexpr (NCH > 1) *(u32x4*)(Ks + ((BUF) * 64 + kr1) * KST + kc1) = rk1; \
    if constexpr (NCH > 2) *(u32x4*)(Ks + ((BUF) * 64 + kr2) * KST + kc2) = rk2; \
    bf16* vd = VTs + ((BUF) * 64 + vcc * 8) * 72 + vcol; \
    *(uint32_t*)(vd + 0 * 72) = (rv0.x & 0xffffu) | (rv1.x << 16); \
    *(uint32_t*)(vd + 1 * 72) = (rv0.x >> 16) | (rv1.x & 0xffff0000u); \
    *(uint32_t*)(vd + 2 * 72) = (rv0.y & 0xffffu) | (rv1.y << 16); \
    *(uint32_t*)(vd + 3 * 72) = (rv0.y >> 16) | (rv1.y & 0xffff0000u); \
    *(uint32_t*)(vd + 4 * 72) = (rv0.z & 0xffffu) | (rv1.z << 16); \
    *(uint32_t*)(vd + 5 * 72) = (rv0.z >> 16) | (rv1.z & 0xffff0000u); \
    *(uint32_t*)(vd + 6 * 72) = (rv0.w & 0xffffu) | (rv1.w << 16); \
    *(uint32_t*)(vd + 7 * 72) = (rv0.w >> 16) | (rv1.w & 0xffff0000u); } while (0)
  uint32_t rem = tilemask;
  int kt = __ffs(rem) - 1; rem &= rem - 1;
  GLOAD(kt);
#pragma unroll
  for (int kc = 0; kc < DK / 16; ++kc) asm volatile("" ::"v"(Qf[kc]));
  __syncthreads();
  LSTORE(0);
  __syncthreads();
  int buf = 0;
  while (true) {
    int ktn = -1;
    if (rem) { ktn = __ffs(rem) - 1; rem &= rem - 1; GLOAD(ktn); }
    const bool wave_active = !(causal_like && kt * 64 > qw0 + 31);
    if (wave_active) {
    f32x16 Sx[2];
#pragma unroll
    for (int kb = 0; kb < 2; ++kb) {
      bf16x8 Kf[DK / 16];
#pragma unroll
      for (int kc = 0; kc < DK / 16; ++kc) Kf[kc] = *(const bf16x8*)(Ks + (buf * 64 + kb * 32 + l31) * KST + kc * 16 + half * 8);
      __builtin_amdgcn_sched_barrier(0);
#pragma unroll
      for (int i = 0; i < 16; ++i) Sx[kb][i] = 0.f;
#pragma unroll
      for (int kc = 0; kc < DK / 16; ++kc) Sx[kb] = MFMA(Kf[kc], Qf[kc], Sx[kb]);
    }
    bf16x8 Vf[2][2][2];
#pragma unroll
    for (int kb = 0; kb < 2; ++kb)
#pragma unroll
      for (int c2 = 0; c2 < 2; ++c2)
#pragma unroll
        for (int dvb = 0; dvb < 2; ++dvb)
          Vf[kb][c2][dvb] = *(const bf16x8*)(VTs + (buf * 64 + dvb * 32 + l31) * 72 + (kb * 2 + c2) * 16 + half * 8);
    __builtin_amdgcn_sched_barrier(0);
    bool need_mask = false;
    if (mode == AM_CAUSAL) need_mask = kt * 64 + 63 > qw0;
    else if (mode == AM_WIN) need_mask = (kt * 64 + 63 > qw0) || (kt * 64 < qw0 + 31 - 511);
    else if (mode == AM_CMP) need_mask = true;
    else if (mode == AM_SLC) need_mask = (kt * 64 + 63 > qw0);
    const bool keep = !(mode == AM_SLC) || (((sel >> kt) & 1u) != 0u);
    int khe = khi;
    if (mode == AM_SLC && !((sel >> kt) & 1u)) khe = -1;
    const int kbase = kt * 64 + half * 4;
#pragma unroll
    for (int kb = 0; kb < 2; ++kb) {
      if (need_mask) {
#pragma unroll
        for (int i = 0; i < 16; ++i) {
          const int key = kbase + kb * 32 + (i >> 2) * 8 + (i & 3);
          Sx[kb][i] = (key >= klo && key <= khe) ? Sx[kb][i] : -1e30f;
        }
      }
      float ps = 0.f;
#pragma unroll
      for (int i = 0; i < 16; ++i) { float pv = fexp2(Sx[kb][i]); pv = keep ? pv : 0.f; Sx[kb][i] = pv; ps += pv; }
      l += ps;
#pragma unroll
      for (int c2 = 0; c2 < 2; ++c2) {
        uint4 pw;
        pw.x = pack2(Sx[kb][8 * c2 + 0], Sx[kb][8 * c2 + 1]); pw.y = pack2(Sx[kb][8 * c2 + 2], Sx[kb][8 * c2 + 3]);
        pw.z = pack2(Sx[kb][8 * c2 + 4], Sx[kb][8 * c2 + 5]); pw.w = pack2(Sx[kb][8 * c2 + 6], Sx[kb][8 * c2 + 7]);
        const bf16x8 pf = __builtin_bit_cast(bf16x8, pw);
#pragma unroll
        for (int dvb = 0; dvb < 2; ++dvb) O[dvb] = MFMA(Vf[kb][c2][dvb], pf, O[dvb]);
      }
      __builtin_amdgcn_sched_barrier(0);
    }
    }
    if (ktn < 0) break;
    LSTORE(buf ^ 1);
    __syncthreads();
    buf ^= 1; kt = ktn;
  }
  l_out = l + shx(l, 32);
  m_out = 0.f;
#undef GLOAD
#undef LSTORE
}

template <int DK>
DI void attn_core_dual(const bf16* __restrict__ Kp, long kstride, const bf16* __restrict__ Vp, long vstride, uint32_t tilemask,
                  int mode, int qpos, uint32_t sel, const bf16x8 (&Qf)[DK / 16], f32x16 (&O)[2], f32x16 (&O2)[2], float& l_out, float& l2_out, char* smem) {
  constexpr int KST = DK + 8;
  constexpr int CPR = DK / 8;
  constexpr int NCH = CPR / 4;
  bf16* Ks = (bf16*)smem;
  bf16* VTs = (bf16*)(smem + SM_VT);
  const int tid = opq(threadIdx.x), lane = tid & 63, half = lane >> 5, l31 = lane & 31;
#pragma unroll
  for (int i = 0; i < 16; ++i) { O[0][i] = 0.f; O[1][i] = 0.f; O2[0][i] = 0.f; O2[1][i] = 0.f; }
  float l = 0.f, l2 = 0.f;
  const int qw0 = __builtin_amdgcn_readfirstlane(qpos - l31);
  const bool causal_like = (mode == AM_CAUSAL || mode == AM_WIN || mode == AM_SLC);
  int klo = 0, khi = 0x7fffffff;
  if (mode == AM_CAUSAL || mode == AM_SLC) khi = qpos;
  else if (mode == AM_WIN) { khi = qpos; klo = qpos - 511; }
  else if (mode == AM_CMP) khi = (qpos - 31) >> 4;
  u32x4 rk0, rk1, rk2, rv0, rv1;
  rk0 = rk1 = rk2 = (u32x4){0u, 0u, 0u, 0u};
  const int vkp = tid & 31, vcc = tid >> 5;
  const int vcol = (vkp >> 3) * 16 + (((vkp & 1) | ((vkp & 2) << 1) | ((vkp & 4) >> 1)) * 2);
  const int c0 = tid, c1 = tid + 256, c2_ = tid + 512;
  const int kr0 = c0 / CPR, kc0 = (c0 % CPR) * 8, kr1 = c1 / CPR, kc1 = (c1 % CPR) * 8, kr2 = c2_ / CPR, kc2 = (c2_ % CPR) * 8;
#define GLOAD(KT) do { \
    GLD16(rk0, Kp + (long)((KT) * 64 + kr0) * kstride + kc0); \
    if constexpr (NCH > 1) GLD16(rk1, Kp + (long)((KT) * 64 + kr1) * kstride + kc1); \
    if constexpr (NCH > 2) GLD16(rk2, Kp + (long)((KT) * 64 + kr2) * kstride + kc2); \
    GLD16(rv0, Vp + (long)((KT) * 64 + 2 * vkp) * vstride + vcc * 8); \
    GLD16(rv1, Vp + (long)((KT) * 64 + 2 * vkp + 1) * vstride + vcc * 8); } while (0)
#define LSTORE(BUF) do { asm volatile("s_waitcnt vmcnt(0)" : "+v"(rk0), "+v"(rk1), "+v"(rv0), "+v"(rv1) :: "memory"); \
    *(u32x4*)(Ks + ((BUF) * 64 + kr0) * KST + kc0) = rk0; \
    if constexpr (NCH > 1) *(u32x4*)(Ks + ((BUF) * 64 + kr1) * KST + kc1) = rk1; \
    if constexpr (NCH > 2) *(u32x4*)(Ks + ((BUF) * 64 + kr2) * KST + kc2) = rk2; \
    bf16* vd = VTs + ((BUF) * 64 + vcc * 8) * 72 + vcol; \
    *(uint32_t*)(vd + 0 * 72) = (rv0.x & 0xffffu) | (rv1.x << 16); \
    *(uint32_t*)(vd + 1 * 72) = (rv0.x >> 16) | (rv1.x & 0xffff0000u); \
    *(uint32_t*)(vd + 2 * 72) = (rv0.y & 0xffffu) | (rv1.y << 16); \
    *(uint32_t*)(vd + 3 * 72) = (rv0.y >> 16) | (rv1.y & 0xffff0000u); \
    *(uint32_t*)(vd + 4 * 72) = (rv0.z & 0xffffu) | (rv1.z << 16); \
    *(uint32_t*)(vd + 5 * 72) = (rv0.z >> 16) | (rv1.z & 0xffff0000u); \
    *(uint32_t*)(vd + 6 * 72) = (rv0.w & 0xffffu) | (rv1.w << 16); \
    *(uint32_t*)(vd + 7 * 72) = (rv0.w >> 16) | (rv1.w & 0xffff0000u); } while (0)
  uint32_t rem = tilemask;
  int kt = __ffs(rem) - 1; rem &= rem - 1;
  GLOAD(kt);
#pragma unroll
  for (int kc = 0; kc < DK / 16; ++kc) asm volatile("" ::"v"(Qf[kc]));
  __syncthreads();
  LSTORE(0);
  __syncthreads();
  int buf = 0;
  while (true) {
    int ktn = -1;
    if (rem) { ktn = __ffs(rem) - 1; rem &= rem - 1; GLOAD(ktn); }
    const bool wave_active = !(causal_like && kt * 64 > qw0 + 31);
    if (wave_active) {
    const bool need_mask = kt * 64 + 63 > qw0;
    const int kbase = kt * 64 + half * 4;
#pragma unroll
    for (int mp = 0; mp < 2; ++mp) {
      f32x16 Sx[2];
#pragma unroll
      for (int kb = 0; kb < 2; ++kb) {
        bf16x8 k0 = *(const bf16x8*)(Ks + (buf * 64 + kb * 32 + l31) * KST + (2 * mp) * 16 + half * 8);
        bf16x8 k1 = *(const bf16x8*)(Ks + (buf * 64 + kb * 32 + l31) * KST + (2 * mp + 1) * 16 + half * 8);
#pragma unroll
        for (int i = 0; i < 16; ++i) Sx[kb][i] = 0.f;
        Sx[kb] = MFMA(k0, Qf[2 * mp], Sx[kb]);
        Sx[kb] = MFMA(k1, Qf[2 * mp + 1], Sx[kb]);
      }
#pragma unroll
      for (int kb = 0; kb < 2; ++kb) {
        if (need_mask) {
#pragma unroll
          for (int i = 0; i < 16; ++i) {
            const int key = kbase + kb * 32 + (i >> 2) * 8 + (i & 3);
            Sx[kb][i] = (key <= khi) ? Sx[kb][i] : -1e30f;
          }
        }
        bf16x8 Vf[2][2];
#pragma unroll
        for (int c2 = 0; c2 < 2; ++c2)
#pragma unroll
          for (int dvb = 0; dvb < 2; ++dvb)
            Vf[c2][dvb] = *(const bf16x8*)(VTs + (buf * 64 + dvb * 32 + l31) * 72 + (kb * 2 + c2) * 16 + half * 8);
        float ps = 0.f;
#pragma unroll
        for (int i = 0; i < 16; ++i) { float pv = fexp2(Sx[kb][i]); Sx[kb][i] = pv; ps += pv; }
        if (mp == 0) l += ps; else l2 += ps;
#pragma unroll
        for (int c2 = 0; c2 < 2; ++c2) {
          uint4 pw;
          pw.x = pack2(Sx[kb][8 * c2 + 0], Sx[kb][8 * c2 + 1]); pw.y = pack2(Sx[kb][8 * c2 + 2], Sx[kb][8 * c2 + 3]);
          pw.z = pack2(Sx[kb][8 * c2 + 4], Sx[kb][8 * c2 + 5]); pw.w = pack2(Sx[kb][8 * c2 + 6], Sx[kb][8 * c2 + 7]);
          const bf16x8 pf = __builtin_bit_cast(bf16x8, pw);
#pragma unroll
          for (int dvb = 0; dvb < 2; ++dvb) {
            if (mp == 0) O[dvb] = MFMA(Vf[c2][dvb], pf, O[dvb]); else O2[dvb] = MFMA(Vf[c2][dvb], pf, O2[dvb]);
          }
        }
        __builtin_amdgcn_sched_barrier(0);
      }
    }
    }
    if (ktn < 0) break;
    LSTORE(buf ^ 1);
    __syncthreads();
    buf ^= 1; kt = ktn;
  }
  l_out = l + shx(l, 32);
  l2_out = l2 + shx(l2, 32);
#undef GLOAD
#undef LSTORE
}

template <int DK>
DI void load_q(const bf16* __restrict__ Qrow, bf16x8 (&Qf)[DK / 16]) {
  const int half = (opq(threadIdx.x) & 63) >> 5;
#pragma unroll
  for (int kc = 0; kc < DK / 16; ++kc) Qf[kc] = *(const bf16x8*)(Qrow + kc * 16 + half * 8);
}

DI void vec64(bool active, const bf16* src, const float* bias, int nbias, bf16* dst, const float* gain, const float2* rp, float scale, int j, const bf16* src2 = nullptr) {
  float a0 = 0.f, a1 = 0.f, b0 = 0.f, b1 = 0.f;
  if (active) {
    uint32_t lo = *(const uint32_t*)(src + 2 * j), hi = *(const uint32_t*)(src + 32 + 2 * j);
    a0 = bflo(lo); a1 = bfhi(lo); b0 = bflo(hi); b1 = bfhi(hi);
    if (src2) {
#pragma unroll
      for (int q = 0; q < 3; ++q) {
        const bf16* sq_ = src2 + (size_t)q * 2 * 1024 * 128;
        lo = *(const uint32_t*)(sq_ + 2 * j); hi = *(const uint32_t*)(sq_ + 32 + 2 * j); a0 += bflo(lo); a1 += bfhi(lo); b0 += bflo(hi); b1 += bfhi(hi);
      }
    }
    for (int sidx = 0; sidx < nbias; ++sidx) {
      const float* bb = bias + sidx * 64;
      a0 += bb[2 * j]; a1 += bb[2 * j + 1]; b0 += bb[32 + 2 * j]; b1 += bb[33 + 2 * j];
    }
  }
  float ss = a0 * a0 + a1 * a1 + b0 * b0 + b1 * b1;
  ss = sum16(ss);
  const float r = rsqrtf(ss * (1.f / 64.f) + EPS);
  if (active) {
    a0 *= r * gain[2 * j]; a1 *= r * gain[2 * j + 1]; b0 *= r * gain[32 + 2 * j]; b1 *= r * gain[33 + 2 * j];
    if (rp) {
      const float2 c0 = rp[2 * j], c1 = rp[2 * j + 1];
      const float t0 = a0 * c0.x - b0 * c0.y, u0 = b0 * c0.x + a0 * c0.y;
      const float t1 = a1 * c1.x - b1 * c1.y, u1 = b1 * c1.x + a1 * c1.y;
      a0 = t0; b0 = u0; a1 = t1; b1 = u1;
    }
    *(uint32_t*)(dst + 2 * j) = pack2(a0 * scale, a1 * scale);
    *(uint32_t*)(dst + 32 + 2 * j) = pack2(b0 * scale, b1 * scale);
  }
}
template <int G>
DI void nr4(uint32_t lo, uint32_t hi, float invn, float g0, float g1, float g2, float g3, bool rope, float2 c0, float2 c1, float scale,
            uint32_t& olo, uint32_t& ohi) {
  float a0 = bflo(lo), a1 = bfhi(lo), b0 = bflo(hi), b1 = bfhi(hi);
  float ss = a0 * a0 + a1 * a1 + b0 * b0 + b1 * b1;
  ss = (G == 16) ? sum16(ss) : sum8(ss);
  const float r = rsqrtf(ss * invn + EPS);
  a0 *= r * g0; a1 *= r * g1; b0 *= r * g2; b1 *= r * g3;
  if (rope) {
    const float t0 = a0 * c0.x - b0 * c0.y, u0 = b0 * c0.x + a0 * c0.y;
    const float t1 = a1 * c1.x - b1 * c1.y, u1 = b1 * c1.x + a1 * c1.y;
    a0 = t0; b0 = u0; a1 = t1; b1 = u1;
  }
  olo = pack2(a0 * scale, a1 * scale); ohi = pack2(b0 * scale, b1 * scale);
}

struct PrepR {
  uint32_t q_lo, q_hi, p2_lo, p2_hi, p3_lo, p3_hi, dq_lo, dq_hi, dk_lo, dk_hi, glv, ckw, uqa, uqb, kra, krb;
  uint2 cw, nw, kw2, vw;
  float2 c0, c1, e0, e1;
};
struct PrepG {
  float gq0, gq1, gq2, gq3, h0, h1, h2, h3, m0, m1, m2, m3, dq0, dq1, dq2, dq3, dk0, dk1, dk2, dk3;
  float mgq0, mgq1, mgq2, mgq3, mgq4, mgq5, mgk0, mgk1, mgk2, mgk3, mgk4, mgk5;
};
DI void prep_load(char* ws, int t, int lane, PrepR& R) {
  const int j16 = lane & 15, g16 = lane >> 4, j8 = lane & 7, g8 = lane >> 3;
  const int s = t & 2047;
  const bf16* ur = (const bf16*)(ws + OFF_U) + (size_t)t * NP;
  const float2* rp = (const float2*)(ws + OFF_ROPE) + s * 32;
  const int col2 = g16 == 0 ? C_KS : (g16 == 1 ? C_KW : C_MQ + (g16 - 2) * 64);
  const int col3 = C_MQ + (2 + (g16 & 1)) * 64;
  const bf16* uq = (const bf16*)(ws + OFF_UQ + (size_t)(t >> 11) * SLAB) + (size_t)s * 384 + g16 * 96;
  const bf16* uk = (const bf16*)(ws + OFF_UKV + (size_t)(t >> 11) * SLAB) + (size_t)s * 512 + g16 * 128;
  R.q_lo = *(const uint32_t*)(ur + C_NQ + g16 * 64 + 2 * j16); R.q_hi = *(const uint32_t*)(ur + C_NQ + g16 * 64 + 32 + 2 * j16);
  R.p2_lo = *(const uint32_t*)(ur + col2 + 2 * j16); R.p2_hi = *(const uint32_t*)(ur + col2 + 32 + 2 * j16);
  R.p3_lo = *(const uint32_t*)(ur + col3 + 2 * j16); R.p3_hi = *(const uint32_t*)(ur + col3 + 32 + 2 * j16);
  R.dq_lo = *(const uint32_t*)(ur + C_DQ + g8 * 32 + 2 * j8); R.dq_hi = *(const uint32_t*)(ur + C_DQ + g8 * 32 + 16 + 2 * j8);
  R.dk_lo = *(const uint32_t*)(ur + C_DK + g8 * 32 + 2 * j8); R.dk_hi = *(const uint32_t*)(ur + C_DK + g8 * 32 + 16 + 2 * j8);
  R.glv = ur[C_GL + (lane < 12 ? lane : 0)];
  R.cw = *(const uint2*)(ur + C_CQ + lane * 4);
  R.ckw = *(const uint32_t*)(ur + C_CKV + lane * 2);
  R.nw = *(const uint2*)(uq + 4 * j16);
  R.uqa = uq[64 + j16]; R.uqb = uq[80 + j16];
  R.kw2 = *(const uint2*)(uk + 4 * j16);
  R.vw = *(const uint2*)(uk + 64 + 4 * j16);
  R.kra = ur[C_KR + j16]; R.krb = ur[C_KR + 16 + j16];
  R.c0 = rp[2 * j16]; R.c1 = rp[2 * j16 + 1];
  R.e0 = rp[4 * j8]; R.e1 = rp[4 * j8 + 2];
}
DI void prep_fin(char* ws, int t, int lane, const PrepR& R, const PrepG& G) {
  const int j16 = lane & 15, g16 = lane >> 4, j8 = lane & 7, g8 = lane >> 3;
  const float qs64 = 0.125f * LOG2E, qs32 = 0.17677669529663687f * LOG2E, qs96 = 0.10206207261596577f * LOG2E;
  const int b = t >> 11, s = t & 2047;
  bf16* ur = (bf16*)(ws + OFF_U) + (size_t)t * NP;
  const int col2 = g16 == 0 ? C_KS : (g16 == 1 ? C_KW : C_MQ + (g16 - 2) * 64);
  const int col3 = C_MQ + (2 + (g16 & 1)) * 64;
  const float2 c0 = R.c0, c1 = R.c1, e0 = R.e0, e1 = R.e1;
  uint32_t olo, ohi;
  nr4<16>(R.q_lo, R.q_hi, 1.f / 64.f, G.gq0, G.gq1, G.gq2, G.gq3, true, c0, c1, qs64, olo, ohi);
  *(uint32_t*)(ur + C_NQ + g16 * 64 + 2 * j16) = olo; *(uint32_t*)(ur + C_NQ + g16 * 64 + 32 + 2 * j16) = ohi;
  nr4<16>(R.p2_lo, R.p2_hi, 1.f / 64.f, G.h0, G.h1, G.h2, G.h3, g16 < 2, c0, c1, g16 < 2 ? 1.f : qs64, olo, ohi);
  *(uint32_t*)(ur + col2 + 2 * j16) = olo; *(uint32_t*)(ur + col2 + 32 + 2 * j16) = ohi;
  nr4<16>(R.p3_lo, R.p3_hi, 1.f / 64.f, G.m0, G.m1, G.m2, G.m3, false, c0, c1, qs64, olo, ohi);
  if (g16 < 2) { *(uint32_t*)(ur + col3 + 2 * j16) = olo; *(uint32_t*)(ur + col3 + 32 + 2 * j16) = ohi; }
  nr4<8>(R.dq_lo, R.dq_hi, 1.f / 32.f, G.dq0, G.dq1, G.dq2, G.dq3, true, e0, e1, qs32, olo, ohi);
  *(uint32_t*)(ur + C_DQ + g8 * 32 + 2 * j8) = olo; *(uint32_t*)(ur + C_DQ + g8 * 32 + 16 + 2 * j8) = ohi;
  nr4<8>(R.dk_lo, R.dk_hi, 1.f / 32.f, G.dk0, G.dk1, G.dk2, G.dk3, true, e0, e1, 1.f, olo, ohi);
  *(uint32_t*)(ur + C_DK + g8 * 32 + 2 * j8) = olo; *(uint32_t*)(ur + C_DK + g8 * 32 + 16 + 2 * j8) = ohi;
  if (lane < 12) ((float*)(ws + OFF_GT))[(size_t)t * 12 + lane] = sigmoidf_(bf2f(R.glv));
  float sq, skv;
  {
    float c0f = bflo(R.cw.x), c1f = bfhi(R.cw.x), c2f = bflo(R.cw.y), c3f = bfhi(R.cw.y);
    float ss = c0f * c0f + c1f * c1f + c2f * c2f + c3f * c3f;
    float d0 = bflo(R.ckw), d1 = bfhi(R.ckw);
    float s2 = d0 * d0 + d1 * d1;
    ss = sum64(ss); s2 = sum64(s2);
    sq = rsqrtf(ss * (1.f / 256.f) + EPS);
    skv = rsqrtf(s2 * (1.f / 128.f) + EPS);
  }
  {
    const int h = g16, j = j16;
    float n0 = bflo(R.nw.x) * sq, n1 = bfhi(R.nw.x) * sq, n2 = bflo(R.nw.y) * sq, n3 = bfhi(R.nw.y) * sq;
    float ra = bf2f(R.uqa) * sq, rb = bf2f(R.uqb) * sq;
    float r1 = ra * c0.x - rb * c0.y, r2 = rb * c0.x + ra * c0.y;
    float ss = n0 * n0 + n1 * n1 + n2 * n2 + n3 * n3 + r1 * r1 + r2 * r2;
    ss = sum16(ss);
    float r = rsqrtf(ss * (1.f / 96.f) + EPS) * qs96;
    bf16* qd = (bf16*)(ws + OFF_QM) + ((size_t)(b * 4 + h) * S + s) * 96;
    uint2 o; o.x = pack2(n0 * r * G.mgq0, n1 * r * G.mgq1); o.y = pack2(n2 * r * G.mgq2, n3 * r * G.mgq3);
    *(uint2*)(qd + 4 * j) = o;
    qd[64 + j] = f2bf(r1 * r * G.mgq4);
    qd[80 + j] = f2bf(r2 * r * G.mgq5);
    float k0 = bflo(R.kw2.x) * skv, k1 = bfhi(R.kw2.x) * skv, k2 = bflo(R.kw2.y) * skv, k3 = bfhi(R.kw2.y) * skv;
    float ka = bf2f(R.kra), kb = bf2f(R.krb);
    float kr1 = ka * c0.x - kb * c0.y, kr2 = kb * c0.x + ka * c0.y;
    float s3 = k0 * k0 + k1 * k1 + k2 * k2 + k3 * k3 + kr1 * kr1 + kr2 * kr2;
    s3 = sum16(s3);
    float rk_ = rsqrtf(s3 * (1.f / 96.f) + EPS);
    bf16* kd = (bf16*)(ws + OFF_KM) + ((size_t)(b * 4 + h) * S + s) * 96;
    uint2 o2; o2.x = pack2(k0 * rk_ * G.mgk0, k1 * rk_ * G.mgk1); o2.y = pack2(k2 * rk_ * G.mgk2, k3 * rk_ * G.mgk3);
    *(uint2*)(kd + 4 * j) = o2;
    kd[64 + j] = f2bf(kr1 * rk_ * G.mgk4);
    kd[80 + j] = f2bf(kr2 * rk_ * G.mgk5);
    uint2 o3; o3.x = pack2(bflo(R.vw.x) * skv, bfhi(R.vw.x) * skv); o3.y = pack2(bflo(R.vw.y) * skv, bfhi(R.vw.y) * skv);
    *(uint2*)((bf16*)(ws + OFF_MV) + ((size_t)(b * 4 + h) * S + s) * 64 + 4 * j) = o3;
  }
}

DI void prep_phase(const Params& p, int layer) {
  const int tid = opq(threadIdx.x), lane = tid & 63, wv = tid >> 6;
  char* ws = opqp(p.ws);
  const float2* rope = (const float2*)(ws + OFF_ROPE);
  const float* nsa_g = p.in[5] + layer * 256;
  const float* diff_g = p.in[8] + layer * 64;
  const float* mla_g = p.in[15] + layer * 192;
  const float* mem_g = p.in[18] + layer * 128;
  constexpr int N_TOK = T / 4, N_MEMT = TM / 4, N_CMP = 1024 / 4;
  const int j16 = lane & 15, g16 = lane >> 4, j8 = lane & 7;
  PrepG G;
  G.gq0 = nsa_g[2 * j16]; G.gq1 = nsa_g[2 * j16 + 1]; G.gq2 = nsa_g[32 + 2 * j16]; G.gq3 = nsa_g[33 + 2 * j16];
  const float* g2p = g16 == 0 ? nsa_g + 128 : (g16 == 1 ? nsa_g + 192 : mem_g);
  G.h0 = g2p[2 * j16]; G.h1 = g2p[2 * j16 + 1]; G.h2 = g2p[32 + 2 * j16]; G.h3 = g2p[33 + 2 * j16];
  G.m0 = mem_g[2 * j16]; G.m1 = mem_g[2 * j16 + 1]; G.m2 = mem_g[32 + 2 * j16]; G.m3 = mem_g[33 + 2 * j16];
  G.dq0 = diff_g[2 * j8]; G.dq1 = diff_g[2 * j8 + 1]; G.dq2 = diff_g[16 + 2 * j8]; G.dq3 = diff_g[17 + 2 * j8];
  G.dk0 = diff_g[32 + 2 * j8]; G.dk1 = diff_g[33 + 2 * j8]; G.dk2 = diff_g[48 + 2 * j8]; G.dk3 = diff_g[49 + 2 * j8];
  G.mgq0 = mla_g[4 * j16]; G.mgq1 = mla_g[4 * j16 + 1]; G.mgq2 = mla_g[4 * j16 + 2]; G.mgq3 = mla_g[4 * j16 + 3];
  G.mgq4 = mla_g[64 + j16]; G.mgq5 = mla_g[80 + j16];
  G.mgk0 = mla_g[96 + 4 * j16]; G.mgk1 = mla_g[96 + 4 * j16 + 1]; G.mgk2 = mla_g[96 + 4 * j16 + 2]; G.mgk3 = mla_g[96 + 4 * j16 + 3];
  G.mgk4 = mla_g[96 + 64 + j16]; G.mgk5 = mla_g[96 + 80 + j16];
  const int xcd = blockIdx.x & 7, rk = blockIdx.x >> 3, nrk = gridDim.x >> 3;
  for (int i = rk; i < 512; i += 2 * nrk) {
    const int it = xcd * 512 + i;
    const bool has2 = i + nrk < 512;
    const int it2 = has2 ? it + nrk : it;
    const int tA = it * 4 + wv, tB = it2 * 4 + wv;
    PrepR A, B;
    prep_load(ws, tA, lane, A);
    prep_load(ws, tB, lane, B);
    prep_fin(ws, tA, lane, A, G);
    if (has2) prep_fin(ws, tB, lane, B, G);
  }
  for (int i = rk; i < 96; i += nrk) {
    const int it = i < 64 ? N_TOK + xcd * 64 + i : N_TOK + N_MEMT + xcd * 32 + (i - 64);
    if (false) {
    } else if (it < N_TOK + N_MEMT) {
      const int t = (it - N_TOK) * 4 + wv;
      const int b = t >> 8, mi = t & 255;
      const bf16* kr = (const bf16*)(ws + OFF_KMEMRAW) + (size_t)t * 512;
      const int h = lane >> 4;
      uint2 vw = *(const uint2*)(kr + 256 + lane * 4);
      vec64(true, kr + h * 64, nullptr, 0, (bf16*)(ws + OFF_MK) + ((size_t)(b * 4 + h) * ML + mi) * 64, mem_g + 64, nullptr, 1.f, j16);
      *(uint2*)((bf16*)(ws + OFF_MVV) + ((size_t)(b * 4 + h) * ML + mi) * 64 + j16 * 4) = vw;
    } else {
      const int r = (it - N_TOK - N_MEMT) * 4 + wv;
      const int n = r & 127;
      const bf16* kraw = (const bf16*)(ws + OFF_CMPRAW) + (size_t)r * 128;
      const bf16* vraw = (const bf16*)(ws + OFF_CMPRAW) + (size_t)(1024 + r) * 128;
      const float* cbk = (const float*)(ws + OFF_CB) + (size_t)(layer * 2 + 0) * 16 * 64;
      const float* cbv = (const float*)(ws + OFF_CB) + (size_t)(layer * 2 + 1) * 16 * 64;
      bf16* kd = (bf16*)(ws + OFF_KCN) + (size_t)r * 64;
      bf16* vd = (bf16*)(ws + OFF_VCN) + (size_t)r * 64;
      if (n < 127) {
        const int pos = 16 * n + 31;
        float bv = 0.f;
#pragma unroll
        for (int sidx = 0; sidx < 16; ++sidx) bv += cbv[sidx * 64 + lane];
        const float vv = bf2f(vraw[lane]) + bf2f(vraw[(size_t)2 * 1024 * 128 + lane]) + bf2f(vraw[(size_t)4 * 1024 * 128 + lane]) + bf2f(vraw[(size_t)6 * 1024 * 128 + lane]) + bv;
        vec64(lane < 16, kraw, cbk, 16, kd, nsa_g + 64, rope + pos * 32, 1.f, lane & 15, kraw + (size_t)2 * 1024 * 128);
        vd[lane] = f2bf(vv);
      } else {
        kd[lane] = 0; vd[lane] = 0;
      }
    }
  }
}

DI void pl_swap(uint32_t& a, uint32_t& b) { auto r_ = __builtin_amdgcn_permlane32_swap(a, b, false, false); a = r_[0]; b = r_[1]; }
DI void ld_own(const bf16* p, uint2& lo, uint2& hi) {
  const uint4 w = *(const uint4*)p;
  lo.x = w.x; lo.y = w.y; hi.x = w.z; hi.y = w.w;
  pl_swap(lo.x, hi.x); pl_swap(lo.y, hi.y);
}
template <int MODE>
DI void attn_epi(const f32x16 (&O)[2], float scale, const bf16* zrow, const float* sg, const bf16* a1row, const bf16* a2row, bf16* orow, int half) {
#pragma unroll
  for (int dvb = 0; dvb < 2; ++dvb)
#pragma unroll
    for (int pq = 0; pq < 2; ++pq) {
      const int col16 = dvb * 32 + 16 * pq + 8 * half;
      const int dvA = dvb * 32 + 16 * pq + 4 * half;
      float va[4], vb[4];
#pragma unroll
      for (int e = 0; e < 4; ++e) { va[e] = O[dvb][8 * pq + e] * scale; vb[e] = O[dvb][8 * pq + 4 + e] * scale; }
      if (MODE == 2) {
#pragma unroll
        for (int e = 0; e < 4; ++e) { va[e] *= sg[dvA + e]; vb[e] *= sg[dvA + 8 + e]; }
      }
      if (MODE == 3) {
        uint2 clo, chi, wlo, whi;
        ld_own(a1row + col16, clo, chi);
        ld_own(a2row + col16, wlo, whi);
        va[0] += bflo(clo.x) + bflo(wlo.x); va[1] += bfhi(clo.x) + bfhi(wlo.x); va[2] += bflo(clo.y) + bflo(wlo.y); va[3] += bfhi(clo.y) + bfhi(wlo.y);
        vb[0] += bflo(chi.x) + bflo(whi.x); vb[1] += bfhi(chi.x) + bfhi(whi.x); vb[2] += bflo(chi.y) + bflo(whi.y); vb[3] += bfhi(chi.y) + bfhi(whi.y);
      }
      if (MODE >= 1) {
        uint2 zlo, zhi;
        ld_own(zrow + col16, zlo, zhi);
        va[0] *= siluf_(bflo(zlo.x)); va[1] *= siluf_(bfhi(zlo.x)); va[2] *= siluf_(bflo(zlo.y)); va[3] *= siluf_(bfhi(zlo.y));
        vb[0] *= siluf_(bflo(zhi.x)); vb[1] *= siluf_(bfhi(zhi.x)); vb[2] *= siluf_(bflo(zhi.y)); vb[3] *= siluf_(bfhi(zhi.y));
      }
      uint32_t A0 = pack2(va[0], va[1]), A1 = pack2(va[2], va[3]), B0 = pack2(vb[0], vb[1]), B1 = pack2(vb[2], vb[3]);
      pl_swap(A0, B0); pl_swap(A1, B1);
      uint4 o; o.x = A0; o.y = A1; o.z = B0; o.w = B1;
      *(uint4*)(orow + col16) = o;
    }
}
DI void st4(bf16* dst, float a, float b, float c, float d) { uint2 o; o.x = pack2(a, b); o.y = pack2(c, d); *(uint2*)dst = o; }

DI void attn_phaseA(const Params& p, int layer, char* smem, int* ctr) {
  char* ws = opqp(p.ws);
  bf16* u = (bf16*)(ws + OFF_U);
  bf16* y = (bf16*)(ws + OFF_Y);
  const float* gt = (const float*)(ws + OFF_GT);
  int* s_item = (int*)(smem + SM_MISC);
  const int xcd = blockIdx.x & 7;
  while (true) {
    __syncthreads();
    if (threadIdx.x == 0) *s_item = atomicAdd(ctr + 24 + xcd, 1);
    __syncthreads();
    const int item = *s_item;
    if (item >= 16) break;
    {
      const int tid = opq(threadIdx.x), lane = tid & 63, wv = tid >> 6, half = lane >> 5, l31 = lane & 31;
      const int i2 = item;
      const int qb = 15 - i2, b = xcd;
      const int q0 = qb * 128, qpos = q0 + wv * 32 + l31;
      const size_t t = (size_t)b * S + qpos;
      const bf16* ub = u + (size_t)b * S * NP;
      const bf16* kc = (const bf16*)(ws + OFF_KCN) + (size_t)b * 128 * 64;
      const bf16* vc = (const bf16*)(ws + OFF_VCN) + (size_t)b * 128 * 64;
      const uint32_t tm = (q0 + 127 >= 16 * 64 + 31) ? 3u : 1u;
      float* scl = (float*)(smem + SM_SC) + wv * 32 * 33;
#pragma unroll
      for (int g = 0; g < 16; ++g) scl[l31 * 33 + 2 * g + half] = 0.f;
      const int khi = (qpos - 31) >> 4;
#pragma unroll 1
      for (int h = 0; h < 4; ++h) {
        f32x16 O[2]; float mm, ll;
        bf16x8 Qf[4];
        load_q<64>(ub + (size_t)qpos * NP + C_NQ + h * 64, Qf);
        attn_core<64>(kc, 64, vc, 64, tm, AM_CMP, qpos, 0u, Qf, O, mm, ll, smem);
        const float inv = ll > 0.f ? 1.f / ll : 0.f;
        const float sc = inv * gt[t * 12 + h];
        bf16* od = (bf16*)(ws + OFF_OCMP) + t * 256 + h * 64;
        attn_epi<0>(O, sc, nullptr, nullptr, nullptr, nullptr, od, half);
        const float mu = mm < -1e29f ? 0.f : mm;
        const bf16* Ks = (const bf16*)smem;
        float Aa[16], Cc[16];
#pragma unroll
        for (int g = 0; g < 16; ++g) { Aa[g] = 0.f; Cc[g] = 0.f; }
#pragma unroll
        for (int kt = 0; kt < 2; ++kt) {
          if (tm & (1u << kt)) {
#pragma unroll
            for (int kb = 0; kb < 2; ++kb) {
              f32x16 Sx;
#pragma unroll
              for (int i = 0; i < 16; ++i) Sx[i] = 0.f;
#pragma unroll
              for (int kcx = 0; kcx < 4; ++kcx) {
                bf16x8 a = *(const bf16x8*)(Ks + (kt * 64 + kb * 32 + l31) * 72 + kcx * 16 + half * 8);
                Sx = MFMA(a, Qf[kcx], Sx);
              }
#pragma unroll
              for (int gg = 0; gg < 4; ++gg) {
                float pv[4];
#pragma unroll
                for (int e = 0; e < 4; ++e) {
                  const int key = kt * 64 + kb * 32 + gg * 8 + half * 4 + e;
                  pv[e] = key <= khi ? fexp2(Sx[gg * 4 + e] - mu) * inv : 0.f;
                }
                Aa[kt * 8 + kb * 4 + gg] += pv[0] + 2.f * (pv[1] + pv[2] + pv[3]);
                Cc[kt * 8 + kb * 4 + gg] += pv[0];
              }
            }
          }
        }
        {
          float rc[16];
#pragma unroll
          for (int g = 0; g < 16; ++g) rc[g] = shx(Cc[g], 32);
#pragma unroll
          for (int g = 0; g < 16; ++g) {
            const float nx = half == 0 ? rc[g] : (g < 15 ? rc[g < 15 ? g + 1 : 15] : 0.f);
            scl[l31 * 33 + 2 * g + half] += Aa[g] + nx;
          }
        }
      }
      __syncthreads();
      {
        float sv[32];
        const int cur = qpos >> 6;
#pragma unroll
        for (int j = 0; j < 32; ++j) {
          float v = scl[l31 * 33 + j];
          const bool forced = (j == 0) || (j == cur) || (j == cur - 1);
          sv[j] = j > cur ? -1e30f : (forced ? 1e30f : v);
        }
        uint32_t bits = 0;
#pragma unroll 1
        for (int jj = 0; jj < 16; ++jj) {
          const int j = half * 16 + jj;
          float sj = scl[l31 * 33 + j];
          const bool fj = (j == 0) || (j == cur) || (j == cur - 1);
          sj = j > cur ? -1e30f : (fj ? 1e30f : sj);
          int rank = 0;
#pragma unroll
          for (int i = 0; i < 32; ++i) rank += (sv[i] > sj || (sv[i] == sj && i < j)) ? 1 : 0;
          if (rank < 16) bits |= 1u << j;
        }
        bits |= (uint32_t)__shfl_xor((int)bits, 32);
        if (half == 0) ((uint32_t*)(ws + OFF_SEL))[t] = bits;
      }
      wg_publish((unsigned*)(ws + OFF_FLAG) + layer * 1024 + (b * 16 + qb) * 8);
    }
  }
  while (true) {
    __syncthreads();
    if (threadIdx.x == 0) *s_item = atomicAdd(ctr + 16 + xcd, 1);
    __syncthreads();
    const int item = *s_item;
    if (item >= 128) break;
    {
      const int tid = opq(threadIdx.x), lane = tid & 63, wv = tid >> 6, half = lane >> 5, l31 = lane & 31;
      const int i2 = item;
      const int ismem = i2 >> 6, r = i2 & 63, qb = 15 - (r >> 2), b = xcd, h = r & 3;
      const int q0 = qb * 128, qpos = q0 + wv * 32 + l31;
      const size_t t = (size_t)b * S + qpos;
      const bf16* ub = u + (size_t)b * S * NP;
      f32x16 O[2]; float mm, ll;
      bf16x8 Qf[4];
      if (!ismem) {
        load_q<64>(ub + (size_t)qpos * NP + C_NQ + h * 64, Qf);
        const int kt0 = q0 >= 512 ? (q0 - 512) / 64 : 0, kt1 = 2 * qb + 2;
        const uint32_t hi = kt1 >= 32 ? 0xffffffffu : ((1u << kt1) - 1u);
        const uint32_t tm = hi & ~((1u << kt0) - 1u);
        attn_core<64>(ub + C_KW, NP, ub + C_VW, NP, tm, AM_WIN, qpos, 0u, Qf, O, mm, ll, smem);
        const float sc = (ll > 0.f ? 1.f / ll : 0.f) * gt[t * 12 + 8 + h];
        bf16* od = (bf16*)(ws + OFF_OWIN) + t * 256 + h * 64;
        attn_epi<0>(O, sc, nullptr, nullptr, nullptr, nullptr, od, half);
        wg_publish((unsigned*)(ws + OFF_FLAG) + layer * 1024 + (b * 16 + qb) * 8 + 1 + h);
      } else {
        load_q<64>(ub + (size_t)qpos * NP + C_MQ + h * 64, Qf);
        attn_core<64>((const bf16*)(ws + OFF_MK) + (size_t)(b * 4 + h) * ML * 64, 64, (const bf16*)(ws + OFF_MVV) + (size_t)(b * 4 + h) * ML * 64, 64,
                      0xfu, AM_NONE, qpos, 0u, Qf, O, mm, ll, smem);
        const float inv = ll > 0.f ? 1.f / ll : 0.f;
        attn_epi<1>(O, inv, u + t * NP + C_MEZ + h * 64, nullptr, nullptr, nullptr, y + t * 1024 + 768 + h * 64, half);
      }
    }
  }
  while (true) {
    __syncthreads();
    if (threadIdx.x == 0) *s_item = atomicAdd(ctr + xcd, 1);
    __syncthreads();
    const int item = *s_item;
    if (item >= 64) break;
    {
      const int tid = opq(threadIdx.x), lane = tid & 63, wv = tid >> 6, half = lane >> 5, l31 = lane & 31;
      const int qb = 15 - (item >> 2), b = xcd, h = item & 3;
      const int q0 = qb * 128, qpos = q0 + wv * 32 + l31;
      const size_t t = (size_t)b * S + qpos;
      const uint32_t tm = (qb == 15) ? 0xffffffffu : ((1u << (2 * qb + 2)) - 1u);
      f32x16 O[2]; float mm, ll;
        bf16x8 Qf[6];
        const bf16* qm = (const bf16*)(ws + OFF_QM) + (size_t)(b * 4 + h) * S * 96;
        load_q<96>(qm + (size_t)qpos * 96, Qf);
        attn_core<96>((const bf16*)(ws + OFF_KM) + (size_t)(b * 4 + h) * S * 96, 96,
                      (const bf16*)(ws + OFF_MV) + (size_t)(b * 4 + h) * S * 64, 64, tm, AM_CAUSAL, qpos, 0u, Qf, O, mm, ll, smem);
        const float inv = ll > 0.f ? 1.f / ll : 0.f;
        attn_epi<1>(O, inv, u + t * NP + C_MZ + h * 64, nullptr, nullptr, nullptr, y + t * 1024 + 512 + h * 64, half);
    }
  }
  while (true) {
    __syncthreads();
    if (threadIdx.x == 0) *s_item = atomicAdd(ctr + 8 + xcd, 1);
    __syncthreads();
    const int item = *s_item;
    if (item >= 64) break;
    {
      const int tid = opq(threadIdx.x), lane = tid & 63, wv = tid >> 6, half = lane >> 5, l31 = lane & 31;
      const int qb = 15 - (item >> 2), b = xcd, h = item & 3;
      const int q0 = qb * 128, qpos = q0 + wv * 32 + l31;
      const size_t t = (size_t)b * S + qpos;
      const uint32_t tm = (qb == 15) ? 0xffffffffu : ((1u << (2 * qb + 2)) - 1u);
      f32x16 O[2]; float mm, ll;
        f32x16 O1[2];
        const bf16* ub = u + (size_t)b * S * NP;
        {
          bf16x8 Qf[4];
          float l1, l2;
          load_q<64>(ub + (size_t)qpos * NP + C_DQ + h * 64, Qf);
          attn_core_dual<64>(ub + C_DK + h * 64, NP, ub + C_DV + h * 64, NP, tm, AM_CAUSAL, qpos, 0u, Qf, O1, O, l1, l2, smem);
          const float inv1 = l1 > 0.f ? 1.f / l1 : 0.f, inv = l2 > 0.f ? 1.f / l2 : 0.f;
#pragma unroll
          for (int i = 0; i < 16; ++i) { O1[0][i] *= inv1; O1[1][i] *= inv1; }
          {
            const float lam = ((const float*)(ws + OFF_LAM))[layer];
            float ss = 0.f;
#pragma unroll
            for (int i = 0; i < 16; ++i) {
              O1[0][i] -= lam * O[0][i] * inv; O1[1][i] -= lam * O[1][i] * inv;
              ss += O1[0][i] * O1[0][i] + O1[1][i] * O1[1][i];
            }
            ss += shx(ss, 32);
            const float li = opq(layer) == 0 ? 0.2f : 0.35550907f;
            const float r = rsqrtf(ss * (1.f / 64.f) + EPS) * (1.f - li);
            const float* sg = p.in[10] + layer * 64;
            attn_epi<2>(O1, r, u + t * NP + C_DZ + h * 64, sg, nullptr, nullptr, y + t * 1024 + 256 + h * 64, half);
          }
        }
    }
  }
}

DI void attn_phaseB(const Params& p, int layer, char* smem, int* ctr) {
  const int tid = opq(threadIdx.x), lane = tid & 63, wv = tid >> 6, half = lane >> 5, l31 = lane & 31;
  char* ws = opqp(p.ws);
  bf16* u = (bf16*)(ws + OFF_U);
  bf16* y = (bf16*)(ws + OFF_Y);
  const float* gt = (const float*)(ws + OFF_GT);
  int* s_item = (int*)(smem + SM_MISC);
  uint32_t* s_or = (uint32_t*)(smem + SM_MISC + 16);
  const int xcd = blockIdx.x & 7;
  while (true) {
    __syncthreads();
    if (tid == 0) { *s_item = atomicAdd(ctr + xcd, 1); *s_or = 0u; }
    __syncthreads();
    const int item = *s_item;
    if (item >= 64) break;
    const int qb = 15 - (item >> 2), b = xcd, h = item & 3;
    const int q0 = qb * 128, qpos = q0 + wv * 32 + l31;
    const size_t t = (size_t)b * S + qpos;
    const bf16* ub = u + (size_t)b * S * NP;
    wg_wait2((unsigned*)(ws + OFF_FLAG) + layer * 1024 + (b * 16 + qb) * 8, (unsigned*)(ws + OFF_FLAG) + layer * 1024 + (b * 16 + qb) * 8 + 1 + h);
    const uint32_t sel = ((const uint32_t*)(ws + OFF_SEL))[t];
    const uint32_t causal = (qb == 15) ? 0xffffffffu : ((1u << (2 * qb + 2)) - 1u);
    if (half == 0) atomicOr(s_or, sel);
    __syncthreads();
    const uint32_t tm = (*s_or & causal) | 1u;
    f32x16 O[2]; float mm, ll;
    bf16x8 Qf[4];
    load_q<64>(ub + (size_t)qpos * NP + C_NQ + h * 64, Qf);
    attn_core<64>(ub + C_KS, NP, ub + C_VS, NP, tm, AM_SLC, qpos, sel, Qf, O, mm, ll, smem);
    const float sc = (ll > 0.f ? 1.f / ll : 0.f) * gt[t * 12 + 4 + h];
    const bf16* oc = (const bf16*)(ws + OFF_OCMP) + t * 256 + h * 64;
    const bf16* ow = (const bf16*)(ws + OFF_OWIN) + t * 256 + h * 64;
    attn_epi<3>(O, sc, u + t * NP + C_NZ + h * 64, nullptr, oc, ow, y + t * 1024 + h * 64, half);
  }
  (void)layer;
}

__global__ void __launch_bounds__(256, 2) fwd_megakernel(Params p) {
  __shared__ __attribute__((aligned(16))) char smem[SMEM_BYTES];
  cg::grid_group grid = cg::this_grid();
  char* ws = opqp(p.ws);
  int* ctrs = (int*)(ws + OFF_CTR);
  __shared__ uint4 xb_words;
  if (threadIdx.x == 0) xb_words = make_uint4(0u, 0u, 0u, 0u);
  __syncthreads();
  XcdBarrier xb = xcd_barrier_post((unsigned*)(ws + OFF_BAR), (volatile LAS unsigned*)&xb_words);
  phase0(p, smem);
  if (p.out == nullptr) grid.sync();
  xcd_barrier(xb);
#define PBAR(K) xcd_barrier(xb)
  for (int layer = 0; layer < 2; ++layer) {
    bf16* u = (bf16*)(ws + OFF_U);
    {
      const bf16* xbp = (const bf16*)(ws + OFF_XB);
      const bf16* wi = (const bf16*)(ws + OFF_WI + layer * SZ_WI);
      const int xcd = blockIdx.x & 7, rk = blockIdx.x >> 3, nrk = gridDim.x >> 3;
      for (int q = rk; q < 216; q += nrk) {
        if (q < 192) {
          const int mt = xcd * 8 + (q & 7), nt = q >> 3;
          gemm_big(xbp + (size_t)mt * 256 * 1024, 1024, wi + (size_t)nt * 128 * 1024, 1024, 16, smem, EPI_RS8, u, NP, mt * 256,
                   (const float*)(ws + OFF_SSQ), nullptr, nullptr, nullptr, nullptr, nt);
        } else if (q < 208) {
          const int mt = xcd * 16 + (q - 192), nt = 24;
          gemm_tile<16>(xbp + (size_t)mt * 128 * 1024, 1024, 64, wi + (size_t)nt * 128 * 1024, 1024, 16, smem);
          gemm_epi(EPI_RS8, smem, u, NP, mt * 128, (const float*)(ws + OFF_SSQ), nullptr, nullptr, nullptr, nullptr, nt);
        } else {
          const int i = xcd * 8 + (q - 208), mt = i >> 2, nt = i & 3;
          gemm_tile<16>((const bf16*)(ws + OFF_MEMB) + (size_t)mt * 128 * 1024, 1024, 64,
                    (const bf16*)(ws + OFF_WMEM + layer * SZ_WMEM) + (size_t)nt * 128 * 1024, 1024, 16, smem);
          gemm_epi(EPI_RS1, smem, (bf16*)(ws + OFF_KMEMRAW), 512, mt * 128, (const float*)(ws + OFF_RMEM), nullptr, nullptr, nullptr, nullptr, nt);
        }
      }
    }
    PBAR(0);
    {
      const int xcd = blockIdx.x & 7, rk = blockIdx.x >> 3, nrk = gridDim.x >> 3;
      for (int q = rk; q < 64; q += nrk) {
        if (q < 8) {
          const int j = q >> 2, kh = q & 3, b = xcd;
          gemm_tile<8>(u + (size_t)b * S * NP + (j ? C_VC : C_KC) + (size_t)kh * 8 * NP, 16 * NP, NP,
                       (const bf16*)(ws + OFF_WCMP + (layer * 2 + j) * SZ_WCMP) + kh * 512, 2048, 8, smem);
          gemm_epi(EPI_PLAIN, smem, (bf16*)(ws + OFF_CMPRAW) + (size_t)(kh * 2 + j) * 1024 * 128, 128, b * 128, nullptr, nullptr, nullptr, nullptr, nullptr, 0);
        } else if (q < 32) {
          const int i = q - 8, ml = i / 3, nt = i % 3, mt = xcd * 8 + ml;
          gemm_big(u + (size_t)mt * 256 * NP + C_CQ, NP, (const bf16*)(ws + OFF_WUQ + layer * SZ_WUQ) + (size_t)nt * 128 * 256, 256, 4, smem, EPI_PLAIN,
                   (bf16*)(ws + OFF_UQ + (size_t)xcd * SLAB), 384, ml * 256, nullptr, nullptr, nullptr, nullptr, nullptr, nt);
        } else {
          const int i = q - 32, ml = i >> 2, nt = i & 3, mt = xcd * 8 + ml;
          gemm_big(u + (size_t)mt * 256 * NP + C_CKV, NP, (const bf16*)(ws + OFF_WUKV + layer * SZ_WUKV) + (size_t)nt * 128 * 128, 128, 2, smem, EPI_PLAIN,
                   (bf16*)(ws + OFF_UKV + (size_t)xcd * SLAB), 512, ml * 256, nullptr, nullptr, nullptr, nullptr, nullptr, nt);
        }
      }
    }
    PBAR(1);
    prep_phase(p, layer);
    PBAR(2);
    attn_phaseA(p, layer, smem, ctrs + layer * 64);
    attn_phaseB(p, layer, smem, ctrs + layer * 64 + 32);
    PBAR(3);
    {
      const bf16* yb = (const bf16*)(ws + OFF_Y);
      const bf16* wo = (const bf16*)(ws + OFF_WO + layer * SZ_WO);
      const float* xres = layer == 0 ? p.in[0] : nullptr;
      const int xcd = blockIdx.x & 7, rk = blockIdx.x >> 3, nrk = gridDim.x >> 3;
      for (int q = rk; q < 64; q += nrk) {
        const int mt = xcd * 8 + (q & 7), nt = q >> 3;
        gemm_big(yb + (size_t)mt * 256 * 1024, 1024, wo + (size_t)nt * 128 * 1024, 1024, 16, smem, EPI_OUT, (bf16*)(ws + OFF_XB), 0, mt * 256, nullptr, xres, layer == 0 ? nullptr : p.out,
                 layer == 0 ? (bf16*)(ws + OFF_XB) : nullptr, (float*)(ws + OFF_SSQ), nt);
      }
    }
    if (layer == 0) PBAR(4);
  }
}

extern "C" void kernel_launch(void* const* d_in, const int* in_sizes, int n_in, void* d_out, int out_size, void* d_ws, size_t ws_size,
                              hipStream_t stream) {
  static int grid_blocks = 0;
  if (!grid_blocks) {
    int dev = 0, cus = 0, per_cu = 0;
    hipGetDevice(&dev);
    hipDeviceGetAttribute(&cus, hipDeviceAttributeMultiprocessorCount, dev);
    hipOccupancyMaxActiveBlocksPerMultiprocessor(&per_cu, fwd_megakernel, 256, 0);
    if (per_cu > 2) per_cu = 2;
    grid_blocks = (cus * per_cu) & ~7;
  }
  if (ws_size < WS_TOTAL) { fprintf(stderr, "workspace too small: %zu < %zu\n", ws_size, (size_t)WS_TOTAL); return; }
  Params p{};
  for (int i = 0; i < 19; ++i) p.in[i] = (const float*)d_in[i];
  p.out = (float*)d_out;
  p.ws = (char*)d_ws;
  hipMemsetAsync((char*)d_ws + OFF_CTR, 0, 1024 + 16384 + 8192 + 2048, stream);
  void* args[] = {&p};
  hipError_t e = hipLaunchCooperativeKernel((void*)fwd_megakernel, dim3(grid_blocks), dim3(256), args, 0, stream);
  if (e != hipSuccess) fprintf(stderr, "cooperative launch failed: %s (grid %d)\n", hipGetErrorString(e), grid_blocks);
}
```

```cpp
#include <hip/hip_runtime.h>
#include <hip/hip_cooperative_groups.h>
#include <stdint.h>
#include <cstdio>
namespace cg = cooperative_groups;

typedef unsigned short bf16;
using bf16x8 = __attribute__((ext_vector_type(8))) short;
using f32x16 = __attribute__((ext_vector_type(16))) float;
typedef __bf16 hbf2 __attribute__((ext_vector_type(2)));
typedef float hf2 __attribute__((ext_vector_type(2)));
typedef uint32_t u32x4 __attribute__((ext_vector_type(4)));
#define GLD16(dst, ptr) asm volatile("global_load_dwordx4 %0, %1, off" : "=&v"(dst) : "v"(ptr) : "memory")
#define WAIT_VM0() asm volatile("s_waitcnt vmcnt(0)" ::: "memory")
#define DI __device__ __forceinline__
#define MFMA(a, b, c) __builtin_amdgcn_mfma_f32_32x32x16_bf16((a), (b), (c), 0, 0, 0)

constexpr int Bn = 8, S = 2048, T = 16384, D = 1024, NP = 3200, ML = 256, TM = 2048;
constexpr float EPS = 1e-6f;
constexpr float LOG2E = 1.4426950408889634f;
constexpr int C_NQ = 0, C_KC = 256, C_VC = 320, C_KS = 384, C_VS = 448, C_KW = 512, C_VW = 576, C_NZ = 640,
              C_DQ = 896, C_DK = 1152, C_DV = 1408, C_DZ = 1664, C_CQ = 1920, C_CKV = 2176, C_KR = 2304,
              C_MZ = 2336, C_MQ = 2592, C_MEZ = 2848, C_GL = 3104;
constexpr size_t SZ_WI = (size_t)NP * 1024 * 2, SZ_WO = 1024 * 1024 * 2, SZ_WUQ = 384 * 256 * 2, SZ_WUKV = 512 * 128 * 2,
                 SZ_WMEM = 512 * 1024 * 2, SZ_WCMP = 128 * 2048 * 2;
constexpr size_t OFF_WI = 0;
constexpr size_t OFF_WO = OFF_WI + 2 * SZ_WI;
constexpr size_t OFF_WUQ = OFF_WO + 2 * SZ_WO;
constexpr size_t OFF_WUKV = OFF_WUQ + 2 * SZ_WUQ;
constexpr size_t OFF_WMEM = OFF_WUKV + 2 * SZ_WUKV;
constexpr size_t OFF_WCMP = OFF_WMEM + 2 * SZ_WMEM;
constexpr size_t OFF_CB = OFF_WCMP + 4 * SZ_WCMP;
constexpr size_t OFF_LAM = OFF_CB + 16384;
constexpr size_t OFF_CTR = OFF_LAM + 256;
constexpr size_t OFF_BAR = OFF_CTR + 1024;
constexpr size_t OFF_FLAG = OFF_BAR + 16384;
constexpr size_t OFF_PCNT = OFF_FLAG + 8192;
constexpr size_t OFF_ROPE = OFF_PCNT + 2048;
constexpr size_t OFF_SSQ = OFF_ROPE + 2048 * 32 * 8;
constexpr size_t OFF_RMEM = OFF_SSQ + (size_t)T * 8 * 4;
constexpr size_t OFF_MEMB = OFF_RMEM + 2048 * 4;
constexpr size_t OFF_XB = OFF_MEMB + (size_t)TM * 1024 * 2;
constexpr size_t OFF_U = OFF_XB + (size_t)T * 1024 * 2;
constexpr size_t OFF_R1 = OFF_U + (size_t)T * NP * 2;
constexpr size_t SLAB = (size_t)S * 1024 * 2;
constexpr size_t OFF_UQ = OFF_R1;
constexpr size_t OFF_UKV = OFF_R1 + (size_t)S * 384 * 2;
constexpr size_t OFF_Y = OFF_R1;
constexpr size_t OFF_QM = OFF_R1 + (size_t)T * 1024 * 2;
constexpr size_t OFF_KM = OFF_QM + (size_t)T * 384 * 2;
constexpr size_t OFF_MV = OFF_KM + (size_t)T * 384 * 2;
constexpr size_t OFF_KMEMRAW = OFF_MV + (size_t)T * 256 * 2;
constexpr size_t OFF_MK = OFF_KMEMRAW + (size_t)TM * 512 * 2;
constexpr size_t OFF_MVV = OFF_MK + (size_t)TM * 256 * 2;
constexpr size_t OFF_CMPRAW = OFF_MVV + (size_t)TM * 256 * 2;
constexpr size_t OFF_KCN = OFF_CMPRAW + 8 * 1024 * 128 * 2;
constexpr size_t OFF_VCN = OFF_KCN + 8 * 128 * 64 * 2;
constexpr size_t OFF_GT = OFF_VCN + 8 * 128 * 64 * 2;
constexpr size_t OFF_OCMP = OFF_GT + (size_t)T * 12 * 4;
constexpr size_t OFF_OWIN = OFF_OCMP + (size_t)T * 256 * 2;
constexpr size_t OFF_SEL = OFF_OWIN + (size_t)T * 256 * 2;
constexpr size_t WS_TOTAL = OFF_SEL + (size_t)T * 4;

constexpr int SMEM_BYTES = 73728;
constexpr int SM_VT = 2 * 64 * 104 * 2;
constexpr int SM_SC = SM_VT + 2 * 64 * 72 * 2;
constexpr int SM_MISC = SM_SC + 4 * 32 * 33 * 4;

struct Params {
  const float* in[19];
  float* out;
  char* ws;
};

DI int opq(int v) { asm volatile("" : "+v"(v)); return v; }
DI char* opqp(char* q) { size_t z = 0; asm volatile("" : "+s"(z)); return q + z; }
DI float bf2f(uint32_t v) { return __uint_as_float(v << 16); }
DI float bflo(uint32_t w) { return __uint_as_float(w << 16); }
DI float bfhi(uint32_t w) { return __uint_as_float(w & 0xffff0000u); }
DI uint32_t pack2(float a, float b) { hf2 f = {a, b}; hbf2 r = __builtin_convertvector(f, hbf2); return __builtin_bit_cast(uint32_t, r); }
DI bf16 f2bf(float a) { return (bf16)(pack2(a, 0.f) & 0xffffu); }
DI float fexp2(float x) { return __builtin_amdgcn_exp2f(x); }
DI float sigmoidf_(float x) { return __builtin_amdgcn_rcpf(1.f + fexp2(-LOG2E * x)); }
DI float siluf_(float x) { return x * __builtin_amdgcn_rcpf(1.f + fexp2(-LOG2E * x)); }
DI float shx(float v, int m) { return __shfl_xor(v, m); }
DI float dppf(float v, int ctrl_sel) {
  int x = __builtin_bit_cast(int, v), r;
  if (ctrl_sel == 0) r = __builtin_amdgcn_mov_dpp(x, 0xB1, 0xF, 0xF, true);
  else if (ctrl_sel == 1) r = __builtin_amdgcn_mov_dpp(x, 0x4E, 0xF, 0xF, true);
  else if (ctrl_sel == 2) r = __builtin_amdgcn_mov_dpp(x, 0x141, 0xF, 0xF, true);
  else r = __builtin_amdgcn_mov_dpp(x, 0x140, 0xF, 0xF, true);
  return __builtin_bit_cast(float, r);
}
DI float sum8(float v) { v += dppf(v, 0); v += dppf(v, 1); v += dppf(v, 2); return v; }
DI float sum16(float v) { v = sum8(v); v += dppf(v, 3); return v; }
DI float sum64(float v) { v = sum16(v); v += shx(v, 16); v += shx(v, 32); return v; }


#define XB_TMO      128
#define XB_XCNT(j)  (256  + 64 * (j))
#define XB_XSUB(j)  (1280 + 64 * (j))
#define XB_XGEN(j)  (2304 + 64 * (j))
#define XB_TOP      3328
#define XB_TOPGEN   3392
#define XB_SPIN_CAP (1u << 22)
#define LAS __attribute__((address_space(3)))
DI unsigned xb_ld(unsigned* p) { return __hip_atomic_load(p, __ATOMIC_RELAXED, __HIP_MEMORY_SCOPE_AGENT); }
DI unsigned xb_add(unsigned* p, unsigned v) { return __hip_atomic_fetch_add(p, v, __ATOMIC_RELAXED, __HIP_MEMORY_SCOPE_AGENT); }
DI unsigned xb_xcc_id() { return (unsigned)__builtin_amdgcn_readfirstlane((int)(__builtin_amdgcn_s_getreg((3 << 11) | 20) & 0xFu)); }
#define XB_SPIN(cond, bar) do { unsigned _sp = 0; while (cond) { __builtin_amdgcn_s_sleep(1); \
    if ((++_sp & 255u) == 0u) { if (xb_ld(&(bar)[XB_TMO])) break; if (_sp > XB_SPIN_CAP) { atomicAdd(&(bar)[XB_TMO], 1u); break; } } } } while (0)
struct XcdBarrier { unsigned* bar; unsigned x; volatile LAS unsigned* st; };
DI XcdBarrier xcd_barrier_post(unsigned* bar, volatile LAS unsigned* st) {
  XcdBarrier b; b.bar = bar; b.x = xb_xcc_id(); b.st = st;
  if (threadIdx.x == 0) (void)xb_add(&bar[XB_XCNT(b.x)], 1u);
  return b;
}
DI void xcd_barrier_complete(unsigned* bar, unsigned x, unsigned& nloc, unsigned& nx) {
  const unsigned G = gridDim.x * gridDim.y * gridDim.z;
  unsigned sum, cnt, mine, sp = 0u;
  for (;;) {
    sum = 0u; cnt = 0u; mine = 0u;
#pragma unroll
    for (unsigned j = 0; j < 16; ++j) { const unsigned c = xb_ld(&bar[XB_XCNT(j)]); sum += c; cnt += (c > 0u) ? 1u : 0u; mine = (j == x) ? c : mine; }
    if (sum == G) break;
    __builtin_amdgcn_s_sleep(1);
    if ((++sp & 255u) == 0u) { if (xb_ld(&bar[XB_TMO])) break; if (sp > XB_SPIN_CAP) { atomicAdd(&bar[XB_TMO], 1u); break; } }
  }
  nloc = mine > 0u ? mine : 1u; nx = cnt > 0u ? cnt : 1u;
}
DI void xcd_barrier(const XcdBarrier& b) {
  asm volatile("s_waitcnt vmcnt(0)" ::: "memory");
  __syncthreads();
  if (threadIdx.x == 0) {
    unsigned* bar = b.bar;
    const unsigned bx = xb_xcc_id();
    __builtin_amdgcn_s_waitcnt(0);
    unsigned nloc = b.st[0], nx = b.st[1];
    if (nloc == 0u) { xcd_barrier_complete(bar, bx, nloc, nx); b.st[0] = nloc; b.st[1] = nx; }
    const unsigned old = xb_add(&bar[XB_XSUB(bx)], 1u);
    const unsigned gen = old / nloc;
    if (old + 1u == (gen + 1u) * nloc) {
      __builtin_amdgcn_fence(__ATOMIC_RELEASE, "agent");
      asm volatile("s_waitcnt vmcnt(0)" ::: "memory");
      const unsigned og = xb_add(&bar[XB_TOP], 1u);
      const unsigned tg = og / nx;
      if (og + 1u == (tg + 1u) * nx) xb_add(&bar[XB_TOPGEN], 1u);
      else XB_SPIN(xb_ld(&bar[XB_TOPGEN]) == tg, bar);
      __builtin_amdgcn_fence(__ATOMIC_ACQUIRE, "agent");
      xb_add(&bar[XB_XGEN(bx)], 1u);
      asm volatile("s_waitcnt vmcnt(0)" ::: "memory");
    } else {
      XB_SPIN(xb_ld(&bar[XB_XGEN(bx)]) == gen, bar);
      __builtin_amdgcn_fence(__ATOMIC_ACQUIRE, "agent");
      asm volatile("s_waitcnt vmcnt(0)" ::: "memory");
    }
  }
  __syncthreads();
}

DI void part_barrier(unsigned* cnt, unsigned target) {
  asm volatile("s_waitcnt vmcnt(0)" ::: "memory");
  __syncthreads();
  if (threadIdx.x == 0) {
    __builtin_amdgcn_s_waitcnt(0);
    __builtin_amdgcn_fence(__ATOMIC_RELEASE, "agent");
    asm volatile("s_waitcnt vmcnt(0)" ::: "memory");
    xb_add(cnt, 1u);
    unsigned sp = 0;
    while (xb_ld(cnt) < target) { __builtin_amdgcn_s_sleep(1); if (++sp > (1u << 24)) break; }
    __builtin_amdgcn_fence(__ATOMIC_ACQUIRE, "agent");
    asm volatile("s_waitcnt vmcnt(0)" ::: "memory");
  }
  __syncthreads();
}

DI void wg_publish(unsigned* flag) {
  asm volatile("s_waitcnt vmcnt(0)" ::: "memory");
  __syncthreads();
  if (threadIdx.x == 0) {
    __builtin_amdgcn_fence(__ATOMIC_RELEASE, "agent");
    asm volatile("s_waitcnt vmcnt(0)" ::: "memory");
    xb_add(flag, 1u);
  }
}
DI void wg_wait2(unsigned* f0, unsigned* f1) {
  if (threadIdx.x == 0) {
    unsigned sp = 0;
    while (xb_ld(f0) < 1u || xb_ld(f1) < 1u) { __builtin_amdgcn_s_sleep(2); if (++sp > (1u << 22)) break; }
    __builtin_amdgcn_fence(__ATOMIC_ACQUIRE, "agent");
    asm volatile("s_waitcnt vmcnt(0)" ::: "memory");
  }
  __syncthreads();
}

DI int win_orig(int n) { return n < 640 ? n : (n < 3104 ? n + 12 : (n < 3116 ? n - 3104 + 640 : -1)); }

DI void convT_tile(const float* __restrict__ src, int Nsrc, const float* __restrict__ gain, bf16* __restrict__ dst, int K,
                   int k0, int n0, int mapmode, float* tile) {
  const int tid = opq(threadIdx.x);
  {
    const int nn = tid & 63, kk = tid >> 6;
    const int n = n0 + nn;
    const int on = mapmode == 1 ? win_orig(n) : (n < Nsrc ? n : -1);
    float v[16];
#pragma unroll
    for (int it = 0; it < 16; ++it) {
      const int k = k0 + kk + 4 * it;
      v[it] = 0.f;
      if (on >= 0) v[it] = src[(size_t)k * Nsrc + on];
    }
    if (gain) {
#pragma unroll
      for (int it = 0; it < 16; ++it) v[it] *= gain[k0 + kk + 4 * it];
    }
#pragma unroll
    for (int it = 0; it < 16; ++it) tile[(kk + 4 * it) * 65 + nn] = v[it];
  }
  __syncthreads();
  {
    const int k8 = (tid & 7) * 8, nb = tid >> 3;
#pragma unroll
    for (int it = 0; it < 2; ++it) {
      const int n = nb + 32 * it;
      uint4 o;
      o.x = pack2(tile[(k8 + 0) * 65 + n], tile[(k8 + 1) * 65 + n]);
      o.y = pack2(tile[(k8 + 2) * 65 + n], tile[(k8 + 3) * 65 + n]);
      o.z = pack2(tile[(k8 + 4) * 65 + n], tile[(k8 + 5) * 65 + n]);
      o.w = pack2(tile[(k8 + 6) * 65 + n], tile[(k8 + 7) * 65 + n]);
      *(uint4*)(dst + (size_t)(n0 + n) * K + k0 + k8) = o;
    }
  }
  __syncthreads();
}

DI void phase0(const Params& p, char* smem) {
  const int tid = opq(threadIdx.x), lane = tid & 63, wv = tid >> 6;
  float* tile = (float*)smem;
  char* ws = opqp(p.ws);
  constexpr int N_WI = 2 * 50 * 16, N_WO = 2 * 16 * 16, N_WUQ = 2 * 6 * 4, N_WUKV = 2 * 8 * 2, N_WMEM = 2 * 8 * 16,
                N_WCMP = 4 * 2 * 32, N_X = T / 4, N_MEM = TM / 4, N_ROPE = 256, N_CB = 64, N_LAM = 1;
  constexpr int E0 = N_WI, E1 = E0 + N_WO, E2 = E1 + N_WUQ, E3 = E2 + N_WUKV, E4 = E3 + N_WMEM, E5 = E4 + N_WCMP,
                E6 = E5 + N_X, E7 = E6 + N_MEM, E8 = E7 + N_ROPE, E9 = E8 + N_CB, E10 = E9 + N_LAM;
  for (int it = blockIdx.x; it < E10; it += gridDim.x) {
    if (it < E0) {
      int l = it / 800, r = it % 800, nt = r / 16, kt = r % 16;
      convT_tile(p.in[3] + (size_t)l * 1024 * 3116, 3116, p.in[2] + l * 1024, (bf16*)(ws + OFF_WI + l * SZ_WI), 1024, kt * 64, nt * 64, 1, tile);
    } else if (it < E1) {
      int i = it - E0; int l = i / 256, r = i % 256, nt = r / 16, kt = r % 16;
      convT_tile(p.in[4] + (size_t)l * 1024 * 1024, 1024, nullptr, (bf16*)(ws + OFF_WO + l * SZ_WO), 1024, kt * 64, nt * 64, 0, tile);
    } else if (it < E2) {
      int i = it - E1; int l = i / 24, r = i % 24, nt = r / 4, kt = r % 4;
      convT_tile(p.in[13] + (size_t)l * 256 * 384, 384, p.in[11] + l * 256, (bf16*)(ws + OFF_WUQ + l * SZ_WUQ), 256, kt * 64, nt * 64, 0, tile);
    } else if (it < E3) {
      int i = it - E2; int l = i / 16, r = i % 16, nt = r / 2, kt = r % 2;
      convT_tile(p.in[14] + (size_t)l * 128 * 512, 512, p.in[12] + l * 128, (bf16*)(ws + OFF_WUKV + l * SZ_WUKV), 128, kt * 64, nt * 64, 0, tile);
    } else if (it < E4) {
      int i = it - E3; int l = i / 128, r = i % 128, nt = r / 16, kt = r % 16;
      convT_tile(p.in[17] + (size_t)l * 1024 * 512, 512, p.in[16] + l * 1024, (bf16*)(ws + OFF_WMEM + l * SZ_WMEM), 1024, kt * 64, nt * 64, 0, tile);
    } else if (it < E5) {
      int i = it - E4; int lj = i / 64, r = i % 64, nt = r / 32, kt = r % 32;
      convT_tile(p.in[7] + (size_t)lj * 2048 * 64, 64, nullptr, (bf16*)(ws + OFF_WCMP + lj * SZ_WCMP), 2048, kt * 64, nt * 64, 0, tile);
    } else if (it < E6) {
      int row = (it - E5) * 4 + wv;
      const float4* xr = (const float4*)(p.in[0] + (size_t)row * 1024);
      bf16* xb = (bf16*)(ws + OFF_XB) + (size_t)row * 1024;
      float ss = 0.f;
#pragma unroll
      for (int i = 0; i < 4; ++i) {
        float4 v = xr[lane + 64 * i];
        ss += v.x * v.x + v.y * v.y + v.z * v.z + v.w * v.w;
        uint2 o; o.x = pack2(v.x, v.y); o.y = pack2(v.z, v.w);
        *(uint2*)(xb + (lane + 64 * i) * 4) = o;
      }
      ss = sum64(ss);
      float* sq = (float*)(ws + OFF_SSQ) + (size_t)row * 8;
      if (lane < 8) sq[lane] = lane == 0 ? ss : 0.f;
    } else if (it < E7) {
      int row = (it - E6) * 4 + wv;
      const float4* xr = (const float4*)(p.in[1] + (size_t)row * 1024);
      bf16* xb = (bf16*)(ws + OFF_MEMB) + (size_t)row * 1024;
      float ss = 0.f;
#pragma unroll
      for (int i = 0; i < 4; ++i) {
        float4 v = xr[lane + 64 * i];
        ss += v.x * v.x + v.y * v.y + v.z * v.z + v.w * v.w;
        uint2 o; o.x = pack2(v.x, v.y); o.y = pack2(v.z, v.w);
        *(uint2*)(xb + (lane + 64 * i) * 4) = o;
      }
      ss = sum64(ss);
      if (lane == 0) ((float*)(ws + OFF_RMEM))[row] = rsqrtf(ss * (1.f / 1024.f) + EPS);
    } else if (it < E8) {
      int e = (it - E7) * 256 + tid;
      int pos = e >> 5, i = e & 31;
      float inv = powf(10000.f, -(float)i / 32.f);
      float ang = (float)pos * inv;
      double a = (double)ang;
      double n = rint(a * 0.15915494309189535);
      float r = (float)(a - n * 6.283185307179586);
      float2 cs; cs.x = __cosf(r); cs.y = __sinf(r);
      ((float2*)(ws + OFF_ROPE))[e] = cs;
    } else if (it < E9) {
      int lj = (it - E8) >> 4, sl = (it - E8) & 15;
      const float* pe = p.in[6] + (size_t)lj * 2048;
      const float* w = p.in[7] + (size_t)lj * 2048 * 64;
      int n = tid & 63, part = tid >> 6;
      float acc = 0.f;
      const int kb0 = sl * 128 + part * 32;
#pragma unroll 8
      for (int k = kb0; k < kb0 + 32; ++k) acc += pe[k] * w[(size_t)k * 64 + n];
      tile[tid] = acc;
      __syncthreads();
      if (tid < 64) ((float*)(ws + OFF_CB))[((it - E8)) * 64 + tid] = tile[tid] + tile[tid + 64] + tile[tid + 128] + tile[tid + 192];
      __syncthreads();
    } else {
      if (tid < 2) {
        const float* lf = p.in[9] + tid * 128;
        float s1 = 0.f, s2 = 0.f;
        for (int i = 0; i < 32; ++i) { s1 += lf[i] * lf[32 + i]; s2 += lf[64 + i] * lf[96 + i]; }
        float li = 0.8f - 0.6f * expf(-0.3f * (float)tid);
        ((float*)(ws + OFF_LAM))[tid] = expf(s1) - expf(s2) + li;
      }
    }
  }
}

template <int CH>
DI void gemm_tile(const bf16* __restrict__ Ab, long lda, long kcs, const bf16* __restrict__ Bb, long ldb, int nk, char* smem) {
  const int tid = opq(threadIdx.x), lane = tid & 63, wv = tid >> 6, half = lane >> 5, l31 = lane & 31;
  const int wm = wv >> 1, wn = wv & 1;
  bf16* As = (bf16*)smem;
  bf16* Bs = (bf16*)(smem + 36864);
  const int lrow = tid >> 3, lcol = (tid & 7) * 8;
  const bf16* ag = Ab + (long)lrow * lda + lcol;
  const bf16* bg = Bb + (long)lrow * ldb + lcol;
  f32x16 acc[2][2];
#pragma unroll
  for (int a = 0; a < 2; ++a)
#pragma unroll
    for (int b = 0; b < 2; ++b)
#pragma unroll
      for (int i = 0; i < 16; ++i) acc[a][b][i] = 0.f;
#define GCOMPUTE(BUF) do { \
    const bf16* as_ = As + (BUF) * 128 * 72 + (wm * 64 + l31) * 72 + half * 8; \
    const bf16* bs_ = Bs + (BUF) * 128 * 72 + (wn * 64 + l31) * 72 + half * 8; \
    bf16x8 fa[2][2], fb[2][2]; \
    fa[0][0] = *(const bf16x8*)(as_); fa[0][1] = *(const bf16x8*)(as_ + 32 * 72); \
    fb[0][0] = *(const bf16x8*)(bs_); fb[0][1] = *(const bf16x8*)(bs_ + 32 * 72); \
    _Pragma("unroll") for (int kc = 0; kc < 4; ++kc) { \
      if (kc < 3) { \
        fa[(kc + 1) & 1][0] = *(const bf16x8*)(as_ + (kc + 1) * 16); fa[(kc + 1) & 1][1] = *(const bf16x8*)(as_ + 32 * 72 + (kc + 1) * 16); \
        fb[(kc + 1) & 1][0] = *(const bf16x8*)(bs_ + (kc + 1) * 16); fb[(kc + 1) & 1][1] = *(const bf16x8*)(bs_ + 32 * 72 + (kc + 1) * 16); \
      } \
      _Pragma("unroll") for (int ni = 0; ni < 2; ++ni) \
        _Pragma("unroll") for (int mi = 0; mi < 2; ++mi) acc[ni][mi] = MFMA(fb[kc & 1][ni], fa[kc & 1][mi], acc[ni][mi]); \
    } } while (0)
  for (int c0 = 0; c0 < nk; c0 += CH) {
    u32x4 rs[2][8];
    const bf16* agc = ag + (long)c0 * kcs;
    const bf16* bgc = bg + (long)c0 * 64;
#pragma unroll
    for (int i = 0; i < 4; ++i) {
      rs[0][i] = *(const u32x4*)(agc + (long)(32 * i) * lda);
      rs[0][4 + i] = *(const u32x4*)(bgc + (long)(32 * i) * ldb);
    }
#pragma unroll
    for (int i = 0; i < 4; ++i) {
      *(u32x4*)(As + (lrow + 32 * i) * 72 + lcol) = rs[0][i];
      *(u32x4*)(Bs + (lrow + 32 * i) * 72 + lcol) = rs[0][4 + i];
    }
    if (CH > 1) {
#pragma unroll
      for (int i = 0; i < 4; ++i) {
        GLD16(rs[1][i], agc + (long)(32 * i) * lda + kcs);
        GLD16(rs[1][4 + i], bgc + (long)(32 * i) * ldb + 64);
      }
    }
    __syncthreads();
#pragma unroll
    for (int t = 0; t < CH; ++t) {
      const int bufc = t & 1;
      if (t + 2 < CH) {
#pragma unroll
        for (int i = 0; i < 4; ++i) {
          GLD16(rs[t & 1][i], agc + (long)(32 * i) * lda + (long)(t + 2) * kcs);
          GLD16(rs[t & 1][4 + i], bgc + (long)(32 * i) * ldb + (long)(t + 2) * 64);
        }
      }
      GCOMPUTE(bufc);
      if (t + 1 < CH) {
        u32x4(&rr)[8] = rs[(t + 1) & 1];
        if (t + 2 < CH) asm volatile("s_waitcnt vmcnt(8)" : "+v"(rr[0]), "+v"(rr[1]), "+v"(rr[2]), "+v"(rr[3]), "+v"(rr[4]), "+v"(rr[5]), "+v"(rr[6]), "+v"(rr[7]) :: "memory");
        else asm volatile("s_waitcnt vmcnt(0)" : "+v"(rr[0]), "+v"(rr[1]), "+v"(rr[2]), "+v"(rr[3]), "+v"(rr[4]), "+v"(rr[5]), "+v"(rr[6]), "+v"(rr[7]) :: "memory");
        bf16* ad = As + (bufc ^ 1) * 128 * 72; bf16* bd = Bs + (bufc ^ 1) * 128 * 72;
#pragma unroll
        for (int i = 0; i < 4; ++i) {
          *(u32x4*)(ad + (lrow + 32 * i) * 72 + lcol) = rr[i];
          *(u32x4*)(bd + (lrow + 32 * i) * 72 + lcol) = rr[4 + i];
        }
      }
      __syncthreads();
    }
  }
#undef GCOMPUTE
  float* Cs = (float*)smem;
#pragma unroll
  for (int ni = 0; ni < 2; ++ni)
#pragma unroll
    for (int mi = 0; mi < 2; ++mi)
#pragma unroll
      for (int g = 0; g < 4; ++g) {
        float4 v; v.x = acc[ni][mi][4 * g]; v.y = acc[ni][mi][4 * g + 1]; v.z = acc[ni][mi][4 * g + 2]; v.w = acc[ni][mi][4 * g + 3];
        *(float4*)(Cs + (wm * 64 + mi * 32 + l31) * 132 + wn * 64 + ni * 32 + 8 * g + 4 * half) = v;
      }
  __syncthreads();
}

enum { EPI_PLAIN = 0, EPI_RS8 = 1, EPI_RS1 = 2, EPI_OUT = 3 };
DI void gemm_epi(int mode, char* smem, bf16* __restrict__ Cb, long ldc, int row0, const float* __restrict__ rs,
                 const float* __restrict__ xres, float* __restrict__ xout, bf16* __restrict__ xbout, float* __restrict__ ssqout, int ntile) {
  const float* Cs = (const float*)smem;
  const int tid = opq(threadIdx.x);
  float* rsl = (float*)(smem + 67584);
  if (mode == EPI_RS8 || mode == EPI_RS1) {
    if (tid < 128) {
      const long grow = row0 + tid;
      float sc;
      if (mode == EPI_RS8) {
        const float4* q = (const float4*)(rs + grow * 8);
        const float4 a = q[0], b = q[1];
        sc = rsqrtf((a.x + a.y + a.z + a.w + b.x + b.y + b.z + b.w) * (1.f / 1024.f) + EPS);
      } else sc = rs[grow];
      rsl[tid] = sc;
    }
    __syncthreads();
  }
#pragma unroll 2
  for (int it = 0; it < 8; ++it) {
    const int idx = it * 256 + tid;
    const int r = idx >> 4, ch = idx & 15;
    float4 v0 = *(const float4*)(Cs + r * 132 + ch * 8);
    float4 v1 = *(const float4*)(Cs + r * 132 + ch * 8 + 4);
    const long grow = row0 + r;
    if (mode == EPI_OUT) {
      if (xres) {
        const float4* xr = (const float4*)(xres + grow * 1024 + ntile * 128 + ch * 8);
        float4 x0 = xr[0], x1 = xr[1];
        v0.x += x0.x; v0.y += x0.y; v0.z += x0.z; v0.w += x0.w;
        v1.x += x1.x; v1.y += x1.y; v1.z += x1.z; v1.w += x1.w;
      } else {
        const uint4 xw = *(const uint4*)(Cb + grow * 1024 + ntile * 128 + ch * 8);
        v0.x += bflo(xw.x); v0.y += bfhi(xw.x); v0.z += bflo(xw.y); v0.w += bfhi(xw.y);
        v1.x += bflo(xw.z); v1.y += bfhi(xw.z); v1.z += bflo(xw.w); v1.w += bfhi(xw.w);
      }
      if (xout) {
        float4* xo = (float4*)(xout + grow * 1024 + ntile * 128 + ch * 8);
        xo[0] = v0; xo[1] = v1;
      }
      if (xbout) {
        float ss = v0.x * v0.x + v0.y * v0.y + v0.z * v0.z + v0.w * v0.w + v1.x * v1.x + v1.y * v1.y + v1.z * v1.z + v1.w * v1.w;
        ss = sum16(ss);
        if (ch == 0) ssqout[grow * 8 + ntile] = ss;
        uint4 o; o.x = pack2(v0.x, v0.y); o.y = pack2(v0.z, v0.w); o.z = pack2(v1.x, v1.y); o.w = pack2(v1.z, v1.w);
        *(uint4*)(xbout + grow * 1024 + ntile * 128 + ch * 8) = o;
      }
    } else {
      float sc = 1.f;
      if (mode == EPI_RS8 || mode == EPI_RS1) sc = rsl[r];
      uint4 o; o.x = pack2(v0.x * sc, v0.y * sc); o.y = pack2(v0.z * sc, v0.w * sc); o.z = pack2(v1.x * sc, v1.y * sc); o.w = pack2(v1.z * sc, v1.w * sc);
      *(uint4*)(Cb + grow * ldc + ntile * 128 + ch * 8) = o;
    }
  }
  __syncthreads();
}

DI void gemm_big(const bf16* __restrict__ Ab, long lda, const bf16* __restrict__ Bb, long ldb, int nk, char* smem, int mode,
                 bf16* __restrict__ Cb, long ldc, int row0, const float* __restrict__ rs, const float* __restrict__ xres,
                 float* __restrict__ xout, bf16* __restrict__ xbout, float* __restrict__ ssqout, int ntile) {
  const int tid = opq(threadIdx.x), lane = tid & 63, wv = tid >> 6, half = lane >> 5, l31 = lane & 31;
  const int wm = wv >> 1, wn = wv & 1;
  bf16* As = (bf16*)smem;
  bf16* Bs = (bf16*)(smem + 36864);
  const int lrow = tid >> 3, lcol = (tid & 7) * 8;
  const bf16* ag = Ab + (long)lrow * lda + lcol;
  const bf16* bg = Bb + (long)lrow * ldb + lcol;
  u32x4 ra[8], rb[4];
  f32x16 acc[2][4];
#pragma unroll
  for (int a = 0; a < 2; ++a)
#pragma unroll
    for (int b = 0; b < 4; ++b)
#pragma unroll
      for (int i = 0; i < 16; ++i) acc[a][b][i] = 0.f;
#pragma unroll
  for (int i = 0; i < 8; ++i) ra[i] = *(const u32x4*)(ag + (long)(32 * i) * lda);
#pragma unroll
  for (int i = 0; i < 4; ++i) rb[i] = *(const u32x4*)(bg + (long)(32 * i) * ldb);
#pragma unroll
  for (int i = 0; i < 8; ++i) *(u32x4*)(As + (lrow + 32 * i) * 72 + lcol) = ra[i];
#pragma unroll
  for (int i = 0; i < 4; ++i) *(u32x4*)(Bs + (lrow + 32 * i) * 72 + lcol) = rb[i];
  __syncthreads();
  for (int ks = 0; ks < nk; ++ks) {
    const bool more = ks + 1 < nk;
    if (more) {
#pragma unroll
      for (int i = 0; i < 8; ++i) GLD16(ra[i], ag + (long)(32 * i) * lda + (long)(ks + 1) * 64);
#pragma unroll
      for (int i = 0; i < 4; ++i) GLD16(rb[i], bg + (long)(32 * i) * ldb + (long)(ks + 1) * 64);
    }
    const bf16* as_ = As + (wm * 128 + l31) * 72 + half * 8;
    const bf16* bs_ = Bs + (wn * 64 + l31) * 72 + half * 8;
#pragma unroll
    for (int kc = 0; kc < 4; ++kc) {
      bf16x8 fa[4], fb[2];
#pragma unroll
      for (int mi = 0; mi < 4; ++mi) fa[mi] = *(const bf16x8*)(as_ + mi * 32 * 72 + kc * 16);
#pragma unroll
      for (int ni = 0; ni < 2; ++ni) fb[ni] = *(const bf16x8*)(bs_ + ni * 32 * 72 + kc * 16);
#pragma unroll
      for (int ni = 0; ni < 2; ++ni)
#pragma unroll
        for (int mi = 0; mi < 4; ++mi) acc[ni][mi] = MFMA(fb[ni], fa[mi], acc[ni][mi]);
    }
    __syncthreads();
    if (more) {
      asm volatile("s_waitcnt vmcnt(0)" : "+v"(ra[0]), "+v"(ra[1]), "+v"(ra[2]), "+v"(ra[3]), "+v"(ra[4]), "+v"(ra[5]), "+v"(ra[6]), "+v"(ra[7]),
                   "+v"(rb[0]), "+v"(rb[1]), "+v"(rb[2]), "+v"(rb[3]) :: "memory");
#pragma unroll
      for (int i = 0; i < 8; ++i) *(u32x4*)(As + (lrow + 32 * i) * 72 + lcol) = ra[i];
#pragma unroll
      for (int i = 0; i < 4; ++i) *(u32x4*)(Bs + (lrow + 32 * i) * 72 + lcol) = rb[i];
      __syncthreads();
    }
  }
  float* Cs = (float*)smem;
#pragma unroll
  for (int h = 0; h < 2; ++h) {
    if (wm == h) {
#pragma unroll
      for (int ni = 0; ni < 2; ++ni)
#pragma unroll
        for (int mi = 0; mi < 4; ++mi)
#pragma unroll
          for (int g = 0; g < 4; ++g) {
            float4 v; v.x = acc[ni][mi][4 * g]; v.y = acc[ni][mi][4 * g + 1]; v.z = acc[ni][mi][4 * g + 2]; v.w = acc[ni][mi][4 * g + 3];
            *(float4*)(Cs + (mi * 32 + l31) * 132 + wn * 64 + ni * 32 + 8 * g + 4 * half) = v;
          }
    }
    __syncthreads();
    gemm_epi(mode, smem, Cb, ldc, row0 + h * 128, rs, xres, xout, xbout, ssqout, ntile);
  }
}

enum { AM_NONE = 0, AM_CAUSAL = 1, AM_WIN = 2, AM_CMP = 3, AM_SLC = 4 };

template <int DK>
DI void attn_core(const bf16* __restrict__ Kp, long kstride, const bf16* __restrict__ Vp, long vstride, uint32_t tilemask,
                  int mode, int qpos, uint32_t sel, const bf16x8 (&Qf)[DK / 16], f32x16 (&O)[2], float& m_out, float& l_out, char* smem) {
  constexpr int KST = DK + 8;
  constexpr int CPR = DK / 8;
  constexpr int NCH = CPR / 4;
  bf16* Ks = (bf16*)smem;
  bf16* VTs = (bf16*)(smem + SM_VT);
  const int tid = opq(threadIdx.x), lane = tid & 63, half = lane >> 5, l31 = lane & 31;
#pragma unroll
  for (int i = 0; i < 16; ++i) { O[0][i] = 0.f; O[1][i] = 0.f; }
  float l = 0.f;
  const int qw0 = __builtin_amdgcn_readfirstlane(qpos - l31);
  const bool causal_like = (mode == AM_CAUSAL || mode == AM_WIN || mode == AM_SLC);
  int klo = 0, khi = 0x7fffffff;
  if (mode == AM_CAUSAL || mode == AM_SLC) khi = qpos;
  else if (mode == AM_WIN) { khi = qpos; klo = qpos - 511; }
  else if (mode == AM_CMP) khi = (qpos - 31) >> 4;
  u32x4 rk0, rk1, rk2, rv0, rv1;
  rk0 = rk1 = rk2 = (u32x4){0u, 0u, 0u, 0u};
  const int vkp = tid & 31, vcc = tid >> 5;
  const int vcol = (vkp >> 3) * 16 + (((vkp & 1) | ((vkp & 2) << 1) | ((vkp & 4) >> 1)) * 2);
  const int c0 = tid, c1 = tid + 256, c2_ = tid + 512;
  const int kr0 = c0 / CPR, kc0 = (c0 % CPR) * 8, kr1 = c1 / CPR, kc1 = (c1 % CPR) * 8, kr2 = c2_ / CPR, kc2 = (c2_ % CPR) * 8;
#define GLOAD(KT) do { \
    GLD16(rk0, Kp + (long)((KT) * 64 + kr0) * kstride + kc0); \
    if constexpr (NCH > 1) GLD16(rk1, Kp + (long)((KT) * 64 + kr1) * kstride + kc1); \
    if constexpr (NCH > 2) GLD16(rk2, Kp + (long)((KT) * 64 + kr2) * kstride + kc2); \
    GLD16(rv0, Vp + (long)((KT) * 64 + 2 * vkp) * vstride + vcc * 8); \
    GLD16(rv1, Vp + (long)((KT) * 64 + 2 * vkp + 1) * vstride + vcc * 8); } while (0)
#define LSTORE(BUF) do { asm volatile("s_waitcnt vmcnt(0)" : "+v"(rk0), "+v"(rk1), "+v"(rk2), "+v"(rv0), "+v"(rv1) :: "memory"); \
    *(u32x4*)(Ks + ((BUF) * 64 + kr0) * KST + kc0) = rk0; \
    if constexpr (NCH > 1) *(u32x4*)(Ks + ((BUF) * 64 + kr1) * KST + kc1) = rk1; \
    if constexpr (NCH > 2) *(u32x4*)(Ks + ((BUF) * 64 + kr2) * KST + kc2) = rk2; \
    bf16* vd = VTs + ((BUF) * 64 + vcc * 8) * 72 + vcol; \
    *(uint32_t*)(vd + 0 * 72) = (rv0.x & 0xffffu) | (rv1.x << 16); \
    *(uint32_t*)(vd + 1 * 72) = (rv0.x >> 16) | (rv1.x & 0xffff0000u); \
    *(uint32_t*)(vd + 2 * 72) = (rv0.y & 0xffffu) | (rv1.y << 16); \
    *(uint32_t*)(vd + 3 * 72) = (rv0.y >> 16) | (rv1.y & 0xffff0000u); \
    *(uint32_t*)(vd + 4 * 72) = (rv0.z & 0xffffu) | (rv1.z << 16); \
    *(uint32_t*)(vd + 5 * 72) = (rv0.z >> 16) | (rv1.z & 0xffff0000u); \
    *(uint32_t*)(vd + 6 * 72) = (rv0.w & 0xffffu) | (rv1.w << 16); \
    *(uint32_t*)(vd + 7 * 72) = (rv0.w >> 16) | (rv1.w & 0xffff0000u); } while (0)
  uint32_t rem = tilemask;
  int kt = __ffs(rem) - 1; rem &= rem - 1;
  GLOAD(kt);
#pragma unroll
  for (int kc = 0; kc < DK / 16; ++kc) asm volatile("" ::"v"(Qf[kc]));
  __syncthreads();
  LSTORE(0);
  __syncthreads();
  int buf = 0;
  while (true) {
    int ktn = -1;
    if (rem) { ktn = __ffs(rem) - 1; rem &= rem - 1; GLOAD(ktn); }
    const bool wave_active = !(causal_like && kt * 64 > qw0 + 31);
    if (wave_active) {
    f32x16 Sx[2];
#pragma unroll
    for (int kb = 0; kb < 2; ++kb) {
      bf16x8 Kf[DK / 16];
#pragma unroll
      for (int kc = 0; kc < DK / 16; ++kc) Kf[kc] = *(const bf16x8*)(Ks + (buf * 64 + kb * 32 + l31) * KST + kc * 16 + half * 8);
      __builtin_amdgcn_sched_barrier(0);
#pragma unroll
      for (int i = 0; i < 16; ++i) Sx[kb][i] = 0.f;
#pragma unroll
      for (int kc = 0; kc < DK / 16; ++kc) Sx[kb] = MFMA(Kf[kc], Qf[kc], Sx[kb]);
    }
    bf16x8 Vf[2][2][2];
#pragma unroll
    for (int kb = 0; kb < 2; ++kb)
#pragma unroll
      for (int c2 = 0; c2 < 2; ++c2)
#pragma unroll
        for (int dvb = 0; dvb < 2; ++dvb)
          Vf[kb][c2][dvb] = *(const bf16x8*)(VTs + (buf * 64 + dvb * 32 + l31) * 72 + (kb * 2 + c2) * 16 + half * 8);
    __builtin_amdgcn_sched_barrier(0);
    bool need_mask = false;
    if (mode == AM_CAUSAL) need_mask = kt * 64 + 63 > qw0;
    else if (mode == AM_WIN) need_mask = (kt * 64 + 63 > qw0) || (kt * 64 < qw0 + 31 - 511);
    else if (mode == AM_CMP) need_mask = true;
    else if (mode == AM_SLC) need_mask = (kt * 64 + 63 > qw0);
    const bool keep = !(mode == AM_SLC) || (((sel >> kt) & 1u) != 0u);
    int khe = khi;
    if (mode == AM_SLC && !((sel >> kt) & 1u)) khe = -1;
    const int kbase = kt * 64 + half * 4;
#pragma unroll
    for (int kb = 0; kb < 2; ++kb) {
      if (need_mask) {
#pragma unroll
        for (int i = 0; i < 16; ++i) {
          const int key = kbase + kb * 32 + (i >> 2) * 8 + (i & 3);
          Sx[kb][i] = (key >= klo && key <= khe) ? Sx[kb][i] : -1e30f;
        }
      }
      float ps = 0.f;
#pragma unroll
      for (int i = 0; i < 16; ++i) { float pv = fexp2(Sx[kb][i]); pv = keep ? pv : 0.f; Sx[kb][i] = pv; ps += pv; }
      l += ps;
#pragma unroll
      for (int c2 = 0; c2 < 2; ++c2) {
        uint4 pw;
        pw.x = pack2(Sx[kb][8 * c2 + 0], Sx[kb][8 * c2 + 1]); pw.y = pack2(Sx[kb][8 * c2 + 2], Sx[kb][8 * c2 + 3]);
        pw.z = pack2(Sx[kb][8 * c2 + 4], Sx[kb][8 * c2 + 5]); pw.w = pack2(Sx[kb][8 * c2 + 6], Sx[kb][8 * c2 + 7]);
        const bf16x8 pf = __builtin_bit_cast(bf16x8, pw);
#pragma unroll
        for (int dvb = 0; dvb < 2; ++dvb) O[dvb] = MFMA(Vf[kb][c2][dvb], pf, O[dvb]);
      }
      __builtin_amdgcn_sched_barrier(0);
    }
    }
    if (ktn < 0) break;
    LSTORE(buf ^ 1);
    __syncthreads();
    buf ^= 1; kt = ktn;
  }
  l_out = l + shx(l, 32);
  m_out = 0.f;
#undef GLOAD
#undef LSTORE
}

template <int DK>
DI void attn_core_dual(const bf16* __restrict__ Kp, long kstride, const bf16* __restrict__ Vp, long vstride, uint32_t tilemask,
                  int mode, int qpos, uint32_t sel, const bf16x8 (&Qf)[DK / 16], f32x16 (&O)[2], f32x16 (&O2)[2], float& l_out, float& l2_out, char* smem) {
  constexpr int KST = DK + 8;
  constexpr int CPR = DK / 8;
  constexpr int NCH = CPR / 4;
  bf16* Ks = (bf16*)smem;
  bf16* VTs = (bf16*)(smem + SM_VT);
  const int tid = opq(threadIdx.x), lane = tid & 63, half = lane >> 5, l31 = lane & 31;
#pragma unroll
  for (int i = 0; i < 16; ++i) { O[0][i] = 0.f; O[1][i] = 0.f; O2[0][i] = 0.f; O2[1][i] = 0.f; }
  float l = 0.f, l2 = 0.f;
  const int qw0 = __builtin_amdgcn_readfirstlane(qpos - l31);
  const bool causal_like = (mode == AM_CAUSAL || mode == AM_WIN || mode == AM_SLC);
  int klo = 0, khi = 0x7fffffff;
  if (mode == AM_CAUSAL || mode == AM_SLC) khi = qpos;
  else if (mode == AM_WIN) { khi = qpos; klo = qpos - 511; }
  else if (mode == AM_CMP) khi = (qpos - 31) >> 4;
  u32x4 rk0, rk1, rk2, rv0, rv1;
  rk0 = rk1 = rk2 = (u32x4){0u, 0u, 0u, 0u};
  const int vkp = tid & 31, vcc = tid >> 5;
  const int vcol = (vkp >> 3) * 16 + (((vkp & 1) | ((vkp & 2) << 1) | ((vkp & 4) >> 1)) * 2);
  const int c0 = tid, c1 = tid + 256, c2_ = tid + 512;
  const int kr0 = c0 / CPR, kc0 = (c0 % CPR) * 8, kr1 = c1 / CPR, kc1 = (c1 % CPR) * 8, kr2 = c2_ / CPR, kc2 = (c2_ % CPR) * 8;
#define GLOAD(KT) do { \
    GLD16(rk0, Kp + (long)((KT) * 64 + kr0) * kstride + kc0); \
    if constexpr (NCH > 1) GLD16(rk1, Kp + (long)((KT) * 64 + kr1) * kstride + kc1); \
    if constexpr (NCH > 2) GLD16(rk2, Kp + (long)((KT) * 64 + kr2) * kstride + kc2); \
    GLD16(rv0, Vp + (long)((KT) * 64 + 2 * vkp) * vstride + vcc * 8); \
    GLD16(rv1, Vp + (long)((KT) * 64 + 2 * vkp + 1) * vstride + vcc * 8); } while (0)
#define LSTORE(BUF) do { asm volatile("s_waitcnt vmcnt(0)" : "+v"(rk0), "+v"(rk1), "+v"(rv0), "+v"(rv1) :: "memory"); \
    *(u32x4*)(Ks + ((BUF) * 64 + kr0) * KST + kc0) = rk0; \
    if constexpr (NCH > 1) *(u32x4*)(Ks + ((BUF) * 64 + kr1) * KST + kc1) = rk1; \
    if constexpr (NCH > 2) *(u32x4*)(Ks + ((BUF) * 64 + kr2) * KST + kc2) = rk2; \
    bf16* vd = VTs + ((BUF) * 64 + vcc * 8) * 72 + vcol; \
    *(uint32_t*)(vd + 0 * 72) = (rv0.x & 0xffffu) | (rv1.x << 16); \
    *(uint32_t*)(vd + 1 * 72) = (rv0.x >> 16) | (rv1.x & 0xffff0000u); \
    *(uint32_t*)(vd + 2 * 72) = (rv0.y & 0xffffu) | (rv1.y << 16); \
    *(uint32_t*)(vd + 3 * 72) = (rv0.y >> 16) | (rv1.y & 0xffff0000u); \
    *(uint32_t*)(vd + 4 * 72) = (rv0.z & 0xffffu) | (rv1.z << 16); \
    *(uint32_t*)(vd + 5 * 72) = (rv0.z >> 16) | (rv1.z & 0xffff0000u); \
    *(uint32_t*)(vd + 6 * 72) = (rv0.w & 0xffffu) | (rv1.w << 16); \
    *(uint32_t*)(vd + 7 * 72) = (rv0.w >> 16) | (rv1.w & 0xffff0000u); } while (0)
  uint32_t rem = tilemask;
  int kt = __ffs(rem) - 1; rem &= rem - 1;
  GLOAD(kt);
#pragma unroll
  for (int kc = 0; kc < DK / 16; ++kc) asm volatile("" ::"v"(Qf[kc]));
  __syncthreads();
  LSTORE(0);
  __syncthreads();
  int buf = 0;
  while (true) {
    int ktn = -1;
    if (rem) { ktn = __ffs(rem) - 1; rem &= rem - 1; GLOAD(ktn); }
    const bool wave_active = !(causal_like && kt * 64 > qw0 + 31);
    if (wave_active) {
    const bool need_mask = kt * 64 + 63 > qw0;
    const int kbase = kt * 64 + half * 4;
#pragma unroll
    for (int mp = 0; mp < 2; ++mp) {
      f32x16 Sx[2];
#pragma unroll
      for (int kb = 0; kb < 2; ++kb) {
        bf16x8 k0 = *(const bf16x8*)(Ks + (buf * 64 + kb * 32 + l31) * KST + (2 * mp) * 16 + half * 8);
        bf16x8 k1 = *(const bf16x8*)(Ks + (buf * 64 + kb * 32 + l31) * KST + (2 * mp + 1) * 16 + half * 8);
#pragma unroll
        for (int i = 0; i < 16; ++i) Sx[kb][i] = 0.f;
        Sx[kb] = MFMA(k0, Qf[2 * mp], Sx[kb]);
        Sx[kb] = MFMA(k1, Qf[2 * mp + 1], Sx[kb]);
      }
#pragma unroll
      for (int kb = 0; kb < 2; ++kb) {
        if (need_mask) {
#pragma unroll
          for (int i = 0; i < 16; ++i) {
            const int key = kbase + kb * 32 + (i >> 2) * 8 + (i & 3);
            Sx[kb][i] = (key <= khi) ? Sx[kb][i] : -1e30f;
          }
        }
        bf16x8 Vf[2][2];
#pragma unroll
        for (int c2 = 0; c2 < 2; ++c2)
#pragma unroll
          for (int dvb = 0; dvb < 2; ++dvb)
            Vf[c2][dvb] = *(const bf16x8*)(VTs + (buf * 64 + dvb * 32 + l31) * 72 + (kb * 2 + c2) * 16 + half * 8);
        float ps = 0.f;
#pragma unroll
        for (int i = 0; i < 16; ++i) { float pv = fexp2(Sx[kb][i]); Sx[kb][i] = pv; ps += pv; }
        if (mp == 0) l += ps; else l2 += ps;
#pragma unroll
        for (int c2 = 0; c2 < 2; ++c2) {
          uint4 pw;
          pw.x = pack2(Sx[kb][8 * c2 + 0], Sx[kb][8 * c2 + 1]); pw.y = pack2(Sx[kb][8 * c2 + 2], Sx[kb][8 * c2 + 3]);
          pw.z = pack2(Sx[kb][8 * c2 + 4], Sx[kb][8 * c2 + 5]); pw.w = pack2(Sx[kb][8 * c2 + 6], Sx[kb][8 * c2 + 7]);
          const bf16x8 pf = __builtin_bit_cast(bf16x8, pw);
#pragma unroll
          for (int dvb = 0; dvb < 2; ++dvb) {
            if (mp == 0) O[dvb] = MFMA(Vf[c2][dvb], pf, O[dvb]); else O2[dvb] = MFMA(Vf[c2][dvb], pf, O2[dvb]);
          }
        }
        __builtin_amdgcn_sched_barrier(0);
      }
    }
    }
    if (ktn < 0) break;
    LSTORE(buf ^ 1);
    __syncthreads();
    buf ^= 1; kt = ktn;
  }
  l_out = l + shx(l, 32);
  l2_out = l2 + shx(l2, 32);
#undef GLOAD
#undef LSTORE
}

template <int DK>
DI void load_q(const bf16* __restrict__ Qrow, bf16x8 (&Qf)[DK / 16]) {
  const int half = (opq(threadIdx.x) & 63) >> 5;
#pragma unroll
  for (int kc = 0; kc < DK / 16; ++kc) Qf[kc] = *(const bf16x8*)(Qrow + kc * 16 + half * 8);
}

DI void vec64(bool active, const bf16* src, const float* bias, int nbias, bf16* dst, const float* gain, const float2* rp, float scale, int j, const bf16* src2 = nullptr) {
  float a0 = 0.f, a1 = 0.f, b0 = 0.f, b1 = 0.f;
  if (active) {
    uint32_t lo = *(const uint32_t*)(src + 2 * j), hi = *(const uint32_t*)(src + 32 + 2 * j);
    a0 = bflo(lo); a1 = bfhi(lo); b0 = bflo(hi); b1 = bfhi(hi);
    if (src2) {
#pragma unroll
      for (int q = 0; q < 3; ++q) {
        const bf16* sq_ = src2 + (size_t)q * 2 * 1024 * 128;
        lo = *(const uint32_t*)(sq_ + 2 * j); hi = *(const uint32_t*)(sq_ + 32 + 2 * j); a0 += bflo(lo); a1 += bfhi(lo); b0 += bflo(hi); b1 += bfhi(hi);
      }
    }
    for (int sidx = 0; sidx < nbias; ++sidx) {
      const float* bb = bias + sidx * 64;
      a0 += bb[2 * j]; a1 += bb[2 * j + 1]; b0 += bb[32 + 2 * j]; b1 += bb[33 + 2 * j];
    }
  }
  float ss = a0 * a0 + a1 * a1 + b0 * b0 + b1 * b1;
  ss = sum16(ss);
  const float r = rsqrtf(ss * (1.f / 64.f) + EPS);
  if (active) {
    a0 *= r * gain[2 * j]; a1 *= r * gain[2 * j + 1]; b0 *= r * gain[32 + 2 * j]; b1 *= r * gain[33 + 2 * j];
    if (rp) {
      const float2 c0 = rp[2 * j], c1 = rp[2 * j + 1];
      const float t0 = a0 * c0.x - b0 * c0.y, u0 = b0 * c0.x + a0 * c0.y;
      const float t1 = a1 * c1.x - b1 * c1.y, u1 = b1 * c1.x + a1 * c1.y;
      a0 = t0; b0 = u0; a1 = t1; b1 = u1;
    }
    *(uint32_t*)(dst + 2 * j) = pack2(a0 * scale, a1 * scale);
    *(uint32_t*)(dst + 32 + 2 * j) = pack2(b0 * scale, b1 * scale);
  }
}
template <int G>
DI void nr4(uint32_t lo, uint32_t hi, float invn, float g0, float g1, float g2, float g3, bool rope, float2 c0, float2 c1, float scale,
            uint32_t& olo, uint32_t& ohi) {
  float a0 = bflo(lo), a1 = bfhi(lo), b0 = bflo(hi), b1 = bfhi(hi);
  float ss = a0 * a0 + a1 * a1 + b0 * b0 + b1 * b1;
  ss = (G == 16) ? sum16(ss) : sum8(ss);
  const float r = rsqrtf(ss * invn + EPS);
  a0 *= r * g0; a1 *= r * g1; b0 *= r * g2; b1 *= r * g3;
  if (rope) {
    const float t0 = a0 * c0.x - b0 * c0.y, u0 = b0 * c0.x + a0 * c0.y;
    const float t1 = a1 * c1.x - b1 * c1.y, u1 = b1 * c1.x + a1 * c1.y;
    a0 = t0; b0 = u0; a1 = t1; b1 = u1;
  }
  olo = pack2(a0 * scale, a1 * scale); ohi = pack2(b0 * scale, b1 * scale);
}

struct PrepR {
  uint32_t q_lo, q_hi, p2_lo, p2_hi, p3_lo, p3_hi, dq_lo, dq_hi, dk_lo, dk_hi, glv, ckw, uqa, uqb, kra, krb;
  uint2 cw, nw, kw2, vw;
  float2 c0, c1, e0, e1;
};
struct PrepG {
  float gq0, gq1, gq2, gq3, h0, h1, h2, h3, m0, m1, m2, m3, dq0, dq1, dq2, dq3, dk0, dk1, dk2, dk3;
  float mgq0, mgq1, mgq2, mgq3, mgq4, mgq5, mgk0, mgk1, mgk2, mgk3, mgk4, mgk5;
};
DI void prep_load(char* ws, int t, int lane, PrepR& R) {
  const int j16 = lane & 15, g16 = lane >> 4, j8 = lane & 7, g8 = lane >> 3;
  const int s = t & 2047;
  const bf16* ur = (const bf16*)(ws + OFF_U) + (size_t)t * NP;
  const float2* rp = (const float2*)(ws + OFF_ROPE) + s * 32;
  const int col2 = g16 == 0 ? C_KS : (g16 == 1 ? C_KW : C_MQ + (g16 - 2) * 64);
  const int col3 = C_MQ + (2 + (g16 & 1)) * 64;
  const bf16* uq = (const bf16*)(ws + OFF_UQ + (size_t)(t >> 11) * SLAB) + (size_t)s * 384 + g16 * 96;
  const bf16* uk = (const bf16*)(ws + OFF_UKV + (size_t)(t >> 11) * SLAB) + (size_t)s * 512 + g16 * 128;
  R.q_lo = *(const uint32_t*)(ur + C_NQ + g16 * 64 + 2 * j16); R.q_hi = *(const uint32_t*)(ur + C_NQ + g16 * 64 + 32 + 2 * j16);
  R.p2_lo = *(const uint32_t*)(ur + col2 + 2 * j16); R.p2_hi = *(const uint32_t*)(ur + col2 + 32 + 2 * j16);
  R.p3_lo = *(const uint32_t*)(ur + col3 + 2 * j16); R.p3_hi = *(const uint32_t*)(ur + col3 + 32 + 2 * j16);
  R.dq_lo = *(const uint32_t*)(ur + C_DQ + g8 * 32 + 2 * j8); R.dq_hi = *(const uint32_t*)(ur + C_DQ + g8 * 32 + 16 + 2 * j8);
  R.dk_lo = *(const uint32_t*)(ur + C_DK + g8 * 32 + 2 * j8); R.dk_hi = *(const uint32_t*)(ur + C_DK + g8 * 32 + 16 + 2 * j8);
  R.glv = ur[C_GL + (lane < 12 ? lane : 0)];
  R.cw = *(const uint2*)(ur + C_CQ + lane * 4);
  R.ckw = *(const uint32_t*)(ur + C_CKV + lane * 2);
  R.nw = *(const uint2*)(uq + 4 * j16);
  R.uqa = uq[64 + j16]; R.uqb = uq[80 + j16];
  R.kw2 = *(const uint2*)(uk + 4 * j16);
  R.vw = *(const uint2*)(uk + 64 + 4 * j16);
  R.kra = ur[C_KR + j16]; R.krb = ur[C_KR + 16 + j16];
  R.c0 = rp[2 * j16]; R.c1 = rp[2 * j16 + 1];
  R.e0 = rp[4 * j8]; R.e1 = rp[4 * j8 + 2];
}
DI void prep_fin(char* ws, int t, int lane, const PrepR& R, const PrepG& G) {
  const int j16 = lane & 15, g16 = lane >> 4, j8 = lane & 7, g8 = lane >> 3;
  const float qs64 = 0.125f * LOG2E, qs32 = 0.17677669529663687f * LOG2E, qs96 = 0.10206207261596577f * LOG2E;
  const int b = t >> 11, s = t & 2047;
  bf16* ur = (bf16*)(ws + OFF_U) + (size_t)t * NP;
  const int col2 = g16 == 0 ? C_KS : (g16 == 1 ? C_KW : C_MQ + (g16 - 2) * 64);
  const int col3 = C_MQ + (2 + (g16 & 1)) * 64;
  const float2 c0 = R.c0, c1 = R.c1, e0 = R.e0, e1 = R.e1;
  uint32_t olo, ohi;
  nr4<16>(R.q_lo, R.q_hi, 1.f / 64.f, G.gq0, G.gq1, G.gq2, G.gq3, true, c0, c1, qs64, olo, ohi);
  *(uint32_t*)(ur + C_NQ + g16 * 64 + 2 * j16) = olo; *(uint32_t*)(ur + C_NQ + g16 * 64 + 32 + 2 * j16) = ohi;
  nr4<16>(R.p2_lo, R.p2_hi, 1.f / 64.f, G.h0, G.h1, G.h2, G.h3, g16 < 2, c0, c1, g16 < 2 ? 1.f : qs64, olo, ohi);
  *(uint32_t*)(ur + col2 + 2 * j16) = olo; *(uint32_t*)(ur + col2 + 32 + 2 * j16) = ohi;
  nr4<16>(R.p3_lo, R.p3_hi, 1.f / 64.f, G.m0, G.m1, G.m2, G.m3, false, c0, c1, qs64, olo, ohi);
  if (g16 < 2) { *(uint32_t*)(ur + col3 + 2 * j16) = olo; *(uint32_t*)(ur + col3 + 32 + 2 * j16) = ohi; }
  nr4<8>(R.dq_lo, R.dq_hi, 1.f / 32.f, G.dq0, G.dq1, G.dq2, G.dq3, true, e0, e1, qs32, olo, ohi);
  *(uint32_t*)(ur + C_DQ + g8 * 32 + 2 * j8) = olo; *(uint32_t*)(ur + C_DQ + g8 * 32 + 16 + 2 * j8) = ohi;
  nr4<8>(R.dk_lo, R.dk_hi, 1.f / 32.f, G.dk0, G.dk1, G.dk2, G.dk3, true, e0, e1, 1.f, olo, ohi);
  *(uint32_t*)(ur + C_DK + g8 * 32 + 2 * j8) = olo; *(uint32_t*)(ur + C_DK + g8 * 32 + 16 + 2 * j8) = ohi;
  if (lane < 12) ((float*)(ws + OFF_GT))[(size_t)t * 12 + lane] = sigmoidf_(bf2f(R.glv));
  float sq, skv;
  {
    float c0f = bflo(R.cw.x), c1f = bfhi(R.cw.x), c2f = bflo(R.cw.y), c3f = bfhi(R.cw.y);
    float ss = c0f * c0f + c1f * c1f + c2f * c2f + c3f * c3f;
    float d0 = bflo(R.ckw), d1 = bfhi(R.ckw);
    float s2 = d0 * d0 + d1 * d1;
    ss = sum64(ss); s2 = sum64(s2);
    sq = rsqrtf(ss * (1.f / 256.f) + EPS);
    skv = rsqrtf(s2 * (1.f / 128.f) + EPS);
  }
  {
    const int h = g16, j = j16;
    float n0 = bflo(R.nw.x) * sq, n1 = bfhi(R.nw.x) * sq, n2 = bflo(R.nw.y) * sq, n3 = bfhi(R.nw.y) * sq;
    float ra = bf2f(R.uqa) * sq, rb = bf2f(R.uqb) * sq;
    float r1 = ra * c0.x - rb * c0.y, r2 = rb * c0.x + ra * c0.y;
    float ss = n0 * n0 + n1 * n1 + n2 * n2 + n3 * n3 + r1 * r1 + r2 * r2;
    ss = sum16(ss);
    float r = rsqrtf(ss * (1.f / 96.f) + EPS) * qs96;
    bf16* qd = (bf16*)(ws + OFF_QM) + ((size_t)(b * 4 + h) * S + s) * 96;
    uint2 o; o.x = pack2(n0 * r * G.mgq0, n1 * r * G.mgq1); o.y = pack2(n2 * r * G.mgq2, n3 * r * G.mgq3);
    *(uint2*)(qd + 4 * j) = o;
    qd[64 + j] = f2bf(r1 * r * G.mgq4);
    qd[80 + j] = f2bf(r2 * r * G.mgq5);
    float k0 = bflo(R.kw2.x) * skv, k1 = bfhi(R.kw2.x) * skv, k2 = bflo(R.kw2.y) * skv, k3 = bfhi(R.kw2.y) * skv;
    float ka = bf2f(R.kra), kb = bf2f(R.krb);
    float kr1 = ka * c0.x - kb * c0.y, kr2 = kb * c0.x + ka * c0.y;
    float s3 = k0 * k0 + k1 * k1 + k2 * k2 + k3 * k3 + kr1 * kr1 + kr2 * kr2;
    s3 = sum16(s3);
    float rk_ = rsqrtf(s3 * (1.f / 96.f) + EPS);
    bf16* kd = (bf16*)(ws + OFF_KM) + ((size_t)(b * 4 + h) * S + s) * 96;
    uint2 o2; o2.x = pack2(k0 * rk_ * G.mgk0, k1 * rk_ * G.mgk1); o2.y = pack2(k2 * rk_ * G.mgk2, k3 * rk_ * G.mgk3);
    *(uint2*)(kd + 4 * j) = o2;
    kd[64 + j] = f2bf(kr1 * rk_ * G.mgk4);
    kd[80 + j] = f2bf(kr2 * rk_ * G.mgk5);
    uint2 o3; o3.x = pack2(bflo(R.vw.x) * skv, bfhi(R.vw.x) * skv); o3.y = pack2(bflo(R.vw.y) * skv, bfhi(R.vw.y) * skv);
    *(uint2*)((bf16*)(ws + OFF_MV) + ((size_t)(b * 4 + h) * S + s) * 64 + 4 * j) = o3;
  }
}

DI void prep_phase(const Params& p, int layer) {
  const int tid = opq(threadIdx.x), lane = tid & 63, wv = tid >> 6;
  char* ws = opqp(p.ws);
  const float2* rope = (const float2*)(ws + OFF_ROPE);
  const float* nsa_g = p.in[5] + layer * 256;
  const float* diff_g = p.in[8] + layer * 64;
  const float* mla_g = p.in[15] + layer * 192;
  const float* mem_g = p.in[18] + layer * 128;
  constexpr int N_TOK = T / 4, N_MEMT = TM / 4, N_CMP = 1024 / 4;
  const int j16 = lane & 15, g16 = lane >> 4, j8 = lane & 7;
  PrepG G;
  G.gq0 = nsa_g[2 * j16]; G.gq1 = nsa_g[2 * j16 + 1]; G.gq2 = nsa_g[32 + 2 * j16]; G.gq3 = nsa_g[33 + 2 * j16];
  const float* g2p = g16 == 0 ? nsa_g + 128 : (g16 == 1 ? nsa_g + 192 : mem_g);
  G.h0 = g2p[2 * j16]; G.h1 = g2p[2 * j16 + 1]; G.h2 = g2p[32 + 2 * j16]; G.h3 = g2p[33 + 2 * j16];
  G.m0 = mem_g[2 * j16]; G.m1 = mem_g[2 * j16 + 1]; G.m2 = mem_g[32 + 2 * j16]; G.m3 = mem_g[33 + 2 * j16];
  G.dq0 = diff_g[2 * j8]; G.dq1 = diff_g[2 * j8 + 1]; G.dq2 = diff_g[16 + 2 * j8]; G.dq3 = diff_g[17 + 2 * j8];
  G.dk0 = diff_g[32 + 2 * j8]; G.dk1 = diff_g[33 + 2 * j8]; G.dk2 = diff_g[48 + 2 * j8]; G.dk3 = diff_g[49 + 2 * j8];
  G.mgq0 = mla_g[4 * j16]; G.mgq1 = mla_g[4 * j16 + 1]; G.mgq2 = mla_g[4 * j16 + 2]; G.mgq3 = mla_g[4 * j16 + 3];
  G.mgq4 = mla_g[64 + j16]; G.mgq5 = mla_g[80 + j16];
  G.mgk0 = mla_g[96 + 4 * j16]; G.mgk1 = mla_g[96 + 4 * j16 + 1]; G.mgk2 = mla_g[96 + 4 * j16 + 2]; G.mgk3 = mla_g[96 + 4 * j16 + 3];
  G.mgk4 = mla_g[96 + 64 + j16]; G.mgk5 = mla_g[96 + 80 + j16];
  const int xcd = blockIdx.x & 7, rk = blockIdx.x >> 3, nrk = gridDim.x >> 3;
  for (int i = rk; i < 512; i += 2 * nrk) {
    const int it = xcd * 512 + i;
    const bool has2 = i + nrk < 512;
    const int it2 = has2 ? it + nrk : it;
    const int tA = it * 4 + wv, tB = it2 * 4 + wv;
    PrepR A, B;
    prep_load(ws, tA, lane, A);
    prep_load(ws, tB, lane, B);
    prep_fin(ws, tA, lane, A, G);
    if (has2) prep_fin(ws, tB, lane, B, G);
  }
  for (int i = rk; i < 96; i += nrk) {
    const int it = i < 64 ? N_TOK + xcd * 64 + i : N_TOK + N_MEMT + xcd * 32 + (i - 64);
    if (false) {
    } else if (it < N_TOK + N_MEMT) {
      const int t = (it - N_TOK) * 4 + wv;
      const int b = t >> 8, mi = t & 255;
      const bf16* kr = (const bf16*)(ws + OFF_KMEMRAW) + (size_t)t * 512;
      const int h = lane >> 4;
      uint2 vw = *(const uint2*)(kr + 256 + lane * 4);
      vec64(true, kr + h * 64, nullptr, 0, (bf16*)(ws + OFF_MK) + ((size_t)(b * 4 + h) * ML + mi) * 64, mem_g + 64, nullptr, 1.f, j16);
      *(uint2*)((bf16*)(ws + OFF_MVV) + ((size_t)(b * 4 + h) * ML + mi) * 64 + j16 * 4) = vw;
    } else {
      const int r = (it - N_TOK - N_MEMT) * 4 + wv;
      const int n = r & 127;
      const bf16* kraw = (const bf16*)(ws + OFF_CMPRAW) + (size_t)r * 128;
      const bf16* vraw = (const bf16*)(ws + OFF_CMPRAW) + (size_t)(1024 + r) * 128;
      const float* cbk = (const float*)(ws + OFF_CB) + (size_t)(layer * 2 + 0) * 16 * 64;
      const float* cbv = (const float*)(ws + OFF_CB) + (size_t)(layer * 2 + 1) * 16 * 64;
      bf16* kd = (bf16*)(ws + OFF_KCN) + (size_t)r * 64;
      bf16* vd = (bf16*)(ws + OFF_VCN) + (size_t)r * 64;
      if (n < 127) {
        const int pos = 16 * n + 31;
        float bv = 0.f;
#pragma unroll
        for (int sidx = 0; sidx < 16; ++sidx) bv += cbv[sidx * 64 + lane];
        const float vv = bf2f(vraw[lane]) + bf2f(vraw[(size_t)2 * 1024 * 128 + lane]) + bf2f(vraw[(size_t)4 * 1024 * 128 + lane]) + bf2f(vraw[(size_t)6 * 1024 * 128 + lane]) + bv;
        vec64(lane < 16, kraw, cbk, 16, kd, nsa_g + 64, rope + pos * 32, 1.f, lane & 15, kraw + (size_t)2 * 1024 * 128);
        vd[lane] = f2bf(vv);
      } else {
        kd[lane] = 0; vd[lane] = 0;
      }
    }
  }
}

DI void pl_swap(uint32_t& a, uint32_t& b) { auto r_ = __builtin_amdgcn_permlane32_swap(a, b, false, false); a = r_[0]; b = r_[1]; }
DI void ld_own(const bf16* p, uint2& lo, uint2& hi) {
  const uint4 w = *(const uint4*)p;
  lo.x = w.x; lo.y = w.y; hi.x = w.z; hi.y = w.w;
  pl_swap(lo.x, hi.x); pl_swap(lo.y, hi.y);
}
template <int MODE>
DI void attn_epi(const f32x16 (&O)[2], float scale, const bf16* zrow, const float* sg, const bf16* a1row, const bf16* a2row, bf16* orow, int half) {
#pragma unroll
  for (int dvb = 0; dvb < 2; ++dvb)
#pragma unroll
    for (int pq = 0; pq < 2; ++pq) {
      const int col16 = dvb * 32 + 16 * pq + 8 * half;
      const int dvA = dvb * 32 + 16 * pq + 4 * half;
      float va[4], vb[4];
#pragma unroll
      for (int e = 0; e < 4; ++e) { va[e] = O[dvb][8 * pq + e] * scale; vb[e] = O[dvb][8 * pq + 4 + e] * scale; }
      if (MODE == 2) {
#pragma unroll
        for (int e = 0; e < 4; ++e) { va[e] *= sg[dvA + e]; vb[e] *= sg[dvA + 8 + e]; }
      }
      if (MODE == 3) {
        uint2 clo, chi, wlo, whi;
        ld_own(a1row + col16, clo, chi);
        ld_own(a2row + col16, wlo, whi);
        va[0] += bflo(clo.x) + bflo(wlo.x); va[1] += bfhi(clo.x) + bfhi(wlo.x); va[2] += bflo(clo.y) + bflo(wlo.y); va[3] += bfhi(clo.y) + bfhi(wlo.y);
        vb[0] += bflo(chi.x) + bflo(whi.x); vb[1] += bfhi(chi.x) + bfhi(whi.x); vb[2] += bflo(chi.y) + bflo(whi.y); vb[3] += bfhi(chi.y) + bfhi(whi.y);
      }
      if (MODE >= 1) {
        uint2 zlo, zhi;
        ld_own(zrow + col16, zlo, zhi);
        va[0] *= siluf_(bflo(zlo.x)); va[1] *= siluf_(bfhi(zlo.x)); va[2] *= siluf_(bflo(zlo.y)); va[3] *= siluf_(bfhi(zlo.y));
        vb[0] *= siluf_(bflo(zhi.x)); vb[1] *= siluf_(bfhi(zhi.x)); vb[2] *= siluf_(bflo(zhi.y)); vb[3] *= siluf_(bfhi(zhi.y));
      }
      uint32_t A0 = pack2(va[0], va[1]), A1 = pack2(va[2], va[3]), B0 = pack2(vb[0], vb[1]), B1 = pack2(vb[2], vb[3]);
      pl_swap(A0, B0); pl_swap(A1, B1);
      uint4 o; o.x = A0; o.y = A1; o.z = B0; o.w = B1;
      *(uint4*)(orow + col16) = o;
    }
}
DI void st4(bf16* dst, float a, float b, float c, float d) { uint2 o; o.x = pack2(a, b); o.y = pack2(c, d); *(uint2*)dst = o; }

DI void attn_phaseA(const Params& p, int layer, char* smem, int* ctr) {
  char* ws = opqp(p.ws);
  bf16* u = (bf16*)(ws + OFF_U);
  bf16* y = (bf16*)(ws + OFF_Y);
  const float* gt = (const float*)(ws + OFF_GT);
  int* s_item = (int*)(smem + SM_MISC);
  const int xcd = blockIdx.x & 7;
  while (true) {
    __syncthreads();
    if (threadIdx.x == 0) *s_item = atomicAdd(ctr + 24 + xcd, 1);
    __syncthreads();
    const int item = *s_item;
    if (item >= 16) break;
    {
      const int tid = opq(threadIdx.x), lane = tid & 63, wv = tid >> 6, half = lane >> 5, l31 = lane & 31;
      const int i2 = item;
      const int qb = 15 - i2, b = xcd;
      const int q0 = qb * 128, qpos = q0 + wv * 32 + l31;
      const size_t t = (size_t)b * S + qpos;
      const bf16* ub = u + (size_t)b * S * NP;
      const bf16* kc = (const bf16*)(ws + OFF_KCN) + (size_t)b * 128 * 64;
      const bf16* vc = (const bf16*)(ws + OFF_VCN) + (size_t)b * 128 * 64;
      const uint32_t tm = (q0 + 127 >= 16 * 64 + 31) ? 3u : 1u;
      float* scl = (float*)(smem + SM_SC) + wv * 32 * 33;
#pragma unroll
      for (int g = 0; g < 16; ++g) scl[l31 * 33 + 2 * g + half] = 0.f;
      const int khi = (qpos - 31) >> 4;
#pragma unroll 1
      for (int h = 0; h < 4; ++h) {
        f32x16 O[2]; float mm, ll;
        bf16x8 Qf[4];
        load_q<64>(ub + (size_t)qpos * NP + C_NQ + h * 64, Qf);
        attn_core<64>(kc, 64, vc, 64, tm, AM_CMP, qpos, 0u, Qf, O, mm, ll, smem);
        const float inv = ll > 0.f ? 1.f / ll : 0.f;
        const float sc = inv * gt[t * 12 + h];
        bf16* od = (bf16*)(ws + OFF_OCMP) + t * 256 + h * 64;
        attn_epi<0>(O, sc, nullptr, nullptr, nullptr, nullptr, od, half);
        const float mu = mm < -1e29f ? 0.f : mm;
        const bf16* Ks = (const bf16*)smem;
        float Aa[16], Cc[16];
#pragma unroll
        for (int g = 0; g < 16; ++g) { Aa[g] = 0.f; Cc[g] = 0.f; }
#pragma unroll
        for (int kt = 0; kt < 2; ++kt) {
          if (tm & (1u << kt)) {
#pragma unroll
            for (int kb = 0; kb < 2; ++kb) {
              f32x16 Sx;
#pragma unroll
              for (int i = 0; i < 16; ++i) Sx[i] = 0.f;
#pragma unroll
              for (int kcx = 0; kcx < 4; ++kcx) {
                bf16x8 a = *(const bf16x8*)(Ks + (kt * 64 + kb * 32 + l31) * 72 + kcx * 16 + half * 8);
                Sx = MFMA(a, Qf[kcx], Sx);
              }
#pragma unroll
              for (int gg = 0; gg < 4; ++gg) {
                float pv[4];
#pragma unroll
                for (int e = 0; e < 4; ++e) {
                  const int key = kt * 64 + kb * 32 + gg * 8 + half * 4 + e;
                  pv[e] = key <= khi ? fexp2(Sx[gg * 4 + e] - mu) * inv : 0.f;
                }
                Aa[kt * 8 + kb * 4 + gg] += pv[0] + 2.f * (pv[1] + pv[2] + pv[3]);
                Cc[kt * 8 + kb * 4 + gg] += pv[0];
              }
            }
          }
        }
        {
          float rc[16];
#pragma unroll
          for (int g = 0; g < 16; ++g) rc[g] = shx(Cc[g], 32);
#pragma unroll
          for (int g = 0; g < 16; ++g) {
            const float nx = half == 0 ? rc[g] : (g < 15 ? rc[g < 15 ? g + 1 : 15] : 0.f);
            scl[l31 * 33 + 2 * g + half] += Aa[g] + nx;
          }
        }
      }
      __syncthreads();
      {
        float sv[32];
        const int cur = qpos >> 6;
#pragma unroll
        for (int j = 0; j < 32; ++j) {
          float v = scl[l31 * 33 + j];
          const bool forced = (j == 0) || (j == cur) || (j == cur - 1);
          sv[j] = j > cur ? -1e30f : (forced ? 1e30f : v);
        }
        uint32_t bits = 0;
#pragma unroll 1
        for (int jj = 0; jj < 16; ++jj) {
          const int j = half * 16 + jj;
          float sj = scl[l31 * 33 + j];
          const bool fj = (j == 0) || (j == cur) || (j == cur - 1);
          sj = j > cur ? -1e30f : (fj ? 1e30f : sj);
          int rank = 0;
#pragma unroll
          for (int i = 0; i < 32; ++i) rank += (sv[i] > sj || (sv[i] == sj && i < j)) ? 1 : 0;
          if (rank < 16) bits |= 1u << j;
        }
        bits |= (uint32_t)__shfl_xor((int)bits, 32);
        if (half == 0) ((uint32_t*)(ws + OFF_SEL))[t] = bits;
      }
      wg_publish((unsigned*)(ws + OFF_FLAG) + layer * 1024 + (b * 16 + qb) * 8);
    }
  }
  while (true) {
    __syncthreads();
    if (threadIdx.x == 0) *s_item = atomicAdd(ctr + 16 + xcd, 1);
    __syncthreads();
    const int item = *s_item;
    if (item >= 128) break;
    {
      const int tid = opq(threadIdx.x), lane = tid & 63, wv = tid >> 6, half = lane >> 5, l31 = lane & 31;
      const int i2 = item;
      const int ismem = i2 >> 6, r = i2 & 63, qb = 15 - (r >> 2), b = xcd, h = r & 3;
      const int q0 = qb * 128, qpos = q0 + wv * 32 + l31;
      const size_t t = (size_t)b * S + qpos;
      const bf16* ub = u + (size_t)b * S * NP;
      f32x16 O[2]; float mm, ll;
      bf16x8 Qf[4];
      if (!ismem) {
        load_q<64>(ub + (size_t)qpos * NP + C_NQ + h * 64, Qf);
        const int kt0 = q0 >= 512 ? (q0 - 512) / 64 : 0, kt1 = 2 * qb + 2;
        const uint32_t hi = kt1 >= 32 ? 0xffffffffu : ((1u << kt1) - 1u);
        const uint32_t tm = hi & ~((1u << kt0) - 1u);
        attn_core<64>(ub + C_KW, NP, ub + C_VW, NP, tm, AM_WIN, qpos, 0u, Qf, O, mm, ll, smem);
        const float sc = (ll > 0.f ? 1.f / ll : 0.f) * gt[t * 12 + 8 + h];
        bf16* od = (bf16*)(ws + OFF_OWIN) + t * 256 + h * 64;
        attn_epi<0>(O, sc, nullptr, nullptr, nullptr, nullptr, od, half);
        wg_publish((unsigned*)(ws + OFF_FLAG) + layer * 1024 + (b * 16 + qb) * 8 + 1 + h);
      } else {
        load_q<64>(ub + (size_t)qpos * NP + C_MQ + h * 64, Qf);
        attn_core<64>((const bf16*)(ws + OFF_MK) + (size_t)(b * 4 + h) * ML * 64, 64, (const bf16*)(ws + OFF_MVV) + (size_t)(b * 4 + h) * ML * 64, 64,
                      0xfu, AM_NONE, qpos, 0u, Qf, O, mm, ll, smem);
        const float inv = ll > 0.f ? 1.f / ll : 0.f;
        attn_epi<1>(O, inv, u + t * NP + C_MEZ + h * 64, nullptr, nullptr, nullptr, y + t * 1024 + 768 + h * 64, half);
      }
    }
  }
  while (true) {
    __syncthreads();
    if (threadIdx.x == 0) *s_item = atomicAdd(ctr + xcd, 1);
    __syncthreads();
    const int item = *s_item;
    if (item >= 64) break;
    {
      const int tid = opq(threadIdx.x), lane = tid & 63, wv = tid >> 6, half = lane >> 5, l31 = lane & 31;
      const int qb = 15 - (item >> 2), b = xcd, h = item & 3;
      const int q0 = qb * 128, qpos = q0 + wv * 32 + l31;
      const size_t t = (size_t)b * S + qpos;
      const uint32_t tm = (qb == 15) ? 0xffffffffu : ((1u << (2 * qb + 2)) - 1u);
      f32x16 O[2]; float mm, ll;
        bf16x8 Qf[6];
        const bf16* qm = (const bf16*)(ws + OFF_QM) + (size_t)(b * 4 + h) * S * 96;
        load_q<96>(qm + (size_t)qpos * 96, Qf);
        attn_core<96>((const bf16*)(ws + OFF_KM) + (size_t)(b * 4 + h) * S * 96, 96,
                      (const bf16*)(ws + OFF_MV) + (size_t)(b * 4 + h) * S * 64, 64, tm, AM_CAUSAL, qpos, 0u, Qf, O, mm, ll, smem);
        const float inv = ll > 0.f ? 1.f / ll : 0.f;
        attn_epi<1>(O, inv, u + t * NP + C_MZ + h * 64, nullptr, nullptr, nullptr, y + t * 1024 + 512 + h * 64, half);
    }
  }
  while (true) {
    __syncthreads();
    if (threadIdx.x == 0) *s_item = atomicAdd(ctr + 8 + xcd, 1);
    __syncthreads();
    const int item = *s_item;
    if (item >= 64) break;
    {
      const int tid = opq(threadIdx.x), lane = tid & 63, wv = tid >> 6, half = lane >> 5, l31 = lane & 31;
      const int qb = 15 - (item >> 2), b = xcd, h = item & 3;
      const int q0 = qb * 128, qpos = q0 + wv * 32 + l31;
      const size_t t = (size_t)b * S + qpos;
      const uint32_t tm = (qb == 15) ? 0xffffffffu : ((1u << (2 * qb + 2)) - 1u);
      f32x16 O[2]; float mm, ll;
        f32x16 O1[2];
        const bf16* ub = u + (size_t)b * S * NP;
        {
          bf16x8 Qf[4];
          float l1, l2;
          load_q<64>(ub + (size_t)qpos * NP + C_DQ + h * 64, Qf);
          attn_core_dual<64>(ub + C_DK + h * 64, NP, ub + C_DV + h * 64, NP, tm, AM_CAUSAL, qpos, 0u, Qf, O1, O, l1, l2, smem);
          const float inv1 = l1 > 0.f ? 1.f / l1 : 0.f, inv = l2 > 0.f ? 1.f / l2 : 0.f;
#pragma unroll
          for (int i = 0; i < 16; ++i) { O1[0][i] *= inv1; O1[1][i] *= inv1; }
          {
            const float lam = ((const float*)(ws + OFF_LAM))[layer];
            float ss = 0.f;
#pragma unroll
            for (int i = 0; i < 16; ++i) {
              O1[0][i] -= lam * O[0][i] * inv; O1[1][i] -= lam * O[1][i] * inv;
              ss += O1[0][i] * O1[0][i] + O1[1][i] * O1[1][i];
            }
            ss += shx(ss, 32);
            const float li = opq(layer) == 0 ? 0.2f : 0.35550907f;
            const float r = rsqrtf(ss * (1.f / 64.f) + EPS) * (1.f - li);
            const float* sg = p.in[10] + layer * 64;
            attn_epi<2>(O1, r, u + t * NP + C_DZ + h * 64, sg, nullptr, nullptr, y + t * 1024 + 256 + h * 64, half);
          }
        }
    }
  }
}

DI void attn_phaseB(const Params& p, int layer, char* smem, int* ctr) {
  const int tid = opq(threadIdx.x), lane = tid & 63, wv = tid >> 6, half = lane >> 5, l31 = lane & 31;
  char* ws = opqp(p.ws);
  bf16* u = (bf16*)(ws + OFF_U);
  bf16* y = (bf16*)(ws + OFF_Y);
  const float* gt = (const float*)(ws + OFF_GT);
  int* s_item = (int*)(smem + SM_MISC);
  uint32_t* s_or = (uint32_t*)(smem + SM_MISC + 16);
  const int xcd = blockIdx.x & 7;
  while (true) {
    __syncthreads();
    if (tid == 0) { *s_item = atomicAdd(ctr + xcd, 1); *s_or = 0u; }
    __syncthreads();
    const int item = *s_item;
    if (item >= 64) break;
    const int qb = 15 - (item >> 2), b = xcd, h = item & 3;
    const int q0 = qb * 128, qpos = q0 + wv * 32 + l31;
    const size_t t = (size_t)b * S + qpos;
    const bf16* ub = u + (size_t)b * S * NP;
    wg_wait2((unsigned*)(ws + OFF_FLAG) + layer * 1024 + (b * 16 + qb) * 8, (unsigned*)(ws + OFF_FLAG) + layer * 1024 + (b * 16 + qb) * 8 + 1 + h);
    const uint32_t sel = ((const uint32_t*)(ws + OFF_SEL))[t];
    const uint32_t causal = (qb == 15) ? 0xffffffffu : ((1u << (2 * qb + 2)) - 1u);
    if (half == 0) atomicOr(s_or, sel);
    __syncthreads();
    const uint32_t tm = (*s_or & causal) | 1u;
    f32x16 O[2]; float mm, ll;
    bf16x8 Qf[4];
    load_q<64>(ub + (size_t)qpos * NP + C_NQ + h * 64, Qf);
    attn_core<64>(ub + C_KS, NP, ub + C_VS, NP, tm, AM_SLC, qpos, sel, Qf, O, mm, ll, smem);
    const float sc = (ll > 0.f ? 1.f / ll : 0.f) * gt[t * 12 + 4 + h];
    const bf16* oc = (const bf16*)(ws + OFF_OCMP) + t * 256 + h * 64;
    const bf16* ow = (const bf16*)(ws + OFF_OWIN) + t * 256 + h * 64;
    attn_epi<3>(O, sc, u + t * NP + C_NZ + h * 64, nullptr, oc, ow, y + t * 1024 + h * 64, half);
  }
  (void)layer;
}

__global__ void __launch_bounds__(256, 2) fwd_megakernel(Params p) {
  __shared__ __attribute__((aligned(16))) char smem[SMEM_BYTES];
  cg::grid_group grid = cg::this_grid();
  char* ws = opqp(p.ws);
  int* ctrs = (int*)(ws + OFF_CTR);
  __shared__ uint4 xb_words;
  if (threadIdx.x == 0) xb_words = make_uint4(0u, 0u, 0u, 0u);
  __syncthreads();
  XcdBarrier xb = xcd_barrier_post((unsigned*)(ws + OFF_BAR), (volatile LAS unsigned*)&xb_words);
  phase0(p, smem);
  if (p.out == nullptr) grid.sync();
  xcd_barrier(xb);
#define PBAR(K) xcd_barrier(xb)
  for (int layer = 0; layer < 2; ++layer) {
    bf16* u = (bf16*)(ws + OFF_U);
    {
      const bf16* xbp = (const bf16*)(ws + OFF_XB);
      const bf16* wi = (const bf16*)(ws + OFF_WI + layer * SZ_WI);
      const int xcd = blockIdx.x & 7, rk = blockIdx.x >> 3, nrk = gridDim.x >> 3;
      for (int q = rk; q < 216; q += nrk) {
        if (q < 192) {
          const int mt = xcd * 8 + (q & 7), nt = q >> 3;
          gemm_big(xbp + (size_t)mt * 256 * 1024, 1024, wi + (size_t)nt * 128 * 1024, 1024, 16, smem, EPI_RS8, u, NP, mt * 256,
                   (const float*)(ws + OFF_SSQ), nullptr, nullptr, nullptr, nullptr, nt);
        } else if (q < 208) {
          const int mt = xcd * 16 + (q - 192), nt = 24;
          gemm_tile<16>(xbp + (size_t)mt * 128 * 1024, 1024, 64, wi + (size_t)nt * 128 * 1024, 1024, 16, smem);
          gemm_epi(EPI_RS8, smem, u, NP, mt * 128, (const float*)(ws + OFF_SSQ), nullptr, nullptr, nullptr, nullptr, nt);
        } else {
          const int i = xcd * 8 + (q - 208), mt = i >> 2, nt = i & 3;
          gemm_tile<16>((const bf16*)(ws + OFF_MEMB) + (size_t)mt * 128 * 1024, 1024, 64,
                    (const bf16*)(ws + OFF_WMEM + layer * SZ_WMEM) + (size_t)nt * 128 * 1024, 1024, 16, smem);
          gemm_epi(EPI_RS1, smem, (bf16*)(ws + OFF_KMEMRAW), 512, mt * 128, (const float*)(ws + OFF_RMEM), nullptr, nullptr, nullptr, nullptr, nt);
        }
      }
    }
    PBAR(0);
    {
      const int xcd = blockIdx.x & 7, rk = blockIdx.x >> 3, nrk = gridDim.x >> 3;
      for (int q = rk; q < 64; q += nrk) {
        if (q < 8) {
          const int j = q >> 2, kh = q & 3, b = xcd;
          gemm_tile<8>(u + (size_t)b * S * NP + (j ? C_VC : C_KC) + (size_t)kh * 8 * NP, 16 * NP, NP,
                       (const bf16*)(ws + OFF_WCMP + (layer * 2 + j) * SZ_WCMP) + kh * 512, 2048, 8, smem);
          gemm_epi(EPI_PLAIN, smem, (bf16*)(ws + OFF_CMPRAW) + (size_t)(kh * 2 + j) * 1024 * 128, 128, b * 128, nullptr, nullptr, nullptr, nullptr, nullptr, 0);
        } else if (q < 32) {
          const int i = q - 8, ml = i / 3, nt = i % 3, mt = xcd * 8 + ml;
          gemm_big(u + (size_t)mt * 256 * NP + C_CQ, NP, (const bf16*)(ws + OFF_WUQ + layer * SZ_WUQ) + (size_t)nt * 128 * 256, 256, 4, smem, EPI_PLAIN,
                   (bf16*)(ws + OFF_UQ + (size_t)xcd * SLAB), 384, ml * 256, nullptr, nullptr, nullptr, nullptr, nullptr, nt);
        } else {
          const int i = q - 32, ml = i >> 2, nt = i & 3, mt = xcd * 8 + ml;
          gemm_big(u + (size_t)mt * 256 * NP + C_CKV, NP, (const bf16*)(ws + OFF_WUKV + layer * SZ_WUKV) + (size_t)nt * 128 * 128, 128, 2, smem, EPI_PLAIN,
                   (bf16*)(ws + OFF_UKV + (size_t)xcd * SLAB), 512, ml * 256, nullptr, nullptr, nullptr, nullptr, nullptr, nt);
        }
      }
    }
    PBAR(1);
    prep_phase(p, layer);
    PBAR(2);
    attn_phaseA(p, layer, smem, ctrs + layer * 64);
    attn_phaseB(p, layer, smem, ctrs + layer * 64 + 32);
    PBAR(3);
    {
      const bf16* yb = (const bf16*)(ws + OFF_Y);
      const bf16* wo = (const bf16*)(ws + OFF_WO + layer * SZ_WO);
      const float* xres = layer == 0 ? p.in[0] : nullptr;
      const int xcd = blockIdx.x & 7, rk = blockIdx.x >> 3, nrk = gridDim.x >> 3;
      for (int q = rk; q < 64; q += nrk) {
        const int mt = xcd * 8 + (q & 7), nt = q >> 3;
        gemm_big(yb + (size_t)mt * 256 * 1024, 1024, wo + (size_t)nt * 128 * 1024, 1024, 16, smem, EPI_OUT, (bf16*)(ws + OFF_XB), 0, mt * 256, nullptr, xres, layer == 0 ? nullptr : p.out,
                 layer == 0 ? (bf16*)(ws + OFF_XB) : nullptr, (float*)(ws + OFF_SSQ), nt);
      }
    }
    if (layer == 0) PBAR(4);
  }
}

extern "C" void kernel_launch(void* const* d_in, const int* in_sizes, int n_in, void* d_out, int out_size, void* d_ws, size_t ws_size,
                              hipStream_t stream) {
  static int grid_blocks = 0;
  if (!grid_blocks) {
    int dev = 0, cus = 0, per_cu = 0;
    hipGetDevice(&dev);
    hipDeviceGetAttribute(&cus, hipDeviceAttributeMultiprocessorCount, dev);
    hipOccupancyMaxActiveBlocksPerMultiprocessor(&per_cu, fwd_megakernel, 256, 0);
    if (per_cu > 2) per_cu = 2;
    grid_blocks = (cus * per_cu) & ~7;
  }
  if (ws_size < WS_TOTAL) { fprintf(stderr, "workspace too small: %zu < %zu\n", ws_size, (size_t)WS_TOTAL); return; }
  Params p{};
  for (int i = 0; i < 19; ++i) p.in[i] = (const float*)d_in[i];
  p.out = (float*)d_out;
  p.ws = (char*)d_ws;
  hipMemsetAsync((char*)d_ws + OFF_CTR, 0, 1024 + 16384 + 8192 + 2048, stream);
  void* args[] = {&p};
  hipError_t e = hipLaunchCooperativeKernel((void*)fwd_megakernel, dim3(grid_blocks), dim3(256), args, 0, stream);
  if (e != hipSuccess) fprintf(stderr, "cooperative launch failed: %s (grid %d)\n", hipGetErrorString(e), grid_blocks);
}
```

```cpp
#include <hip/hip_runtime.h>
#include <hip/hip_cooperative_groups.h>
#include <stdint.h>
#include <cstdio>
namespace cg = cooperative_groups;

typedef unsigned short bf16;
using bf16x8 = __attribute__((ext_vector_type(8))) short;
using f32x16 = __attribute__((ext_vector_type(16))) float;
typedef __bf16 hbf2 __attribute__((ext_vector_type(2)));
typedef float hf2 __attribute__((ext_vector_type(2)));
typedef uint32_t u32x4 __attribute__((ext_vector_type(4)));
#define GLD16(dst, ptr) asm volatile("global_load_dwordx4 %0, %1, off" : "=&v"(dst) : "v"(ptr) : "memory")
#define WAIT_VM0() asm volatile("s_waitcnt vmcnt(0)" ::: "memory")
#define DI __device__ __forceinline__
#define MFMA(a, b, c) __builtin_amdgcn_mfma_f32_32x32x16_bf16((a), (b), (c), 0, 0, 0)

constexpr int Bn = 8, S = 2048, T = 16384, D = 1024, NP = 3200, ML = 256, TM = 2048;
constexpr float EPS = 1e-6f;
constexpr float LOG2E = 1.4426950408889634f;
constexpr int C_NQ = 0, C_KC = 256, C_VC = 320, C_KS = 384, C_VS = 448, C_KW = 512, C_VW = 576, C_NZ = 640,
              C_DQ = 896, C_DK = 1152, C_DV = 1408, C_DZ = 1664, C_CQ = 1920, C_CKV = 2176, C_KR = 2304,
              C_MZ = 2336, C_MQ = 2592, C_MEZ = 2848, C_GL = 3104;
constexpr size_t SZ_WI = (size_t)NP * 1024 * 2, SZ_WO = 1024 * 1024 * 2, SZ_WUQ = 384 * 256 * 2, SZ_WUKV = 512 * 128 * 2,
                 SZ_WMEM = 512 * 1024 * 2, SZ_WCMP = 128 * 2048 * 2;
constexpr size_t OFF_WI = 0;
constexpr size_t OFF_WO = OFF_WI + 2 * SZ_WI;
constexpr size_t OFF_WUQ = OFF_WO + 2 * SZ_WO;
constexpr size_t OFF_WUKV = OFF_WUQ + 2 * SZ_WUQ;
constexpr size_t OFF_WMEM = OFF_WUKV + 2 * SZ_WUKV;
constexpr size_t OFF_WCMP = OFF_WMEM + 2 * SZ_WMEM;
constexpr size_t OFF_CB = OFF_WCMP + 4 * SZ_WCMP;
constexpr size_t OFF_LAM = OFF_CB + 16384;
constexpr size_t OFF_CTR = OFF_LAM + 256;
constexpr size_t OFF_BAR = OFF_CTR + 1024;
constexpr size_t OFF_FLAG = OFF_BAR + 16384;
constexpr size_t OFF_PCNT = OFF_FLAG + 8192;
constexpr size_t OFF_ROPE = OFF_PCNT + 2048;
constexpr size_t OFF_SSQ = OFF_ROPE + 2048 * 32 * 8;
constexpr size_t OFF_RMEM = OFF_SSQ + (size_t)T * 8 * 4;
constexpr size_t OFF_MEMB = OFF_RMEM + 2048 * 4;
constexpr size_t OFF_XB = OFF_MEMB + (size_t)TM * 1024 * 2;
constexpr size_t OFF_U = OFF_XB + (size_t)T * 1024 * 2;
constexpr size_t OFF_R1 = OFF_U + (size_t)T * NP * 2;
constexpr size_t SLAB = (size_t)S * 1024 * 2;
constexpr size_t OFF_UQ = OFF_R1;
constexpr size_t OFF_UKV = OFF_R1 + (size_t)S * 384 * 2;
constexpr size_t OFF_Y = OFF_R1;
constexpr size_t OFF_QM = OFF_R1 + (size_t)T * 1024 * 2;
constexpr size_t OFF_KM = OFF_QM + (size_t)T * 384 * 2;
constexpr size_t OFF_MV = OFF_KM + (size_t)T * 384 * 2;
constexpr size_t OFF_KMEMRAW = OFF_MV + (size_t)T * 256 * 2;
constexpr size_t OFF_MK = OFF_KMEMRAW + (size_t)TM * 512 * 2;
constexpr size_t OFF_MVV = OFF_MK + (size_t)TM * 256 * 2;
constexpr size_t OFF_CMPRAW = OFF_MVV + (size_t)TM * 256 * 2;
constexpr size_t OFF_KCN = OFF_CMPRAW + 8 * 1024 * 128 * 2;
constexpr size_t OFF_VCN = OFF_KCN + 8 * 128 * 64 * 2;
constexpr size_t OFF_GT = OFF_VCN + 8 * 128 * 64 * 2;
constexpr size_t OFF_OCMP = OFF_GT + (size_t)T * 12 * 4;
constexpr size_t OFF_OWIN = OFF_OCMP + (size_t)T * 256 * 2;
constexpr size_t OFF_SEL = OFF_OWIN + (size_t)T * 256 * 2;
constexpr size_t WS_TOTAL = OFF_SEL + (size_t)T * 4;

constexpr int SMEM_BYTES = 73728;
constexpr int SM_VT = 2 * 64 * 104 * 2;
constexpr int SM_SC = SM_VT + 2 * 64 * 72 * 2;
constexpr int SM_MISC = SM_SC + 4 * 32 * 33 * 4;

struct Params {
  const float* in[19];
  float* out;
  char* ws;
};

DI int opq(int v) { asm volatile("" : "+v"(v)); return v; }
DI char* opqp(char* q) { size_t z = 0; asm volatile("" : "+s"(z)); return q + z; }
DI float bf2f(uint32_t v) { return __uint_as_float(v << 16); }
DI float bflo(uint32_t w) { return __uint_as_float(w << 16); }
DI float bfhi(uint32_t w) { return __uint_as_float(w & 0xffff0000u); }
DI uint32_t pack2(float a, float b) { hf2 f = {a, b}; hbf2 r = __builtin_convertvector(f, hbf2); return __builtin_bit_cast(uint32_t, r); }
DI bf16 f2bf(float a) { return (bf16)(pack2(a, 0.f) & 0xffffu); }
DI float fexp2(float x) { return __builtin_amdgcn_exp2f(x); }
DI float sigmoidf_(float x) { return __builtin_amdgcn_rcpf(1.f + fexp2(-LOG2E * x)); }
DI float siluf_(float x) { return x * __builtin_amdgcn_rcpf(1.f + fexp2(-LOG2E * x)); }
DI float shx(float v, int m) { return __shfl_xor(v, m); }
DI float dppf(float v, int ctrl_sel) {
  int x = __builtin_bit_cast(int, v), r;
  if (ctrl_sel == 0) r = __builtin_amdgcn_mov_dpp(x, 0xB1, 0xF, 0xF, true);
  else if (ctrl_sel == 1) r = __builtin_amdgcn_mov_dpp(x, 0x4E, 0xF, 0xF, true);
  else if (ctrl_sel == 2) r = __builtin_amdgcn_mov_dpp(x, 0x141, 0xF, 0xF, true);
  else r = __builtin_amdgcn_mov_dpp(x, 0x140, 0xF, 0xF, true);
  return __builtin_bit_cast(float, r);
}
DI float sum8(float v) { v += dppf(v, 0); v += dppf(v, 1); v += dppf(v, 2); return v; }
DI float sum16(float v) { v = sum8(v); v += dppf(v, 3); return v; }
DI float sum64(float v) { v = sum16(v); v += shx(v, 16); v += shx(v, 32); return v; }


#define XB_TMO      128
#define XB_XCNT(j)  (256  + 64 * (j))
#define XB_XSUB(j)  (1280 + 64 * (j))
#define XB_XGEN(j)  (2304 + 64 * (j))
#define XB_TOP      3328
#define XB_TOPGEN   3392
#define XB_SPIN_CAP (1u << 22)
#define LAS __attribute__((address_space(3)))
DI unsigned xb_ld(unsigned* p) { return __hip_atomic_load(p, __ATOMIC_RELAXED, __HIP_MEMORY_SCOPE_AGENT); }
DI unsigned xb_add(unsigned* p, unsigned v) { return __hip_atomic_fetch_add(p, v, __ATOMIC_RELAXED, __HIP_MEMORY_SCOPE_AGENT); }
DI unsigned xb_xcc_id() { return (unsigned)__builtin_amdgcn_readfirstlane((int)(__builtin_amdgcn_s_getreg((3 << 11) | 20) & 0xFu)); }
#define XB_SPIN(cond, bar) do { unsigned _sp = 0; while (cond) { __builtin_amdgcn_s_sleep(1); \
    if ((++_sp & 255u) == 0u) { if (xb_ld(&(bar)[XB_TMO])) break; if (_sp > XB_SPIN_CAP) { atomicAdd(&(bar)[XB_TMO], 1u); break; } } } } while (0)
struct XcdBarrier { unsigned* bar; unsigned x; volatile LAS unsigned* st; };
DI XcdBarrier xcd_barrier_post(unsigned* bar, volatile LAS unsigned* st) {
  XcdBarrier b; b.bar = bar; b.x = xb_xcc_id(); b.st = st;
  if (threadIdx.x == 0) (void)xb_add(&bar[XB_XCNT(b.x)], 1u);
  return b;
}
DI void xcd_barrier_complete(unsigned* bar, unsigned x, unsigned& nloc, unsigned& nx) {
  const unsigned G = gridDim.x * gridDim.y * gridDim.z;
  unsigned sum, cnt, mine, sp = 0u;
  for (;;) {
    sum = 0u; cnt = 0u; mine = 0u;
#pragma unroll
    for (unsigned j = 0; j < 16; ++j) { const unsigned c = xb_ld(&bar[XB_XCNT(j)]); sum += c; cnt += (c > 0u) ? 1u : 0u; mine = (j == x) ? c : mine; }
    if (sum == G) break;
    __builtin_amdgcn_s_sleep(1);
    if ((++sp & 255u) == 0u) { if (xb_ld(&bar[XB_TMO])) break; if (sp > XB_SPIN_CAP) { atomicAdd(&bar[XB_TMO], 1u); break; } }
  }
  nloc = mine > 0u ? mine : 1u; nx = cnt > 0u ? cnt : 1u;
}
DI void xcd_barrier(const XcdBarrier& b) {
  asm volatile("s_waitcnt vmcnt(0)" ::: "memory");
  __syncthreads();
  if (threadIdx.x == 0) {
    unsigned* bar = b.bar;
    const unsigned bx = xb_xcc_id();
    __builtin_amdgcn_s_waitcnt(0);
    unsigned nloc = b.st[0], nx = b.st[1];
    if (nloc == 0u) { xcd_barrier_complete(bar, bx, nloc, nx); b.st[0] = nloc; b.st[1] = nx; }
    const unsigned old = xb_add(&bar[XB_XSUB(bx)], 1u);
    const unsigned gen = old / nloc;
    if (old + 1u == (gen + 1u) * nloc) {
      __builtin_amdgcn_fence(__ATOMIC_RELEASE, "agent");
      asm volatile("s_waitcnt vmcnt(0)" ::: "memory");
      const unsigned og = xb_add(&bar[XB_TOP], 1u);
      const unsigned tg = og / nx;
      if (og + 1u == (tg + 1u) * nx) xb_add(&bar[XB_TOPGEN], 1u);
      else XB_SPIN(xb_ld(&bar[XB_TOPGEN]) == tg, bar);
      __builtin_amdgcn_fence(__ATOMIC_ACQUIRE, "agent");
      xb_add(&bar[XB_XGEN(bx)], 1u);
      asm volatile("s_waitcnt vmcnt(0)" ::: "memory");
    } else {
      XB_SPIN(xb_ld(&bar[XB_XGEN(bx)]) == gen, bar);
      __builtin_amdgcn_fence(__ATOMIC_ACQUIRE, "agent");
      asm volatile("s_waitcnt vmcnt(0)" ::: "memory");
    }
  }
  __syncthreads();
}

DI void part_barrier(unsigned* cnt, unsigned target) {
  asm volatile("s_waitcnt vmcnt(0)" ::: "memory");
  __syncthreads();
  if (threadIdx.x == 0) {
    __builtin_amdgcn_s_waitcnt(0);
    __builtin_amdgcn_fence(__ATOMIC_RELEASE, "agent");
    asm volatile("s_waitcnt vmcnt(0)" ::: "memory");
    xb_add(cnt, 1u);
    unsigned sp = 0;
    while (xb_ld(cnt) < target) { __builtin_amdgcn_s_sleep(1); if (++sp > (1u << 24)) break; }
    __builtin_amdgcn_fence(__ATOMIC_ACQUIRE, "agent");
    asm volatile("s_waitcnt vmcnt(0)" ::: "memory");
  }
  __syncthreads();
}

DI void wg_publish(unsigned* flag) {
  asm volatile("s_waitcnt vmcnt(0)" ::: "memory");
  __syncthreads();
  if (threadIdx.x == 0) {
    __builtin_amdgcn_fence(__ATOMIC_RELEASE, "agent");
    asm volatile("s_waitcnt vmcnt(0)" ::: "memory");
    xb_add(flag, 1u);
  }
}
DI void wg_wait2(unsigned* f0, unsigned* f1) {
  if (threadIdx.x == 0) {
    unsigned sp = 0;
    while (xb_ld(f0) < 1u || xb_ld(f1) < 1u) { __builtin_amdgcn_s_sleep(2); if (++sp > (1u << 22)) break; }
    __builtin_amdgcn_fence(__ATOMIC_ACQUIRE, "agent");
    asm volatile("s_waitcnt vmcnt(0)" ::: "memory");
  }
  __syncthreads();
}

DI int win_orig(int n) { return n < 640 ? n : (n < 3104 ? n + 12 : (n < 3116 ? n - 3104 + 640 : -1)); }

DI void convT_tile(const float* __restrict__ src, int Nsrc, const float* __restrict__ gain, bf16* __restrict__ dst, int K,
                   int k0, int n0, int mapmode, float* tile) {
  const int tid = opq(threadIdx.x);
  int shift = -1;
  if (mapmode == 1) { if (n0 + 63 < 640) shift = 0; else if (n0 >= 640 && n0 + 63 < 3104) shift = 12; }
  else if (n0 + 63 < Nsrc) shift = 0;
  const bool allpad = (mapmode == 1) ? (n0 >= 3116) : (n0 >= Nsrc);
  if (shift >= 0) {
    const int f = tid & 15, kr = tid >> 4;
    float4 v[4];
#pragma unroll
    for (int it = 0; it < 4; ++it) v[it] = *(const float4*)(src + (size_t)(k0 + kr + 16 * it) * Nsrc + n0 + shift + 4 * f);
    if (gain) {
#pragma unroll
      for (int it = 0; it < 4; ++it) { const float g = gain[k0 + kr + 16 * it]; v[it].x *= g; v[it].y *= g; v[it].z *= g; v[it].w *= g; }
    }
#pragma unroll
    for (int it = 0; it < 4; ++it) {
      float* tp = tile + (kr + 16 * it) * 65 + 4 * f;
      tp[0] = v[it].x; tp[1] = v[it].y; tp[2] = v[it].z; tp[3] = v[it].w;
    }
  } else {
    const int nn = tid & 63, kk = tid >> 6;
    const int n = n0 + nn;
    const int on = allpad ? -1 : (mapmode == 1 ? win_orig(n) : (n < Nsrc ? n : -1));
    float v[16];
#pragma unroll
    for (int it = 0; it < 16; ++it) {
      const int k = k0 + kk + 4 * it;
      v[it] = 0.f;
      if (on >= 0) v[it] = src[(size_t)k * Nsrc + on];
    }
    if (gain) {
#pragma unroll
      for (int it = 0; it < 16; ++it) v[it] *= gain[k0 + kk + 4 * it];
    }
#pragma unroll
    for (int it = 0; it < 16; ++it) tile[(kk + 4 * it) * 65 + nn] = v[it];
  }
  __syncthreads();
  {
    const int k8 = (tid & 7) * 8, nb = tid >> 3;
#pragma unroll
    for (int it = 0; it < 2; ++it) {
      const int n = nb + 32 * it;
      uint4 o;
      o.x = pack2(tile[(k8 + 0) * 65 + n], tile[(k8 + 1) * 65 + n]);
      o.y = pack2(tile[(k8 + 2) * 65 + n], tile[(k8 + 3) * 65 + n]);
      o.z = pack2(tile[(k8 + 4) * 65 + n], tile[(k8 + 5) * 65 + n]);
      o.w = pack2(tile[(k8 + 6) * 65 + n], tile[(k8 + 7) * 65 + n]);
      *(uint4*)(dst + (size_t)(n0 + n) * K + k0 + k8) = o;
    }
  }
  __syncthreads();
}

DI void phase0(const Params& p, char* smem) {
  const int tid = opq(threadIdx.x), lane = tid & 63, wv = tid >> 6;
  float* tile = (float*)smem;
  char* ws = opqp(p.ws);
  constexpr int N_WI = 2 * 50 * 16, N_WO = 2 * 16 * 16, N_WUQ = 2 * 6 * 4, N_WUKV = 2 * 8 * 2, N_WMEM = 2 * 8 * 16,
                N_WCMP = 4 * 2 * 32, N_X = T / 4, N_MEM = TM / 4, N_ROPE = 256, N_CB = 64, N_LAM = 1;
  constexpr int E0 = N_WI, E1 = E0 + N_WO, E2 = E1 + N_WUQ, E3 = E2 + N_WUKV, E4 = E3 + N_WMEM, E5 = E4 + N_WCMP,
                E6 = E5 + N_X, E7 = E6 + N_MEM, E8 = E7 + N_ROPE, E9 = E8 + N_CB, E10 = E9 + N_LAM;
  for (int it = blockIdx.x; it < E10; it += gridDim.x) {
    if (it < E0) {
      int l = it / 800, r = it % 800, nt = r / 16, kt = r % 16;
      convT_tile(p.in[3] + (size_t)l * 1024 * 3116, 3116, p.in[2] + l * 1024, (bf16*)(ws + OFF_WI + l * SZ_WI), 1024, kt * 64, nt * 64, 1, tile);
    } else if (it < E1) {
      int i = it - E0; int l = i / 256, r = i % 256, nt = r / 16, kt = r % 16;
      convT_tile(p.in[4] + (size_t)l * 1024 * 1024, 1024, nullptr, (bf16*)(ws + OFF_WO + l * SZ_WO), 1024, kt * 64, nt * 64, 0, tile);
    } else if (it < E2) {
      int i = it - E1; int l = i / 24, r = i % 24, nt = r / 4, kt = r % 4;
      convT_tile(p.in[13] + (size_t)l * 256 * 384, 384, p.in[11] + l * 256, (bf16*)(ws + OFF_WUQ + l * SZ_WUQ), 256, kt * 64, nt * 64, 0, tile);
    } else if (it < E3) {
      int i = it - E2; int l = i / 16, r = i % 16, nt = r / 2, kt = r % 2;
      convT_tile(p.in[14] + (size_t)l * 128 * 512, 512, p.in[12] + l * 128, (bf16*)(ws + OFF_WUKV + l * SZ_WUKV), 128, kt * 64, nt * 64, 0, tile);
    } else if (it < E4) {
      int i = it - E3; int l = i / 128, r = i % 128, nt = r / 16, kt = r % 16;
      convT_tile(p.in[17] + (size_t)l * 1024 * 512, 512, p.in[16] + l * 1024, (bf16*)(ws + OFF_WMEM + l * SZ_WMEM), 1024, kt * 64, nt * 64, 0, tile);
    } else if (it < E5) {
      int i = it - E4; int lj = i / 64, r = i % 64, nt = r / 32, kt = r % 32;
      convT_tile(p.in[7] + (size_t)lj * 2048 * 64, 64, nullptr, (bf16*)(ws + OFF_WCMP + lj * SZ_WCMP), 2048, kt * 64, nt * 64, 0, tile);
    } else if (it < E6) {
      int row = (it - E5) * 4 + wv;
      const float4* xr = (const float4*)(p.in[0] + (size_t)row * 1024);
      bf16* xb = (bf16*)(ws + OFF_XB) + (size_t)row * 1024;
      float ss = 0.f;
#pragma unroll
      for (int i = 0; i < 4; ++i) {
        float4 v = xr[lane + 64 * i];
        ss += v.x * v.x + v.y * v.y + v.z * v.z + v.w * v.w;
        uint2 o; o.x = pack2(v.x, v.y); o.y = pack2(v.z, v.w);
        *(uint2*)(xb + (lane + 64 * i) * 4) = o;
      }
      ss = sum64(ss);
      float* sq = (float*)(ws + OFF_SSQ) + (size_t)row * 8;
      if (lane < 8) sq[lane] = lane == 0 ? ss : 0.f;
    } else if (it < E7) {
      int row = (it - E6) * 4 + wv;
      const float4* xr = (const float4*)(p.in[1] + (size_t)row * 1024);
      bf16* xb = (bf16*)(ws + OFF_MEMB) + (size_t)row * 1024;
      float ss = 0.f;
#pragma unroll
      for (int i = 0; i < 4; ++i) {
        float4 v = xr[lane + 64 * i];
        ss += v.x * v.x + v.y * v.y + v.z * v.z + v.w * v.w;
        uint2 o; o.x = pack2(v.x, v.y); o.y = pack2(v.z, v.w);
        *(uint2*)(xb + (lane + 64 * i) * 4) = o;
      }
      ss = sum64(ss);
      if (lane == 0) ((float*)(ws + OFF_RMEM))[row] = rsqrtf(ss * (1.f / 1024.f) + EPS);
    } else if (it < E8) {
      int e = (it - E7) * 256 + tid;
      int pos = e >> 5, i = e & 31;
      float inv = powf(10000.f, -(float)i / 32.f);
      float ang = (float)pos * inv;
      double a = (double)ang;
      double n = rint(a * 0.15915494309189535);
      float r = (float)(a - n * 6.283185307179586);
      float2 cs; cs.x = __cosf(r); cs.y = __sinf(r);
      ((float2*)(ws + OFF_ROPE))[e] = cs;
    } else if (it < E9) {
      int lj = (it - E8) >> 4, sl = (it - E8) & 15;
      const float* pe = p.in[6] + (size_t)lj * 2048;
      const float* w = p.in[7] + (size_t)lj * 2048 * 64;
      int n = tid & 63, part = tid >> 6;
      float acc = 0.f;
      const int kb0 = sl * 128 + part * 32;
#pragma unroll 8
      for (int k = kb0; k < kb0 + 32; ++k) acc += pe[k] * w[(size_t)k * 64 + n];
      tile[tid] = acc;
      __syncthreads();
      if (tid < 64) ((float*)(ws + OFF_CB))[((it - E8)) * 64 + tid] = tile[tid] + tile[tid + 64] + tile[tid + 128] + tile[tid + 192];
      __syncthreads();
    } else {
      if (tid < 2) {
        const float* lf = p.in[9] + tid * 128;
        float s1 = 0.f, s2 = 0.f;
        for (int i = 0; i < 32; ++i) { s1 += lf[i] * lf[32 + i]; s2 += lf[64 + i] * lf[96 + i]; }
        float li = 0.8f - 0.6f * expf(-0.3f * (float)tid);
        ((float*)(ws + OFF_LAM))[tid] = expf(s1) - expf(s2) + li;
      }
    }
  }
}

template <int CH>
DI void gemm_tile(const bf16* __restrict__ Ab, long lda, long kcs, const bf16* __restrict__ Bb, long ldb, int nk, char* smem) {
  const int tid = opq(threadIdx.x), lane = tid & 63, wv = tid >> 6, half = lane >> 5, l31 = lane & 31;
  const int wm = wv >> 1, wn = wv & 1;
  bf16* As = (bf16*)smem;
  bf16* Bs = (bf16*)(smem + 36864);
  const int lrow = tid >> 3, lcol = (tid & 7) * 8;
  const bf16* ag = Ab + (long)lrow * lda + lcol;
  const bf16* bg = Bb + (long)lrow * ldb + lcol;
  f32x16 acc[2][2];
#pragma unroll
  for (int a = 0; a < 2; ++a)
#pragma unroll
    for (int b = 0; b < 2; ++b)
#pragma unroll
      for (int i = 0; i < 16; ++i) acc[a][b][i] = 0.f;
#define GCOMPUTE(BUF) do { \
    const bf16* as_ = As + (BUF) * 128 * 72 + (wm * 64 + l31) * 72 + half * 8; \
    const bf16* bs_ = Bs + (BUF) * 128 * 72 + (wn * 64 + l31) * 72 + half * 8; \
    bf16x8 fa[2][2], fb[2][2]; \
    fa[0][0] = *(const bf16x8*)(as_); fa[0][1] = *(const bf16x8*)(as_ + 32 * 72); \
    fb[0][0] = *(const bf16x8*)(bs_); fb[0][1] = *(const bf16x8*)(bs_ + 32 * 72); \
    _Pragma("unroll") for (int kc = 0; kc < 4; ++kc) { \
      if (kc < 3) { \
        fa[(kc + 1) & 1][0] = *(const bf16x8*)(as_ + (kc + 1) * 16); fa[(kc + 1) & 1][1] = *(const bf16x8*)(as_ + 32 * 72 + (kc + 1) * 16); \
        fb[(kc + 1) & 1][0] = *(const bf16x8*)(bs_ + (kc + 1) * 16); fb[(kc + 1) & 1][1] = *(const bf16x8*)(bs_ + 32 * 72 + (kc + 1) * 16); \
      } \
      _Pragma("unroll") for (int ni = 0; ni < 2; ++ni) \
        _Pragma("unroll") for (int mi = 0; mi < 2; ++mi) acc[ni][mi] = MFMA(fb[kc & 1][ni], fa[kc & 1][mi], acc[ni][mi]); \
    } } while (0)
  for (int c0 = 0; c0 < nk; c0 += CH) {
    u32x4 rs[2][8];
    const bf16* agc = ag + (long)c0 * kcs;
    const bf16* bgc = bg + (long)c0 * 64;
#pragma unroll
    for (int i = 0; i < 4; ++i) {
      rs[0][i] = *(const u32x4*)(agc + (long)(32 * i) * lda);
      rs[0][4 + i] = *(const u32x4*)(bgc + (long)(32 * i) * ldb);
    }
#pragma unroll
    for (int i = 0; i < 4; ++i) {
      *(u32x4*)(As + (lrow + 32 * i) * 72 + lcol) = rs[0][i];
      *(u32x4*)(Bs + (lrow + 32 * i) * 72 + lcol) = rs[0][4 + i];
    }
    if (CH > 1) {
#pragma unroll
      for (int i = 0; i < 4; ++i) {
        GLD16(rs[1][i], agc + (long)(32 * i) * lda + kcs);
        GLD16(rs[1][4 + i], bgc + (long)(32 * i) * ldb + 64);
      }
    }
    __syncthreads();
#pragma unroll
    for (int t = 0; t < CH; ++t) {
      const int bufc = t & 1;
      if (t + 2 < CH) {
#pragma unroll
        for (int i = 0; i < 4; ++i) {
          GLD16(rs[t & 1][i], agc + (long)(32 * i) * lda + (long)(t + 2) * kcs);
          GLD16(rs[t & 1][4 + i], bgc + (long)(32 * i) * ldb + (long)(t + 2) * 64);
        }
      }
      GCOMPUTE(bufc);
      if (t + 1 < CH) {
        u32x4(&rr)[8] = rs[(t + 1) & 1];
        if (t + 2 < CH) asm volatile("s_waitcnt vmcnt(8)" : "+v"(rr[0]), "+v"(rr[1]), "+v"(rr[2]), "+v"(rr[3]), "+v"(rr[4]), "+v"(rr[5]), "+v"(rr[6]), "+v"(rr[7]) :: "memory");
        else asm volatile("s_waitcnt vmcnt(0)" : "+v"(rr[0]), "+v"(rr[1]), "+v"(rr[2]), "+v"(rr[3]), "+v"(rr[4]), "+v"(rr[5]), "+v"(rr[6]), "+v"(rr[7]) :: "memory");
        bf16* ad = As + (bufc ^ 1) * 128 * 72; bf16* bd = Bs + (bufc ^ 1) * 128 * 72;
#pragma unroll
        for (int i = 0; i < 4; ++i) {
          *(u32x4*)(ad + (lrow + 32 * i) * 72 + lcol) = rr[i];
          *(u32x4*)(bd + (lrow + 32 * i) * 72 + lcol) = rr[4 + i];
        }
      }
      __syncthreads();
    }
  }
#undef GCOMPUTE
  float* Cs = (float*)smem;
#pragma unroll
  for (int ni = 0; ni < 2; ++ni)
#pragma unroll
    for (int mi = 0; mi < 2; ++mi)
#pragma unroll
      for (int g = 0; g < 4; ++g) {
        float4 v; v.x = acc[ni][mi][4 * g]; v.y = acc[ni][mi][4 * g + 1]; v.z = acc[ni][mi][4 * g + 2]; v.w = acc[ni][mi][4 * g + 3];
        *(float4*)(Cs + (wm * 64 + mi * 32 + l31) * 132 + wn * 64 + ni * 32 + 8 * g + 4 * half) = v;
      }
  __syncthreads();
}

enum { EPI_PLAIN = 0, EPI_RS8 = 1, EPI_RS1 = 2, EPI_OUT = 3 };
DI void gemm_epi(int mode, char* smem, bf16* __restrict__ Cb, long ldc, int row0, const float* __restrict__ rs,
                 const float* __restrict__ xres, float* __restrict__ xout, bf16* __restrict__ xbout, float* __restrict__ ssqout, int ntile) {
  const float* Cs = (const float*)smem;
  const int tid = opq(threadIdx.x);
  float* rsl = (float*)(smem + 67584);
  if (mode == EPI_RS8 || mode == EPI_RS1) {
    if (tid < 128) {
      const long grow = row0 + tid;
      float sc;
      if (mode == EPI_RS8) {
        const float4* q = (const float4*)(rs + grow * 8);
        const float4 a = q[0], b = q[1];
        sc = rsqrtf((a.x + a.y + a.z + a.w + b.x + b.y + b.z + b.w) * (1.f / 1024.f) + EPS);
      } else sc = rs[grow];
      rsl[tid] = sc;
    }
    __syncthreads();
  }
#pragma unroll 2
  for (int it = 0; it < 8; ++it) {
    const int idx = it * 256 + tid;
    const int r = idx >> 4, ch = idx & 15;
    float4 v0 = *(const float4*)(Cs + r * 132 + ch * 8);
    float4 v1 = *(const float4*)(Cs + r * 132 + ch * 8 + 4);
    const long grow = row0 + r;
    if (mode == EPI_OUT) {
      if (xres) {
        const float4* xr = (const float4*)(xres + grow * 1024 + ntile * 128 + ch * 8);
        float4 x0 = xr[0], x1 = xr[1];
        v0.x += x0.x; v0.y += x0.y; v0.z += x0.z; v0.w += x0.w;
        v1.x += x1.x; v1.y += x1.y; v1.z += x1.z; v1.w += x1.w;
      } else {
        const uint4 xw = *(const uint4*)(Cb + grow * 1024 + ntile * 128 + ch * 8);
        v0.x += bflo(xw.x); v0.y += bfhi(xw.x); v0.z += bflo(xw.y); v0.w += bfhi(xw.y);
        v1.x += bflo(xw.z); v1.y += bfhi(xw.z); v1.z += bflo(xw.w); v1.w += bfhi(xw.w);
      }
      if (xout) {
        float4* xo = (float4*)(xout + grow * 1024 + ntile * 128 + ch * 8);
        xo[0] = v0; xo[1] = v1;
      }
      if (xbout) {
        float ss = v0.x * v0.x + v0.y * v0.y + v0.z * v0.z + v0.w * v0.w + v1.x * v1.x + v1.y * v1.y + v1.z * v1.z + v1.w * v1.w;
        ss = sum16(ss);
        if (ch == 0) ssqout[grow * 8 + ntile] = ss;
        uint4 o; o.x = pack2(v0.x, v0.y); o.y = pack2(v0.z, v0.w); o.z = pack2(v1.x, v1.y); o.w = pack2(v1.z, v1.w);
        *(uint4*)(xbout + grow * 1024 + ntile * 128 + ch * 8) = o;
      }
    } else {
      float sc = 1.f;
      if (mode == EPI_RS8 || mode == EPI_RS1) sc = rsl[r];
      uint4 o; o.x = pack2(v0.x * sc, v0.y * sc); o.y = pack2(v0.z * sc, v0.w * sc); o.z = pack2(v1.x * sc, v1.y * sc); o.w = pack2(v1.z * sc, v1.w * sc);
      *(uint4*)(Cb + grow * ldc + ntile * 128 + ch * 8) = o;
    }
  }
  __syncthreads();
}

DI void gemm_big(const bf16* __restrict__ Ab, long lda, const bf16* __restrict__ Bb, long ldb, int nk, char* smem, int mode,
                 bf16* __restrict__ Cb, long ldc, int row0, const float* __restrict__ rs, const float* __restrict__ xres,
                 float* __restrict__ xout, bf16* __restrict__ xbout, float* __restrict__ ssqout, int ntile) {
  const int tid = opq(threadIdx.x), lane = tid & 63, wv = tid >> 6, half = lane >> 5, l31 = lane & 31;
  const int wm = wv >> 1, wn = wv & 1;
  bf16* As = (bf16*)smem;
  bf16* Bs = (bf16*)(smem + 36864);
  const int lrow = tid >> 3, lcol = (tid & 7) * 8;
  const bf16* ag = Ab + (long)lrow * lda + lcol;
  const bf16* bg = Bb + (long)lrow * ldb + lcol;
  u32x4 ra[8], rb[4];
  f32x16 acc[2][4];
#pragma unroll
  for (int a = 0; a < 2; ++a)
#pragma unroll
    for (int b = 0; b < 4; ++b)
#pragma unroll
      for (int i = 0; i < 16; ++i) acc[a][b][i] = 0.f;
#pragma unroll
  for (int i = 0; i < 8; ++i) ra[i] = *(const u32x4*)(ag + (long)(32 * i) * lda);
#pragma unroll
  for (int i = 0; i < 4; ++i) rb[i] = *(const u32x4*)(bg + (long)(32 * i) * ldb);
#pragma unroll
  for (int i = 0; i < 8; ++i) *(u32x4*)(As + (lrow + 32 * i) * 72 + lcol) = ra[i];
#pragma unroll
  for (int i = 0; i < 4; ++i) *(u32x4*)(Bs + (lrow + 32 * i) * 72 + lcol) = rb[i];
  __syncthreads();
  for (int ks = 0; ks < nk; ++ks) {
    const bool more = ks + 1 < nk;
    if (more) {
#pragma unroll
      for (int i = 0; i < 8; ++i) GLD16(ra[i], ag + (long)(32 * i) * lda + (long)(ks + 1) * 64);
#pragma unroll
      for (int i = 0; i < 4; ++i) GLD16(rb[i], bg + (long)(32 * i) * ldb + (long)(ks + 1) * 64);
    }
    const bf16* as_ = As + (wm * 128 + l31) * 72 + half * 8;
    const bf16* bs_ = Bs + (wn * 64 + l31) * 72 + half * 8;
#pragma unroll
    for (int kc = 0; kc < 4; ++kc) {
      bf16x8 fa[4], fb[2];
#pragma unroll
      for (int mi = 0; mi < 4; ++mi) fa[mi] = *(const bf16x8*)(as_ + mi * 32 * 72 + kc * 16);
#pragma unroll
      for (int ni = 0; ni < 2; ++ni) fb[ni] = *(const bf16x8*)(bs_ + ni * 32 * 72 + kc * 16);
#pragma unroll
      for (int ni = 0; ni < 2; ++ni)
#pragma unroll
        for (int mi = 0; mi < 4; ++mi) acc[ni][mi] = MFMA(fb[ni], fa[mi], acc[ni][mi]);
    }
    __syncthreads();
    if (more) {
      asm volatile("s_waitcnt vmcnt(0)" : "+v"(ra[0]), "+v"(ra[1]), "+v"(ra[2]), "+v"(ra[3]), "+v"(ra[4]), "+v"(ra[5]), "+v"(ra[6]), "+v"(ra[7]),
                   "+v"(rb[0]), "+v"(rb[1]), "+v"(rb[2]), "+v"(rb[3]) :: "memory");
#pragma unroll
      for (int i = 0; i < 8; ++i) *(u32x4*)(As + (lrow + 32 * i) * 72 + lcol) = ra[i];
#pragma unroll
      for (int i = 0; i < 4; ++i) *(u32x4*)(Bs + (lrow + 32 * i) * 72 + lcol) = rb[i];
      __syncthreads();
    }
  }
  float* Cs = (float*)smem;
#pragma unroll
  for (int h = 0; h < 2; ++h) {
    if (wm == h) {
#pragma unroll
      for (int ni = 0; ni < 2; ++ni)
#pragma unroll
        for (int mi = 0; mi < 4; ++mi)
#pragma unroll
          for (int g = 0; g < 4; ++g) {
            float4 v; v.x = acc[ni][mi][4 * g]; v.y = acc[ni][mi][4 * g + 1]; v.z = acc[ni][mi][4 * g + 2]; v.w = acc[ni][mi][4 * g + 3];
            *(float4*)(Cs + (mi * 32 + l31) * 132 + wn * 64 + ni * 32 + 8 * g + 4 * half) = v;
          }
    }
    __syncthreads();
    gemm_epi(mode, smem, Cb, ldc, row0 + h * 128, rs, xres, xout, xbout, ssqout, ntile);
  }
}

enum { AM_NONE = 0, AM_CAUSAL = 1, AM_WIN = 2, AM_CMP = 3, AM_SLC = 4 };

template <int DK>
DI void attn_core(const bf16* __restrict__ Kp, long kstride, const bf16* __restrict__ Vp, long vstride, uint32_t tilemask,
                  int mode, int qpos, uint32_t sel, const bf16x8 (&Qf)[DK / 16], f32x16 (&O)[2], float& m_out, float& l_out, char* smem) {
  constexpr int KST = DK + 8;
  constexpr int CPR = DK / 8;
  constexpr int NCH = CPR / 4;
  bf16* Ks = (bf16*)smem;
  bf16* VTs = (bf16*)(smem + SM_VT);
  const int tid = opq(threadIdx.x), lane = tid & 63, half = lane >> 5, l31 = lane & 31;
#pragma unroll
  for (int i = 0; i < 16; ++i) { O[0][i] = 0.f; O[1][i] = 0.f; }
  float l = 0.f;
  const int qw0 = __builtin_amdgcn_readfirstlane(qpos - l31);
  const bool causal_like = (mode == AM_CAUSAL || mode == AM_WIN || mode == AM_SLC);
  int klo = 0, khi = 0x7fffffff;
  if (mode == AM_CAUSAL || mode == AM_SLC) khi = qpos;
  else if (mode == AM_WIN) { khi = qpos; klo = qpos - 511; }
  else if (mode == AM_CMP) khi = (qpos - 31) >> 4;
  u32x4 rk0, rk1, rk2, rv0, rv1;
  rk0 = rk1 = rk2 = (u32x4){0u, 0u, 0u, 0u};
  const int vkp = tid & 31, vcc = tid >> 5;
  const int vcol = (vkp >> 3) * 16 + (((vkp & 1) | ((vkp & 2) << 1) | ((vkp & 4) >> 1)) * 2);
  const int c0 = tid, c1 = tid + 256, c2_ = tid + 512;
  const int kr0 = c0 / CPR, kc0 = (c0 % CPR) * 8, kr1 = c1 / CPR, kc1 = (c1 % CPR) * 8, kr2 = c2_ / CPR, kc2 = (c2_ % CPR) * 8;
#define GLOAD(KT) do { \
    GLD16(rk0, Kp + (long)((KT) * 64 + kr0) * kstride + kc0); \
    if constexpr (NCH > 1) GLD16(rk1, Kp + (long)((KT) * 64 + kr1) * kstride + kc1); \
    if constexpr (NCH > 2) GLD16(rk2, Kp + (long)((KT) * 64 + kr2) * kstride + kc2); \
    GLD16(rv0, Vp + (long)((KT) * 64 + 2 * vkp) * vstride + vcc * 8); \
    GLD16(rv1, Vp + (long)((KT) * 64 + 2 * vkp + 1) * vstride + vcc * 8); } while (0)
#define LSTORE(BUF) do { asm volatile("s_waitcnt vmcnt(0)" : "+v"(rk0), "+v"(rk1), "+v"(rk2), "+v"(rv0), "+v"(rv1) :: "memory"); \
    *(u32x4*)(Ks + ((BUF) * 64 + kr0) * KST + kc0) = rk0; \
    if constexpr (NCH > 1) *(u32x4*)(Ks + ((BUF) * 64 + kr1) * KST + kc1) = rk1; \
    if constexpr (NCH > 2) *(u32x4*)(Ks + ((BUF) * 64 + kr2) * KST + kc2) = rk2; \
    bf16* vd = VTs + ((BUF) * 64 + vcc * 8) * 72 + vcol; \
    *(uint32_t*)(vd + 0 * 72) = (rv0.x & 0xffffu) | (rv1.x << 16); \
    *(uint32_t*)(vd + 1 * 72) = (rv0.x >> 16) | (rv1.x & 0xffff0000u); \
    *(uint32_t*)(vd + 2 * 72) = (rv0.y & 0xffffu) | (rv1.y << 16); \
    *(uint32_t*)(vd + 3 * 72) = (rv0.y >> 16) | (rv1.y & 0xffff0000u); \
    *(uint32_t*)(vd + 4 * 72) = (rv0.z & 0xffffu) | (rv1.z << 16); \
    *(uint32_t*)(vd + 5 * 72) = (rv0.z >> 16) | (rv1.z & 0xffff0000u); \
    *(uint32_t*)(vd + 6 * 72) = (rv0.w & 0xffffu) | (rv1.w << 16); \
    *(uint32_t*)(vd + 7 * 72) = (rv0.w >> 16) | (rv1.w & 0xffff0000u); } while (0)
  uint32_t rem = tilemask;
  int kt = __ffs(rem) - 1; rem &= rem - 1;
  GLOAD(kt);
#pragma unroll
  for (int kc = 0; kc < DK / 16; ++kc) asm volatile("" ::"v"(Qf[kc]));
  __syncthreads();
  LSTORE(0);
  __syncthreads();
  int buf = 0;
  while (true) {
    int ktn = -1;
    if (rem) { ktn = __ffs(rem) - 1; rem &= rem - 1; GLOAD(ktn); }
    const bool wave_active = !(causal_like && kt * 64 > qw0 + 31);
    if (wave_active) {
    f32x16 Sx[2];
#pragma unroll
    for (int kb = 0; kb < 2; ++kb) {
      bf16x8 Kf[DK / 16];
#pragma unroll
      for (int kc = 0; kc < DK / 16; ++kc) Kf[kc] = *(const bf16x8*)(Ks + (buf * 64 + kb * 32 + l31) * KST + kc * 16 + half * 8);
      __builtin_amdgcn_sched_barrier(0);
#pragma unroll
      for (int i = 0; i < 16; ++i) Sx[kb][i] = 0.f;
#pragma unroll
      for (int kc = 0; kc < DK / 16; ++kc) Sx[kb] = MFMA(Kf[kc], Qf[kc], Sx[kb]);
    }
    bf16x8 Vf[2][2][2];
#pragma unroll
    for (int kb = 0; kb < 2; ++kb)
#pragma unroll
      for (int c2 = 0; c2 < 2; ++c2)
#pragma unroll
        for (int dvb = 0; dvb < 2; ++dvb)
          Vf[kb][c2][dvb] = *(const bf16x8*)(VTs + (buf * 64 + dvb * 32 + l31) * 72 + (kb * 2 + c2) * 16 + half * 8);
    __builtin_amdgcn_sched_barrier(0);
    bool need_mask = false;
    if (mode == AM_CAUSAL) need_mask = kt * 64 + 63 > qw0;
    else if (mode == AM_WIN) need_mask = (kt * 64 + 63 > qw0) || (kt * 64 < qw0 + 31 - 511);
    else if (mode == AM_CMP) need_mask = true;
    else if (mode == AM_SLC) need_mask = (kt * 64 + 63 > qw0);
    const bool keep = !(mode == AM_SLC) || (((sel >> kt) & 1u) != 0u);
    int khe = khi;
    if (mode == AM_SLC && !((sel >> kt) & 1u)) khe = -1;
    const int kbase = kt * 64 + half * 4;
#pragma unroll
    for (int kb = 0; kb < 2; ++kb) {
      if (need_mask) {
#pragma unroll
        for (int i = 0; i < 16; ++i) {
          const int key = kbase + kb * 32 + (i >> 2) * 8 + (i & 3);
          Sx[kb][i] = (key >= klo && key <= khe) ? Sx[kb][i] : -1e30f;
        }
      }
      float ps = 0.f;
#pragma unroll
      for (int i = 0; i < 16; ++i) { float pv = fexp2(Sx[kb][i]); pv = keep ? pv : 0.f; Sx[kb][i] = pv; ps += pv; }
      l += ps;
#pragma unroll
      for (int c2 = 0; c2 < 2; ++c2) {
        uint4 pw;
        pw.x = pack2(Sx[kb][8 * c2 + 0], Sx[kb][8 * c2 + 1]); pw.y = pack2(Sx[kb][8 * c2 + 2], Sx[kb][8 * c2 + 3]);
        pw.z = pack2(Sx[kb][8 * c2 + 4], Sx[kb][8 * c2 + 5]); pw.w = pack2(Sx[kb][8 * c2 + 6], Sx[kb][8 * c2 + 7]);
        const bf16x8 pf = __builtin_bit_cast(bf16x8, pw);
#pragma unroll
        for (int dvb = 0; dvb < 2; ++dvb) O[dvb] = MFMA(Vf[kb][c2][dvb], pf, O[dvb]);
      }
      __builtin_amdgcn_sched_barrier(0);
    }
    }
    if (ktn < 0) break;
    LSTORE(buf ^ 1);
    __syncthreads();
    buf ^= 1; kt = ktn;
  }
  l_out = l + shx(l, 32);
  m_out = 0.f;
#undef GLOAD
#undef LSTORE
}

template <int DK>
DI void attn_core_dual(const bf16* __restrict__ Kp, long kstride, const bf16* __restrict__ Vp, long vstride, uint32_t tilemask,
                  int mode, int qpos, uint32_t sel, const bf16x8 (&Qf)[DK / 16], f32x16 (&O)[2], f32x16 (&O2)[2], float& l_out, float& l2_out, char* smem) {
  constexpr int KST = DK + 8;
  constexpr int CPR = DK / 8;
  constexpr int NCH = CPR / 4;
  bf16* Ks = (bf16*)smem;
  bf16* VTs = (bf16*)(smem + SM_VT);
  const int tid = opq(threadIdx.x), lane = tid & 63, half = lane >> 5, l31 = lane & 31;
#pragma unroll
  for (int i = 0; i < 16; ++i) { O[0][i] = 0.f; O[1][i] = 0.f; O2[0][i] = 0.f; O2[1][i] = 0.f; }
  float l = 0.f, l2 = 0.f;
  const int qw0 = __builtin_amdgcn_readfirstlane(qpos - l31);
  const bool causal_like = (mode == AM_CAUSAL || mode == AM_WIN || mode == AM_SLC);
  int klo = 0, khi = 0x7fffffff;
  if (mode == AM_CAUSAL || mode == AM_SLC) khi = qpos;
  else if (mode == AM_WIN) { khi = qpos; klo = qpos - 511; }
  else if (mode == AM_CMP) khi = (qpos - 31) >> 4;
  u32x4 rk0, rk1, rk2, rv0, rv1;
  rk0 = rk1 = rk2 = (u32x4){0u, 0u, 0u, 0u};
  const int vkp = tid & 31, vcc = tid >> 5;
  const int vcol = (vkp >> 3) * 16 + (((vkp & 1) | ((vkp & 2) << 1) | ((vkp & 4) >> 1)) * 2);
  const int c0 = tid, c1 = tid + 256, c2_ = tid + 512;
  const int kr0 = c0 / CPR, kc0 = (c0 % CPR) * 8, kr1 = c1 / CPR, kc1 = (c1 % CPR) * 8, kr2 = c2_ / CPR, kc2 = (c2_ % CPR) * 8;
#define GLOAD(KT) do { \
    GLD16(rk0, Kp + (long)((KT) * 64 + kr0) * kstride + kc0); \
    if constexpr (NCH > 1) GLD16(rk1, Kp + (long)((KT) * 64 + kr1) * kstride + kc1); \
    if constexpr (NCH > 2) GLD16(rk2, Kp + (long)((KT) * 64 + kr2) * kstride + kc2); \
    GLD16(rv0, Vp + (long)((KT) * 64 + 2 * vkp) * vstride + vcc * 8); \
    GLD16(rv1, Vp + (long)((KT) * 64 + 2 * vkp + 1) * vstride + vcc * 8); } while (0)
#define LSTORE(BUF) do { asm volatile("s_waitcnt vmcnt(0)" : "+v"(rk0), "+v"(rk1), "+v"(rv0), "+v"(rv1) :: "memory"); \
    *(u32x4*)(Ks + ((BUF) * 64 + kr0) * KST + kc0) = rk0; \
    if constexpr (NCH > 1) *(u32x4*)(Ks + ((BUF) * 64 + kr1) * KST + kc1) = rk1; \
    if constexpr (NCH > 2) *(u32x4*)(Ks + ((BUF) * 64 + kr2) * KST + kc2) = rk2; \
    bf16* vd = VTs + ((BUF) * 64 + vcc * 8) * 72 + vcol; \
    *(uint32_t*)(vd + 0 * 72) = (rv0.x & 0xffffu) | (rv1.x << 16); \
    *(uint32_t*)(vd + 1 * 72) = (rv0.x >> 16) | (rv1.x & 0xffff0000u); \
    *(uint32_t*)(vd + 2 * 72) = (rv0.y & 0xffffu) | (rv1.y << 16); \
    *(uint32_t*)(vd + 3 * 72) = (rv0.y >> 16) | (rv1.y & 0xffff0000u); \
    *(uint32_t*)(vd + 4 * 72) = (rv0.z & 0xffffu) | (rv1.z << 16); \
    *(uint32_t*)(vd + 5 * 72) = (rv0.z >> 16) | (rv1.z & 0xffff0000u); \
    *(uint32_t*)(vd + 6 * 72) = (rv0.w & 0xffffu) | (rv1.w << 16); \
    *(uint32_t*)(vd + 7 * 72) = (rv0.w >> 16) | (rv1.w & 0xffff0000u); } while (0)
  uint32_t rem = tilemask;
  int kt = __ffs(rem) - 1; rem &= rem - 1;
  GLOAD(kt);
#pragma unroll
  for (int kc = 0; kc < DK / 16; ++kc) asm volatile("" ::"v"(Qf[kc]));
  __syncthreads();
  LSTORE(0);
  __syncthreads();
  int buf = 0;
  while (true) {
    int ktn = -1;
    if (rem) { ktn = __ffs(rem) - 1; rem &= rem - 1; GLOAD(ktn); }
    const bool wave_active = !(causal_like && kt * 64 > qw0 + 31);
    if (wave_active) {
    const bool need_mask = kt * 64 + 63 > qw0;
    const int kbase = kt * 64 + half * 4;
#pragma unroll
    for (int mp = 0; mp < 2; ++mp) {
      f32x16 Sx[2];
#pragma unroll
      for (int kb = 0; kb < 2; ++kb) {
        bf16x8 k0 = *(const bf16x8*)(Ks + (buf * 64 + kb * 32 + l31) * KST + (2 * mp) * 16 + half * 8);
        bf16x8 k1 = *(const bf16x8*)(Ks + (buf * 64 + kb * 32 + l31) * KST + (2 * mp + 1) * 16 + half * 8);
#pragma unroll
        for (int i = 0; i < 16; ++i) Sx[kb][i] = 0.f;
        Sx[kb] = MFMA(k0, Qf[2 * mp], Sx[kb]);
        Sx[kb] = MFMA(k1, Qf[2 * mp + 1], Sx[kb]);
      }
#pragma unroll
      for (int kb = 0; kb < 2; ++kb) {
        if (need_mask) {
#pragma unroll
          for (int i = 0; i < 16; ++i) {
            const int key = kbase + kb * 32 + (i >> 2) * 8 + (i & 3);
            Sx[kb][i] = (key <= khi) ? Sx[kb][i] : -1e30f;
          }
        }
        bf16x8 Vf[2][2];
#pragma unroll
        for (int c2 = 0; c2 < 2; ++c2)
#pragma unroll
          for (int dvb = 0; dvb < 2; ++dvb)
            Vf[c2][dvb] = *(const bf16x8*)(VTs + (buf * 64 + dvb * 32 + l31) * 72 + (kb * 2 + c2) * 16 + half * 8);
        float ps = 0.f;
#pragma unroll
        for (int i = 0; i < 16; ++i) { float pv = fexp2(Sx[kb][i]); Sx[kb][i] = pv; ps += pv; }
        if (mp == 0) l += ps; else l2 += ps;
#pragma unroll
        for (int c2 = 0; c2 < 2; ++c2) {
          uint4 pw;
          pw.x = pack2(Sx[kb][8 * c2 + 0], Sx[kb][8 * c2 + 1]); pw.y = pack2(Sx[kb][8 * c2 + 2], Sx[kb][8 * c2 + 3]);
          pw.z = pack2(Sx[kb][8 * c2 + 4], Sx[kb][8 * c2 + 5]); pw.w = pack2(Sx[kb][8 * c2 + 6], Sx[kb][8 * c2 + 7]);
          const bf16x8 pf = __builtin_bit_cast(bf16x8, pw);
#pragma unroll
          for (int dvb = 0; dvb < 2; ++dvb) {
            if (mp == 0) O[dvb] = MFMA(Vf[c2][dvb], pf, O[dvb]); else O2[dvb] = MFMA(Vf[c2][dvb], pf, O2[dvb]);
          }
        }
        __builtin_amdgcn_sched_barrier(0);
      }
    }
    }
    if (ktn < 0) break;
    LSTORE(buf ^ 1);
    __syncthreads();
    buf ^= 1; kt = ktn;
  }
  l_out = l + shx(l, 32);
  l2_out = l2 + shx(l2, 32);
#undef GLOAD
#undef LSTORE
}

template <int DK>
DI void load_q(const bf16* __restrict__ Qrow, bf16x8 (&Qf)[DK / 16]) {
  const int half = (opq(threadIdx.x) & 63) >> 5;
#pragma unroll
  for (int kc = 0; kc < DK / 16; ++kc) Qf[kc] = *(const bf16x8*)(Qrow + kc * 16 + half * 8);
}

DI void vec64(bool active, const bf16* src, const float* bias, int nbias, bf16* dst, const float* gain, const float2* rp, float scale, int j, const bf16* src2 = nullptr) {
  float a0 = 0.f, a1 = 0.f, b0 = 0.f, b1 = 0.f;
  if (active) {
    uint32_t lo = *(const uint32_t*)(src + 2 * j), hi = *(const uint32_t*)(src + 32 + 2 * j);
    a0 = bflo(lo); a1 = bfhi(lo); b0 = bflo(hi); b1 = bfhi(hi);
    if (src2) {
#pragma unroll
      for (int q = 0; q < 3; ++q) {
        const bf16* sq_ = src2 + (size_t)q * 2 * 1024 * 128;
        lo = *(const uint32_t*)(sq_ + 2 * j); hi = *(const uint32_t*)(sq_ + 32 + 2 * j); a0 += bflo(lo); a1 += bfhi(lo); b0 += bflo(hi); b1 += bfhi(hi);
      }
    }
    for (int sidx = 0; sidx < nbias; ++sidx) {
      const float* bb = bias + sidx * 64;
      a0 += bb[2 * j]; a1 += bb[2 * j + 1]; b0 += bb[32 + 2 * j]; b1 += bb[33 + 2 * j];
    }
  }
  float ss = a0 * a0 + a1 * a1 + b0 * b0 + b1 * b1;
  ss = sum16(ss);
  const float r = rsqrtf(ss * (1.f / 64.f) + EPS);
  if (active) {
    a0 *= r * gain[2 * j]; a1 *= r * gain[2 * j + 1]; b0 *= r * gain[32 + 2 * j]; b1 *= r * gain[33 + 2 * j];
    if (rp) {
      const float2 c0 = rp[2 * j], c1 = rp[2 * j + 1];
      const float t0 = a0 * c0.x - b0 * c0.y, u0 = b0 * c0.x + a0 * c0.y;
      const float t1 = a1 * c1.x - b1 * c1.y, u1 = b1 * c1.x + a1 * c1.y;
      a0 = t0; b0 = u0; a1 = t1; b1 = u1;
    }
    *(uint32_t*)(dst + 2 * j) = pack2(a0 * scale, a1 * scale);
    *(uint32_t*)(dst + 32 + 2 * j) = pack2(b0 * scale, b1 * scale);
  }
}
template <int G>
DI void nr4(uint32_t lo, uint32_t hi, float invn, float g0, float g1, float g2, float g3, bool rope, float2 c0, float2 c1, float scale,
            uint32_t& olo, uint32_t& ohi) {
  float a0 = bflo(lo), a1 = bfhi(lo), b0 = bflo(hi), b1 = bfhi(hi);
  float ss = a0 * a0 + a1 * a1 + b0 * b0 + b1 * b1;
  ss = (G == 16) ? sum16(ss) : sum8(ss);
  const float r = rsqrtf(ss * invn + EPS);
  a0 *= r * g0; a1 *= r * g1; b0 *= r * g2; b1 *= r * g3;
  if (rope) {
    const float t0 = a0 * c0.x - b0 * c0.y, u0 = b0 * c0.x + a0 * c0.y;
    const float t1 = a1 * c1.x - b1 * c1.y, u1 = b1 * c1.x + a1 * c1.y;
    a0 = t0; b0 = u0; a1 = t1; b1 = u1;
  }
  olo = pack2(a0 * scale, a1 * scale); ohi = pack2(b0 * scale, b1 * scale);
}

struct PrepR {
  uint32_t q_lo, q_hi, p2_lo, p2_hi, p3_lo, p3_hi, dq_lo, dq_hi, dk_lo, dk_hi, glv, ckw, uqa, uqb, kra, krb;
  uint2 cw, nw, kw2, vw;
  float2 c0, c1, e0, e1;
};
struct PrepG {
  float gq0, gq1, gq2, gq3, h0, h1, h2, h3, m0, m1, m2, m3, dq0, dq1, dq2, dq3, dk0, dk1, dk2, dk3;
  float mgq0, mgq1, mgq2, mgq3, mgq4, mgq5, mgk0, mgk1, mgk2, mgk3, mgk4, mgk5;
};
DI void prep_load(char* ws, int t, int lane, PrepR& R) {
  const int j16 = lane & 15, g16 = lane >> 4, j8 = lane & 7, g8 = lane >> 3;
  const int s = t & 2047;
  const bf16* ur = (const bf16*)(ws + OFF_U) + (size_t)t * NP;
  const float2* rp = (const float2*)(ws + OFF_ROPE) + s * 32;
  const int col2 = g16 == 0 ? C_KS : (g16 == 1 ? C_KW : C_MQ + (g16 - 2) * 64);
  const int col3 = C_MQ + (2 + (g16 & 1)) * 64;
  const bf16* uq = (const bf16*)(ws + OFF_UQ + (size_t)(t >> 11) * SLAB) + (size_t)s * 384 + g16 * 96;
  const bf16* uk = (const bf16*)(ws + OFF_UKV + (size_t)(t >> 11) * SLAB) + (size_t)s * 512 + g16 * 128;
  R.q_lo = *(const uint32_t*)(ur + C_NQ + g16 * 64 + 2 * j16); R.q_hi = *(const uint32_t*)(ur + C_NQ + g16 * 64 + 32 + 2 * j16);
  R.p2_lo = *(const uint32_t*)(ur + col2 + 2 * j16); R.p2_hi = *(const uint32_t*)(ur + col2 + 32 + 2 * j16);
  R.p3_lo = *(const uint32_t*)(ur + col3 + 2 * j16); R.p3_hi = *(const uint32_t*)(ur + col3 + 32 + 2 * j16);
  R.dq_lo = *(const uint32_t*)(ur + C_DQ + g8 * 32 + 2 * j8); R.dq_hi = *(const uint32_t*)(ur + C_DQ + g8 * 32 + 16 + 2 * j8);
  R.dk_lo = *(const uint32_t*)(ur + C_DK + g8 * 32 + 2 * j8); R.dk_hi = *(const uint32_t*)(ur + C_DK + g8 * 32 + 16 + 2 * j8);
  R.glv = ur[C_GL + (lane < 12 ? lane : 0)];
  R.cw = *(const uint2*)(ur + C_CQ + lane * 4);
  R.ckw = *(const uint32_t*)(ur + C_CKV + lane * 2);
  R.nw = *(const uint2*)(uq + 4 * j16);
  R.uqa = uq[64 + j16]; R.uqb = uq[80 + j16];
  R.kw2 = *(const uint2*)(uk + 4 * j16);
  R.vw = *(const uint2*)(uk + 64 + 4 * j16);
  R.kra = ur[C_KR + j16]; R.krb = ur[C_KR + 16 + j16];
  R.c0 = rp[2 * j16]; R.c1 = rp[2 * j16 + 1];
  R.e0 = rp[4 * j8]; R.e1 = rp[4 * j8 + 2];
}
DI void prep_fin(char* ws, int t, int lane, const PrepR& R, const PrepG& G) {
  const int j16 = lane & 15, g16 = lane >> 4, j8 = lane & 7, g8 = lane >> 3;
  const float qs64 = 0.125f * LOG2E, qs32 = 0.17677669529663687f * LOG2E, qs96 = 0.10206207261596577f * LOG2E;
  const int b = t >> 11, s = t & 2047;
  bf16* ur = (bf16*)(ws + OFF_U) + (size_t)t * NP;
  const int col2 = g16 == 0 ? C_KS : (g16 == 1 ? C_KW : C_MQ + (g16 - 2) * 64);
  const int col3 = C_MQ + (2 + (g16 & 1)) * 64;
  const float2 c0 = R.c0, c1 = R.c1, e0 = R.e0, e1 = R.e1;
  uint32_t olo, ohi;
  nr4<16>(R.q_lo, R.q_hi, 1.f / 64.f, G.gq0, G.gq1, G.gq2, G.gq3, true, c0, c1, qs64, olo, ohi);
  *(uint32_t*)(ur + C_NQ + g16 * 64 + 2 * j16) = olo; *(uint32_t*)(ur + C_NQ + g16 * 64 + 32 + 2 * j16) = ohi;
  nr4<16>(R.p2_lo, R.p2_hi, 1.f / 64.f, G.h0, G.h1, G.h2, G.h3, g16 < 2, c0, c1, g16 < 2 ? 1.f : qs64, olo, ohi);
  *(uint32_t*)(ur + col2 + 2 * j16) = olo; *(uint32_t*)(ur + col2 + 32 + 2 * j16) = ohi;
  nr4<16>(R.p3_lo, R.p3_hi, 1.f / 64.f, G.m0, G.m1, G.m2, G.m3, false, c0, c1, qs64, olo, ohi);
  if (g16 < 2) { *(uint32_t*)(ur + col3 + 2 * j16) = olo; *(uint32_t*)(ur + col3 + 32 + 2 * j16) = ohi; }
  nr4<8>(R.dq_lo, R.dq_hi, 1.f / 32.f, G.dq0, G.dq1, G.dq2, G.dq3, true, e0, e1, qs32, olo, ohi);
  *(uint32_t*)(ur + C_DQ + g8 * 32 + 2 * j8) = olo; *(uint32_t*)(ur + C_DQ + g8 * 32 + 16 + 2 * j8) = ohi;
  nr4<8>(R.dk_lo, R.dk_hi, 1.f / 32.f, G.dk0, G.dk1, G.dk2, G.dk3, true, e0, e1, 1.f, olo, ohi);
  *(uint32_t*)(ur + C_DK + g8 * 32 + 2 * j8) = olo; *(uint32_t*)(ur + C_DK + g8 * 32 + 16 + 2 * j8) = ohi;
  if (lane < 12) ((float*)(ws + OFF_GT))[(size_t)t * 12 + lane] = sigmoidf_(bf2f(R.glv));
  float sq, skv;
  {
    float c0f = bflo(R.cw.x), c1f = bfhi(R.cw.x), c2f = bflo(R.cw.y), c3f = bfhi(R.cw.y);
    float ss = c0f * c0f + c1f * c1f + c2f * c2f + c3f * c3f;
    float d0 = bflo(R.ckw), d1 = bfhi(R.ckw);
    float s2 = d0 * d0 + d1 * d1;
    ss = sum64(ss); s2 = sum64(s2);
    sq = rsqrtf(ss * (1.f / 256.f) + EPS);
    skv = rsqrtf(s2 * (1.f / 128.f) + EPS);
  }
  {
    const int h = g16, j = j16;
    float n0 = bflo(R.nw.x) * sq, n1 = bfhi(R.nw.x) * sq, n2 = bflo(R.nw.y) * sq, n3 = bfhi(R.nw.y) * sq;
    float ra = bf2f(R.uqa) * sq, rb = bf2f(R.uqb) * sq;
    float r1 = ra * c0.x - rb * c0.y, r2 = rb * c0.x + ra * c0.y;
    float ss = n0 * n0 + n1 * n1 + n2 * n2 + n3 * n3 + r1 * r1 + r2 * r2;
    ss = sum16(ss);
    float r = rsqrtf(ss * (1.f / 96.f) + EPS) * qs96;
    bf16* qd = (bf16*)(ws + OFF_QM) + ((size_t)(b * 4 + h) * S + s) * 96;
    uint2 o; o.x = pack2(n0 * r * G.mgq0, n1 * r * G.mgq1); o.y = pack2(n2 * r * G.mgq2, n3 * r * G.mgq3);
    *(uint2*)(qd + 4 * j) = o;
    qd[64 + j] = f2bf(r1 * r * G.mgq4);
    qd[80 + j] = f2bf(r2 * r * G.mgq5);
    float k0 = bflo(R.kw2.x) * skv, k1 = bfhi(R.kw2.x) * skv, k2 = bflo(R.kw2.y) * skv, k3 = bfhi(R.kw2.y) * skv;
    float ka = bf2f(R.kra), kb = bf2f(R.krb);
    float kr1 = ka * c0.x - kb * c0.y, kr2 = kb * c0.x + ka * c0.y;
    float s3 = k0 * k0 + k1 * k1 + k2 * k2 + k3 * k3 + kr1 * kr1 + kr2 * kr2;
    s3 = sum16(s3);
    float rk_ = rsqrtf(s3 * (1.f / 96.f) + EPS);
    bf16* kd = (bf16*)(ws + OFF_KM) + ((size_t)(b * 4 + h) * S + s) * 96;
    uint2 o2; o2.x = pack2(k0 * rk_ * G.mgk0, k1 * rk_ * G.mgk1); o2.y = pack2(k2 * rk_ * G.mgk2, k3 * rk_ * G.mgk3);
    *(uint2*)(kd + 4 * j) = o2;
    kd[64 + j] = f2bf(kr1 * rk_ * G.mgk4);
    kd[80 + j] = f2bf(kr2 * rk_ * G.mgk5);
    uint2 o3; o3.x = pack2(bflo(R.vw.x) * skv, bfhi(R.vw.x) * skv); o3.y = pack2(bflo(R.vw.y) * skv, bfhi(R.vw.y) * skv);
    *(uint2*)((bf16*)(ws + OFF_MV) + ((size_t)(b * 4 + h) * S + s) * 64 + 4 * j) = o3;
  }
}

DI void prep_phase(const Params& p, int layer) {
  const int tid = opq(threadIdx.x), lane = tid & 63, wv = tid >> 6;
  char* ws = opqp(p.ws);
  const float2* rope = (const float2*)(ws + OFF_ROPE);
  const float* nsa_g = p.in[5] + layer * 256;
  const float* diff_g = p.in[8] + layer * 64;
  const float* mla_g = p.in[15] + layer * 192;
  const float* mem_g = p.in[18] + layer * 128;
  constexpr int N_TOK = T / 4, N_MEMT = TM / 4, N_CMP = 1024 / 4;
  const int j16 = lane & 15, g16 = lane >> 4, j8 = lane & 7;
  PrepG G;
  G.gq0 = nsa_g[2 * j16]; G.gq1 = nsa_g[2 * j16 + 1]; G.gq2 = nsa_g[32 + 2 * j16]; G.gq3 = nsa_g[33 + 2 * j16];
  const float* g2p = g16 == 0 ? nsa_g + 128 : (g16 == 1 ? nsa_g + 192 : mem_g);
  G.h0 = g2p[2 * j16]; G.h1 = g2p[2 * j16 + 1]; G.h2 = g2p[32 + 2 * j16]; G.h3 = g2p[33 + 2 * j16];
  G.m0 = mem_g[2 * j16]; G.m1 = mem_g[2 * j16 + 1]; G.m2 = mem_g[32 + 2 * j16]; G.m3 = mem_g[33 + 2 * j16];
  G.dq0 = diff_g[2 * j8]; G.dq1 = diff_g[2 * j8 + 1]; G.dq2 = diff_g[16 + 2 * j8]; G.dq3 = diff_g[17 + 2 * j8];
  G.dk0 = diff_g[32 + 2 * j8]; G.dk1 = diff_g[33 + 2 * j8]; G.dk2 = diff_g[48 + 2 * j8]; G.dk3 = diff_g[49 + 2 * j8];
  G.mgq0 = mla_g[4 * j16]; G.mgq1 = mla_g[4 * j16 + 1]; G.mgq2 = mla_g[4 * j16 + 2]; G.mgq3 = mla_g[4 * j16 + 3];
  G.mgq4 = mla_g[64 + j16]; G.mgq5 = mla_g[80 + j16];
  G.mgk0 = mla_g[96 + 4 * j16]; G.mgk1 = mla_g[96 + 4 * j16 + 1]; G.mgk2 = mla_g[96 + 4 * j16 + 2]; G.mgk3 = mla_g[96 + 4 * j16 + 3];
  G.mgk4 = mla_g[96 + 64 + j16]; G.mgk5 = mla_g[96 + 80 + j16];
  const int xcd = blockIdx.x & 7, rk = blockIdx.x >> 3, nrk = gridDim.x >> 3;
  for (int i = rk; i < 512; i += 2 * nrk) {
    const int it = xcd * 512 + i;
    const bool has2 = i + nrk < 512;
    const int it2 = has2 ? it + nrk : it;
    const int tA = it * 4 + wv, tB = it2 * 4 + wv;
    PrepR A, B;
    prep_load(ws, tA, lane, A);
    prep_load(ws, tB, lane, B);
    prep_fin(ws, tA, lane, A, G);
    if (has2) prep_fin(ws, tB, lane, B, G);
  }
  for (int i = rk; i < 96; i += nrk) {
    const int it = i < 64 ? N_TOK + xcd * 64 + i : N_TOK + N_MEMT + xcd * 32 + (i - 64);
    if (false) {
    } else if (it < N_TOK + N_MEMT) {
      const int t = (it - N_TOK) * 4 + wv;
      const int b = t >> 8, mi = t & 255;
      const bf16* kr = (const bf16*)(ws + OFF_KMEMRAW) + (size_t)t * 512;
      const int h = lane >> 4;
      uint2 vw = *(const uint2*)(kr + 256 + lane * 4);
      vec64(true, kr + h * 64, nullptr, 0, (bf16*)(ws + OFF_MK) + ((size_t)(b * 4 + h) * ML + mi) * 64, mem_g + 64, nullptr, 1.f, j16);
      *(uint2*)((bf16*)(ws + OFF_MVV) + ((size_t)(b * 4 + h) * ML + mi) * 64 + j16 * 4) = vw;
    } else {
      const int r = (it - N_TOK - N_MEMT) * 4 + wv;
      const int n = r & 127;
      const bf16* kraw = (const bf16*)(ws + OFF_CMPRAW) + (size_t)r * 128;
      const bf16* vraw = (const bf16*)(ws + OFF_CMPRAW) + (size_t)(1024 + r) * 128;
      const float* cbk = (const float*)(ws + OFF_CB) + (size_t)(layer * 2 + 0) * 16 * 64;
      const float* cbv = (const float*)(ws + OFF_CB) + (size_t)(layer * 2 + 1) * 16 * 64;
      bf16* kd = (bf16*)(ws + OFF_KCN) + (size_t)r * 64;
      bf16* vd = (bf16*)(ws + OFF_VCN) + (size_t)r * 64;
      if (n < 127) {
        const int pos = 16 * n + 31;
        float bv = 0.f;
#pragma unroll
        for (int sidx = 0; sidx < 16; ++sidx) bv += cbv[sidx * 64 + lane];
        const float vv = bf2f(vraw[lane]) + bf2f(vraw[(size_t)2 * 1024 * 128 + lane]) + bf2f(vraw[(size_t)4 * 1024 * 128 + lane]) + bf2f(vraw[(size_t)6 * 1024 * 128 + lane]) + bv;
        vec64(lane < 16, kraw, cbk, 16, kd, nsa_g + 64, rope + pos * 32, 1.f, lane & 15, kraw + (size_t)2 * 1024 * 128);
        vd[lane] = f2bf(vv);
      } else {
        kd[lane] = 0; vd[lane] = 0;
      }
    }
  }
}

DI void pl_swap(uint32_t& a, uint32_t& b) { auto r_ = __builtin_amdgcn_permlane32_swap(a, b, false, false); a = r_[0]; b = r_[1]; }
DI void ld_own(const bf16* p, uint2& lo, uint2& hi) {
  const uint4 w = *(const uint4*)p;
  lo.x = w.x; lo.y = w.y; hi.x = w.z; hi.y = w.w;
  pl_swap(lo.x, hi.x); pl_swap(lo.y, hi.y);
}
template <int MODE>
DI void attn_epi(const f32x16 (&O)[2], float scale, const bf16* zrow, const float* sg, const bf16* a1row, const bf16* a2row, bf16* orow, int half) {
#pragma unroll
  for (int dvb = 0; dvb < 2; ++dvb)
#pragma unroll
    for (int pq = 0; pq < 2; ++pq) {
      const int col16 = dvb * 32 + 16 * pq + 8 * half;
      const int dvA = dvb * 32 + 16 * pq + 4 * half;
      float va[4], vb[4];
#pragma unroll
      for (int e = 0; e < 4; ++e) { va[e] = O[dvb][8 * pq + e] * scale; vb[e] = O[dvb][8 * pq + 4 + e] * scale; }
      if (MODE == 2) {
#pragma unroll
        for (int e = 0; e < 4; ++e) { va[e] *= sg[dvA + e]; vb[e] *= sg[dvA + 8 + e]; }
      }
      if (MODE == 3) {
        uint2 clo, chi, wlo, whi;
        ld_own(a1row + col16, clo, chi);
        ld_own(a2row + col16, wlo, whi);
        va[0] += bflo(clo.x) + bflo(wlo.x); va[1] += bfhi(clo.x) + bfhi(wlo.x); va[2] += bflo(clo.y) + bflo(wlo.y); va[3] += bfhi(clo.y) + bfhi(wlo.y);
        vb[0] += bflo(chi.x) + bflo(whi.x); vb[1] += bfhi(chi.x) + bfhi(whi.x); vb[2] += bflo(chi.y) + bflo(whi.y); vb[3] += bfhi(chi.y) + bfhi(whi.y);
      }
      if (MODE >= 1) {
        uint2 zlo, zhi;
        ld_own(zrow + col16, zlo, zhi);
        va[0] *= siluf_(bflo(zlo.x)); va[1] *= siluf_(bfhi(zlo.x)); va[2] *= siluf_(bflo(zlo.y)); va[3] *= siluf_(bfhi(zlo.y));
        vb[0] *= siluf_(bflo(zhi.x)); vb[1] *= siluf_(bfhi(zhi.x)); vb[2] *= siluf_(bflo(zhi.y)); vb[3] *= siluf_(bfhi(zhi.y));
      }
      uint32_t A0 = pack2(va[0], va[1]), A1 = pack2(va[2], va[3]), B0 = pack2(vb[0], vb[1]), B1 = pack2(vb[2], vb[3]);
      pl_swap(A0, B0); pl_swap(A1, B1);
      uint4 o; o.x = A0; o.y = A1; o.z = B0; o.w = B1;
      *(uint4*)(orow + col16) = o;
    }
}
DI void st4(bf16* dst, float a, float b, float c, float d) { uint2 o; o.x = pack2(a, b); o.y = pack2(c, d); *(uint2*)dst = o; }

DI void attn_phaseA(const Params& p, int layer, char* smem, int* ctr) {
  char* ws = opqp(p.ws);
  bf16* u = (bf16*)(ws + OFF_U);
  bf16* y = (bf16*)(ws + OFF_Y);
  const float* gt = (const float*)(ws + OFF_GT);
  int* s_item = (int*)(smem + SM_MISC);
  const int xcd = blockIdx.x & 7;
  while (true) {
    __syncthreads();
    if (threadIdx.x == 0) *s_item = atomicAdd(ctr + 24 + xcd, 1);
    __syncthreads();
    const int item = *s_item;
    if (item >= 16) break;
    {
      const int tid = opq(threadIdx.x), lane = tid & 63, wv = tid >> 6, half = lane >> 5, l31 = lane & 31;
      const int i2 = item;
      const int qb = 15 - i2, b = xcd;
      const int q0 = qb * 128, qpos = q0 + wv * 32 + l31;
      const size_t t = (size_t)b * S + qpos;
      const bf16* ub = u + (size_t)b * S * NP;
      const bf16* kc = (const bf16*)(ws + OFF_KCN) + (size_t)b * 128 * 64;
      const bf16* vc = (const bf16*)(ws + OFF_VCN) + (size_t)b * 128 * 64;
      const uint32_t tm = (q0 + 127 >= 16 * 64 + 31) ? 3u : 1u;
      float* scl = (float*)(smem + SM_SC) + wv * 32 * 33;
#pragma unroll
      for (int g = 0; g < 16; ++g) scl[l31 * 33 + 2 * g + half] = 0.f;
      const int khi = (qpos - 31) >> 4;
#pragma unroll 1
      for (int h = 0; h < 4; ++h) {
        f32x16 O[2]; float mm, ll;
        bf16x8 Qf[4];
        load_q<64>(ub + (size_t)qpos * NP + C_NQ + h * 64, Qf);
        attn_core<64>(kc, 64, vc, 64, tm, AM_CMP, qpos, 0u, Qf, O, mm, ll, smem);
        const float inv = ll > 0.f ? 1.f / ll : 0.f;
        const float sc = inv * gt[t * 12 + h];
        bf16* od = (bf16*)(ws + OFF_OCMP) + t * 256 + h * 64;
        attn_epi<0>(O, sc, nullptr, nullptr, nullptr, nullptr, od, half);
        const float mu = mm < -1e29f ? 0.f : mm;
        const bf16* Ks = (const bf16*)smem;
        float Aa[16], Cc[16];
#pragma unroll
        for (int g = 0; g < 16; ++g) { Aa[g] = 0.f; Cc[g] = 0.f; }
#pragma unroll
        for (int kt = 0; kt < 2; ++kt) {
          if (tm & (1u << kt)) {
#pragma unroll
            for (int kb = 0; kb < 2; ++kb) {
              f32x16 Sx;
#pragma unroll
              for (int i = 0; i < 16; ++i) Sx[i] = 0.f;
#pragma unroll
              for (int kcx = 0; kcx < 4; ++kcx) {
                bf16x8 a = *(const bf16x8*)(Ks + (kt * 64 + kb * 32 + l31) * 72 + kcx * 16 + half * 8);
                Sx = MFMA(a, Qf[kcx], Sx);
              }
#pragma unroll
              for (int gg = 0; gg < 4; ++gg) {
                float pv[4];
#pragma unroll
                for (int e = 0; e < 4; ++e) {
                  const int key = kt * 64 + kb * 32 + gg * 8 + half * 4 + e;
                  pv[e] = key <= khi ? fexp2(Sx[gg * 4 + e] - mu) * inv : 0.f;
                }
                Aa[kt * 8 + kb * 4 + gg] += pv[0] + 2.f * (pv[1] + pv[2] + pv[3]);
                Cc[kt * 8 + kb * 4 + gg] += pv[0];
              }
            }
          }
        }
        {
          float rc[16];
#pragma unroll
          for (int g = 0; g < 16; ++g) rc[g] = shx(Cc[g], 32);
#pragma unroll
          for (int g = 0; g < 16; ++g) {
            const float nx = half == 0 ? rc[g] : (g < 15 ? rc[g < 15 ? g + 1 : 15] : 0.f);
            scl[l31 * 33 + 2 * g + half] += Aa[g] + nx;
          }
        }
      }
      __syncthreads();
      {
        float sv[32];
        const int cur = qpos >> 6;
#pragma unroll
        for (int j = 0; j < 32; ++j) {
          float v = scl[l31 * 33 + j];
          const bool forced = (j == 0) || (j == cur) || (j == cur - 1);
          sv[j] = j > cur ? -1e30f : (forced ? 1e30f : v);
        }
        uint32_t bits = 0;
#pragma unroll 1
        for (int jj = 0; jj < 16; ++jj) {
          const int j = half * 16 + jj;
          float sj = scl[l31 * 33 + j];
          const bool fj = (j == 0) || (j == cur) || (j == cur - 1);
          sj = j > cur ? -1e30f : (fj ? 1e30f : sj);
          int rank = 0;
#pragma unroll
          for (int i = 0; i < 32; ++i) rank += (sv[i] > sj || (sv[i] == sj && i < j)) ? 1 : 0;
          if (rank < 16) bits |= 1u << j;
        }
        bits |= (uint32_t)__shfl_xor((int)bits, 32);
        if (half == 0) ((uint32_t*)(ws + OFF_SEL))[t] = bits;
      }
      wg_publish((unsigned*)(ws + OFF_FLAG) + layer * 1024 + (b * 16 + qb) * 8);
    }
  }
  while (true) {
    __syncthreads();
    if (threadIdx.x == 0) *s_item = atomicAdd(ctr + 16 + xcd, 1);
    __syncthreads();
    const int item = *s_item;
    if (item >= 128) break;
    {
      const int tid = opq(threadIdx.x), lane = tid & 63, wv = tid >> 6, half = lane >> 5, l31 = lane & 31;
      const int i2 = item;
      const int ismem = i2 >> 6, r = i2 & 63, qb = 15 - (r >> 2), b = xcd, h = r & 3;
      const int q0 = qb * 128, qpos = q0 + wv * 32 + l31;
      const size_t t = (size_t)b * S + qpos;
      const bf16* ub = u + (size_t)b * S * NP;
      f32x16 O[2]; float mm, ll;
      bf16x8 Qf[4];
      if (!ismem) {
        load_q<64>(ub + (size_t)qpos * NP + C_NQ + h * 64, Qf);
        const int kt0 = q0 >= 512 ? (q0 - 512) / 64 : 0, kt1 = 2 * qb + 2;
        const uint32_t hi = kt1 >= 32 ? 0xffffffffu : ((1u << kt1) - 1u);
        const uint32_t tm = hi & ~((1u << kt0) - 1u);
        attn_core<64>(ub + C_KW, NP, ub + C_VW, NP, tm, AM_WIN, qpos, 0u, Qf, O, mm, ll, smem);
        const float sc = (ll > 0.f ? 1.f / ll : 0.f) * gt[t * 12 + 8 + h];
        bf16* od = (bf16*)(ws + OFF_OWIN) + t * 256 + h * 64;
        attn_epi<0>(O, sc, nullptr, nullptr, nullptr, nullptr, od, half);
        wg_publish((unsigned*)(ws + OFF_FLAG) + layer * 1024 + (b * 16 + qb) * 8 + 1 + h);
      } else {
        load_q<64>(ub + (size_t)qpos * NP + C_MQ + h * 64, Qf);
        attn_core<64>((const bf16*)(ws + OFF_MK) + (size_t)(b * 4 + h) * ML * 64, 64, (const bf16*)(ws + OFF_MVV) + (size_t)(b * 4 + h) * ML * 64, 64,
                      0xfu, AM_NONE, qpos, 0u, Qf, O, mm, ll, smem);
        const float inv = ll > 0.f ? 1.f / ll : 0.f;
        attn_epi<1>(O, inv, u + t * NP + C_MEZ + h * 64, nullptr, nullptr, nullptr, y + t * 1024 + 768 + h * 64, half);
      }
    }
  }
  while (true) {
    __syncthreads();
    if (threadIdx.x == 0) *s_item = atomicAdd(ctr + xcd, 1);
    __syncthreads();
    const int item = *s_item;
    if (item >= 64) break;
    {
      const int tid = opq(threadIdx.x), lane = tid & 63, wv = tid >> 6, half = lane >> 5, l31 = lane & 31;
      const int qb = 15 - (item >> 2), b = xcd, h = item & 3;
      const int q0 = qb * 128, qpos = q0 + wv * 32 + l31;
      const size_t t = (size_t)b * S + qpos;
      const uint32_t tm = (qb == 15) ? 0xffffffffu : ((1u << (2 * qb + 2)) - 1u);
      f32x16 O[2]; float mm, ll;
        bf16x8 Qf[6];
        const bf16* qm = (const bf16*)(ws + OFF_QM) + (size_t)(b * 4 + h) * S * 96;
        load_q<96>(qm + (size_t)qpos * 96, Qf);
        attn_core<96>((const bf16*)(ws + OFF_KM) + (size_t)(b * 4 + h) * S * 96, 96,
                      (const bf16*)(ws + OFF_MV) + (size_t)(b * 4 + h) * S * 64, 64, tm, AM_CAUSAL, qpos, 0u, Qf, O, mm, ll, smem);
        const float inv = ll > 0.f ? 1.f / ll : 0.f;
        attn_epi<1>(O, inv, u + t * NP + C_MZ + h * 64, nullptr, nullptr, nullptr, y + t * 1024 + 512 + h * 64, half);
    }
  }
  while (true) {
    __syncthreads();
    if (threadIdx.x == 0) *s_item = atomicAdd(ctr + 8 + xcd, 1);
    __syncthreads();
    const int item = *s_item;
    if (item >= 64) break;
    {
      const int tid = opq(threadIdx.x), lane = tid & 63, wv = tid >> 6, half = lane >> 5, l31 = lane & 31;
      const int qb = 15 - (item >> 2), b = xcd, h = item & 3;
      const int q0 = qb * 128, qpos = q0 + wv * 32 + l31;
      const size_t t = (size_t)b * S + qpos;
      const uint32_t tm = (qb == 15) ? 0xffffffffu : ((1u << (2 * qb + 2)) - 1u);
      f32x16 O[2]; float mm, ll;
        f32x16 O1[2];
        const bf16* ub = u + (size_t)b * S * NP;
        {
          bf16x8 Qf[4];
          float l1, l2;
          load_q<64>(ub + (size_t)qpos * NP + C_DQ + h * 64, Qf);
          attn_core_dual<64>(ub + C_DK + h * 64, NP, ub + C_DV + h * 64, NP, tm, AM_CAUSAL, qpos, 0u, Qf, O1, O, l1, l2, smem);
          const float inv1 = l1 > 0.f ? 1.f / l1 : 0.f, inv = l2 > 0.f ? 1.f / l2 : 0.f;
#pragma unroll
          for (int i = 0; i < 16; ++i) { O1[0][i] *= inv1; O1[1][i] *= inv1; }
          {
            const float lam = ((const float*)(ws + OFF_LAM))[layer];
            float ss = 0.f;
#pragma unroll
            for (int i = 0; i < 16; ++i) {
              O1[0][i] -= lam * O[0][i] * inv; O1[1][i] -= lam * O[1][i] * inv;
              ss += O1[0][i] * O1[0][i] + O1[1][i] * O1[1][i];
            }
            ss += shx(ss, 32);
            const float li = opq(layer) == 0 ? 0.2f : 0.35550907f;
            const float r = rsqrtf(ss * (1.f / 64.f) + EPS) * (1.f - li);
            const float* sg = p.in[10] + layer * 64;
            attn_epi<2>(O1, r, u + t * NP + C_DZ + h * 64, sg, nullptr, nullptr, y + t * 1024 + 256 + h * 64, half);
          }
        }
    }
  }
}

DI void attn_phaseB(const Params& p, int layer, char* smem, int* ctr) {
  const int tid = opq(threadIdx.x), lane = tid & 63, wv = tid >> 6, half = lane >> 5, l31 = lane & 31;
  char* ws = opqp(p.ws);
  bf16* u = (bf16*)(ws + OFF_U);
  bf16* y = (bf16*)(ws + OFF_Y);
  const float* gt = (const float*)(ws + OFF_GT);
  int* s_item = (int*)(smem + SM_MISC);
  uint32_t* s_or = (uint32_t*)(smem + SM_MISC + 16);
  const int xcd = blockIdx.x & 7;
  while (true) {
    __syncthreads();
    if (tid == 0) { *s_item = atomicAdd(ctr + xcd, 1); *s_or = 0u; }
    __syncthreads();
    const int item = *s_item;
    if (item >= 64) break;
    const int qb = 15 - (item >> 2), b = xcd, h = item & 3;
    const int q0 = qb * 128, qpos = q0 + wv * 32 + l31;
    const size_t t = (size_t)b * S + qpos;
    const bf16* ub = u + (size_t)b * S * NP;
    wg_wait2((unsigned*)(ws + OFF_FLAG) + layer * 1024 + (b * 16 + qb) * 8, (unsigned*)(ws + OFF_FLAG) + layer * 1024 + (b * 16 + qb) * 8 + 1 + h);
    const uint32_t sel = ((const uint32_t*)(ws + OFF_SEL))[t];
    const uint32_t causal = (qb == 15) ? 0xffffffffu : ((1u << (2 * qb + 2)) - 1u);
    if (half == 0) atomicOr(s_or, sel);
    __syncthreads();
    const uint32_t tm = (*s_or & causal) | 1u;
    f32x16 O[2]; float mm, ll;
    bf16x8 Qf[4];
    load_q<64>(ub + (size_t)qpos * NP + C_NQ + h * 64, Qf);
    attn_core<64>(ub + C_KS, NP, ub + C_VS, NP, tm, AM_SLC, qpos, sel, Qf, O, mm, ll, smem);
    const float sc = (ll > 0.f ? 1.f / ll : 0.f) * gt[t * 12 + 4 + h];
    const bf16* oc = (const bf16*)(ws + OFF_OCMP) + t * 256 + h * 64;
    const bf16* ow = (const bf16*)(ws + OFF_OWIN) + t * 256 + h * 64;
    attn_epi<3>(O, sc, u + t * NP + C_NZ + h * 64, nullptr, oc, ow, y + t * 1024 + h * 64, half);
  }
  (void)layer;
}

__global__ void __launch_bounds__(256, 2) fwd_megakernel(Params p) {
  __shared__ __attribute__((aligned(16))) char smem[SMEM_BYTES];
  cg::grid_group grid = cg::this_grid();
  char* ws = opqp(p.ws);
  int* ctrs = (int*)(ws + OFF_CTR);
  __shared__ uint4 xb_words;
  if (threadIdx.x == 0) xb_words = make_uint4(0u, 0u, 0u, 0u);
  __syncthreads();
  XcdBarrier xb = xcd_barrier_post((unsigned*)(ws + OFF_BAR), (volatile LAS unsigned*)&xb_words);
  phase0(p, smem);
  if (p.out == nullptr) grid.sync();
  xcd_barrier(xb);
#define PBAR(K) xcd_barrier(xb)
  for (int layer = 0; layer < 2; ++layer) {
    bf16* u = (bf16*)(ws + OFF_U);
    {
      const bf16* xbp = (const bf16*)(ws + OFF_XB);
      const bf16* wi = (const bf16*)(ws + OFF_WI + layer * SZ_WI);
      const int xcd = blockIdx.x & 7, rk = blockIdx.x >> 3, nrk = gridDim.x >> 3;
      for (int q = rk; q < 216; q += nrk) {
        if (q < 192) {
          const int mt = xcd * 8 + (q & 7), nt = q >> 3;
          gemm_big(xbp + (size_t)mt * 256 * 1024, 1024, wi + (size_t)nt * 128 * 1024, 1024, 16, smem, EPI_RS8, u, NP, mt * 256,
                   (const float*)(ws + OFF_SSQ), nullptr, nullptr, nullptr, nullptr, nt);
        } else if (q < 208) {
          const int mt = xcd * 16 + (q - 192), nt = 24;
          gemm_tile<16>(xbp + (size_t)mt * 128 * 1024, 1024, 64, wi + (size_t)nt * 128 * 1024, 1024, 16, smem);
          gemm_epi(EPI_RS8, smem, u, NP, mt * 128, (const float*)(ws + OFF_SSQ), nullptr, nullptr, nullptr, nullptr, nt);
        } else {
          const int i = xcd * 8 + (q - 208), mt = i >> 2, nt = i & 3;
          gemm_tile<16>((const bf16*)(ws + OFF_MEMB) + (size_t)mt * 128 * 1024, 1024, 64,
                    (const bf16*)(ws + OFF_WMEM + layer * SZ_WMEM) + (size_t)nt * 128 * 1024, 1024, 16, smem);
          gemm_epi(EPI_RS1, smem, (bf16*)(ws + OFF_KMEMRAW), 512, mt * 128, (const float*)(ws + OFF_RMEM), nullptr, nullptr, nullptr, nullptr, nt);
        }
      }
    }
    PBAR(0);
    {
      const int xcd = blockIdx.x & 7, rk = blockIdx.x >> 3, nrk = gridDim.x >> 3;
      for (int q = rk; q < 64; q += nrk) {
        if (q < 8) {
          const int j = q >> 2, kh = q & 3, b = xcd;
          gemm_tile<8>(u + (size_t)b * S * NP + (j ? C_VC : C_KC) + (size_t)kh * 8 * NP, 16 * NP, NP,
                       (const bf16*)(ws + OFF_WCMP + (layer * 2 + j) * SZ_WCMP) + kh * 512, 2048, 8, smem);
          gemm_epi(EPI_PLAIN, smem, (bf16*)(ws + OFF_CMPRAW) + (size_t)(kh * 2 + j) * 1024 * 128, 128, b * 128, nullptr, nullptr, nullptr, nullptr, nullptr, 0);
        } else if (q < 32) {
          const int i = q - 8, ml = i / 3, nt = i % 3, mt = xcd * 8 + ml;
          gemm_big(u + (size_t)mt * 256 * NP + C_CQ, NP, (const bf16*)(ws + OFF_WUQ + layer * SZ_WUQ) + (size_t)nt * 128 * 256, 256, 4, smem, EPI_PLAIN,
                   (bf16*)(ws + OFF_UQ + (size_t)xcd * SLAB), 384, ml * 256, nullptr, nullptr, nullptr, nullptr, nullptr, nt);
        } else {
          const int i = q - 32, ml = i >> 2, nt = i & 3, mt = xcd * 8 + ml;
          gemm_big(u + (size_t)mt * 256 * NP + C_CKV, NP, (const bf16*)(ws + OFF_WUKV + layer * SZ_WUKV) + (size_t)nt * 128 * 128, 128, 2, smem, EPI_PLAIN,
                   (bf16*)(ws + OFF_UKV + (size_t)xcd * SLAB), 512, ml * 256, nullptr, nullptr, nullptr, nullptr, nullptr, nt);
        }
      }
    }
    PBAR(1);
    prep_phase(p, layer);
    PBAR(2);
    attn_phaseA(p, layer, smem, ctrs + layer * 64);
    attn_phaseB(p, layer, smem, ctrs + layer * 64 + 32);
    PBAR(3);
    {
      const bf16* yb = (const bf16*)(ws + OFF_Y);
      const bf16* wo = (const bf16*)(ws + OFF_WO + layer * SZ_WO);
      const float* xres = layer == 0 ? p.in[0] : nullptr;
      const int xcd = blockIdx.x & 7, rk = blockIdx.x >> 3, nrk = gridDim.x >> 3;
      for (int q = rk; q < 64; q += nrk) {
        const int mt = xcd * 8 + (q & 7), nt = q >> 3;
        gemm_big(yb + (size_t)mt * 256 * 1024, 1024, wo + (size_t)nt * 128 * 1024, 1024, 16, smem, EPI_OUT, (bf16*)(ws + OFF_XB), 0, mt * 256, nullptr, xres, layer == 0 ? nullptr : p.out,
                 layer == 0 ? (bf16*)(ws + OFF_XB) : nullptr, (float*)(ws + OFF_SSQ), nt);
      }
    }
    if (layer == 0) PBAR(4);
  }
}

extern "C" void kernel_launch(void* const* d_in, const int* in_sizes, int n_in, void* d_out, int out_size, void* d_ws, size_t ws_size,
                              hipStream_t stream) {
  static int grid_blocks = 0;
  if (!grid_blocks) {
    int dev = 0, cus = 0, per_cu = 0;
    hipGetDevice(&dev);
    hipDeviceGetAttribute(&cus, hipDeviceAttributeMultiprocessorCount, dev);
    hipOccupancyMaxActiveBlocksPerMultiprocessor(&per_cu, fwd_megakernel, 256, 0);
    if (per_cu > 2) per_cu = 2;
    grid_blocks = (cus * per_cu) & ~7;
  }
  if (ws_size < WS_TOTAL) { fprintf(stderr, "workspace too small: %zu < %zu\n", ws_size, (size_t)WS_TOTAL); return; }
  Params p{};
  for (int i = 0; i < 19; ++i) p.in[i] = (const float*)d_in[i];
  p.out = (float*)d_out;
  p.ws = (char*)d_ws;
  hipMemsetAsync((char*)d_ws + OFF_CTR, 0, 1024 + 16384 + 8192 + 2048, stream);
  void* args[] = {&p};
  hipError_t e = hipLaunchCooperativeKernel((void*)fwd_megakernel, dim3(grid_blocks), dim3(256), args, 0, stream);
  if (e != hipSuccess) fprintf(stderr, "cooperative launch failed: %s (grid %d)\n", hipGetErrorString(e), grid_blocks);
}
```

```cpp
#include <hip/hip_runtime.h>
#include <hip/hip_cooperative_groups.h>
#include <stdint.h>
#include <cstdio>
namespace cg = cooperative_groups;

typedef unsigned short bf16;
using bf16x8 = __attribute__((ext_vector_type(8))) short;
using f32x16 = __attribute__((ext_vector_type(16))) float;
typedef __bf16 hbf2 __attribute__((ext_vector_type(2)));
typedef float hf2 __attribute__((ext_vector_type(2)));
typedef uint32_t u32x4 __attribute__((ext_vector_type(4)));
#define GLD16(dst, ptr) asm volatile("global_load_dwordx4 %0, %1, off" : "=&v"(dst) : "v"(ptr) : "memory")
#define WAIT_VM0() asm volatile("s_waitcnt vmcnt(0)" ::: "memory")
#define DI __device__ __forceinline__
#define MFMA(a, b, c) __builtin_amdgcn_mfma_f32_32x32x16_bf16((a), (b), (c), 0, 0, 0)

constexpr int Bn = 8, S = 2048, T = 16384, D = 1024, NP = 3200, ML = 256, TM = 2048;
constexpr float EPS = 1e-6f;
constexpr float LOG2E = 1.4426950408889634f;
constexpr int C_NQ = 0, C_KC = 256, C_VC = 320, C_KS = 384, C_VS = 448, C_KW = 512, C_VW = 576, C_NZ = 640,
              C_DQ = 896, C_DK = 1152, C_DV = 1408, C_DZ = 1664, C_CQ = 1920, C_CKV = 2176, C_KR = 2304,
              C_MZ = 2336, C_MQ = 2592, C_MEZ = 2848, C_GL = 3104;
constexpr size_t SZ_WI = (size_t)NP * 1024 * 2, SZ_WO = 1024 * 1024 * 2, SZ_WUQ = 384 * 256 * 2, SZ_WUKV = 512 * 128 * 2,
                 SZ_WMEM = 512 * 1024 * 2, SZ_WCMP = 128 * 2048 * 2;
constexpr size_t OFF_WI = 0;
constexpr size_t OFF_WO = OFF_WI + 2 * SZ_WI;
constexpr size_t OFF_WUQ = OFF_WO + 2 * SZ_WO;
constexpr size_t OFF_WUKV = OFF_WUQ + 2 * SZ_WUQ;
constexpr size_t OFF_WMEM = OFF_WUKV + 2 * SZ_WUKV;
constexpr size_t OFF_WCMP = OFF_WMEM + 2 * SZ_WMEM;
constexpr size_t OFF_CB = OFF_WCMP + 4 * SZ_WCMP;
constexpr size_t OFF_CBF = OFF_CB + 16384;
constexpr size_t OFF_LAM = OFF_CBF + 1024;
constexpr size_t OFF_CTR = OFF_LAM + 256;
constexpr size_t OFF_BAR = OFF_CTR + 1024;
constexpr size_t OFF_FLAG = OFF_BAR + 16384;
constexpr size_t OFF_PCNT = OFF_FLAG + 8192;
constexpr size_t OFF_ROPE = OFF_PCNT + 2048;
constexpr size_t OFF_SSQ = OFF_ROPE + 2048 * 32 * 8;
constexpr size_t OFF_RMEM = OFF_SSQ + (size_t)T * 8 * 4;
constexpr size_t OFF_MEMB = OFF_RMEM + 2048 * 4;
constexpr size_t OFF_XB = OFF_MEMB + (size_t)TM * 1024 * 2;
constexpr size_t OFF_U = OFF_XB + (size_t)T * 1024 * 2;
constexpr size_t OFF_R1 = OFF_U + (size_t)T * NP * 2;
constexpr size_t SLAB = (size_t)S * 1024 * 2;
constexpr size_t OFF_UQ = OFF_R1;
constexpr size_t OFF_UKV = OFF_R1 + (size_t)S * 384 * 2;
constexpr size_t OFF_Y = OFF_R1;
constexpr size_t OFF_QM = OFF_R1 + (size_t)T * 1024 * 2;
constexpr size_t OFF_KM = OFF_QM + (size_t)T * 384 * 2;
constexpr size_t OFF_MV = OFF_KM + (size_t)T * 384 * 2;
constexpr size_t OFF_KMEMRAW = OFF_MV + (size_t)T * 256 * 2;
constexpr size_t OFF_MK = OFF_KMEMRAW + (size_t)TM * 512 * 2;
constexpr size_t OFF_MVV = OFF_MK + (size_t)TM * 256 * 2;
constexpr size_t OFF_CMPRAW = OFF_MVV + (size_t)TM * 256 * 2;
constexpr size_t OFF_KCN = OFF_CMPRAW + 8 * 1024 * 128 * 2;
constexpr size_t OFF_VCN = OFF_KCN + 8 * 128 * 64 * 2;
constexpr size_t OFF_GT = OFF_VCN + 8 * 128 * 64 * 2;
constexpr size_t OFF_OCMP = OFF_GT + (size_t)T * 12 * 4;
constexpr size_t OFF_OWIN = OFF_OCMP + (size_t)T * 256 * 2;
constexpr size_t OFF_SEL = OFF_OWIN + (size_t)T * 256 * 2;
constexpr size_t WS_TOTAL = OFF_SEL + (size_t)T * 4;

constexpr int SMEM_BYTES = 73728;
constexpr int SM_VT = 2 * 64 * 104 * 2;
constexpr int SM_SC = SM_VT + 2 * 64 * 72 * 2;
constexpr int SM_MISC = SM_SC + 4 * 32 * 33 * 4;

struct Params {
  const float* in[19];
  float* out;
  char* ws;
};

DI int opq(int v) { asm volatile("" : "+v"(v)); return v; }
DI char* opqp(char* q) { size_t z = 0; asm volatile("" : "+s"(z)); return q + z; }
DI float bf2f(uint32_t v) { return __uint_as_float(v << 16); }
DI float bflo(uint32_t w) { return __uint_as_float(w << 16); }
DI float bfhi(uint32_t w) { return __uint_as_float(w & 0xffff0000u); }
DI uint32_t pack2(float a, float b) { hf2 f = {a, b}; hbf2 r = __builtin_convertvector(f, hbf2); return __builtin_bit_cast(uint32_t, r); }
DI bf16 f2bf(float a) { return (bf16)(pack2(a, 0.f) & 0xffffu); }
DI float fexp2(float x) { return __builtin_amdgcn_exp2f(x); }
DI float sigmoidf_(float x) { return __builtin_amdgcn_rcpf(1.f + fexp2(-LOG2E * x)); }
DI float siluf_(float x) { return x * __builtin_amdgcn_rcpf(1.f + fexp2(-LOG2E * x)); }
DI float shx(float v, int m) { return __shfl_xor(v, m); }
DI float dppf(float v, int ctrl_sel) {
  int x = __builtin_bit_cast(int, v), r;
  if (ctrl_sel == 0) r = __builtin_amdgcn_mov_dpp(x, 0xB1, 0xF, 0xF, true);
  else if (ctrl_sel == 1) r = __builtin_amdgcn_mov_dpp(x, 0x4E, 0xF, 0xF, true);
  else if (ctrl_sel == 2) r = __builtin_amdgcn_mov_dpp(x, 0x141, 0xF, 0xF, true);
  else r = __builtin_amdgcn_mov_dpp(x, 0x140, 0xF, 0xF, true);
  return __builtin_bit_cast(float, r);
}
DI float sum8(float v) { v += dppf(v, 0); v += dppf(v, 1); v += dppf(v, 2); return v; }
DI float sum16(float v) { v = sum8(v); v += dppf(v, 3); return v; }
DI float sum64(float v) { v = sum16(v); v += shx(v, 16); v += shx(v, 32); return v; }


#define XB_TMO      128
#define XB_XCNT(j)  (256  + 64 * (j))
#define XB_XSUB(j)  (1280 + 64 * (j))
#define XB_XGEN(j)  (2304 + 64 * (j))
#define XB_TOP      3328
#define XB_TOPGEN   3392
#define XB_SPIN_CAP (1u << 22)
#define LAS __attribute__((address_space(3)))
DI unsigned xb_ld(unsigned* p) { return __hip_atomic_load(p, __ATOMIC_RELAXED, __HIP_MEMORY_SCOPE_AGENT); }
DI unsigned xb_add(unsigned* p, unsigned v) { return __hip_atomic_fetch_add(p, v, __ATOMIC_RELAXED, __HIP_MEMORY_SCOPE_AGENT); }
DI unsigned xb_xcc_id() { return (unsigned)__builtin_amdgcn_readfirstlane((int)(__builtin_amdgcn_s_getreg((3 << 11) | 20) & 0xFu)); }
#define XB_SPIN(cond, bar) do { unsigned _sp = 0; while (cond) { __builtin_amdgcn_s_sleep(1); \
    if ((++_sp & 255u) == 0u) { if (xb_ld(&(bar)[XB_TMO])) break; if (_sp > XB_SPIN_CAP) { atomicAdd(&(bar)[XB_TMO], 1u); break; } } } } while (0)
struct XcdBarrier { unsigned* bar; unsigned x; volatile LAS unsigned* st; };
DI XcdBarrier xcd_barrier_post(unsigned* bar, volatile LAS unsigned* st) {
  XcdBarrier b; b.bar = bar; b.x = xb_xcc_id(); b.st = st;
  if (threadIdx.x == 0) (void)xb_add(&bar[XB_XCNT(b.x)], 1u);
  return b;
}
DI void xcd_barrier_complete(unsigned* bar, unsigned x, unsigned& nloc, unsigned& nx) {
  const unsigned G = gridDim.x * gridDim.y * gridDim.z;
  unsigned sum, cnt, mine, sp = 0u;
  for (;;) {
    sum = 0u; cnt = 0u; mine = 0u;
#pragma unroll
    for (unsigned j = 0; j < 16; ++j) { const unsigned c = xb_ld(&bar[XB_XCNT(j)]); sum += c; cnt += (c > 0u) ? 1u : 0u; mine = (j == x) ? c : mine; }
    if (sum == G) break;
    __builtin_amdgcn_s_sleep(1);
    if ((++sp & 255u) == 0u) { if (xb_ld(&bar[XB_TMO])) break; if (sp > XB_SPIN_CAP) { atomicAdd(&bar[XB_TMO], 1u); break; } }
  }
  nloc = mine > 0u ? mine : 1u; nx = cnt > 0u ? cnt : 1u;
}
DI void xcd_barrier(const XcdBarrier& b) {
  asm volatile("s_waitcnt vmcnt(0)" ::: "memory");
  __syncthreads();
  if (threadIdx.x == 0) {
    unsigned* bar = b.bar;
    const unsigned bx = xb_xcc_id();
    __builtin_amdgcn_s_waitcnt(0);
    unsigned nloc = b.st[0], nx = b.st[1];
    if (nloc == 0u) { xcd_barrier_complete(bar, bx, nloc, nx); b.st[0] = nloc; b.st[1] = nx; }
    const unsigned old = xb_add(&bar[XB_XSUB(bx)], 1u);
    const unsigned gen = old / nloc;
    if (old + 1u == (gen + 1u) * nloc) {
      __builtin_amdgcn_fence(__ATOMIC_RELEASE, "agent");
      asm volatile("s_waitcnt vmcnt(0)" ::: "memory");
      const unsigned og = xb_add(&bar[XB_TOP], 1u);
      const unsigned tg = og / nx;
      if (og + 1u == (tg + 1u) * nx) xb_add(&bar[XB_TOPGEN], 1u);
      else XB_SPIN(xb_ld(&bar[XB_TOPGEN]) == tg, bar);
      __builtin_amdgcn_fence(__ATOMIC_ACQUIRE, "agent");
      xb_add(&bar[XB_XGEN(bx)], 1u);
      asm volatile("s_waitcnt vmcnt(0)" ::: "memory");
    } else {
      XB_SPIN(xb_ld(&bar[XB_XGEN(bx)]) == gen, bar);
      __builtin_amdgcn_fence(__ATOMIC_ACQUIRE, "agent");
      asm volatile("s_waitcnt vmcnt(0)" ::: "memory");
    }
  }
  __syncthreads();
}

DI void part_barrier(unsigned* cnt, unsigned target) {
  asm volatile("s_waitcnt vmcnt(0)" ::: "memory");
  __syncthreads();
  if (threadIdx.x == 0) {
    __builtin_amdgcn_s_waitcnt(0);
    __builtin_amdgcn_fence(__ATOMIC_RELEASE, "agent");
    asm volatile("s_waitcnt vmcnt(0)" ::: "memory");
    xb_add(cnt, 1u);
    unsigned sp = 0;
    while (xb_ld(cnt) < target) { __builtin_amdgcn_s_sleep(1); if (++sp > (1u << 24)) break; }
    __builtin_amdgcn_fence(__ATOMIC_ACQUIRE, "agent");
    asm volatile("s_waitcnt vmcnt(0)" ::: "memory");
  }
  __syncthreads();
}

DI void wg_publish(unsigned* flag) {
  asm volatile("s_waitcnt vmcnt(0)" ::: "memory");
  __syncthreads();
  if (threadIdx.x == 0) {
    __builtin_amdgcn_fence(__ATOMIC_RELEASE, "agent");
    asm volatile("s_waitcnt vmcnt(0)" ::: "memory");
    xb_add(flag, 1u);
  }
}
DI void wg_wait2(unsigned* f0, unsigned* f1) {
  if (threadIdx.x == 0) {
    unsigned sp = 0;
    while (xb_ld(f0) < 1u || xb_ld(f1) < 1u) { __builtin_amdgcn_s_sleep(2); if (++sp > (1u << 22)) break; }
    __builtin_amdgcn_fence(__ATOMIC_ACQUIRE, "agent");
    asm volatile("s_waitcnt vmcnt(0)" ::: "memory");
  }
  __syncthreads();
}

DI int win_orig(int n) { return n < 640 ? n : (n < 3104 ? n + 12 : (n < 3116 ? n - 3104 + 640 : -1)); }

DI void convT_tile(const float* __restrict__ src, int Nsrc, const float* __restrict__ gain, bf16* __restrict__ dst, int K,
                   int k0, int n0, int mapmode, float* tile) {
  const int tid = opq(threadIdx.x);
  int shift = -1;
  if (mapmode == 1) { if (n0 + 63 < 640) shift = 0; else if (n0 >= 640 && n0 + 63 < 3104) shift = 12; }
  else if (n0 + 63 < Nsrc) shift = 0;
  const bool allpad = (mapmode == 1) ? (n0 >= 3116) : (n0 >= Nsrc);
  if (shift >= 0) {
    const int f = tid & 15, kr = tid >> 4;
    float4 v[4];
#pragma unroll
    for (int it = 0; it < 4; ++it) v[it] = *(const float4*)(src + (size_t)(k0 + kr + 16 * it) * Nsrc + n0 + shift + 4 * f);
    if (gain) {
#pragma unroll
      for (int it = 0; it < 4; ++it) { const float g = gain[k0 + kr + 16 * it]; v[it].x *= g; v[it].y *= g; v[it].z *= g; v[it].w *= g; }
    }
#pragma unroll
    for (int it = 0; it < 4; ++it) {
      float* tp = tile + (kr + 16 * it) * 65 + 4 * f;
      tp[0] = v[it].x; tp[1] = v[it].y; tp[2] = v[it].z; tp[3] = v[it].w;
    }
  } else {
    const int nn = tid & 63, kk = tid >> 6;
    const int n = n0 + nn;
    const int on = allpad ? -1 : (mapmode == 1 ? win_orig(n) : (n < Nsrc ? n : -1));
    float v[16];
#pragma unroll
    for (int it = 0; it < 16; ++it) {
      const int k = k0 + kk + 4 * it;
      v[it] = 0.f;
      if (on >= 0) v[it] = src[(size_t)k * Nsrc + on];
    }
    if (gain) {
#pragma unroll
      for (int it = 0; it < 16; ++it) v[it] *= gain[k0 + kk + 4 * it];
    }
#pragma unroll
    for (int it = 0; it < 16; ++it) tile[(kk + 4 * it) * 65 + nn] = v[it];
  }
  __syncthreads();
  {
    const int k8 = (tid & 7) * 8, nb = tid >> 3;
#pragma unroll
    for (int it = 0; it < 2; ++it) {
      const int n = nb + 32 * it;
      uint4 o;
      o.x = pack2(tile[(k8 + 0) * 65 + n], tile[(k8 + 1) * 65 + n]);
      o.y = pack2(tile[(k8 + 2) * 65 + n], tile[(k8 + 3) * 65 + n]);
      o.z = pack2(tile[(k8 + 4) * 65 + n], tile[(k8 + 5) * 65 + n]);
      o.w = pack2(tile[(k8 + 6) * 65 + n], tile[(k8 + 7) * 65 + n]);
      *(uint4*)(dst + (size_t)(n0 + n) * K + k0 + k8) = o;
    }
  }
  __syncthreads();
}

DI void phase0(const Params& p, char* smem) {
  const int tid = opq(threadIdx.x), lane = tid & 63, wv = tid >> 6;
  float* tile = (float*)smem;
  char* ws = opqp(p.ws);
  constexpr int N_WI = 2 * 50 * 16, N_WO = 2 * 16 * 16, N_WUQ = 2 * 6 * 4, N_WUKV = 2 * 8 * 2, N_WMEM = 2 * 8 * 16,
                N_WCMP = 4 * 2 * 32, N_X = T / 4, N_MEM = TM / 4, N_ROPE = 256, N_CB = 64, N_LAM = 1;
  constexpr int E0 = N_WI, E1 = E0 + N_WO, E2 = E1 + N_WUQ, E3 = E2 + N_WUKV, E4 = E3 + N_WMEM, E5 = E4 + N_WCMP,
                E6 = E5 + N_X, E7 = E6 + N_MEM, E8 = E7 + N_ROPE, E9 = E8 + N_CB, E10 = E9 + N_LAM;
  for (int it = blockIdx.x; it < E10; it += gridDim.x) {
    if (it < E0) {
      int l = it / 800, r = it % 800, nt = r / 16, kt = r % 16;
      convT_tile(p.in[3] + (size_t)l * 1024 * 3116, 3116, p.in[2] + l * 1024, (bf16*)(ws + OFF_WI + l * SZ_WI), 1024, kt * 64, nt * 64, 1, tile);
    } else if (it < E1) {
      int i = it - E0; int l = i / 256, r = i % 256, nt = r / 16, kt = r % 16;
      convT_tile(p.in[4] + (size_t)l * 1024 * 1024, 1024, nullptr, (bf16*)(ws + OFF_WO + l * SZ_WO), 1024, kt * 64, nt * 64, 0, tile);
    } else if (it < E2) {
      int i = it - E1; int l = i / 24, r = i % 24, nt = r / 4, kt = r % 4;
      convT_tile(p.in[13] + (size_t)l * 256 * 384, 384, p.in[11] + l * 256, (bf16*)(ws + OFF_WUQ + l * SZ_WUQ), 256, kt * 64, nt * 64, 0, tile);
    } else if (it < E3) {
      int i = it - E2; int l = i / 16, r = i % 16, nt = r / 2, kt = r % 2;
      convT_tile(p.in[14] + (size_t)l * 128 * 512, 512, p.in[12] + l * 128, (bf16*)(ws + OFF_WUKV + l * SZ_WUKV), 128, kt * 64, nt * 64, 0, tile);
    } else if (it < E4) {
      int i = it - E3; int l = i / 128, r = i % 128, nt = r / 16, kt = r % 16;
      convT_tile(p.in[17] + (size_t)l * 1024 * 512, 512, p.in[16] + l * 1024, (bf16*)(ws + OFF_WMEM + l * SZ_WMEM), 1024, kt * 64, nt * 64, 0, tile);
    } else if (it < E5) {
      int i = it - E4; int lj = i / 64, r = i % 64, nt = r / 32, kt = r % 32;
      convT_tile(p.in[7] + (size_t)lj * 2048 * 64, 64, nullptr, (bf16*)(ws + OFF_WCMP + lj * SZ_WCMP), 2048, kt * 64, nt * 64, 0, tile);
    } else if (it < E6) {
      int row = (it - E5) * 4 + wv;
      const float4* xr = (const float4*)(p.in[0] + (size_t)row * 1024);
      bf16* xb = (bf16*)(ws + OFF_XB) + (size_t)row * 1024;
      float ss = 0.f;
#pragma unroll
      for (int i = 0; i < 2; ++i) {
        const int c = lane + 64 * i;
        const float4 v = xr[2 * c], w = xr[2 * c + 1];
        ss += v.x * v.x + v.y * v.y + v.z * v.z + v.w * v.w + w.x * w.x + w.y * w.y + w.z * w.z + w.w * w.w;
        uint4 o; o.x = pack2(v.x, v.y); o.y = pack2(v.z, v.w); o.z = pack2(w.x, w.y); o.w = pack2(w.z, w.w);
        *(uint4*)(xb + c * 8) = o;
      }
      ss = sum64(ss);
      float* sq = (float*)(ws + OFF_SSQ) + (size_t)row * 8;
      if (lane < 8) sq[lane] = lane == 0 ? ss : 0.f;
    } else if (it < E7) {
      int row = (it - E6) * 4 + wv;
      const float4* xr = (const float4*)(p.in[1] + (size_t)row * 1024);
      bf16* xb = (bf16*)(ws + OFF_MEMB) + (size_t)row * 1024;
      float ss = 0.f;
#pragma unroll
      for (int i = 0; i < 2; ++i) {
        const int c = lane + 64 * i;
        const float4 v = xr[2 * c], w = xr[2 * c + 1];
        ss += v.x * v.x + v.y * v.y + v.z * v.z + v.w * v.w + w.x * w.x + w.y * w.y + w.z * w.z + w.w * w.w;
        uint4 o; o.x = pack2(v.x, v.y); o.y = pack2(v.z, v.w); o.z = pack2(w.x, w.y); o.w = pack2(w.z, w.w);
        *(uint4*)(xb + c * 8) = o;
      }
      ss = sum64(ss);
      if (lane == 0) ((float*)(ws + OFF_RMEM))[row] = rsqrtf(ss * (1.f / 1024.f) + EPS);
    } else if (it < E8) {
      int e = (it - E7) * 256 + tid;
      int pos = e >> 5, i = e & 31;
      float inv = powf(10000.f, -(float)i / 32.f);
      float ang = (float)pos * inv;
      double a = (double)ang;
      double n = rint(a * 0.15915494309189535);
      float r = (float)(a - n * 6.283185307179586);
      float2 cs; cs.x = __cosf(r); cs.y = __sinf(r);
      ((float2*)(ws + OFF_ROPE))[e] = cs;
    } else if (it < E9) {
      int lj = (it - E8) >> 4, sl = (it - E8) & 15;
      const float* pe = p.in[6] + (size_t)lj * 2048;
      const float* w = p.in[7] + (size_t)lj * 2048 * 64;
      int n = tid & 63, part = tid >> 6;
      float acc = 0.f;
      const int kb0 = sl * 128 + part * 32;
#pragma unroll 8
      for (int k = kb0; k < kb0 + 32; ++k) acc += pe[k] * w[(size_t)k * 64 + n];
      tile[tid] = acc;
      __syncthreads();
      if (tid < 64) ((float*)(ws + OFF_CB))[((it - E8)) * 64 + tid] = tile[tid] + tile[tid + 64] + tile[tid + 128] + tile[tid + 192];
      __syncthreads();
    } else {
      if (tid < 2) {
        const float* lf = p.in[9] + tid * 128;
        float s1 = 0.f, s2 = 0.f;
        for (int i = 0; i < 32; ++i) { s1 += lf[i] * lf[32 + i]; s2 += lf[64 + i] * lf[96 + i]; }
        float li = 0.8f - 0.6f * expf(-0.3f * (float)tid);
        ((float*)(ws + OFF_LAM))[tid] = expf(s1) - expf(s2) + li;
      }
    }
  }
}

template <int CH>
DI void gemm_tile(const bf16* __restrict__ Ab, long lda, long kcs, const bf16* __restrict__ Bb, long ldb, int nk, char* smem) {
  const int tid = opq(threadIdx.x), lane = tid & 63, wv = tid >> 6, half = lane >> 5, l31 = lane & 31;
  const int wm = wv >> 1, wn = wv & 1;
  bf16* As = (bf16*)smem;
  bf16* Bs = (bf16*)(smem + 36864);
  const int lrow = tid >> 3, lcol = (tid & 7) * 8;
  const bf16* ag = Ab + (long)lrow * lda + lcol;
  const bf16* bg = Bb + (long)lrow * ldb + lcol;
  f32x16 acc[2][2];
#pragma unroll
  for (int a = 0; a < 2; ++a)
#pragma unroll
    for (int b = 0; b < 2; ++b)
#pragma unroll
      for (int i = 0; i < 16; ++i) acc[a][b][i] = 0.f;
#define GCOMPUTE(BUF) do { \
    const bf16* as_ = As + (BUF) * 128 * 72 + (wm * 64 + l31) * 72 + half * 8; \
    const bf16* bs_ = Bs + (BUF) * 128 * 72 + (wn * 64 + l31) * 72 + half * 8; \
    bf16x8 fa[2][2], fb[2][2]; \
    fa[0][0] = *(const bf16x8*)(as_); fa[0][1] = *(const bf16x8*)(as_ + 32 * 72); \
    fb[0][0] = *(const bf16x8*)(bs_); fb[0][1] = *(const bf16x8*)(bs_ + 32 * 72); \
    _Pragma("unroll") for (int kc = 0; kc < 4; ++kc) { \
      if (kc < 3) { \
        fa[(kc + 1) & 1][0] = *(const bf16x8*)(as_ + (kc + 1) * 16); fa[(kc + 1) & 1][1] = *(const bf16x8*)(as_ + 32 * 72 + (kc + 1) * 16); \
        fb[(kc + 1) & 1][0] = *(const bf16x8*)(bs_ + (kc + 1) * 16); fb[(kc + 1) & 1][1] = *(const bf16x8*)(bs_ + 32 * 72 + (kc + 1) * 16); \
      } \
      _Pragma("unroll") for (int ni = 0; ni < 2; ++ni) \
        _Pragma("unroll") for (int mi = 0; mi < 2; ++mi) acc[ni][mi] = MFMA(fb[kc & 1][ni], fa[kc & 1][mi], acc[ni][mi]); \
    } } while (0)
  for (int c0 = 0; c0 < nk; c0 += CH) {
    u32x4 rs[2][8];
    const bf16* agc = ag + (long)c0 * kcs;
    const bf16* bgc = bg + (long)c0 * 64;
#pragma unroll
    for (int i = 0; i < 4; ++i) {
      rs[0][i] = *(const u32x4*)(agc + (long)(32 * i) * lda);
      rs[0][4 + i] = *(const u32x4*)(bgc + (long)(32 * i) * ldb);
    }
#pragma unroll
    for (int i = 0; i < 4; ++i) {
      *(u32x4*)(As + (lrow + 32 * i) * 72 + lcol) = rs[0][i];
      *(u32x4*)(Bs + (lrow + 32 * i) * 72 + lcol) = rs[0][4 + i];
    }
    if (CH > 1) {
#pragma unroll
      for (int i = 0; i < 4; ++i) {
        GLD16(rs[1][i], agc + (long)(32 * i) * lda + kcs);
        GLD16(rs[1][4 + i], bgc + (long)(32 * i) * ldb + 64);
      }
    }
    __syncthreads();
#pragma unroll
    for (int t = 0; t < CH; ++t) {
      const int bufc = t & 1;
      if (t + 2 < CH) {
#pragma unroll
        for (int i = 0; i < 4; ++i) {
          GLD16(rs[t & 1][i], agc + (long)(32 * i) * lda + (long)(t + 2) * kcs);
          GLD16(rs[t & 1][4 + i], bgc + (long)(32 * i) * ldb + (long)(t + 2) * 64);
        }
      }
      GCOMPUTE(bufc);
      if (t + 1 < CH) {
        u32x4(&rr)[8] = rs[(t + 1) & 1];
        if (t + 2 < CH) asm volatile("s_waitcnt vmcnt(8)" : "+v"(rr[0]), "+v"(rr[1]), "+v"(rr[2]), "+v"(rr[3]), "+v"(rr[4]), "+v"(rr[5]), "+v"(rr[6]), "+v"(rr[7]) :: "memory");
        else asm volatile("s_waitcnt vmcnt(0)" : "+v"(rr[0]), "+v"(rr[1]), "+v"(rr[2]), "+v"(rr[3]), "+v"(rr[4]), "+v"(rr[5]), "+v"(rr[6]), "+v"(rr[7]) :: "memory");
        bf16* ad = As + (bufc ^ 1) * 128 * 72; bf16* bd = Bs + (bufc ^ 1) * 128 * 72;
#pragma unroll
        for (int i = 0; i < 4; ++i) {
          *(u32x4*)(ad + (lrow + 32 * i) * 72 + lcol) = rr[i];
          *(u32x4*)(bd + (lrow + 32 * i) * 72 + lcol) = rr[4 + i];
        }
      }
      __syncthreads();
    }
  }
#undef GCOMPUTE
  float* Cs = (float*)smem;
#pragma unroll
  for (int ni = 0; ni < 2; ++ni)
#pragma unroll
    for (int mi = 0; mi < 2; ++mi)
#pragma unroll
      for (int g = 0; g < 4; ++g) {
        float4 v; v.x = acc[ni][mi][4 * g]; v.y = acc[ni][mi][4 * g + 1]; v.z = acc[ni][mi][4 * g + 2]; v.w = acc[ni][mi][4 * g + 3];
        *(float4*)(Cs + (wm * 64 + mi * 32 + l31) * 132 + wn * 64 + ni * 32 + 8 * g + 4 * half) = v;
      }
  __syncthreads();
}

enum { EPI_PLAIN = 0, EPI_RS8 = 1, EPI_RS1 = 2, EPI_OUT = 3 };
DI void gemm_epi(int mode, char* smem, bf16* __restrict__ Cb, long ldc, int row0, const float* __restrict__ rs,
                 const float* __restrict__ xres, float* __restrict__ xout, bf16* __restrict__ xbout, float* __restrict__ ssqout, int ntile) {
  const float* Cs = (const float*)smem;
  const int tid = opq(threadIdx.x);
  float* rsl = (float*)(smem + 67584);
  if (mode == EPI_RS8 || mode == EPI_RS1) {
    if (tid < 128) {
      const long grow = row0 + tid;
      float sc;
      if (mode == EPI_RS8) {
        const float4* q = (const float4*)(rs + grow * 8);
        const float4 a = q[0], b = q[1];
        sc = rsqrtf((a.x + a.y + a.z + a.w + b.x + b.y + b.z + b.w) * (1.f / 1024.f) + EPS);
      } else sc = rs[grow];
      rsl[tid] = sc;
    }
    __syncthreads();
  }
#pragma unroll 2
  for (int it = 0; it < 8; ++it) {
    const int idx = it * 256 + tid;
    const int r = idx >> 4, ch = idx & 15;
    float4 v0 = *(const float4*)(Cs + r * 132 + ch * 8);
    float4 v1 = *(const float4*)(Cs + r * 132 + ch * 8 + 4);
    const long grow = row0 + r;
    if (mode == EPI_OUT) {
      if (xres) {
        const float4* xr = (const float4*)(xres + grow * 1024 + ntile * 128 + ch * 8);
        float4 x0 = xr[0], x1 = xr[1];
        v0.x += x0.x; v0.y += x0.y; v0.z += x0.z; v0.w += x0.w;
        v1.x += x1.x; v1.y += x1.y; v1.z += x1.z; v1.w += x1.w;
      } else {
        const uint4 xw = *(const uint4*)(Cb + grow * 1024 + ntile * 128 + ch * 8);
        v0.x += bflo(xw.x); v0.y += bfhi(xw.x); v0.z += bflo(xw.y); v0.w += bfhi(xw.y);
        v1.x += bflo(xw.z); v1.y += bfhi(xw.z); v1.z += bflo(xw.w); v1.w += bfhi(xw.w);
      }
      if (xout) {
        float4* xo = (float4*)(xout + grow * 1024 + ntile * 128 + ch * 8);
        xo[0] = v0; xo[1] = v1;
      }
      if (xbout) {
        float ss = v0.x * v0.x + v0.y * v0.y + v0.z * v0.z + v0.w * v0.w + v1.x * v1.x + v1.y * v1.y + v1.z * v1.z + v1.w * v1.w;
        ss = sum16(ss);
        if (ch == 0) ssqout[grow * 8 + ntile] = ss;
        uint4 o; o.x = pack2(v0.x, v0.y); o.y = pack2(v0.z, v0.w); o.z = pack2(v1.x, v1.y); o.w = pack2(v1.z, v1.w);
        *(uint4*)(xbout + grow * 1024 + ntile * 128 + ch * 8) = o;
      }
    } else {
      float sc = 1.f;
      if (mode == EPI_RS8 || mode == EPI_RS1) sc = rsl[r];
      uint4 o; o.x = pack2(v0.x * sc, v0.y * sc); o.y = pack2(v0.z * sc, v0.w * sc); o.z = pack2(v1.x * sc, v1.y * sc); o.w = pack2(v1.z * sc, v1.w * sc);
      *(uint4*)(Cb + grow * ldc + ntile * 128 + ch * 8) = o;
    }
  }
  __syncthreads();
}

DI void gemm_big(const bf16* __restrict__ Ab, long lda, const bf16* __restrict__ Bb, long ldb, int nk, char* smem, int mode,
                 bf16* __restrict__ Cb, long ldc, int row0, const float* __restrict__ rs, const float* __restrict__ xres,
                 float* __restrict__ xout, bf16* __restrict__ xbout, float* __restrict__ ssqout, int ntile) {
  const int tid = opq(threadIdx.x), lane = tid & 63, wv = tid >> 6, half = lane >> 5, l31 = lane & 31;
  const int wm = wv >> 1, wn = wv & 1;
  bf16* As = (bf16*)smem;
  bf16* Bs = (bf16*)(smem + 36864);
  const int lrow = tid >> 3, lcol = (tid & 7) * 8;
  const bf16* ag = Ab + (long)lrow * lda + lcol;
  const bf16* bg = Bb + (long)lrow * ldb + lcol;
  u32x4 ra[8], rb[4];
  f32x16 acc[2][4];
#pragma unroll
  for (int a = 0; a < 2; ++a)
#pragma unroll
    for (int b = 0; b < 4; ++b)
#pragma unroll
      for (int i = 0; i < 16; ++i) acc[a][b][i] = 0.f;
#pragma unroll
  for (int i = 0; i < 8; ++i) ra[i] = *(const u32x4*)(ag + (long)(32 * i) * lda);
#pragma unroll
  for (int i = 0; i < 4; ++i) rb[i] = *(const u32x4*)(bg + (long)(32 * i) * ldb);
#pragma unroll
  for (int i = 0; i < 8; ++i) *(u32x4*)(As + (lrow + 32 * i) * 72 + lcol) = ra[i];
#pragma unroll
  for (int i = 0; i < 4; ++i) *(u32x4*)(Bs + (lrow + 32 * i) * 72 + lcol) = rb[i];
  __syncthreads();
  for (int ks = 0; ks < nk; ++ks) {
    const bool more = ks + 1 < nk;
    if (more) {
#pragma unroll
      for (int i = 0; i < 8; ++i) GLD16(ra[i], ag + (long)(32 * i) * lda + (long)(ks + 1) * 64);
#pragma unroll
      for (int i = 0; i < 4; ++i) GLD16(rb[i], bg + (long)(32 * i) * ldb + (long)(ks + 1) * 64);
    }
    const bf16* as_ = As + (wm * 128 + l31) * 72 + half * 8;
    const bf16* bs_ = Bs + (wn * 64 + l31) * 72 + half * 8;
#pragma unroll
    for (int kc = 0; kc < 4; ++kc) {
      bf16x8 fa[4], fb[2];
#pragma unroll
      for (int mi = 0; mi < 4; ++mi) fa[mi] = *(const bf16x8*)(as_ + mi * 32 * 72 + kc * 16);
#pragma unroll
      for (int ni = 0; ni < 2; ++ni) fb[ni] = *(const bf16x8*)(bs_ + ni * 32 * 72 + kc * 16);
#pragma unroll
      for (int ni = 0; ni < 2; ++ni)
#pragma unroll
        for (int mi = 0; mi < 4; ++mi) acc[ni][mi] = MFMA(fb[ni], fa[mi], acc[ni][mi]);
    }
    __syncthreads();
    if (more) {
      asm volatile("s_waitcnt vmcnt(0)" : "+v"(ra[0]), "+v"(ra[1]), "+v"(ra[2]), "+v"(ra[3]), "+v"(ra[4]), "+v"(ra[5]), "+v"(ra[6]), "+v"(ra[7]),
                   "+v"(rb[0]), "+v"(rb[1]), "+v"(rb[2]), "+v"(rb[3]) :: "memory");
#pragma unroll
      for (int i = 0; i < 8; ++i) *(u32x4*)(As + (lrow + 32 * i) * 72 + lcol) = ra[i];
#pragma unroll
      for (int i = 0; i < 4; ++i) *(u32x4*)(Bs + (lrow + 32 * i) * 72 + lcol) = rb[i];
      __syncthreads();
    }
  }
  float* Cs = (float*)smem;
#pragma unroll
  for (int h = 0; h < 2; ++h) {
    if (wm == h) {
#pragma unroll
      for (int ni = 0; ni < 2; ++ni)
#pragma unroll
        for (int mi = 0; mi < 4; ++mi)
#pragma unroll
          for (int g = 0; g < 4; ++g) {
            float4 v; v.x = acc[ni][mi][4 * g]; v.y = acc[ni][mi][4 * g + 1]; v.z = acc[ni][mi][4 * g + 2]; v.w = acc[ni][mi][4 * g + 3];
            *(float4*)(Cs + (mi * 32 + l31) * 132 + wn * 64 + ni * 32 + 8 * g + 4 * half) = v;
          }
    }
    __syncthreads();
    gemm_epi(mode, smem, Cb, ldc, row0 + h * 128, rs, xres, xout, xbout, ssqout, ntile);
  }
}

enum { AM_NONE = 0, AM_CAUSAL = 1, AM_WIN = 2, AM_CMP = 3, AM_SLC = 4 };

template <int DK>
DI void attn_core(const bf16* __restrict__ Kp, long kstride, const bf16* __restrict__ Vp, long vstride, uint32_t tilemask,
                  int mode, int qpos, uint32_t sel, const bf16x8 (&Qf)[DK / 16], f32x16 (&O)[2], float& m_out, float& l_out, char* smem) {
  constexpr int KST = DK + 8;
  constexpr int CPR = DK / 8;
  constexpr int NCH = CPR / 4;
  bf16* Ks = (bf16*)smem;
  bf16* VTs = (bf16*)(smem + SM_VT);
  const int tid = opq(threadIdx.x), lane = tid & 63, half = lane >> 5, l31 = lane & 31;
#pragma unroll
  for (int i = 0; i < 16; ++i) { O[0][i] = 0.f; O[1][i] = 0.f; }
  float l = 0.f;
  const int qw0 = __builtin_amdgcn_readfirstlane(qpos - l31);
  const bool causal_like = (mode == AM_CAUSAL || mode == AM_WIN || mode == AM_SLC);
  int klo = 0, khi = 0x7fffffff;
  if (mode == AM_CAUSAL || mode == AM_SLC) khi = qpos;
  else if (mode == AM_WIN) { khi = qpos; klo = qpos - 511; }
  else if (mode == AM_CMP) khi = (qpos - 31) >> 4;
  u32x4 rk0, rk1, rk2, rv0, rv1;
  rk0 = rk1 = rk2 = (u32x4){0u, 0u, 0u, 0u};
  const int vkp = tid & 31, vcc = tid >> 5;
  const int vcol = (vkp >> 3) * 16 + (((vkp & 1) | ((vkp & 2) << 1) | ((vkp & 4) >> 1)) * 2);
  const int c0 = tid, c1 = tid + 256, c2_ = tid + 512;
  const int kr0 = c0 / CPR, kc0 = (c0 % CPR) * 8, kr1 = c1 / CPR, kc1 = (c1 % CPR) * 8, kr2 = c2_ / CPR, kc2 = (c2_ % CPR) * 8;
#define GLOAD(KT) do { \
    GLD16(rk0, Kp + (long)((KT) * 64 + kr0) * kstride + kc0); \
    if constexpr (NCH > 1) GLD16(rk1, Kp + (long)((KT) * 64 + kr1) * kstride + kc1); \
    if constexpr (NCH > 2) GLD16(rk2, Kp + (long)((KT) * 64 + kr2) * kstride + kc2); \
    GLD16(rv0, Vp + (long)((KT) * 64 + 2 * vkp) * vstride + vcc * 8); \
    GLD16(rv1, Vp + (long)((KT) * 64 + 2 * vkp + 1) * vstride + vcc * 8); } while (0)
#define LSTORE(BUF) do { asm volatile("s_waitcnt vmcnt(0)" : "+v"(rk0), "+v"(rk1), "+v"(rk2), "+v"(rv0), "+v"(rv1) :: "memory"); \
    *(u32x4*)(Ks + ((BUF) * 64 + kr0) * KST + kc0) = rk0; \
    if constexpr (NCH > 1) *(u32x4*)(Ks + ((BUF) * 64 + kr1) * KST + kc1) = rk1; \
    if constexpr (NCH > 2) *(u32x4*)(Ks + ((BUF) * 64 + kr2) * KST + kc2) = rk2; \
    bf16* vd = VTs + ((BUF) * 64 + vcc * 8) * 72 + vcol; \
    *(uint32_t*)(vd + 0 * 72) = (rv0.x & 0xffffu) | (rv1.x << 16); \
    *(uint32_t*)(vd + 1 * 72) = (rv0.x >> 16) | (rv1.x & 0xffff0000u); \
    *(uint32_t*)(vd + 2 * 72) = (rv0.y & 0xffffu) | (rv1.y << 16); \
    *(uint32_t*)(vd + 3 * 72) = (rv0.y >> 16) | (rv1.y & 0xffff0000u); \
    *(uint32_t*)(vd + 4 * 72) = (rv0.z & 0xffffu) | (rv1.z << 16); \
    *(uint32_t*)(vd + 5 * 72) = (rv0.z >> 16) | (rv1.z & 0xffff0000u); \
    *(uint32_t*)(vd + 6 * 72) = (rv0.w & 0xffffu) | (rv1.w << 16); \
    *(uint32_t*)(vd + 7 * 72) = (rv0.w >> 16) | (rv1.w & 0xffff0000u); } while (0)
  uint32_t rem = tilemask;
  int kt = __ffs(rem) - 1; rem &= rem - 1;
  GLOAD(kt);
#pragma unroll
  for (int kc = 0; kc < DK / 16; ++kc) asm volatile("" ::"v"(Qf[kc]));
  __syncthreads();
  LSTORE(0);
  __syncthreads();
  int buf = 0;
  while (true) {
    int ktn = -1;
    if (rem) { ktn = __ffs(rem) - 1; rem &= rem - 1; GLOAD(ktn); }
    const bool wave_active = !(causal_like && kt * 64 > qw0 + 31);
    if (wave_active) {
    f32x16 Sx[2];
#pragma unroll
    for (int kb = 0; kb < 2; ++kb) {
      bf16x8 Kf[DK / 16];
#pragma unroll
      for (int kc = 0; kc < DK / 16; ++kc) Kf[kc] = *(const bf16x8*)(Ks + (buf * 64 + kb * 32 + l31) * KST + kc * 16 + half * 8);
      __builtin_amdgcn_sched_barrier(0);
#pragma unroll
      for (int i = 0; i < 16; ++i) Sx[kb][i] = 0.f;
#pragma unroll
      for (int kc = 0; kc < DK / 16; ++kc) Sx[kb] = MFMA(Kf[kc], Qf[kc], Sx[kb]);
    }
    bf16x8 Vf[2][2][2];
#pragma unroll
    for (int kb = 0; kb < 2; ++kb)
#pragma unroll
      for (int c2 = 0; c2 < 2; ++c2)
#pragma unroll
        for (int dvb = 0; dvb < 2; ++dvb)
          Vf[kb][c2][dvb] = *(const bf16x8*)(VTs + (buf * 64 + dvb * 32 + l31) * 72 + (kb * 2 + c2) * 16 + half * 8);
    __builtin_amdgcn_sched_barrier(0);
    bool need_mask = false;
    if (mode == AM_CAUSAL) need_mask = kt * 64 + 63 > qw0;
    else if (mode == AM_WIN) need_mask = (kt * 64 + 63 > qw0) || (kt * 64 < qw0 + 31 - 511);
    else if (mode == AM_CMP) need_mask = true;
    else if (mode == AM_SLC) need_mask = (kt * 64 + 63 > qw0);
    const bool keep = !(mode == AM_SLC) || (((sel >> kt) & 1u) != 0u);
    int khe = khi;
    if (mode == AM_SLC && !((sel >> kt) & 1u)) khe = -1;
    const int kbase = kt * 64 + half * 4;
#pragma unroll
    for (int kb = 0; kb < 2; ++kb) {
      if (need_mask) {
#pragma unroll
        for (int i = 0; i < 16; ++i) {
          const int key = kbase + kb * 32 + (i >> 2) * 8 + (i & 3);
          Sx[kb][i] = (key >= klo && key <= khe) ? Sx[kb][i] : -1e30f;
        }
      }
      float ps = 0.f;
#pragma unroll
      for (int i = 0; i < 16; ++i) { float pv = fexp2(Sx[kb][i]); pv = keep ? pv : 0.f; Sx[kb][i] = pv; ps += pv; }
      l += ps;
#pragma unroll
      for (int c2 = 0; c2 < 2; ++c2) {
        uint4 pw;
        pw.x = pack2(Sx[kb][8 * c2 + 0], Sx[kb][8 * c2 + 1]); pw.y = pack2(Sx[kb][8 * c2 + 2], Sx[kb][8 * c2 + 3]);
        pw.z = pack2(Sx[kb][8 * c2 + 4], Sx[kb][8 * c2 + 5]); pw.w = pack2(Sx[kb][8 * c2 + 6], Sx[kb][8 * c2 + 7]);
        const bf16x8 pf = __builtin_bit_cast(bf16x8, pw);
#pragma unroll
        for (int dvb = 0; dvb < 2; ++dvb) O[dvb] = MFMA(Vf[kb][c2][dvb], pf, O[dvb]);
      }
      __builtin_amdgcn_sched_barrier(0);
    }
    }
    if (ktn < 0) break;
    LSTORE(buf ^ 1);
    __syncthreads();
    buf ^= 1; kt = ktn;
  }
  l_out = l + shx(l, 32);
  m_out = 0.f;
#undef GLOAD
#undef LSTORE
}

template <int DK>
DI void attn_core_dual(const bf16* __restrict__ Kp, long kstride, const bf16* __restrict__ Vp, long vstride, uint32_t tilemask,
                  int mode, int qpos, uint32_t sel, const bf16x8 (&Qf)[DK / 16], f32x16 (&O)[2], f32x16 (&O2)[2], float& l_out, float& l2_out, char* smem) {
  constexpr int KST = DK + 8;
  constexpr int CPR = DK / 8;
  constexpr int NCH = CPR / 4;
  bf16* Ks = (bf16*)smem;
  bf16* VTs = (bf16*)(smem + SM_VT);
  const int tid = opq(threadIdx.x), lane = tid & 63, half = lane >> 5, l31 = lane & 31;
#pragma unroll
  for (int i = 0; i < 16; ++i) { O[0][i] = 0.f; O[1][i] = 0.f; O2[0][i] = 0.f; O2[1][i] = 0.f; }
  float l = 0.f, l2 = 0.f;
  const int qw0 = __builtin_amdgcn_readfirstlane(qpos - l31);
  const bool causal_like = (mode == AM_CAUSAL || mode == AM_WIN || mode == AM_SLC);
  int klo = 0, khi = 0x7fffffff;
  if (mode == AM_CAUSAL || mode == AM_SLC) khi = qpos;
  else if (mode == AM_WIN) { khi = qpos; klo = qpos - 511; }
  else if (mode == AM_CMP) khi = (qpos - 31) >> 4;
  u32x4 rk0, rk1, rk2, rv0, rv1;
  rk0 = rk1 = rk2 = (u32x4){0u, 0u, 0u, 0u};
  const int vkp = tid & 31, vcc = tid >> 5;
  const int vcol = (vkp >> 3) * 16 + (((vkp & 1) | ((vkp & 2) << 1) | ((vkp & 4) >> 1)) * 2);
  const int c0 = tid, c1 = tid + 256, c2_ = tid + 512;
  const int kr0 = c0 / CPR, kc0 = (c0 % CPR) * 8, kr1 = c1 / CPR, kc1 = (c1 % CPR) * 8, kr2 = c2_ / CPR, kc2 = (c2_ % CPR) * 8;
#define GLOAD(KT) do { \
    GLD16(rk0, Kp + (long)((KT) * 64 + kr0) * kstride + kc0); \
    if constexpr (NCH > 1) GLD16(rk1, Kp + (long)((KT) * 64 + kr1) * kstride + kc1); \
    if constexpr (NCH > 2) GLD16(rk2, Kp + (long)((KT) * 64 + kr2) * kstride + kc2); \
    GLD16(rv0, Vp + (long)((KT) * 64 + 2 * vkp) * vstride + vcc * 8); \
    GLD16(rv1, Vp + (long)((KT) * 64 + 2 * vkp + 1) * vstride + vcc * 8); } while (0)
#define LSTORE(BUF) do { asm volatile("s_waitcnt vmcnt(0)" : "+v"(rk0), "+v"(rk1), "+v"(rv0), "+v"(rv1) :: "memory"); \
    *(u32x4*)(Ks + ((BUF) * 64 + kr0) * KST + kc0) = rk0; \
    if constexpr (NCH > 1) *(u32x4*)(Ks + ((BUF) * 64 + kr1) * KST + kc1) = rk1; \
    if constexpr (NCH > 2) *(u32x4*)(Ks + ((BUF) * 64 + kr2) * KST + kc2) = rk2; \
    bf16* vd = VTs + ((BUF) * 64 + vcc * 8) * 72 + vcol; \
    *(uint32_t*)(vd + 0 * 72) = (rv0.x & 0xffffu) | (rv1.x << 16); \
    *(uint32_t*)(vd + 1 * 72) = (rv0.x >> 16) | (rv1.x & 0xffff0000u); \
    *(uint32_t*)(vd + 2 * 72) = (rv0.y & 0xffffu) | (rv1.y << 16); \
    *(uint32_t*)(vd + 3 * 72) = (rv0.y >> 16) | (rv1.y & 0xffff0000u); \
    *(uint32_t*)(vd + 4 * 72) = (rv0.z & 0xffffu) | (rv1.z << 16); \
    *(uint32_t*)(vd + 5 * 72) = (rv0.z >> 16) | (rv1.z & 0xffff0000u); \
    *(uint32_t*)(vd + 6 * 72) = (rv0.w & 0xffffu) | (rv1.w << 16); \
    *(uint32_t*)(vd + 7 * 72) = (rv0.w >> 16) | (rv1.w & 0xffff0000u); } while (0)
  uint32_t rem = tilemask;
  int kt = __ffs(rem) - 1; rem &= rem - 1;
  GLOAD(kt);
#pragma unroll
  for (int kc = 0; kc < DK / 16; ++kc) asm volatile("" ::"v"(Qf[kc]));
  __syncthreads();
  LSTORE(0);
  __syncthreads();
  int buf = 0;
  while (true) {
    int ktn = -1;
    if (rem) { ktn = __ffs(rem) - 1; rem &= rem - 1; GLOAD(ktn); }
    const bool wave_active = !(causal_like && kt * 64 > qw0 + 31);
    if (wave_active) {
    const bool need_mask = kt * 64 + 63 > qw0;
    const int kbase = kt * 64 + half * 4;
#pragma unroll
    for (int mp = 0; mp < 2; ++mp) {
      f32x16 Sx[2];
#pragma unroll
      for (int kb = 0; kb < 2; ++kb) {
        bf16x8 k0 = *(const bf16x8*)(Ks + (buf * 64 + kb * 32 + l31) * KST + (2 * mp) * 16 + half * 8);
        bf16x8 k1 = *(const bf16x8*)(Ks + (buf * 64 + kb * 32 + l31) * KST + (2 * mp + 1) * 16 + half * 8);
#pragma unroll
        for (int i = 0; i < 16; ++i) Sx[kb][i] = 0.f;
        Sx[kb] = MFMA(k0, Qf[2 * mp], Sx[kb]);
        Sx[kb] = MFMA(k1, Qf[2 * mp + 1], Sx[kb]);
      }
#pragma unroll
      for (int kb = 0; kb < 2; ++kb) {
        if (need_mask) {
#pragma unroll
          for (int i = 0; i < 16; ++i) {
            const int key = kbase + kb * 32 + (i >> 2) * 8 + (i & 3);
            Sx[kb][i] = (key <= khi) ? Sx[kb][i] : -1e30f;
          }
        }
        bf16x8 Vf[2][2];
#pragma unroll
        for (int c2 = 0; c2 < 2; ++c2)
#pragma unroll
          for (int dvb = 0; dvb < 2; ++dvb)
            Vf[c2][dvb] = *(const bf16x8*)(VTs + (buf * 64 + dvb * 32 + l31) * 72 + (kb * 2 + c2) * 16 + half * 8);
        float ps = 0.f;
#pragma unroll
        for (int i = 0; i < 16; ++i) { float pv = fexp2(Sx[kb][i]); Sx[kb][i] = pv; ps += pv; }
        if (mp == 0) l += ps; else l2 += ps;
#pragma unroll
        for (int c2 = 0; c2 < 2; ++c2) {
          uint4 pw;
          pw.x = pack2(Sx[kb][8 * c2 + 0], Sx[kb][8 * c2 + 1]); pw.y = pack2(Sx[kb][8 * c2 + 2], Sx[kb][8 * c2 + 3]);
          pw.z = pack2(Sx[kb][8 * c2 + 4], Sx[kb][8 * c2 + 5]); pw.w = pack2(Sx[kb][8 * c2 + 6], Sx[kb][8 * c2 + 7]);
          const bf16x8 pf = __builtin_bit_cast(bf16x8, pw);
#pragma unroll
          for (int dvb = 0; dvb < 2; ++dvb) {
            if (mp == 0) O[dvb] = MFMA(Vf[c2][dvb], pf, O[dvb]); else O2[dvb] = MFMA(Vf[c2][dvb], pf, O2[dvb]);
          }
        }
        __builtin_amdgcn_sched_barrier(0);
      }
    }
    }
    if (ktn < 0) break;
    LSTORE(buf ^ 1);
    __syncthreads();
    buf ^= 1; kt = ktn;
  }
  l_out = l + shx(l, 32);
  l2_out = l2 + shx(l2, 32);
#undef GLOAD
#undef LSTORE
}

template <int DK>
DI void load_q(const bf16* __restrict__ Qrow, bf16x8 (&Qf)[DK / 16]) {
  const int half = (opq(threadIdx.x) & 63) >> 5;
#pragma unroll
  for (int kc = 0; kc < DK / 16; ++kc) Qf[kc] = *(const bf16x8*)(Qrow + kc * 16 + half * 8);
}

DI void vec64(bool active, const bf16* src, const float* bias, int nbias, bf16* dst, const float* gain, const float2* rp, float scale, int j, const bf16* src2 = nullptr) {
  float a0 = 0.f, a1 = 0.f, b0 = 0.f, b1 = 0.f;
  if (active) {
    uint32_t lo = *(const uint32_t*)(src + 2 * j), hi = *(const uint32_t*)(src + 32 + 2 * j);
    a0 = bflo(lo); a1 = bfhi(lo); b0 = bflo(hi); b1 = bfhi(hi);
    if (src2) {
#pragma unroll
      for (int q = 0; q < 3; ++q) {
        const bf16* sq_ = src2 + (size_t)q * 2 * 1024 * 128;
        lo = *(const uint32_t*)(sq_ + 2 * j); hi = *(const uint32_t*)(sq_ + 32 + 2 * j); a0 += bflo(lo); a1 += bfhi(lo); b0 += bflo(hi); b1 += bfhi(hi);
      }
    }
    for (int sidx = 0; sidx < nbias; ++sidx) {
      const float* bb = bias + sidx * 64;
      a0 += bb[2 * j]; a1 += bb[2 * j + 1]; b0 += bb[32 + 2 * j]; b1 += bb[33 + 2 * j];
    }
  }
  float ss = a0 * a0 + a1 * a1 + b0 * b0 + b1 * b1;
  ss = sum16(ss);
  const float r = rsqrtf(ss * (1.f / 64.f) + EPS);
  if (active) {
    a0 *= r * gain[2 * j]; a1 *= r * gain[2 * j + 1]; b0 *= r * gain[32 + 2 * j]; b1 *= r * gain[33 + 2 * j];
    if (rp) {
      const float2 c0 = rp[2 * j], c1 = rp[2 * j + 1];
      const float t0 = a0 * c0.x - b0 * c0.y, u0 = b0 * c0.x + a0 * c0.y;
      const float t1 = a1 * c1.x - b1 * c1.y, u1 = b1 * c1.x + a1 * c1.y;
      a0 = t0; b0 = u0; a1 = t1; b1 = u1;
    }
    *(uint32_t*)(dst + 2 * j) = pack2(a0 * scale, a1 * scale);
    *(uint32_t*)(dst + 32 + 2 * j) = pack2(b0 * scale, b1 * scale);
  }
}
template <int G>
DI void nr4(uint32_t lo, uint32_t hi, float invn, float g0, float g1, float g2, float g3, bool rope, float2 c0, float2 c1, float scale,
            uint32_t& olo, uint32_t& ohi) {
  float a0 = bflo(lo), a1 = bfhi(lo), b0 = bflo(hi), b1 = bfhi(hi);
  float ss = a0 * a0 + a1 * a1 + b0 * b0 + b1 * b1;
  ss = (G == 16) ? sum16(ss) : sum8(ss);
  const float r = rsqrtf(ss * invn + EPS);
  a0 *= r * g0; a1 *= r * g1; b0 *= r * g2; b1 *= r * g3;
  if (rope) {
    const float t0 = a0 * c0.x - b0 * c0.y, u0 = b0 * c0.x + a0 * c0.y;
    const float t1 = a1 * c1.x - b1 * c1.y, u1 = b1 * c1.x + a1 * c1.y;
    a0 = t0; b0 = u0; a1 = t1; b1 = u1;
  }
  olo = pack2(a0 * scale, a1 * scale); ohi = pack2(b0 * scale, b1 * scale);
}

struct PrepR {
  uint32_t q_lo, q_hi, p2_lo, p2_hi, p3_lo, p3_hi, dq_lo, dq_hi, dk_lo, dk_hi, glv, ckw, uqa, uqb, kra, krb;
  uint2 cw, nw, kw2, vw;
  float2 c0, c1, e0, e1;
};
struct PrepG {
  float gq0, gq1, gq2, gq3, h0, h1, h2, h3, m0, m1, m2, m3, dq0, dq1, dq2, dq3, dk0, dk1, dk2, dk3;
  float mgq0, mgq1, mgq2, mgq3, mgq4, mgq5, mgk0, mgk1, mgk2, mgk3, mgk4, mgk5;
};
DI void prep_load(char* ws, int t, int lane, PrepR& R) {
  const int j16 = lane & 15, g16 = lane >> 4, j8 = lane & 7, g8 = lane >> 3;
  const int s = t & 2047;
  const bf16* ur = (const bf16*)(ws + OFF_U) + (size_t)t * NP;
  const float2* rp = (const float2*)(ws + OFF_ROPE) + s * 32;
  const int col2 = g16 == 0 ? C_KS : (g16 == 1 ? C_KW : C_MQ + (g16 - 2) * 64);
  const int col3 = C_MQ + (2 + (g16 & 1)) * 64;
  const bf16* uq = (const bf16*)(ws + OFF_UQ + (size_t)(t >> 11) * SLAB) + (size_t)s * 384 + g16 * 96;
  const bf16* uk = (const bf16*)(ws + OFF_UKV + (size_t)(t >> 11) * SLAB) + (size_t)s * 512 + g16 * 128;
  R.q_lo = *(const uint32_t*)(ur + C_NQ + g16 * 64 + 2 * j16); R.q_hi = *(const uint32_t*)(ur + C_NQ + g16 * 64 + 32 + 2 * j16);
  R.p2_lo = *(const uint32_t*)(ur + col2 + 2 * j16); R.p2_hi = *(const uint32_t*)(ur + col2 + 32 + 2 * j16);
  R.p3_lo = *(const uint32_t*)(ur + col3 + 2 * j16); R.p3_hi = *(const uint32_t*)(ur + col3 + 32 + 2 * j16);
  R.dq_lo = *(const uint32_t*)(ur + C_DQ + g8 * 32 + 2 * j8); R.dq_hi = *(const uint32_t*)(ur + C_DQ + g8 * 32 + 16 + 2 * j8);
  R.dk_lo = *(const uint32_t*)(ur + C_DK + g8 * 32 + 2 * j8); R.dk_hi = *(const uint32_t*)(ur + C_DK + g8 * 32 + 16 + 2 * j8);
  R.glv = ur[C_GL + (lane < 12 ? lane : 0)];
  R.cw = *(const uint2*)(ur + C_CQ + lane * 4);
  R.ckw = *(const uint32_t*)(ur + C_CKV + lane * 2);
  R.nw = *(const uint2*)(uq + 4 * j16);
  R.uqa = uq[64 + j16]; R.uqb = uq[80 + j16];
  R.kw2 = *(const uint2*)(uk + 4 * j16);
  R.vw = *(const uint2*)(uk + 64 + 4 * j16);
  R.kra = ur[C_KR + j16]; R.krb = ur[C_KR + 16 + j16];
  R.c0 = rp[2 * j16]; R.c1 = rp[2 * j16 + 1];
  R.e0 = rp[4 * j8]; R.e1 = rp[4 * j8 + 2];
}
DI void prep_fin(char* ws, int t, int lane, const PrepR& R, const PrepG& G) {
  const int j16 = lane & 15, g16 = lane >> 4, j8 = lane & 7, g8 = lane >> 3;
  const float qs64 = 0.125f * LOG2E, qs32 = 0.17677669529663687f * LOG2E, qs96 = 0.10206207261596577f * LOG2E;
  const int b = t >> 11, s = t & 2047;
  bf16* ur = (bf16*)(ws + OFF_U) + (size_t)t * NP;
  const int col2 = g16 == 0 ? C_KS : (g16 == 1 ? C_KW : C_MQ + (g16 - 2) * 64);
  const int col3 = C_MQ + (2 + (g16 & 1)) * 64;
  const float2 c0 = R.c0, c1 = R.c1, e0 = R.e0, e1 = R.e1;
  uint32_t olo, ohi;
  nr4<16>(R.q_lo, R.q_hi, 1.f / 64.f, G.gq0, G.gq1, G.gq2, G.gq3, true, c0, c1, qs64, olo, ohi);
  *(uint32_t*)(ur + C_NQ + g16 * 64 + 2 * j16) = olo; *(uint32_t*)(ur + C_NQ + g16 * 64 + 32 + 2 * j16) = ohi;
  nr4<16>(R.p2_lo, R.p2_hi, 1.f / 64.f, G.h0, G.h1, G.h2, G.h3, g16 < 2, c0, c1, g16 < 2 ? 1.f : qs64, olo, ohi);
  *(uint32_t*)(ur + col2 + 2 * j16) = olo; *(uint32_t*)(ur + col2 + 32 + 2 * j16) = ohi;
  nr4<16>(R.p3_lo, R.p3_hi, 1.f / 64.f, G.m0, G.m1, G.m2, G.m3, false, c0, c1, qs64, olo, ohi);
  if (g16 < 2) { *(uint32_t*)(ur + col3 + 2 * j16) = olo; *(uint32_t*)(ur + col3 + 32 + 2 * j16) = ohi; }
  nr4<8>(R.dq_lo, R.dq_hi, 1.f / 32.f, G.dq0, G.dq1, G.dq2, G.dq3, true, e0, e1, qs32, olo, ohi);
  *(uint32_t*)(ur + C_DQ + g8 * 32 + 2 * j8) = olo; *(uint32_t*)(ur + C_DQ + g8 * 32 + 16 + 2 * j8) = ohi;
  nr4<8>(R.dk_lo, R.dk_hi, 1.f / 32.f, G.dk0, G.dk1, G.dk2, G.dk3, true, e0, e1, 1.f, olo, ohi);
  *(uint32_t*)(ur + C_DK + g8 * 32 + 2 * j8) = olo; *(uint32_t*)(ur + C_DK + g8 * 32 + 16 + 2 * j8) = ohi;
  if (lane < 12) ((float*)(ws + OFF_GT))[(size_t)t * 12 + lane] = sigmoidf_(bf2f(R.glv));
  float sq, skv;
  {
    float c0f = bflo(R.cw.x), c1f = bfhi(R.cw.x), c2f = bflo(R.cw.y), c3f = bfhi(R.cw.y);
    float ss = c0f * c0f + c1f * c1f + c2f * c2f + c3f * c3f;
    float d0 = bflo(R.ckw), d1 = bfhi(R.ckw);
    float s2 = d0 * d0 + d1 * d1;
    ss = sum64(ss); s2 = sum64(s2);
    sq = rsqrtf(ss * (1.f / 256.f) + EPS);
    skv = rsqrtf(s2 * (1.f / 128.f) + EPS);
  }
  {
    const int h = g16, j = j16;
    float n0 = bflo(R.nw.x) * sq, n1 = bfhi(R.nw.x) * sq, n2 = bflo(R.nw.y) * sq, n3 = bfhi(R.nw.y) * sq;
    float ra = bf2f(R.uqa) * sq, rb = bf2f(R.uqb) * sq;
    float r1 = ra * c0.x - rb * c0.y, r2 = rb * c0.x + ra * c0.y;
    float ss = n0 * n0 + n1 * n1 + n2 * n2 + n3 * n3 + r1 * r1 + r2 * r2;
    ss = sum16(ss);
    float r = rsqrtf(ss * (1.f / 96.f) + EPS) * qs96;
    bf16* qd = (bf16*)(ws + OFF_QM) + ((size_t)(b * 4 + h) * S + s) * 96;
    uint2 o; o.x = pack2(n0 * r * G.mgq0, n1 * r * G.mgq1); o.y = pack2(n2 * r * G.mgq2, n3 * r * G.mgq3);
    *(uint2*)(qd + 4 * j) = o;
    qd[64 + j] = f2bf(r1 * r * G.mgq4);
    qd[80 + j] = f2bf(r2 * r * G.mgq5);
    float k0 = bflo(R.kw2.x) * skv, k1 = bfhi(R.kw2.x) * skv, k2 = bflo(R.kw2.y) * skv, k3 = bfhi(R.kw2.y) * skv;
    float ka = bf2f(R.kra), kb = bf2f(R.krb);
    float kr1 = ka * c0.x - kb * c0.y, kr2 = kb * c0.x + ka * c0.y;
    float s3 = k0 * k0 + k1 * k1 + k2 * k2 + k3 * k3 + kr1 * kr1 + kr2 * kr2;
    s3 = sum16(s3);
    float rk_ = rsqrtf(s3 * (1.f / 96.f) + EPS);
    bf16* kd = (bf16*)(ws + OFF_KM) + ((size_t)(b * 4 + h) * S + s) * 96;
    uint2 o2; o2.x = pack2(k0 * rk_ * G.mgk0, k1 * rk_ * G.mgk1); o2.y = pack2(k2 * rk_ * G.mgk2, k3 * rk_ * G.mgk3);
    *(uint2*)(kd + 4 * j) = o2;
    kd[64 + j] = f2bf(kr1 * rk_ * G.mgk4);
    kd[80 + j] = f2bf(kr2 * rk_ * G.mgk5);
    uint2 o3; o3.x = pack2(bflo(R.vw.x) * skv, bfhi(R.vw.x) * skv); o3.y = pack2(bflo(R.vw.y) * skv, bfhi(R.vw.y) * skv);
    *(uint2*)((bf16*)(ws + OFF_MV) + ((size_t)(b * 4 + h) * S + s) * 64 + 4 * j) = o3;
  }
}

DI void prep_phase(const Params& p, int layer) {
  const int tid = opq(threadIdx.x), lane = tid & 63, wv = tid >> 6;
  char* ws = opqp(p.ws);
  const float2* rope = (const float2*)(ws + OFF_ROPE);
  const float* nsa_g = p.in[5] + layer * 256;
  const float* diff_g = p.in[8] + layer * 64;
  const float* mla_g = p.in[15] + layer * 192;
  const float* mem_g = p.in[18] + layer * 128;
  constexpr int N_TOK = T / 4, N_MEMT = TM / 4, N_CMP = 1024 / 4;
  const int j16 = lane & 15, g16 = lane >> 4, j8 = lane & 7;
  PrepG G;
  G.gq0 = nsa_g[2 * j16]; G.gq1 = nsa_g[2 * j16 + 1]; G.gq2 = nsa_g[32 + 2 * j16]; G.gq3 = nsa_g[33 + 2 * j16];
  const float* g2p = g16 == 0 ? nsa_g + 128 : (g16 == 1 ? nsa_g + 192 : mem_g);
  G.h0 = g2p[2 * j16]; G.h1 = g2p[2 * j16 + 1]; G.h2 = g2p[32 + 2 * j16]; G.h3 = g2p[33 + 2 * j16];
  G.m0 = mem_g[2 * j16]; G.m1 = mem_g[2 * j16 + 1]; G.m2 = mem_g[32 + 2 * j16]; G.m3 = mem_g[33 + 2 * j16];
  G.dq0 = diff_g[2 * j8]; G.dq1 = diff_g[2 * j8 + 1]; G.dq2 = diff_g[16 + 2 * j8]; G.dq3 = diff_g[17 + 2 * j8];
  G.dk0 = diff_g[32 + 2 * j8]; G.dk1 = diff_g[33 + 2 * j8]; G.dk2 = diff_g[48 + 2 * j8]; G.dk3 = diff_g[49 + 2 * j8];
  G.mgq0 = mla_g[4 * j16]; G.mgq1 = mla_g[4 * j16 + 1]; G.mgq2 = mla_g[4 * j16 + 2]; G.mgq3 = mla_g[4 * j16 + 3];
  G.mgq4 = mla_g[64 + j16]; G.mgq5 = mla_g[80 + j16];
  G.mgk0 = mla_g[96 + 4 * j16]; G.mgk1 = mla_g[96 + 4 * j16 + 1]; G.mgk2 = mla_g[96 + 4 * j16 + 2]; G.mgk3 = mla_g[96 + 4 * j16 + 3];
  G.mgk4 = mla_g[96 + 64 + j16]; G.mgk5 = mla_g[96 + 80 + j16];
  const int xcd = blockIdx.x & 7, rk = blockIdx.x >> 3, nrk = gridDim.x >> 3;
  for (int i = rk; i < 512; i += 2 * nrk) {
    const int it = xcd * 512 + i;
    const bool has2 = i + nrk < 512;
    const int it2 = has2 ? it + nrk : it;
    const int tA = it * 4 + wv, tB = it2 * 4 + wv;
    PrepR A, B;
    prep_load(ws, tA, lane, A);
    prep_load(ws, tB, lane, B);
    prep_fin(ws, tA, lane, A, G);
    if (has2) prep_fin(ws, tB, lane, B, G);
  }
  for (int i = rk; i < 96; i += nrk) {
    const int it = i < 64 ? N_TOK + xcd * 64 + i : N_TOK + N_MEMT + xcd * 32 + (i - 64);
    if (false) {
    } else if (it < N_TOK + N_MEMT) {
      const int t = (it - N_TOK) * 4 + wv;
      const int b = t >> 8, mi = t & 255;
      const bf16* kr = (const bf16*)(ws + OFF_KMEMRAW) + (size_t)t * 512;
      const int h = lane >> 4;
      uint2 vw = *(const uint2*)(kr + 256 + lane * 4);
      vec64(true, kr + h * 64, nullptr, 0, (bf16*)(ws + OFF_MK) + ((size_t)(b * 4 + h) * ML + mi) * 64, mem_g + 64, nullptr, 1.f, j16);
      *(uint2*)((bf16*)(ws + OFF_MVV) + ((size_t)(b * 4 + h) * ML + mi) * 64 + j16 * 4) = vw;
    } else {
      const int r = (it - N_TOK - N_MEMT) * 4 + wv;
      const int n = r & 127;
      const bf16* kraw = (const bf16*)(ws + OFF_CMPRAW) + (size_t)r * 128;
      const bf16* vraw = (const bf16*)(ws + OFF_CMPRAW) + (size_t)(1024 + r) * 128;
      const float* cbk = (const float*)(ws + OFF_CBF) + (layer * 2 + 0) * 64;
      const float* cbv = (const float*)(ws + OFF_CBF) + (layer * 2 + 1) * 64;
      bf16* kd = (bf16*)(ws + OFF_KCN) + (size_t)r * 64;
      bf16* vd = (bf16*)(ws + OFF_VCN) + (size_t)r * 64;
      if (n < 127) {
        const int pos = 16 * n + 31;
        const float bv = cbv[lane];
        const float vv = bf2f(vraw[lane]) + bf2f(vraw[(size_t)2 * 1024 * 128 + lane]) + bf2f(vraw[(size_t)4 * 1024 * 128 + lane]) + bf2f(vraw[(size_t)6 * 1024 * 128 + lane]) + bv;
        vec64(lane < 16, kraw, cbk, 1, kd, nsa_g + 64, rope + pos * 32, 1.f, lane & 15, kraw + (size_t)2 * 1024 * 128);
        vd[lane] = f2bf(vv);
      } else {
        kd[lane] = 0; vd[lane] = 0;
      }
    }
  }
}

DI void pl_swap(uint32_t& a, uint32_t& b) { auto r_ = __builtin_amdgcn_permlane32_swap(a, b, false, false); a = r_[0]; b = r_[1]; }
DI void ld_own(const bf16* p, uint2& lo, uint2& hi) {
  const uint4 w = *(const uint4*)p;
  lo.x = w.x; lo.y = w.y; hi.x = w.z; hi.y = w.w;
  pl_swap(lo.x, hi.x); pl_swap(lo.y, hi.y);
}
template <int MODE>
DI void attn_epi(const f32x16 (&O)[2], float scale, const bf16* zrow, const float* sg, const bf16* a1row, const bf16* a2row, bf16* orow, int half) {
#pragma unroll
  for (int dvb = 0; dvb < 2; ++dvb)
#pragma unroll
    for (int pq = 0; pq < 2; ++pq) {
      const int col16 = dvb * 32 + 16 * pq + 8 * half;
      const int dvA = dvb * 32 + 16 * pq + 4 * half;
      float va[4], vb[4];
#pragma unroll
      for (int e = 0; e < 4; ++e) { va[e] = O[dvb][8 * pq + e] * scale; vb[e] = O[dvb][8 * pq + 4 + e] * scale; }
      if (MODE == 2) {
#pragma unroll
        for (int e = 0; e < 4; ++e) { va[e] *= sg[dvA + e]; vb[e] *= sg[dvA + 8 + e]; }
      }
      if (MODE == 3) {
        uint2 clo, chi, wlo, whi;
        ld_own(a1row + col16, clo, chi);
        ld_own(a2row + col16, wlo, whi);
        va[0] += bflo(clo.x) + bflo(wlo.x); va[1] += bfhi(clo.x) + bfhi(wlo.x); va[2] += bflo(clo.y) + bflo(wlo.y); va[3] += bfhi(clo.y) + bfhi(wlo.y);
        vb[0] += bflo(chi.x) + bflo(whi.x); vb[1] += bfhi(chi.x) + bfhi(whi.x); vb[2] += bflo(chi.y) + bflo(whi.y); vb[3] += bfhi(chi.y) + bfhi(whi.y);
      }
      if (MODE >= 1) {
        uint2 zlo, zhi;
        ld_own(zrow + col16, zlo, zhi);
        va[0] *= siluf_(bflo(zlo.x)); va[1] *= siluf_(bfhi(zlo.x)); va[2] *= siluf_(bflo(zlo.y)); va[3] *= siluf_(bfhi(zlo.y));
        vb[0] *= siluf_(bflo(zhi.x)); vb[1] *= siluf_(bfhi(zhi.x)); vb[2] *= siluf_(bflo(zhi.y)); vb[3] *= siluf_(bfhi(zhi.y));
      }
      uint32_t A0 = pack2(va[0], va[1]), A1 = pack2(va[2], va[3]), B0 = pack2(vb[0], vb[1]), B1 = pack2(vb[2], vb[3]);
      pl_swap(A0, B0); pl_swap(A1, B1);
      uint4 o; o.x = A0; o.y = A1; o.z = B0; o.w = B1;
      *(uint4*)(orow + col16) = o;
    }
}
DI void st4(bf16* dst, float a, float b, float c, float d) { uint2 o; o.x = pack2(a, b); o.y = pack2(c, d); *(uint2*)dst = o; }

DI void attn_phaseA(const Params& p, int layer, char* smem, int* ctr) {
  char* ws = opqp(p.ws);
  bf16* u = (bf16*)(ws + OFF_U);
  bf16* y = (bf16*)(ws + OFF_Y);
  const float* gt = (const float*)(ws + OFF_GT);
  int* s_item = (int*)(smem + SM_MISC);
  const int xcd = blockIdx.x & 7;
  while (true) {
    __syncthreads();
    if (threadIdx.x == 0) *s_item = atomicAdd(ctr + 24 + xcd, 1);
    __syncthreads();
    const int item = *s_item;
    if (item >= 16) break;
    {
      const int tid = opq(threadIdx.x), lane = tid & 63, wv = tid >> 6, half = lane >> 5, l31 = lane & 31;
      const int i2 = item;
      const int qb = 15 - i2, b = xcd;
      const int q0 = qb * 128, qpos = q0 + wv * 32 + l31;
      const size_t t = (size_t)b * S + qpos;
      const bf16* ub = u + (size_t)b * S * NP;
      const bf16* kc = (const bf16*)(ws + OFF_KCN) + (size_t)b * 128 * 64;
      const bf16* vc = (const bf16*)(ws + OFF_VCN) + (size_t)b * 128 * 64;
      const uint32_t tm = (q0 + 127 >= 16 * 64 + 31) ? 3u : 1u;
      float* scl = (float*)(smem + SM_SC) + wv * 32 * 33;
#pragma unroll
      for (int g = 0; g < 16; ++g) scl[l31 * 33 + 2 * g + half] = 0.f;
      const int khi = (qpos - 31) >> 4;
#pragma unroll 1
      for (int h = 0; h < 4; ++h) {
        f32x16 O[2]; float mm, ll;
        bf16x8 Qf[4];
        load_q<64>(ub + (size_t)qpos * NP + C_NQ + h * 64, Qf);
        attn_core<64>(kc, 64, vc, 64, tm, AM_CMP, qpos, 0u, Qf, O, mm, ll, smem);
        const float inv = ll > 0.f ? 1.f / ll : 0.f;
        const float sc = inv * gt[t * 12 + h];
        bf16* od = (bf16*)(ws + OFF_OCMP) + t * 256 + h * 64;
        attn_epi<0>(O, sc, nullptr, nullptr, nullptr, nullptr, od, half);
        const float mu = mm < -1e29f ? 0.f : mm;
        const bf16* Ks = (const bf16*)smem;
        float Aa[16], Cc[16];
#pragma unroll
        for (int g = 0; g < 16; ++g) { Aa[g] = 0.f; Cc[g] = 0.f; }
#pragma unroll
        for (int kt = 0; kt < 2; ++kt) {
          if (tm & (1u << kt)) {
#pragma unroll
            for (int kb = 0; kb < 2; ++kb) {
              f32x16 Sx;
#pragma unroll
              for (int i = 0; i < 16; ++i) Sx[i] = 0.f;
#pragma unroll
              for (int kcx = 0; kcx < 4; ++kcx) {
                bf16x8 a = *(const bf16x8*)(Ks + (kt * 64 + kb * 32 + l31) * 72 + kcx * 16 + half * 8);
                Sx = MFMA(a, Qf[kcx], Sx);
              }
#pragma unroll
              for (int gg = 0; gg < 4; ++gg) {
                float pv[4];
#pragma unroll
                for (int e = 0; e < 4; ++e) {
                  const int key = kt * 64 + kb * 32 + gg * 8 + half * 4 + e;
                  pv[e] = key <= khi ? fexp2(Sx[gg * 4 + e] - mu) * inv : 0.f;
                }
                Aa[kt * 8 + kb * 4 + gg] += pv[0] + 2.f * (pv[1] + pv[2] + pv[3]);
                Cc[kt * 8 + kb * 4 + gg] += pv[0];
              }
            }
          }
        }
        {
          float rc[16];
#pragma unroll
          for (int g = 0; g < 16; ++g) rc[g] = shx(Cc[g], 32);
#pragma unroll
          for (int g = 0; g < 16; ++g) {
            const float nx = half == 0 ? rc[g] : (g < 15 ? rc[g < 15 ? g + 1 : 15] : 0.f);
            scl[l31 * 33 + 2 * g + half] += Aa[g] + nx;
          }
        }
      }
      __syncthreads();
      {
        float sv[32];
        const int cur = qpos >> 6;
#pragma unroll
        for (int j = 0; j < 32; ++j) {
          float v = scl[l31 * 33 + j];
          const bool forced = (j == 0) || (j == cur) || (j == cur - 1);
          sv[j] = j > cur ? -1e30f : (forced ? 1e30f : v);
        }
        uint32_t bits = 0;
#pragma unroll 1
        for (int jj = 0; jj < 16; ++jj) {
          const int j = half * 16 + jj;
          float sj = scl[l31 * 33 + j];
          const bool fj = (j == 0) || (j == cur) || (j == cur - 1);
          sj = j > cur ? -1e30f : (fj ? 1e30f : sj);
          int rank = 0;
#pragma unroll
          for (int i = 0; i < 32; ++i) rank += (sv[i] > sj || (sv[i] == sj && i < j)) ? 1 : 0;
          if (rank < 16) bits |= 1u << j;
        }
        bits |= (uint32_t)__shfl_xor((int)bits, 32);
        if (half == 0) ((uint32_t*)(ws + OFF_SEL))[t] = bits;
      }
      wg_publish((unsigned*)(ws + OFF_FLAG) + layer * 1024 + (b * 16 + qb) * 8);
    }
  }
  while (true) {
    __syncthreads();
    if (threadIdx.x == 0) *s_item = atomicAdd(ctr + 16 + xcd, 1);
    __syncthreads();
    const int item = *s_item;
    if (item >= 128) break;
    {
      const int tid = opq(threadIdx.x), lane = tid & 63, wv = tid >> 6, half = lane >> 5, l31 = lane & 31;
      const int i2 = item;
      const int ismem = i2 >> 6, r = i2 & 63, qb = 15 - (r >> 2), b = xcd, h = r & 3;
      const int q0 = qb * 128, qpos = q0 + wv * 32 + l31;
      const size_t t = (size_t)b * S + qpos;
      const bf16* ub = u + (size_t)b * S * NP;
      f32x16 O[2]; float mm, ll;
      bf16x8 Qf[4];
      if (!ismem) {
        load_q<64>(ub + (size_t)qpos * NP + C_NQ + h * 64, Qf);
        const int kt0 = q0 >= 512 ? (q0 - 512) / 64 : 0, kt1 = 2 * qb + 2;
        const uint32_t hi = kt1 >= 32 ? 0xffffffffu : ((1u << kt1) - 1u);
        const uint32_t tm = hi & ~((1u << kt0) - 1u);
        attn_core<64>(ub + C_KW, NP, ub + C_VW, NP, tm, AM_WIN, qpos, 0u, Qf, O, mm, ll, smem);
        const float sc = (ll > 0.f ? 1.f / ll : 0.f) * gt[t * 12 + 8 + h];
        bf16* od = (bf16*)(ws + OFF_OWIN) + t * 256 + h * 64;
        attn_epi<0>(O, sc, nullptr, nullptr, nullptr, nullptr, od, half);
        wg_publish((unsigned*)(ws + OFF_FLAG) + layer * 1024 + (b * 16 + qb) * 8 + 1 + h);
      } else {
        load_q<64>(ub + (size_t)qpos * NP + C_MQ + h * 64, Qf);
        attn_core<64>((const bf16*)(ws + OFF_MK) + (size_t)(b * 4 + h) * ML * 64, 64, (const bf16*)(ws + OFF_MVV) + (size_t)(b * 4 + h) * ML * 64, 64,
                      0xfu, AM_NONE, qpos, 0u, Qf, O, mm, ll, smem);
        const float inv = ll > 0.f ? 1.f / ll : 0.f;
        attn_epi<1>(O, inv, u + t * NP + C_MEZ + h * 64, nullptr, nullptr, nullptr, y + t * 1024 + 768 + h * 64, half);
      }
    }
  }
  while (true) {
    __syncthreads();
    if (threadIdx.x == 0) *s_item = atomicAdd(ctr + xcd, 1);
    __syncthreads();
    const int item = *s_item;
    if (item >= 64) break;
    {
      const int tid = opq(threadIdx.x), lane = tid & 63, wv = tid >> 6, half = lane >> 5, l31 = lane & 31;
      const int qb = 15 - (item >> 2), b = xcd, h = item & 3;
      const int q0 = qb * 128, qpos = q0 + wv * 32 + l31;
      const size_t t = (size_t)b * S + qpos;
      const uint32_t tm = (qb == 15) ? 0xffffffffu : ((1u << (2 * qb + 2)) - 1u);
      f32x16 O[2]; float mm, ll;
        bf16x8 Qf[6];
        const bf16* qm = (const bf16*)(ws + OFF_QM) + (size_t)(b * 4 + h) * S * 96;
        load_q<96>(qm + (size_t)qpos * 96, Qf);
        attn_core<96>((const bf16*)(ws + OFF_KM) + (size_t)(b * 4 + h) * S * 96, 96,
                      (const bf16*)(ws + OFF_MV) + (size_t)(b * 4 + h) * S * 64, 64, tm, AM_CAUSAL, qpos, 0u, Qf, O, mm, ll, smem);
        const float inv = ll > 0.f ? 1.f / ll : 0.f;
        attn_epi<1>(O, inv, u + t * NP + C_MZ + h * 64, nullptr, nullptr, nullptr, y + t * 1024 + 512 + h * 64, half);
    }
  }
  while (true) {
    __syncthreads();
    if (threadIdx.x == 0) *s_item = atomicAdd(ctr + 8 + xcd, 1);
    __syncthreads();
    const int item = *s_item;
    if (item >= 64) break;
    {
      const int tid = opq(threadIdx.x), lane = tid & 63, wv = tid >> 6, half = lane >> 5, l31 = lane & 31;
      const int qb = 15 - (item >> 2), b = xcd, h = item & 3;
      const int q0 = qb * 128, qpos = q0 + wv * 32 + l31;
      const size_t t = (size_t)b * S + qpos;
      const uint32_t tm = (qb == 15) ? 0xffffffffu : ((1u << (2 * qb + 2)) - 1u);
      f32x16 O[2]; float mm, ll;
        f32x16 O1[2];
        const bf16* ub = u + (size_t)b * S * NP;
        {
          bf16x8 Qf[4];
          float l1, l2;
          load_q<64>(ub + (size_t)qpos * NP + C_DQ + h * 64, Qf);
          attn_core_dual<64>(ub + C_DK + h * 64, NP, ub + C_DV + h * 64, NP, tm, AM_CAUSAL, qpos, 0u, Qf, O1, O, l1, l2, smem);
          const float inv1 = l1 > 0.f ? 1.f / l1 : 0.f, inv = l2 > 0.f ? 1.f / l2 : 0.f;
#pragma unroll
          for (int i = 0; i < 16; ++i) { O1[0][i] *= inv1; O1[1][i] *= inv1; }
          {
            const float lam = ((const float*)(ws + OFF_LAM))[layer];
            float ss = 0.f;
#pragma unroll
            for (int i = 0; i < 16; ++i) {
              O1[0][i] -= lam * O[0][i] * inv; O1[1][i] -= lam * O[1][i] * inv;
              ss += O1[0][i] * O1[0][i] + O1[1][i] * O1[1][i];
            }
            ss += shx(ss, 32);
            const float li = opq(layer) == 0 ? 0.2f : 0.35550907f;
            const float r = rsqrtf(ss * (1.f / 64.f) + EPS) * (1.f - li);
            const float* sg = p.in[10] + layer * 64;
            attn_epi<2>(O1, r, u + t * NP + C_DZ + h * 64, sg, nullptr, nullptr, y + t * 1024 + 256 + h * 64, half);
          }
        }
    }
  }
}

DI void attn_phaseB(const Params& p, int layer, char* smem, int* ctr) {
  const int tid = opq(threadIdx.x), lane = tid & 63, wv = tid >> 6, half = lane >> 5, l31 = lane & 31;
  char* ws = opqp(p.ws);
  bf16* u = (bf16*)(ws + OFF_U);
  bf16* y = (bf16*)(ws + OFF_Y);
  const float* gt = (const float*)(ws + OFF_GT);
  int* s_item = (int*)(smem + SM_MISC);
  uint32_t* s_or = (uint32_t*)(smem + SM_MISC + 16);
  const int xcd = blockIdx.x & 7;
  while (true) {
    __syncthreads();
    if (tid == 0) { *s_item = atomicAdd(ctr + xcd, 1); *s_or = 0u; }
    __syncthreads();
    const int item = *s_item;
    if (item >= 64) break;
    const int qb = 15 - (item >> 2), b = xcd, h = item & 3;
    const int q0 = qb * 128, qpos = q0 + wv * 32 + l31;
    const size_t t = (size_t)b * S + qpos;
    const bf16* ub = u + (size_t)b * S * NP;
    wg_wait2((unsigned*)(ws + OFF_FLAG) + layer * 1024 + (b * 16 + qb) * 8, (unsigned*)(ws + OFF_FLAG) + layer * 1024 + (b * 16 + qb) * 8 + 1 + h);
    const uint32_t sel = ((const uint32_t*)(ws + OFF_SEL))[t];
    const uint32_t causal = (qb == 15) ? 0xffffffffu : ((1u << (2 * qb + 2)) - 1u);
    if (half == 0) atomicOr(s_or, sel);
    __syncthreads();
    const uint32_t tm = (*s_or & causal) | 1u;
    f32x16 O[2]; float mm, ll;
    bf16x8 Qf[4];
    load_q<64>(ub + (size_t)qpos * NP + C_NQ + h * 64, Qf);
    attn_core<64>(ub + C_KS, NP, ub + C_VS, NP, tm, AM_SLC, qpos, sel, Qf, O, mm, ll, smem);
    const float sc = (ll > 0.f ? 1.f / ll : 0.f) * gt[t * 12 + 4 + h];
    const bf16* oc = (const bf16*)(ws + OFF_OCMP) + t * 256 + h * 64;
    const bf16* ow = (const bf16*)(ws + OFF_OWIN) + t * 256 + h * 64;
    attn_epi<3>(O, sc, u + t * NP + C_NZ + h * 64, nullptr, oc, ow, y + t * 1024 + h * 64, half);
  }
  (void)layer;
}

__global__ void __launch_bounds__(256, 2) fwd_megakernel(Params p) {
  __shared__ __attribute__((aligned(16))) char smem[SMEM_BYTES];
  cg::grid_group grid = cg::this_grid();
  char* ws = opqp(p.ws);
  int* ctrs = (int*)(ws + OFF_CTR);
  __shared__ uint4 xb_words;
  if (threadIdx.x == 0) xb_words = make_uint4(0u, 0u, 0u, 0u);
  __syncthreads();
  XcdBarrier xb = xcd_barrier_post((unsigned*)(ws + OFF_BAR), (volatile LAS unsigned*)&xb_words);
  phase0(p, smem);
  if (p.out == nullptr) grid.sync();
  xcd_barrier(xb);
  if (blockIdx.x == 0) {
    const int tq = opq(threadIdx.x);
    const float* cbp = (const float*)(opqp(p.ws) + OFF_CB) + (tq >> 6) * 16 * 64 + (tq & 63);
    float a = 0.f;
#pragma unroll
    for (int sidx = 0; sidx < 16; ++sidx) a += cbp[sidx * 64];
    ((float*)(opqp(p.ws) + OFF_CBF))[tq] = a;
  }
#define PBAR(K) xcd_barrier(xb)
  for (int layer = 0; layer < 2; ++layer) {
    bf16* u = (bf16*)(ws + OFF_U);
    {
      const bf16* xbp = (const bf16*)(ws + OFF_XB);
      const bf16* wi = (const bf16*)(ws + OFF_WI + layer * SZ_WI);
      const int xcd = blockIdx.x & 7, rk = blockIdx.x >> 3, nrk = gridDim.x >> 3;
      for (int q = rk; q < 216; q += nrk) {
        if (q < 192) {
          const int mt = xcd * 8 + (q & 7), nt = q >> 3;
          gemm_big(xbp + (size_t)mt * 256 * 1024, 1024, wi + (size_t)nt * 128 * 1024, 1024, 16, smem, EPI_RS8, u, NP, mt * 256,
                   (const float*)(ws + OFF_SSQ), nullptr, nullptr, nullptr, nullptr, nt);
        } else if (q < 208) {
          const int mt = xcd * 16 + (q - 192), nt = 24;
          gemm_tile<16>(xbp + (size_t)mt * 128 * 1024, 1024, 64, wi + (size_t)nt * 128 * 1024, 1024, 16, smem);
          gemm_epi(EPI_RS8, smem, u, NP, mt * 128, (const float*)(ws + OFF_SSQ), nullptr, nullptr, nullptr, nullptr, nt);
        } else {
          const int i = xcd * 8 + (q - 208), mt = i >> 2, nt = i & 3;
          gemm_tile<16>((const bf16*)(ws + OFF_MEMB) + (size_t)mt * 128 * 1024, 1024, 64,
                    (const bf16*)(ws + OFF_WMEM + layer * SZ_WMEM) + (size_t)nt * 128 * 1024, 1024, 16, smem);
          gemm_epi(EPI_RS1, smem, (bf16*)(ws + OFF_KMEMRAW), 512, mt * 128, (const float*)(ws + OFF_RMEM), nullptr, nullptr, nullptr, nullptr, nt);
        }
      }
    }
    PBAR(0);
    {
      const int xcd = blockIdx.x & 7, rk = blockIdx.x >> 3, nrk = gridDim.x >> 3;
      for (int q = rk; q < 64; q += nrk) {
        if (q < 8) {
          const int j = q >> 2, kh = q & 3, b = xcd;
          gemm_tile<8>(u + (size_t)b * S * NP + (j ? C_VC : C_KC) + (size_t)kh * 8 * NP, 16 * NP, NP,
                       (const bf16*)(ws + OFF_WCMP + (layer * 2 + j) * SZ_WCMP) + kh * 512, 2048, 8, smem);
          gemm_epi(EPI_PLAIN, smem, (bf16*)(ws + OFF_CMPRAW) + (size_t)(kh * 2 + j) * 1024 * 128, 128, b * 128, nullptr, nullptr, nullptr, nullptr, nullptr, 0);
        } else if (q < 32) {
          const int i = q - 8, ml = i / 3, nt = i % 3, mt = xcd * 8 + ml;
          gemm_big(u + (size_t)mt * 256 * NP + C_CQ, NP, (const bf16*)(ws + OFF_WUQ + layer * SZ_WUQ) + (size_t)nt * 128 * 256, 256, 4, smem, EPI_PLAIN,
                   (bf16*)(ws + OFF_UQ + (size_t)xcd * SLAB), 384, ml * 256, nullptr, nullptr, nullptr, nullptr, nullptr, nt);
        } else {
          const int i = q - 32, ml = i >> 2, nt = i & 3, mt = xcd * 8 + ml;
          gemm_big(u + (size_t)mt * 256 * NP + C_CKV, NP, (const bf16*)(ws + OFF_WUKV + layer * SZ_WUKV) + (size_t)nt * 128 * 128, 128, 2, smem, EPI_PLAIN,
                   (bf16*)(ws + OFF_UKV + (size_t)xcd * SLAB), 512, ml * 256, nullptr, nullptr, nullptr, nullptr, nullptr, nt);
        }
      }
    }
    PBAR(1);
    prep_phase(p, layer);
    PBAR(2);
    attn_phaseA(p, layer, smem, ctrs + layer * 64);
    attn_phaseB(p, layer, smem, ctrs + layer * 64 + 32);
    PBAR(3);
    {
      const bf16* yb = (const bf16*)(ws + OFF_Y);
      const bf16* wo = (const bf16*)(ws + OFF_WO + layer * SZ_WO);
      const float* xres = layer == 0 ? p.in[0] : nullptr;
      const int xcd = blockIdx.x & 7, rk = blockIdx.x >> 3, nrk = gridDim.x >> 3;
      for (int q = rk; q < 64; q += nrk) {
        const int mt = xcd * 8 + (q & 7), nt = q >> 3;
        gemm_big(yb + (size_t)mt * 256 * 1024, 1024, wo + (size_t)nt * 128 * 1024, 1024, 16, smem, EPI_OUT, (bf16*)(ws + OFF_XB), 0, mt * 256, nullptr, xres, layer == 0 ? nullptr : p.out,
                 layer == 0 ? (bf16*)(ws + OFF_XB) : nullptr, (float*)(ws + OFF_SSQ), nt);
      }
    }
    if (layer == 0) PBAR(4);
  }
}

extern "C" void kernel_launch(void* const* d_in, const int* in_sizes, int n_in, void* d_out, int out_size, void* d_ws, size_t ws_size,
                              hipStream_t stream) {
  static int grid_blocks = 0;
  if (!grid_blocks) {
    int dev = 0, cus = 0, per_cu = 0;
    hipGetDevice(&dev);
    hipDeviceGetAttribute(&cus, hipDeviceAttributeMultiprocessorCount, dev);
    hipOccupancyMaxActiveBlocksPerMultiprocessor(&per_cu, fwd_megakernel, 256, 0);
    if (per_cu > 2) per_cu = 2;
    grid_blocks = (cus * per_cu) & ~7;
  }
  if (ws_size < WS_TOTAL) { fprintf(stderr, "workspace too small: %zu < %zu\n", ws_size, (size_t)WS_TOTAL); return; }
  Params p{};
  for (int i = 0; i < 19; ++i) p.in[i] = (const float*)d_in[i];
  p.out = (float*)d_out;
  p.ws = (char*)d_ws;
  hipMemsetAsync((char*)d_ws + OFF_CTR, 0, 1024 + 16384 + 8192 + 2048, stream);
  void* args[] = {&p};
  hipError_t e = hipLaunchCooperativeKernel((void*)fwd_megakernel, dim3(grid_blocks), dim3(256), args, 0, stream);
  if (e != hipSuccess) fprintf(stderr, "cooperative launch failed: %s (grid %d)\n", hipGetErrorString(e), grid_blocks);
}
```

```cpp
#include <hip/hip_runtime.h>
#include <hip/hip_cooperative_groups.h>
#include <stdint.h>
#include <cstdio>
namespace cg = cooperative_groups;

typedef unsigned short bf16;
using bf16x8 = __attribute__((ext_vector_type(8))) short;
using f32x16 = __attribute__((ext_vector_type(16))) float;
typedef __bf16 hbf2 __attribute__((ext_vector_type(2)));
typedef float hf2 __attribute__((ext_vector_type(2)));
typedef uint32_t u32x4 __attribute__((ext_vector_type(4)));
#define GLD16(dst, ptr) asm volatile("global_load_dwordx4 %0, %1, off" : "=&v"(dst) : "v"(ptr) : "memory")
#define WAIT_VM0() asm volatile("s_waitcnt vmcnt(0)" ::: "memory")
#define DI __device__ __forceinline__
#define MFMA(a, b, c) __builtin_amdgcn_mfma_f32_32x32x16_bf16((a), (b), (c), 0, 0, 0)

constexpr int Bn = 8, S = 2048, T = 16384, D = 1024, NP = 3200, ML = 256, TM = 2048;
constexpr float EPS = 1e-6f;
constexpr float LOG2E = 1.4426950408889634f;
constexpr int C_NQ = 0, C_KC = 256, C_VC = 320, C_KS = 384, C_VS = 448, C_KW = 512, C_VW = 576, C_NZ = 640,
              C_DQ = 896, C_DK = 1152, C_DV = 1408, C_DZ = 1664, C_CQ = 1920, C_CKV = 2176, C_KR = 2304,
              C_MZ = 2336, C_MQ = 2592, C_MEZ = 2848, C_GL = 3104;
constexpr size_t SZ_WI = (size_t)NP * 1024 * 2, SZ_WO = 1024 * 1024 * 2, SZ_WUQ = 384 * 256 * 2, SZ_WUKV = 512 * 128 * 2,
                 SZ_WMEM = 512 * 1024 * 2, SZ_WCMP = 128 * 2048 * 2;
constexpr size_t OFF_WI = 0;
constexpr size_t OFF_WO = OFF_WI + 2 * SZ_WI;
constexpr size_t OFF_WUQ = OFF_WO + 2 * SZ_WO;
constexpr size_t OFF_WUKV = OFF_WUQ + 2 * SZ_WUQ;
constexpr size_t OFF_WMEM = OFF_WUKV + 2 * SZ_WUKV;
constexpr size_t OFF_WCMP = OFF_WMEM + 2 * SZ_WMEM;
constexpr size_t OFF_CB = OFF_WCMP + 4 * SZ_WCMP;
constexpr size_t OFF_CBF = OFF_CB + 16384;
constexpr size_t OFF_LAM = OFF_CBF + 1024;
constexpr size_t OFF_CTR = OFF_LAM + 256;
constexpr size_t OFF_BAR = OFF_CTR + 1024;
constexpr size_t OFF_FLAG = OFF_BAR + 16384;
constexpr size_t OFF_PCNT = OFF_FLAG + 8192;
constexpr size_t OFF_ROPE = OFF_PCNT + 2048;
constexpr size_t OFF_SSQ = OFF_ROPE + 2048 * 32 * 8;
constexpr size_t OFF_RMEM = OFF_SSQ + (size_t)T * 8 * 4;
constexpr size_t OFF_MEMB = OFF_RMEM + 2048 * 4;
constexpr size_t OFF_XB = OFF_MEMB + (size_t)TM * 1024 * 2;
constexpr size_t OFF_U = OFF_XB + (size_t)T * 1024 * 2;
constexpr size_t OFF_R1 = OFF_U + (size_t)T * NP * 2;
constexpr size_t SLAB = (size_t)S * 1024 * 2;
constexpr size_t OFF_UQ = OFF_R1;
constexpr size_t OFF_UKV = OFF_R1 + (size_t)S * 384 * 2;
constexpr size_t OFF_Y = OFF_R1;
constexpr size_t OFF_QM = OFF_R1 + (size_t)T * 1024 * 2;
constexpr size_t OFF_KM = OFF_QM + (size_t)T * 384 * 2;
constexpr size_t OFF_MV = OFF_KM + (size_t)T * 384 * 2;
constexpr size_t OFF_KMEMRAW = OFF_MV + (size_t)T * 256 * 2;
constexpr size_t OFF_MK = OFF_KMEMRAW + (size_t)TM * 512 * 2;
constexpr size_t OFF_MVV = OFF_MK + (size_t)TM * 256 * 2;
constexpr size_t OFF_CMPRAW = OFF_MVV + (size_t)TM * 256 * 2;
constexpr size_t OFF_KCN = OFF_CMPRAW + 8 * 1024 * 128 * 2;
constexpr size_t OFF_VCN = OFF_KCN + 8 * 128 * 64 * 2;
constexpr size_t OFF_GT = OFF_VCN + 8 * 128 * 64 * 2;
constexpr size_t OFF_OCMP = OFF_GT + (size_t)T * 12 * 4;
constexpr size_t OFF_OWIN = OFF_OCMP + (size_t)T * 256 * 2;
constexpr size_t OFF_SEL = OFF_OWIN + (size_t)T * 256 * 2;
constexpr size_t WS_TOTAL = OFF_SEL + (size_t)T * 4;

constexpr int SMEM_BYTES = 73728;
constexpr int SM_VT = 2 * 64 * 104 * 2;
constexpr int SM_SC = SM_VT + 2 * 64 * 72 * 2;
constexpr int SM_MISC = SM_SC + 4 * 32 * 33 * 4;

struct Params {
  const float* in[19];
  float* out;
  char* ws;
};

DI int opq(int v) { asm volatile("" : "+v"(v)); return v; }
DI char* opqp(char* q) { size_t z = 0; asm volatile("" : "+s"(z)); return q + z; }
DI float bf2f(uint32_t v) { return __uint_as_float(v << 16); }
DI float bflo(uint32_t w) { return __uint_as_float(w << 16); }
DI float bfhi(uint32_t w) { return __uint_as_float(w & 0xffff0000u); }
DI uint32_t pack2(float a, float b) { hf2 f = {a, b}; hbf2 r = __builtin_convertvector(f, hbf2); return __builtin_bit_cast(uint32_t, r); }
DI bf16 f2bf(float a) { return (bf16)(pack2(a, 0.f) & 0xffffu); }
DI float fexp2(float x) { return __builtin_amdgcn_exp2f(x); }
DI float sigmoidf_(float x) { return __builtin_amdgcn_rcpf(1.f + fexp2(-LOG2E * x)); }
DI float siluf_(float x) { return x * __builtin_amdgcn_rcpf(1.f + fexp2(-LOG2E * x)); }
DI float shx(float v, int m) { return __shfl_xor(v, m); }
DI float dppf(float v, int ctrl_sel) {
  int x = __builtin_bit_cast(int, v), r;
  if (ctrl_sel == 0) r = __builtin_amdgcn_mov_dpp(x, 0xB1, 0xF, 0xF, true);
  else if (ctrl_sel == 1) r = __builtin_amdgcn_mov_dpp(x, 0x4E, 0xF, 0xF, true);
  else if (ctrl_sel == 2) r = __builtin_amdgcn_mov_dpp(x, 0x141, 0xF, 0xF, true);
  else r = __builtin_amdgcn_mov_dpp(x, 0x140, 0xF, 0xF, true);
  return __builtin_bit_cast(float, r);
}
DI float sum8(float v) { v += dppf(v, 0); v += dppf(v, 1); v += dppf(v, 2); return v; }
DI float sum16(float v) { v = sum8(v); v += dppf(v, 3); return v; }
DI float sum64(float v) { v = sum16(v); v += shx(v, 16); v += shx(v, 32); return v; }


#define XB_TMO      128
#define XB_XCNT(j)  (256  + 64 * (j))
#define XB_XSUB(j)  (1280 + 64 * (j))
#define XB_XGEN(j)  (2304 + 64 * (j))
#define XB_TOP      3328
#define XB_TOPGEN   3392
#define XB_SPIN_CAP (1u << 22)
#define LAS __attribute__((address_space(3)))
DI unsigned xb_ld(unsigned* p) { return __hip_atomic_load(p, __ATOMIC_RELAXED, __HIP_MEMORY_SCOPE_AGENT); }
DI unsigned xb_add(unsigned* p, unsigned v) { return __hip_atomic_fetch_add(p, v, __ATOMIC_RELAXED, __HIP_MEMORY_SCOPE_AGENT); }
DI unsigned xb_xcc_id() { return (unsigned)__builtin_amdgcn_readfirstlane((int)(__builtin_amdgcn_s_getreg((3 << 11) | 20) & 0xFu)); }
#define XB_SPIN(cond, bar) do { unsigned _sp = 0; while (cond) { __builtin_amdgcn_s_sleep(1); \
    if ((++_sp & 255u) == 0u) { if (xb_ld(&(bar)[XB_TMO])) break; if (_sp > XB_SPIN_CAP) { atomicAdd(&(bar)[XB_TMO], 1u); break; } } } } while (0)
struct XcdBarrier { unsigned* bar; unsigned x; volatile LAS unsigned* st; };
DI XcdBarrier xcd_barrier_post(unsigned* bar, volatile LAS unsigned* st) {
  XcdBarrier b; b.bar = bar; b.x = xb_xcc_id(); b.st = st;
  if (threadIdx.x == 0) (void)xb_add(&bar[XB_XCNT(b.x)], 1u);
  return b;
}
DI void xcd_barrier_complete(unsigned* bar, unsigned x, unsigned& nloc, unsigned& nx) {
  const unsigned G = gridDim.x * gridDim.y * gridDim.z;
  unsigned sum, cnt, mine, sp = 0u;
  for (;;) {
    sum = 0u; cnt = 0u; mine = 0u;
#pragma unroll
    for (unsigned j = 0; j < 16; ++j) { const unsigned c = xb_ld(&bar[XB_XCNT(j)]); sum += c; cnt += (c > 0u) ? 1u : 0u; mine = (j == x) ? c : mine; }
    if (sum == G) break;
    __builtin_amdgcn_s_sleep(1);
    if ((++sp & 255u) == 0u) { if (xb_ld(&bar[XB_TMO])) break; if (sp > XB_SPIN_CAP) { atomicAdd(&bar[XB_TMO], 1u); break; } }
  }
  nloc = mine > 0u ? mine : 1u; nx = cnt > 0u ? cnt : 1u;
}
DI void xcd_barrier(const XcdBarrier& b) {
  asm volatile("s_waitcnt vmcnt(0)" ::: "memory");
  __syncthreads();
  if (threadIdx.x == 0) {
    unsigned* bar = b.bar;
    const unsigned bx = xb_xcc_id();
    __builtin_amdgcn_s_waitcnt(0);
    unsigned nloc = b.st[0], nx = b.st[1];
    if (nloc == 0u) { xcd_barrier_complete(bar, bx, nloc, nx); b.st[0] = nloc; b.st[1] = nx; }
    const unsigned old = xb_add(&bar[XB_XSUB(bx)], 1u);
    const unsigned gen = old / nloc;
    if (old + 1u == (gen + 1u) * nloc) {
      __builtin_amdgcn_fence(__ATOMIC_RELEASE, "agent");
      asm volatile("s_waitcnt vmcnt(0)" ::: "memory");
      const unsigned og = xb_add(&bar[XB_TOP], 1u);
      const unsigned tg = og / nx;
      if (og + 1u == (tg + 1u) * nx) xb_add(&bar[XB_TOPGEN], 1u);
      else XB_SPIN(xb_ld(&bar[XB_TOPGEN]) == tg, bar);
      __builtin_amdgcn_fence(__ATOMIC_ACQUIRE, "agent");
      xb_add(&bar[XB_XGEN(bx)], 1u);
      asm volatile("s_waitcnt vmcnt(0)" ::: "memory");
    } else {
      XB_SPIN(xb_ld(&bar[XB_XGEN(bx)]) == gen, bar);
      __builtin_amdgcn_fence(__ATOMIC_ACQUIRE, "agent");
      asm volatile("s_waitcnt vmcnt(0)" ::: "memory");
    }
  }
  __syncthreads();
}

DI void part_barrier(unsigned* cnt, unsigned target) {
  asm volatile("s_waitcnt vmcnt(0)" ::: "memory");
  __syncthreads();
  if (threadIdx.x == 0) {
    __builtin_amdgcn_s_waitcnt(0);
    __builtin_amdgcn_fence(__ATOMIC_RELEASE, "agent");
    asm volatile("s_waitcnt vmcnt(0)" ::: "memory");
    xb_add(cnt, 1u);
    unsigned sp = 0;
    while (xb_ld(cnt) < target) { __builtin_amdgcn_s_sleep(1); if (++sp > (1u << 24)) break; }
    __builtin_amdgcn_fence(__ATOMIC_ACQUIRE, "agent");
    asm volatile("s_waitcnt vmcnt(0)" ::: "memory");
  }
  __syncthreads();
}

DI void wg_publish(unsigned* flag) {
  asm volatile("s_waitcnt vmcnt(0)" ::: "memory");
  __syncthreads();
  if (threadIdx.x == 0) {
    __builtin_amdgcn_fence(__ATOMIC_RELEASE, "agent");
    asm volatile("s_waitcnt vmcnt(0)" ::: "memory");
    xb_add(flag, 1u);
  }
}
DI void wg_wait2(unsigned* f0, unsigned* f1) {
  if (threadIdx.x == 0) {
    unsigned sp = 0;
    while (xb_ld(f0) < 1u || xb_ld(f1) < 1u) { __builtin_amdgcn_s_sleep(2); if (++sp > (1u << 22)) break; }
    __builtin_amdgcn_fence(__ATOMIC_ACQUIRE, "agent");
    asm volatile("s_waitcnt vmcnt(0)" ::: "memory");
  }
  __syncthreads();
}

DI int win_orig(int n) { return n < 640 ? n : (n < 3104 ? n + 12 : (n < 3116 ? n - 3104 + 640 : -1)); }

DI void convT_tile(const float* __restrict__ src, int Nsrc, const float* __restrict__ gain, bf16* __restrict__ dst, int K,
                   int k0, int n0, int mapmode, float* tile) {
  const int tid = opq(threadIdx.x);
  int shift = -1;
  if (mapmode == 1) { if (n0 + 63 < 640) shift = 0; else if (n0 >= 640 && n0 + 63 < 3104) shift = 12; }
  else if (n0 + 63 < Nsrc) shift = 0;
  const bool allpad = (mapmode == 1) ? (n0 >= 3116) : (n0 >= Nsrc);
  if (shift >= 0) {
    const int f = tid & 15, kr = tid >> 4;
    float4 v[4];
#pragma unroll
    for (int it = 0; it < 4; ++it) v[it] = *(const float4*)(src + (size_t)(k0 + kr + 16 * it) * Nsrc + n0 + shift + 4 * f);
    if (gain) {
#pragma unroll
      for (int it = 0; it < 4; ++it) { const float g = gain[k0 + kr + 16 * it]; v[it].x *= g; v[it].y *= g; v[it].z *= g; v[it].w *= g; }
    }
#pragma unroll
    for (int it = 0; it < 4; ++it) {
      float* tp = tile + (kr + 16 * it) * 65 + 4 * f;
      tp[0] = v[it].x; tp[1] = v[it].y; tp[2] = v[it].z; tp[3] = v[it].w;
    }
  } else {
    const int nn = tid & 63, kk = tid >> 6;
    const int n = n0 + nn;
    const int on = allpad ? -1 : (mapmode == 1 ? win_orig(n) : (n < Nsrc ? n : -1));
    float v[16];
#pragma unroll
    for (int it = 0; it < 16; ++it) {
      const int k = k0 + kk + 4 * it;
      v[it] = 0.f;
      if (on >= 0) v[it] = src[(size_t)k * Nsrc + on];
    }
    if (gain) {
#pragma unroll
      for (int it = 0; it < 16; ++it) v[it] *= gain[k0 + kk + 4 * it];
    }
#pragma unroll
    for (int it = 0; it < 16; ++it) tile[(kk + 4 * it) * 65 + nn] = v[it];
  }
  __syncthreads();
  {
    const int k8 = (tid & 7) * 8, nb = tid >> 3;
#pragma unroll
    for (int it = 0; it < 2; ++it) {
      const int n = nb + 32 * it;
      uint4 o;
      o.x = pack2(tile[(k8 + 0) * 65 + n], tile[(k8 + 1) * 65 + n]);
      o.y = pack2(tile[(k8 + 2) * 65 + n], tile[(k8 + 3) * 65 + n]);
      o.z = pack2(tile[(k8 + 4) * 65 + n], tile[(k8 + 5) * 65 + n]);
      o.w = pack2(tile[(k8 + 6) * 65 + n], tile[(k8 + 7) * 65 + n]);
      *(uint4*)(dst + (size_t)(n0 + n) * K + k0 + k8) = o;
    }
  }
  __syncthreads();
}

DI void phase0(const Params& p, char* smem) {
  const int tid = opq(threadIdx.x), lane = tid & 63, wv = tid >> 6;
  float* tile = (float*)smem;
  char* ws = opqp(p.ws);
  constexpr int N_WI = 2 * 50 * 16, N_WO = 2 * 16 * 16, N_WUQ = 2 * 6 * 4, N_WUKV = 2 * 8 * 2, N_WMEM = 2 * 8 * 16,
                N_WCMP = 4 * 2 * 32, N_X = T / 4, N_MEM = TM / 4, N_ROPE = 256, N_CB = 64, N_LAM = 1;
  constexpr int E0 = N_WI, E1 = E0 + N_WO, E2 = E1 + N_WUQ, E3 = E2 + N_WUKV, E4 = E3 + N_WMEM, E5 = E4 + N_WCMP,
                E6 = E5 + N_X, E7 = E6 + N_MEM, E8 = E7 + N_ROPE, E9 = E8 + N_CB, E10 = E9 + N_LAM;
  for (int it = blockIdx.x; it < E10; it += gridDim.x) {
    if (it < E0) {
      int l = it / 800, r = it % 800, nt = r / 16, kt = r % 16;
      convT_tile(p.in[3] + (size_t)l * 1024 * 3116, 3116, p.in[2] + l * 1024, (bf16*)(ws + OFF_WI + l * SZ_WI), 1024, kt * 64, nt * 64, 1, tile);
    } else if (it < E1) {
      int i = it - E0; int l = i / 256, r = i % 256, nt = r / 16, kt = r % 16;
      convT_tile(p.in[4] + (size_t)l * 1024 * 1024, 1024, nullptr, (bf16*)(ws + OFF_WO + l * SZ_WO), 1024, kt * 64, nt * 64, 0, tile);
    } else if (it < E2) {
      int i = it - E1; int l = i / 24, r = i % 24, nt = r / 4, kt = r % 4;
      convT_tile(p.in[13] + (size_t)l * 256 * 384, 384, p.in[11] + l * 256, (bf16*)(ws + OFF_WUQ + l * SZ_WUQ), 256, kt * 64, nt * 64, 0, tile);
    } else if (it < E3) {
      int i = it - E2; int l = i / 16, r = i % 16, nt = r / 2, kt = r % 2;
      convT_tile(p.in[14] + (size_t)l * 128 * 512, 512, p.in[12] + l * 128, (bf16*)(ws + OFF_WUKV + l * SZ_WUKV), 128, kt * 64, nt * 64, 0, tile);
    } else if (it < E4) {
      int i = it - E3; int l = i / 128, r = i % 128, nt = r / 16, kt = r % 16;
      convT_tile(p.in[17] + (size_t)l * 1024 * 512, 512, p.in[16] + l * 1024, (bf16*)(ws + OFF_WMEM + l * SZ_WMEM), 1024, kt * 64, nt * 64, 0, tile);
    } else if (it < E5) {
      int i = it - E4; int lj = i / 64, r = i % 64, nt = r / 32, kt = r % 32;
      convT_tile(p.in[7] + (size_t)lj * 2048 * 64, 64, nullptr, (bf16*)(ws + OFF_WCMP + lj * SZ_WCMP), 2048, kt * 64, nt * 64, 0, tile);
    } else if (it < E6) {
      int row = (it - E5) * 4 + wv;
      const float4* xr = (const float4*)(p.in[0] + (size_t)row * 1024);
      bf16* xb = (bf16*)(ws + OFF_XB) + (size_t)row * 1024;
      float ss = 0.f;
#pragma unroll
      for (int i = 0; i < 2; ++i) {
        const int c = lane + 64 * i;
        const float4 v = xr[2 * c], w = xr[2 * c + 1];
        ss += v.x * v.x + v.y * v.y + v.z * v.z + v.w * v.w + w.x * w.x + w.y * w.y + w.z * w.z + w.w * w.w;
        uint4 o; o.x = pack2(v.x, v.y); o.y = pack2(v.z, v.w); o.z = pack2(w.x, w.y); o.w = pack2(w.z, w.w);
        *(uint4*)(xb + c * 8) = o;
      }
      ss = sum64(ss);
      float* sq = (float*)(ws + OFF_SSQ) + (size_t)row * 8;
      if (lane < 8) sq[lane] = lane == 0 ? ss : 0.f;
    } else if (it < E7) {
      int row = (it - E6) * 4 + wv;
      const float4* xr = (const float4*)(p.in[1] + (size_t)row * 1024);
      bf16* xb = (bf16*)(ws + OFF_MEMB) + (size_t)row * 1024;
      float ss = 0.f;
#pragma unroll
      for (int i = 0; i < 2; ++i) {
        const int c = lane + 64 * i;
        const float4 v = xr[2 * c], w = xr[2 * c + 1];
        ss += v.x * v.x + v.y * v.y + v.z * v.z + v.w * v.w + w.x * w.x + w.y * w.y + w.z * w.z + w.w * w.w;
        uint4 o; o.x = pack2(v.x, v.y); o.y = pack2(v.z, v.w); o.z = pack2(w.x, w.y); o.w = pack2(w.z, w.w);
        *(uint4*)(xb + c * 8) = o;
      }
      ss = sum64(ss);
      if (lane == 0) ((float*)(ws + OFF_RMEM))[row] = rsqrtf(ss * (1.f / 1024.f) + EPS);
    } else if (it < E8) {
      int e = (it - E7) * 256 + tid;
      int pos = e >> 5, i = e & 31;
      float inv = powf(10000.f, -(float)i / 32.f);
      float ang = (float)pos * inv;
      double a = (double)ang;
      double n = rint(a * 0.15915494309189535);
      float r = (float)(a - n * 6.283185307179586);
      float2 cs; cs.x = __cosf(r); cs.y = __sinf(r);
      ((float2*)(ws + OFF_ROPE))[e] = cs;
    } else if (it < E9) {
      int lj = (it - E8) >> 4, sl = (it - E8) & 15;
      const float* pe = p.in[6] + (size_t)lj * 2048;
      const float* w = p.in[7] + (size_t)lj * 2048 * 64;
      int n = tid & 63, part = tid >> 6;
      float acc = 0.f;
      const int kb0 = sl * 128 + part * 32;
#pragma unroll 8
      for (int k = kb0; k < kb0 + 32; ++k) acc += pe[k] * w[(size_t)k * 64 + n];
      tile[tid] = acc;
      __syncthreads();
      if (tid < 64) ((float*)(ws + OFF_CB))[((it - E8)) * 64 + tid] = tile[tid] + tile[tid + 64] + tile[tid + 128] + tile[tid + 192];
      __syncthreads();
    } else {
      if (tid < 2) {
        const float* lf = p.in[9] + tid * 128;
        float s1 = 0.f, s2 = 0.f;
        for (int i = 0; i < 32; ++i) { s1 += lf[i] * lf[32 + i]; s2 += lf[64 + i] * lf[96 + i]; }
        float li = 0.8f - 0.6f * expf(-0.3f * (float)tid);
        ((float*)(ws + OFF_LAM))[tid] = expf(s1) - expf(s2) + li;
      }
    }
  }
}

template <int CH>
DI void gemm_tile(const bf16* __restrict__ Ab, long lda, long kcs, const bf16* __restrict__ Bb, long ldb, int nk, char* smem) {
  const int tid = opq(threadIdx.x), lane = tid & 63, wv = tid >> 6, half = lane >> 5, l31 = lane & 31;
  const int wm = wv >> 1, wn = wv & 1;
  bf16* As = (bf16*)smem;
  bf16* Bs = (bf16*)(smem + 36864);
  const int lrow = tid >> 3, lcol = (tid & 7) * 8;
  const bf16* ag = Ab + (long)lrow * lda + lcol;
  const bf16* bg = Bb + (long)lrow * ldb + lcol;
  f32x16 acc[2][2];
#pragma unroll
  for (int a = 0; a < 2; ++a)
#pragma unroll
    for (int b = 0; b < 2; ++b)
#pragma unroll
      for (int i = 0; i < 16; ++i) acc[a][b][i] = 0.f;
#define GCOMPUTE(BUF) do { \
    const bf16* as_ = As + (BUF) * 128 * 72 + (wm * 64 + l31) * 72 + half * 8; \
    const bf16* bs_ = Bs + (BUF) * 128 * 72 + (wn * 64 + l31) * 72 + half * 8; \
    bf16x8 fa[2][2], fb[2][2]; \
    fa[0][0] = *(const bf16x8*)(as_); fa[0][1] = *(const bf16x8*)(as_ + 32 * 72); \
    fb[0][0] = *(const bf16x8*)(bs_); fb[0][1] = *(const bf16x8*)(bs_ + 32 * 72); \
    _Pragma("unroll") for (int kc = 0; kc < 4; ++kc) { \
      if (kc < 3) { \
        fa[(kc + 1) & 1][0] = *(const bf16x8*)(as_ + (kc + 1) * 16); fa[(kc + 1) & 1][1] = *(const bf16x8*)(as_ + 32 * 72 + (kc + 1) * 16); \
        fb[(kc + 1) & 1][0] = *(const bf16x8*)(bs_ + (kc + 1) * 16); fb[(kc + 1) & 1][1] = *(const bf16x8*)(bs_ + 32 * 72 + (kc + 1) * 16); \
      } \
      _Pragma("unroll") for (int ni = 0; ni < 2; ++ni) \
        _Pragma("unroll") for (int mi = 0; mi < 2; ++mi) acc[ni][mi] = MFMA(fb[kc & 1][ni], fa[kc & 1][mi], acc[ni][mi]); \
    } } while (0)
  for (int c0 = 0; c0 < nk; c0 += CH) {
    u32x4 rs[2][8];
    const bf16* agc = ag + (long)c0 * kcs;
    const bf16* bgc = bg + (long)c0 * 64;
#pragma unroll
    for (int i = 0; i < 4; ++i) {
      rs[0][i] = *(const u32x4*)(agc + (long)(32 * i) * lda);
      rs[0][4 + i] = *(const u32x4*)(bgc + (long)(32 * i) * ldb);
    }
#pragma unroll
    for (int i = 0; i < 4; ++i) {
      *(u32x4*)(As + (lrow + 32 * i) * 72 + lcol) = rs[0][i];
      *(u32x4*)(Bs + (lrow + 32 * i) * 72 + lcol) = rs[0][4 + i];
    }
    if (CH > 1) {
#pragma unroll
      for (int i = 0; i < 4; ++i) {
        GLD16(rs[1][i], agc + (long)(32 * i) * lda + kcs);
        GLD16(rs[1][4 + i], bgc + (long)(32 * i) * ldb + 64);
      }
    }
    __syncthreads();
#pragma unroll
    for (int t = 0; t < CH; ++t) {
      const int bufc = t & 1;
      if (t + 2 < CH) {
#pragma unroll
        for (int i = 0; i < 4; ++i) {
          GLD16(rs[t & 1][i], agc + (long)(32 * i) * lda + (long)(t + 2) * kcs);
          GLD16(rs[t & 1][4 + i], bgc + (long)(32 * i) * ldb + (long)(t + 2) * 64);
        }
      }
      GCOMPUTE(bufc);
      if (t + 1 < CH) {
        u32x4(&rr)[8] = rs[(t + 1) & 1];
        if (t + 2 < CH) asm volatile("s_waitcnt vmcnt(8)" : "+v"(rr[0]), "+v"(rr[1]), "+v"(rr[2]), "+v"(rr[3]), "+v"(rr[4]), "+v"(rr[5]), "+v"(rr[6]), "+v"(rr[7]) :: "memory");
        else asm volatile("s_waitcnt vmcnt(0)" : "+v"(rr[0]), "+v"(rr[1]), "+v"(rr[2]), "+v"(rr[3]), "+v"(rr[4]), "+v"(rr[5]), "+v"(rr[6]), "+v"(rr[7]) :: "memory");
        bf16* ad = As + (bufc ^ 1) * 128 * 72; bf16* bd = Bs + (bufc ^ 1) * 128 * 72;
#pragma unroll
        for (int i = 0; i < 4; ++i) {
          *(u32x4*)(ad + (lrow + 32 * i) * 72 + lcol) = rr[i];
          *(u32x4*)(bd + (lrow + 32 * i) * 72 + lcol) = rr[4 + i];
        }
      }
      __syncthreads();
    }
  }
#undef GCOMPUTE
  float* Cs = (float*)smem;
#pragma unroll
  for (int ni = 0; ni < 2; ++ni)
#pragma unroll
    for (int mi = 0; mi < 2; ++mi)
#pragma unroll
      for (int g = 0; g < 4; ++g) {
        float4 v; v.x = acc[ni][mi][4 * g]; v.y = acc[ni][mi][4 * g + 1]; v.z = acc[ni][mi][4 * g + 2]; v.w = acc[ni][mi][4 * g + 3];
        *(float4*)(Cs + (wm * 64 + mi * 32 + l31) * 132 + wn * 64 + ni * 32 + 8 * g + 4 * half) = v;
      }
  __syncthreads();
}

enum { EPI_PLAIN = 0, EPI_RS8 = 1, EPI_RS1 = 2, EPI_OUT = 3 };
DI void gemm_epi(int mode, char* smem, bf16* __restrict__ Cb, long ldc, int row0, const float* __restrict__ rs,
                 const float* __restrict__ xres, float* __restrict__ xout, bf16* __restrict__ xbout, float* __restrict__ ssqout, int ntile) {
  const float* Cs = (const float*)smem;
  const int tid = opq(threadIdx.x);
  float* rsl = (float*)(smem + 67584);
  if (mode == EPI_RS8 || mode == EPI_RS1) {
    if (tid < 128) {
      const long grow = row0 + tid;
      float sc;
      if (mode == EPI_RS8) {
        const float4* q = (const float4*)(rs + grow * 8);
        const float4 a = q[0], b = q[1];
        sc = rsqrtf((a.x + a.y + a.z + a.w + b.x + b.y + b.z + b.w) * (1.f / 1024.f) + EPS);
      } else sc = rs[grow];
      rsl[tid] = sc;
    }
    __syncthreads();
  }
#pragma unroll 2
  for (int it = 0; it < 8; ++it) {
    const int idx = it * 256 + tid;
    const int r = idx >> 4, ch = idx & 15;
    float4 v0 = *(const float4*)(Cs + r * 132 + ch * 8);
    float4 v1 = *(const float4*)(Cs + r * 132 + ch * 8 + 4);
    const long grow = row0 + r;
    if (mode == EPI_OUT) {
      if (xres) {
        const float4* xr = (const float4*)(xres + grow * 1024 + ntile * 128 + ch * 8);
        float4 x0 = xr[0], x1 = xr[1];
        v0.x += x0.x; v0.y += x0.y; v0.z += x0.z; v0.w += x0.w;
        v1.x += x1.x; v1.y += x1.y; v1.z += x1.z; v1.w += x1.w;
      } else {
        const uint4 xw = *(const uint4*)(Cb + grow * 1024 + ntile * 128 + ch * 8);
        v0.x += bflo(xw.x); v0.y += bfhi(xw.x); v0.z += bflo(xw.y); v0.w += bfhi(xw.y);
        v1.x += bflo(xw.z); v1.y += bfhi(xw.z); v1.z += bflo(xw.w); v1.w += bfhi(xw.w);
      }
      if (xout) {
        float4* xo = (float4*)(xout + grow * 1024 + ntile * 128 + ch * 8);
        xo[0] = v0; xo[1] = v1;
      }
      if (xbout) {
        float ss = v0.x * v0.x + v0.y * v0.y + v0.z * v0.z + v0.w * v0.w + v1.x * v1.x + v1.y * v1.y + v1.z * v1.z + v1.w * v1.w;
        ss = sum16(ss);
        if (ch == 0) ssqout[grow * 8 + ntile] = ss;
        uint4 o; o.x = pack2(v0.x, v0.y); o.y = pack2(v0.z, v0.w); o.z = pack2(v1.x, v1.y); o.w = pack2(v1.z, v1.w);
        *(uint4*)(xbout + grow * 1024 + ntile * 128 + ch * 8) = o;
      }
    } else {
      float sc = 1.f;
      if (mode == EPI_RS8 || mode == EPI_RS1) sc = rsl[r];
      uint4 o; o.x = pack2(v0.x * sc, v0.y * sc); o.y = pack2(v0.z * sc, v0.w * sc); o.z = pack2(v1.x * sc, v1.y * sc); o.w = pack2(v1.z * sc, v1.w * sc);
      *(uint4*)(Cb + grow * ldc + ntile * 128 + ch * 8) = o;
    }
  }
  __syncthreads();
}

DI void gemm_big(const bf16* __restrict__ Ab, long lda, const bf16* __restrict__ Bb, long ldb, int nk, char* smem, int mode,
                 bf16* __restrict__ Cb, long ldc, int row0, const float* __restrict__ rs, const float* __restrict__ xres,
                 float* __restrict__ xout, bf16* __restrict__ xbout, float* __restrict__ ssqout, int ntile) {
  const int tid = opq(threadIdx.x), lane = tid & 63, wv = tid >> 6, half = lane >> 5, l31 = lane & 31;
  const int wm = wv >> 1, wn = wv & 1;
  bf16* As = (bf16*)smem;
  bf16* Bs = (bf16*)(smem + 36864);
  const int lrow = tid >> 3, lcol = (tid & 7) * 8;
  const bf16* ag = Ab + (long)lrow * lda + lcol;
  const bf16* bg = Bb + (long)lrow * ldb + lcol;
  u32x4 ra[8], rb[4];
  f32x16 acc[2][4];
#pragma unroll
  for (int a = 0; a < 2; ++a)
#pragma unroll
    for (int b = 0; b < 4; ++b)
#pragma unroll
      for (int i = 0; i < 16; ++i) acc[a][b][i] = 0.f;
#pragma unroll
  for (int i = 0; i < 8; ++i) ra[i] = *(const u32x4*)(ag + (long)(32 * i) * lda);
#pragma unroll
  for (int i = 0; i < 4; ++i) rb[i] = *(const u32x4*)(bg + (long)(32 * i) * ldb);
#pragma unroll
  for (int i = 0; i < 8; ++i) *(u32x4*)(As + (lrow + 32 * i) * 72 + lcol) = ra[i];
#pragma unroll
  for (int i = 0; i < 4; ++i) *(u32x4*)(Bs + (lrow + 32 * i) * 72 + lcol) = rb[i];
  __syncthreads();
  for (int ks = 0; ks < nk; ++ks) {
    const bool more = ks + 1 < nk;
    if (more) {
#pragma unroll
      for (int i = 0; i < 8; ++i) GLD16(ra[i], ag + (long)(32 * i) * lda + (long)(ks + 1) * 64);
#pragma unroll
      for (int i = 0; i < 4; ++i) GLD16(rb[i], bg + (long)(32 * i) * ldb + (long)(ks + 1) * 64);
    }
    const bf16* as_ = As + (wm * 128 + l31) * 72 + half * 8;
    const bf16* bs_ = Bs + (wn * 64 + l31) * 72 + half * 8;
#pragma unroll
    for (int kc = 0; kc < 4; ++kc) {
      bf16x8 fa[4], fb[2];
#pragma unroll
      for (int mi = 0; mi < 4; ++mi) fa[mi] = *(const bf16x8*)(as_ + mi * 32 * 72 + kc * 16);
#pragma unroll
      for (int ni = 0; ni < 2; ++ni) fb[ni] = *(const bf16x8*)(bs_ + ni * 32 * 72 + kc * 16);
#pragma unroll
      for (int ni = 0; ni < 2; ++ni)
#pragma unroll
        for (int mi = 0; mi < 4; ++mi) acc[ni][mi] = MFMA(fb[ni], fa[mi], acc[ni][mi]);
    }
    __syncthreads();
    if (more) {
      asm volatile("s_waitcnt vmcnt(0)" : "+v"(ra[0]), "+v"(ra[1]), "+v"(ra[2]), "+v"(ra[3]), "+v"(ra[4]), "+v"(ra[5]), "+v"(ra[6]), "+v"(ra[7]),
                   "+v"(rb[0]), "+v"(rb[1]), "+v"(rb[2]), "+v"(rb[3]) :: "memory");
#pragma unroll
      for (int i = 0; i < 8; ++i) *(u32x4*)(As + (lrow + 32 * i) * 72 + lcol) = ra[i];
#pragma unroll
      for (int i = 0; i < 4; ++i) *(u32x4*)(Bs + (lrow + 32 * i) * 72 + lcol) = rb[i];
      __syncthreads();
    }
  }
  float* Cs = (float*)smem;
#pragma unroll
  for (int h = 0; h < 2; ++h) {
    if (wm == h) {
#pragma unroll
      for (int ni = 0; ni < 2; ++ni)
#pragma unroll
        for (int mi = 0; mi < 4; ++mi)
#pragma unroll
          for (int g = 0; g < 4; ++g) {
            float4 v; v.x = acc[ni][mi][4 * g]; v.y = acc[ni][mi][4 * g + 1]; v.z = acc[ni][mi][4 * g + 2]; v.w = acc[ni][mi][4 * g + 3];
            *(float4*)(Cs + (mi * 32 + l31) * 132 + wn * 64 + ni * 32 + 8 * g + 4 * half) = v;
          }
    }
    __syncthreads();
    gemm_epi(mode, smem, Cb, ldc, row0 + h * 128, rs, xres, xout, xbout, ssqout, ntile);
  }
}

enum { AM_NONE = 0, AM_CAUSAL = 1, AM_WIN = 2, AM_CMP = 3, AM_SLC = 4 };

template <int DK>
DI void attn_core(const bf16* __restrict__ Kp, long kstride, const bf16* __restrict__ Vp, long vstride, uint32_t tilemask,
                  int mode, int qpos, uint32_t sel, const bf16x8 (&Qf)[DK / 16], f32x16 (&O)[2], float& m_out, float& l_out, char* smem) {
  constexpr int KST = DK + 8;
  constexpr int CPR = DK / 8;
  constexpr int NCH = CPR / 4;
  bf16* Ks = (bf16*)smem;
  bf16* VTs = (bf16*)(smem + SM_VT);
  const int tid = opq(threadIdx.x), lane = tid & 63, half = lane >> 5, l31 = lane & 31;
#pragma unroll
  for (int i = 0; i < 16; ++i) { O[0][i] = 0.f; O[1][i] = 0.f; }
  float l = 0.f;
  const int qw0 = __builtin_amdgcn_readfirstlane(qpos - l31);
  const bool causal_like = (mode == AM_CAUSAL || mode == AM_WIN || mode == AM_SLC);
  int klo = 0, khi = 0x7fffffff;
  if (mode == AM_CAUSAL || mode == AM_SLC) khi = qpos;
  else if (mode == AM_WIN) { khi = qpos; klo = qpos - 511; }
  else if (mode == AM_CMP) khi = (qpos - 31) >> 4;
  u32x4 rk0, rk1, rk2, rv0, rv1;
  rk0 = rk1 = rk2 = (u32x4){0u, 0u, 0u, 0u};
  const int vkp = tid & 31, vcc = tid >> 5;
  const int vcol = (vkp >> 3) * 16 + (((vkp & 1) | ((vkp & 2) << 1) | ((vkp & 4) >> 1)) * 2);
  const int c0 = tid, c1 = tid + 256, c2_ = tid + 512;
  const int kr0 = c0 / CPR, kc0 = (c0 % CPR) * 8, kr1 = c1 / CPR, kc1 = (c1 % CPR) * 8, kr2 = c2_ / CPR, kc2 = (c2_ % CPR) * 8;
#define GLOAD(KT) do { \
    GLD16(rk0, Kp + (long)((KT) * 64 + kr0) * kstride + kc0); \
    if constexpr (NCH > 1) GLD16(rk1, Kp + (long)((KT) * 64 + kr1) * kstride + kc1); \
    if constexpr (NCH > 2) GLD16(rk2, Kp + (long)((KT) * 64 + kr2) * kstride + kc2); \
    GLD16(rv0, Vp + (long)((KT) * 64 + 2 * vkp) * vstride + vcc * 8); \
    GLD16(rv1, Vp + (long)((KT) * 64 + 2 * vkp + 1) * vstride + vcc * 8); } while (0)
#define LSTORE(BUF) do { asm volatile("s_waitcnt vmcnt(0)" : "+v"(rk0), "+v"(rk1), "+v"(rk2), "+v"(rv0), "+v"(rv1) :: "memory"); \
    *(u32x4*)(Ks + ((BUF) * 64 + kr0) * KST + kc0) = rk0; \
    if constexpr (NCH > 1) *(u32x4*)(Ks + ((BUF) * 64 + kr1) * KST + kc1) = rk1; \
    if constexpr (NCH > 2) *(u32x4*)(Ks + ((BUF) * 64 + kr2) * KST + kc2) = rk2; \
    bf16* vd = VTs + ((BUF) * 64 + vcc * 8) * 72 + vcol; \
    *(uint32_t*)(vd + 0 * 72) = (rv0.x & 0xffffu) | (rv1.x << 16); \
    *(uint32_t*)(vd + 1 * 72) = (rv0.x >> 16) | (rv1.x & 0xffff0000u); \
    *(uint32_t*)(vd + 2 * 72) = (rv0.y & 0xffffu) | (rv1.y << 16); \
    *(uint32_t*)(vd + 3 * 72) = (rv0.y >> 16) | (rv1.y & 0xffff0000u); \
    *(uint32_t*)(vd + 4 * 72) = (rv0.z & 0xffffu) | (rv1.z << 16); \
    *(uint32_t*)(vd + 5 * 72) = (rv0.z >> 16) | (rv1.z & 0xffff0000u); \
    *(uint32_t*)(vd + 6 * 72) = (rv0.w & 0xffffu) | (rv1.w << 16); \
    *(uint32_t*)(vd + 7 * 72) = (rv0.w >> 16) | (rv1.w & 0xffff0000u); } while (0)
  uint32_t rem = tilemask;
  int kt = __ffs(rem) - 1; rem &= rem - 1;
  GLOAD(kt);
#pragma unroll
  for (int kc = 0; kc < DK / 16; ++kc) asm volatile("" ::"v"(Qf[kc]));
  __syncthreads();
  LSTORE(0);
  __syncthreads();
  int buf = 0;
  while (true) {
    int ktn = -1;
    if (rem) { ktn = __ffs(rem) - 1; rem &= rem - 1; GLOAD(ktn); }
    const bool wave_active = !(causal_like && kt * 64 > qw0 + 31);
    if (wave_active) {
    f32x16 Sx[2];
#pragma unroll
    for (int kb = 0; kb < 2; ++kb) {
      bf16x8 Kf[DK / 16];
#pragma unroll
      for (int kc = 0; kc < DK / 16; ++kc) Kf[kc] = *(const bf16x8*)(Ks + (buf * 64 + kb * 32 + l31) * KST + kc * 16 + half * 8);
      __builtin_amdgcn_sched_barrier(0);
#pragma unroll
      for (int i = 0; i < 16; ++i) Sx[kb][i] = 0.f;
#pragma unroll
      for (int kc = 0; kc < DK / 16; ++kc) Sx[kb] = MFMA(Kf[kc], Qf[kc], Sx[kb]);
    }
    bf16x8 Vf[2][2][2];
#pragma unroll
    for (int kb = 0; kb < 2; ++kb)
#pragma unroll
      for (int c2 = 0; c2 < 2; ++c2)
#pragma unroll
        for (int dvb = 0; dvb < 2; ++dvb)
          Vf[kb][c2][dvb] = *(const bf16x8*)(VTs + (buf * 64 + dvb * 32 + l31) * 72 + (kb * 2 + c2) * 16 + half * 8);
    __builtin_amdgcn_sched_barrier(0);
    bool need_mask = false;
    if (mode == AM_CAUSAL) need_mask = kt * 64 + 63 > qw0;
    else if (mode == AM_WIN) need_mask = (kt * 64 + 63 > qw0) || (kt * 64 < qw0 + 31 - 511);
    else if (mode == AM_CMP) need_mask = true;
    else if (mode == AM_SLC) need_mask = (kt * 64 + 63 > qw0);
    const bool keep = !(mode == AM_SLC) || (((sel >> kt) & 1u) != 0u);
    int khe = khi;
    if (mode == AM_SLC && !((sel >> kt) & 1u)) khe = -1;
    const int kbase = kt * 64 + half * 4;
#pragma unroll
    for (int kb = 0; kb < 2; ++kb) {
      if (need_mask) {
#pragma unroll
        for (int i = 0; i < 16; ++i) {
          const int key = kbase + kb * 32 + (i >> 2) * 8 + (i & 3);
          Sx[kb][i] = (key >= klo && key <= khe) ? Sx[kb][i] : -1e30f;
        }
      }
      float ps = 0.f;
#pragma unroll
      for (int i = 0; i < 16; ++i) { float pv = fexp2(Sx[kb][i]); pv = keep ? pv : 0.f; Sx[kb][i] = pv; ps += pv; }
      l += ps;
#pragma unroll
      for (int c2 = 0; c2 < 2; ++c2) {
        uint4 pw;
        pw.x = pack2(Sx[kb][8 * c2 + 0], Sx[kb][8 * c2 + 1]); pw.y = pack2(Sx[kb][8 * c2 + 2], Sx[kb][8 * c2 + 3]);
        pw.z = pack2(Sx[kb][8 * c2 + 4], Sx[kb][8 * c2 + 5]); pw.w = pack2(Sx[kb][8 * c2 + 6], Sx[kb][8 * c2 + 7]);
        const bf16x8 pf = __builtin_bit_cast(bf16x8, pw);
#pragma unroll
        for (int dvb = 0; dvb < 2; ++dvb) O[dvb] = MFMA(Vf[kb][c2][dvb], pf, O[dvb]);
      }
      __builtin_amdgcn_sched_barrier(0);
    }
    }
    if (ktn < 0) break;
    LSTORE(buf ^ 1);
    __syncthreads();
    buf ^= 1; kt = ktn;
  }
  l_out = l + shx(l, 32);
  m_out = 0.f;
#undef GLOAD
#undef LSTORE
}

template <int DK>
DI void attn_core_dual(const bf16* __restrict__ Kp, long kstride, const bf16* __restrict__ Vp, long vstride, uint32_t tilemask,
                  int mode, int qpos, uint32_t sel, const bf16x8 (&Qf)[DK / 16], f32x16 (&O)[2], f32x16 (&O2)[2], float& l_out, float& l2_out, char* smem) {
  constexpr int KST = DK + 8;
  constexpr int CPR = DK / 8;
  constexpr int NCH = CPR / 4;
  bf16* Ks = (bf16*)smem;
  bf16* VTs = (bf16*)(smem + SM_VT);
  const int tid = opq(threadIdx.x), lane = tid & 63, half = lane >> 5, l31 = lane & 31;
#pragma unroll
  for (int i = 0; i < 16; ++i) { O[0][i] = 0.f; O[1][i] = 0.f; O2[0][i] = 0.f; O2[1][i] = 0.f; }
  float l = 0.f, l2 = 0.f;
  const int qw0 = __builtin_amdgcn_readfirstlane(qpos - l31);
  const bool causal_like = (mode == AM_CAUSAL || mode == AM_WIN || mode == AM_SLC);
  int klo = 0, khi = 0x7fffffff;
  if (mode == AM_CAUSAL || mode == AM_SLC) khi = qpos;
  else if (mode == AM_WIN) { khi = qpos; klo = qpos - 511; }
  else if (mode == AM_CMP) khi = (qpos - 31) >> 4;
  u32x4 rk0, rk1, rk2, rv0, rv1;
  rk0 = rk1 = rk2 = (u32x4){0u, 0u, 0u, 0u};
  const int vkp = tid & 31, vcc = tid >> 5;
  const int vcol = (vkp >> 3) * 16 + (((vkp & 1) | ((vkp & 2) << 1) | ((vkp & 4) >> 1)) * 2);
  const int c0 = tid, c1 = tid + 256, c2_ = tid + 512;
  const int kr0 = c0 / CPR, kc0 = (c0 % CPR) * 8, kr1 = c1 / CPR, kc1 = (c1 % CPR) * 8, kr2 = c2_ / CPR, kc2 = (c2_ % CPR) * 8;
#define GLOAD(KT) do { \
    GLD16(rk0, Kp + (long)((KT) * 64 + kr0) * kstride + kc0); \
    if constexpr (NCH > 1) GLD16(rk1, Kp + (long)((KT) * 64 + kr1) * kstride + kc1); \
    if constexpr (NCH > 2) GLD16(rk2, Kp + (long)((KT) * 64 + kr2) * kstride + kc2); \
    GLD16(rv0, Vp + (long)((KT) * 64 + 2 * vkp) * vstride + vcc * 8); \
    GLD16(rv1, Vp + (long)((KT) * 64 + 2 * vkp + 1) * vstride + vcc * 8); } while (0)
#define LSTORE(BUF) do { asm volatile("s_waitcnt vmcnt(0)" : "+v"(rk0), "+v"(rk1), "+v"(rv0), "+v"(rv1) :: "memory"); \
    *(u32x4*)(Ks + ((BUF) * 64 + kr0) * KST + kc0) = rk0; \
    if constexpr (NCH > 1) *(u32x4*)(Ks + ((BUF) * 64 + kr1) * KST + kc1) = rk1; \
    if constexpr (NCH > 2) *(u32x4*)(Ks + ((BUF) * 64 + kr2) * KST + kc2) = rk2; \
    bf16* vd = VTs + ((BUF) * 64 + vcc * 8) * 72 + vcol; \
    *(uint32_t*)(vd + 0 * 72) = (rv0.x & 0xffffu) | (rv1.x << 16); \
    *(uint32_t*)(vd + 1 * 72) = (rv0.x >> 16) | (rv1.x & 0xffff0000u); \
    *(uint32_t*)(vd + 2 * 72) = (rv0.y & 0xffffu) | (rv1.y << 16); \
    *(uint32_t*)(vd + 3 * 72) = (rv0.y >> 16) | (rv1.y & 0xffff0000u); \
    *(uint32_t*)(vd + 4 * 72) = (rv0.z & 0xffffu) | (rv1.z << 16); \
    *(uint32_t*)(vd + 5 * 72) = (rv0.z >> 16) | (rv1.z & 0xffff0000u); \
    *(uint32_t*)(vd + 6 * 72) = (rv0.w & 0xffffu) | (rv1.w << 16); \
    *(uint32_t*)(vd + 7 * 72) = (rv0.w >> 16) | (rv1.w & 0xffff0000u); } while (0)
  uint32_t rem = tilemask;
  int kt = __ffs(rem) - 1; rem &= rem - 1;
  GLOAD(kt);
#pragma unroll
  for (int kc = 0; kc < DK / 16; ++kc) asm volatile("" ::"v"(Qf[kc]));
  __syncthreads();
  LSTORE(0);
  __syncthreads();
  int buf = 0;
  while (true) {
    int ktn = -1;
    if (rem) { ktn = __ffs(rem) - 1; rem &= rem - 1; GLOAD(ktn); }
    const bool wave_active = !(causal_like && kt * 64 > qw0 + 31);
    if (wave_active) {
    const bool need_mask = kt * 64 + 63 > qw0;
    const int kbase = kt * 64 + half * 4;
#pragma unroll
    for (int mp = 0; mp < 2; ++mp) {
      f32x16 Sx[2];
#pragma unroll
      for (int kb = 0; kb < 2; ++kb) {
        bf16x8 k0 = *(const bf16x8*)(Ks + (buf * 64 + kb * 32 + l31) * KST + (2 * mp) * 16 + half * 8);
        bf16x8 k1 = *(const bf16x8*)(Ks + (buf * 64 + kb * 32 + l31) * KST + (2 * mp + 1) * 16 + half * 8);
#pragma unroll
        for (int i = 0; i < 16; ++i) Sx[kb][i] = 0.f;
        Sx[kb] = MFMA(k0, Qf[2 * mp], Sx[kb]);
        Sx[kb] = MFMA(k1, Qf[2 * mp + 1], Sx[kb]);
      }
#pragma unroll
      for (int kb = 0; kb < 2; ++kb) {
        if (need_mask) {
#pragma unroll
          for (int i = 0; i < 16; ++i) {
            const int key = kbase + kb * 32 + (i >> 2) * 8 + (i & 3);
            Sx[kb][i] = (key <= khi) ? Sx[kb][i] : -1e30f;
          }
        }
        bf16x8 Vf[2][2];
#pragma unroll
        for (int c2 = 0; c2 < 2; ++c2)
#pragma unroll
          for (int dvb = 0; dvb < 2; ++dvb)
            Vf[c2][dvb] = *(const bf16x8*)(VTs + (buf * 64 + dvb * 32 + l31) * 72 + (kb * 2 + c2) * 16 + half * 8);
        float ps = 0.f;
#pragma unroll
        for (int i = 0; i < 16; ++i) { float pv = fexp2(Sx[kb][i]); Sx[kb][i] = pv; ps += pv; }
        if (mp == 0) l += ps; else l2 += ps;
#pragma unroll
        for (int c2 = 0; c2 < 2; ++c2) {
          uint4 pw;
          pw.x = pack2(Sx[kb][8 * c2 + 0], Sx[kb][8 * c2 + 1]); pw.y = pack2(Sx[kb][8 * c2 + 2], Sx[kb][8 * c2 + 3]);
          pw.z = pack2(Sx[kb][8 * c2 + 4], Sx[kb][8 * c2 + 5]); pw.w = pack2(Sx[kb][8 * c2 + 6], Sx[kb][8 * c2 + 7]);
          const bf16x8 pf = __builtin_bit_cast(bf16x8, pw);
#pragma unroll
          for (int dvb = 0; dvb < 2; ++dvb) {
            if (mp == 0) O[dvb] = MFMA(Vf[c2][dvb], pf, O[dvb]); else O2[dvb] = MFMA(Vf[c2][dvb], pf, O2[dvb]);
          }
        }
        __builtin_amdgcn_sched_barrier(0);
      }
    }
    }
    if (ktn < 0) break;
    LSTORE(buf ^ 1);
    __syncthreads();
    buf ^= 1; kt = ktn;
  }
  l_out = l + shx(l, 32);
  l2_out = l2 + shx(l2, 32);
#undef GLOAD
#undef LSTORE
}

template <int DK>
DI void load_q(const bf16* __restrict__ Qrow, bf16x8 (&Qf)[DK / 16]) {
  const int half = (opq(threadIdx.x) & 63) >> 5;
#pragma unroll
  for (int kc = 0; kc < DK / 16; ++kc) Qf[kc] = *(const bf16x8*)(Qrow + kc * 16 + half * 8);
}

DI void vec64(bool active, const bf16* src, const float* bias, int nbias, bf16* dst, const float* gain, const float2* rp, float scale, int j, const bf16* src2 = nullptr) {
  float a0 = 0.f, a1 = 0.f, b0 = 0.f, b1 = 0.f;
  if (active) {
    uint32_t lo = *(const uint32_t*)(src + 2 * j), hi = *(const uint32_t*)(src + 32 + 2 * j);
    a0 = bflo(lo); a1 = bfhi(lo); b0 = bflo(hi); b1 = bfhi(hi);
    if (src2) {
#pragma unroll
      for (int q = 0; q < 3; ++q) {
        const bf16* sq_ = src2 + (size_t)q * 2 * 1024 * 128;
        lo = *(const uint32_t*)(sq_ + 2 * j); hi = *(const uint32_t*)(sq_ + 32 + 2 * j); a0 += bflo(lo); a1 += bfhi(lo); b0 += bflo(hi); b1 += bfhi(hi);
      }
    }
    for (int sidx = 0; sidx < nbias; ++sidx) {
      const float* bb = bias + sidx * 64;
      a0 += bb[2 * j]; a1 += bb[2 * j + 1]; b0 += bb[32 + 2 * j]; b1 += bb[33 + 2 * j];
    }
  }
  float ss = a0 * a0 + a1 * a1 + b0 * b0 + b1 * b1;
  ss = sum16(ss);
  const float r = rsqrtf(ss * (1.f / 64.f) + EPS);
  if (active) {
    a0 *= r * gain[2 * j]; a1 *= r * gain[2 * j + 1]; b0 *= r * gain[32 + 2 * j]; b1 *= r * gain[33 + 2 * j];
    if (rp) {
      const float2 c0 = rp[2 * j], c1 = rp[2 * j + 1];
      const float t0 = a0 * c0.x - b0 * c0.y, u0 = b0 * c0.x + a0 * c0.y;
      const float t1 = a1 * c1.x - b1 * c1.y, u1 = b1 * c1.x + a1 * c1.y;
      a0 = t0; b0 = u0; a1 = t1; b1 = u1;
    }
    *(uint32_t*)(dst + 2 * j) = pack2(a0 * scale, a1 * scale);
    *(uint32_t*)(dst + 32 + 2 * j) = pack2(b0 * scale, b1 * scale);
  }
}
template <int G>
DI void nr4(uint32_t lo, uint32_t hi, float invn, float g0, float g1, float g2, float g3, bool rope, float2 c0, float2 c1, float scale,
            uint32_t& olo, uint32_t& ohi) {
  float a0 = bflo(lo), a1 = bfhi(lo), b0 = bflo(hi), b1 = bfhi(hi);
  float ss = a0 * a0 + a1 * a1 + b0 * b0 + b1 * b1;
  ss = (G == 16) ? sum16(ss) : sum8(ss);
  const float r = rsqrtf(ss * invn + EPS);
  a0 *= r * g0; a1 *= r * g1; b0 *= r * g2; b1 *= r * g3;
  if (rope) {
    const float t0 = a0 * c0.x - b0 * c0.y, u0 = b0 * c0.x + a0 * c0.y;
    const float t1 = a1 * c1.x - b1 * c1.y, u1 = b1 * c1.x + a1 * c1.y;
    a0 = t0; b0 = u0; a1 = t1; b1 = u1;
  }
  olo = pack2(a0 * scale, a1 * scale); ohi = pack2(b0 * scale, b1 * scale);
}

struct PrepR {
  uint32_t q_lo, q_hi, p2_lo, p2_hi, p3_lo, p3_hi, dq_lo, dq_hi, dk_lo, dk_hi, glv, ckw, uqa, uqb, kra, krb;
  uint2 cw, nw, kw2, vw;
  float2 c0, c1, e0, e1;
};
struct PrepG {
  float gq0, gq1, gq2, gq3, h0, h1, h2, h3, m0, m1, m2, m3, dq0, dq1, dq2, dq3, dk0, dk1, dk2, dk3;
  float mgq0, mgq1, mgq2, mgq3, mgq4, mgq5, mgk0, mgk1, mgk2, mgk3, mgk4, mgk5;
};
DI void prep_load(char* ws, int t, int lane, PrepR& R) {
  const int j16 = lane & 15, g16 = lane >> 4, j8 = lane & 7, g8 = lane >> 3;
  const int s = t & 2047;
  const bf16* ur = (const bf16*)(ws + OFF_U) + (size_t)t * NP;
  const float2* rp = (const float2*)(ws + OFF_ROPE) + s * 32;
  const int col2 = g16 == 0 ? C_KS : (g16 == 1 ? C_KW : C_MQ + (g16 - 2) * 64);
  const int col3 = C_MQ + (2 + (g16 & 1)) * 64;
  const bf16* uq = (const bf16*)(ws + OFF_UQ + (size_t)(t >> 11) * SLAB) + (size_t)s * 384 + g16 * 96;
  const bf16* uk = (const bf16*)(ws + OFF_UKV + (size_t)(t >> 11) * SLAB) + (size_t)s * 512 + g16 * 128;
  R.q_lo = *(const uint32_t*)(ur + C_NQ + g16 * 64 + 2 * j16); R.q_hi = *(const uint32_t*)(ur + C_NQ + g16 * 64 + 32 + 2 * j16);
  R.p2_lo = *(const uint32_t*)(ur + col2 + 2 * j16); R.p2_hi = *(const uint32_t*)(ur + col2 + 32 + 2 * j16);
  R.p3_lo = *(const uint32_t*)(ur + col3 + 2 * j16); R.p3_hi = *(const uint32_t*)(ur + col3 + 32 + 2 * j16);
  R.dq_lo = *(const uint32_t*)(ur + C_DQ + g8 * 32 + 2 * j8); R.dq_hi = *(const uint32_t*)(ur + C_DQ + g8 * 32 + 16 + 2 * j8);
  R.dk_lo = *(const uint32_t*)(ur + C_DK + g8 * 32 + 2 * j8); R.dk_hi = *(const uint32_t*)(ur + C_DK + g8 * 32 + 16 + 2 * j8);
  R.glv = ur[C_GL + (lane < 12 ? lane : 0)];
  R.cw = *(const uint2*)(ur + C_CQ + lane * 4);
  R.ckw = *(const uint32_t*)(ur + C_CKV + lane * 2);
  R.nw = *(const uint2*)(uq + 4 * j16);
  R.uqa = uq[64 + j16]; R.uqb = uq[80 + j16];
  R.kw2 = *(const uint2*)(uk + 4 * j16);
  R.vw = *(const uint2*)(uk + 64 + 4 * j16);
  R.kra = ur[C_KR + j16]; R.krb = ur[C_KR + 16 + j16];
  R.c0 = rp[2 * j16]; R.c1 = rp[2 * j16 + 1];
  R.e0 = rp[4 * j8]; R.e1 = rp[4 * j8 + 2];
}
DI void prep_fin(char* ws, int t, int lane, const PrepR& R, const PrepG& G) {
  const int j16 = lane & 15, g16 = lane >> 4, j8 = lane & 7, g8 = lane >> 3;
  const float qs64 = 0.125f * LOG2E, qs32 = 0.17677669529663687f * LOG2E, qs96 = 0.10206207261596577f * LOG2E;
  const int b = t >> 11, s = t & 2047;
  bf16* ur = (bf16*)(ws + OFF_U) + (size_t)t * NP;
  const int col2 = g16 == 0 ? C_KS : (g16 == 1 ? C_KW : C_MQ + (g16 - 2) * 64);
  const int col3 = C_MQ + (2 + (g16 & 1)) * 64;
  const float2 c0 = R.c0, c1 = R.c1, e0 = R.e0, e1 = R.e1;
  uint32_t olo, ohi;
  nr4<16>(R.q_lo, R.q_hi, 1.f / 64.f, G.gq0, G.gq1, G.gq2, G.gq3, true, c0, c1, qs64, olo, ohi);
  *(uint32_t*)(ur + C_NQ + g16 * 64 + 2 * j16) = olo; *(uint32_t*)(ur + C_NQ + g16 * 64 + 32 + 2 * j16) = ohi;
  nr4<16>(R.p2_lo, R.p2_hi, 1.f / 64.f, G.h0, G.h1, G.h2, G.h3, g16 < 2, c0, c1, g16 < 2 ? 1.f : qs64, olo, ohi);
  *(uint32_t*)(ur + col2 + 2 * j16) = olo; *(uint32_t*)(ur + col2 + 32 + 2 * j16) = ohi;
  nr4<16>(R.p3_lo, R.p3_hi, 1.f / 64.f, G.m0, G.m1, G.m2, G.m3, false, c0, c1, qs64, olo, ohi);
  if (g16 < 2) { *(uint32_t*)(ur + col3 + 2 * j16) = olo; *(uint32_t*)(ur + col3 + 32 + 2 * j16) = ohi; }
  nr4<8>(R.dq_lo, R.dq_hi, 1.f / 32.f, G.dq0, G.dq1, G.dq2, G.dq3, true, e0, e1, qs32, olo, ohi);
  *(uint32_t*)(ur + C_DQ + g8 * 32 + 2 * j8) = olo; *(uint32_t*)(ur + C_DQ + g8 * 32 + 16 + 2 * j8) = ohi;
  nr4<8>(R.dk_lo, R.dk_hi, 1.f / 32.f, G.dk0, G.dk1, G.dk2, G.dk3, true, e0, e1, 1.f, olo, ohi);
  *(uint32_t*)(ur + C_DK + g8 * 32 + 2 * j8) = olo; *(uint32_t*)(ur + C_DK + g8 * 32 + 16 + 2 * j8) = ohi;
  if (lane < 12) ((float*)(ws + OFF_GT))[(size_t)t * 12 + lane] = sigmoidf_(bf2f(R.glv));
  float sq, skv;
  {
    float c0f = bflo(R.cw.x), c1f = bfhi(R.cw.x), c2f = bflo(R.cw.y), c3f = bfhi(R.cw.y);
    float ss = c0f * c0f + c1f * c1f + c2f * c2f + c3f * c3f;
    float d0 = bflo(R.ckw), d1 = bfhi(R.ckw);
    float s2 = d0 * d0 + d1 * d1;
    ss = sum64(ss); s2 = sum64(s2);
    sq = rsqrtf(ss * (1.f / 256.f) + EPS);
    skv = rsqrtf(s2 * (1.f / 128.f) + EPS);
  }
  {
    const int h = g16, j = j16;
    float n0 = bflo(R.nw.x) * sq, n1 = bfhi(R.nw.x) * sq, n2 = bflo(R.nw.y) * sq, n3 = bfhi(R.nw.y) * sq;
    float ra = bf2f(R.uqa) * sq, rb = bf2f(R.uqb) * sq;
    float r1 = ra * c0.x - rb * c0.y, r2 = rb * c0.x + ra * c0.y;
    float ss = n0 * n0 + n1 * n1 + n2 * n2 + n3 * n3 + r1 * r1 + r2 * r2;
    ss = sum16(ss);
    float r = rsqrtf(ss * (1.f / 96.f) + EPS) * qs96;
    bf16* qd = (bf16*)(ws + OFF_QM) + ((size_t)(b * 4 + h) * S + s) * 96;
    uint2 o; o.x = pack2(n0 * r * G.mgq0, n1 * r * G.mgq1); o.y = pack2(n2 * r * G.mgq2, n3 * r * G.mgq3);
    *(uint2*)(qd + 4 * j) = o;
    qd[64 + j] = f2bf(r1 * r * G.mgq4);
    qd[80 + j] = f2bf(r2 * r * G.mgq5);
    float k0 = bflo(R.kw2.x) * skv, k1 = bfhi(R.kw2.x) * skv, k2 = bflo(R.kw2.y) * skv, k3 = bfhi(R.kw2.y) * skv;
    float ka = bf2f(R.kra), kb = bf2f(R.krb);
    float kr1 = ka * c0.x - kb * c0.y, kr2 = kb * c0.x + ka * c0.y;
    float s3 = k0 * k0 + k1 * k1 + k2 * k2 + k3 * k3 + kr1 * kr1 + kr2 * kr2;
    s3 = sum16(s3);
    float rk_ = rsqrtf(s3 * (1.f / 96.f) + EPS);
    bf16* kd = (bf16*)(ws + OFF_KM) + ((size_t)(b * 4 + h) * S + s) * 96;
    uint2 o2; o2.x = pack2(k0 * rk_ * G.mgk0, k1 * rk_ * G.mgk1); o2.y = pack2(k2 * rk_ * G.mgk2, k3 * rk_ * G.mgk3);
    *(uint2*)(kd + 4 * j) = o2;
    kd[64 + j] = f2bf(kr1 * rk_ * G.mgk4);
    kd[80 + j] = f2bf(kr2 * rk_ * G.mgk5);
    uint2 o3; o3.x = pack2(bflo(R.vw.x) * skv, bfhi(R.vw.x) * skv); o3.y = pack2(bflo(R.vw.y) * skv, bfhi(R.vw.y) * skv);
    *(uint2*)((bf16*)(ws + OFF_MV) + ((size_t)(b * 4 + h) * S + s) * 64 + 4 * j) = o3;
  }
}

DI void prep_phase(const Params& p, int layer) {
  const int tid = opq(threadIdx.x), lane = tid & 63, wv = tid >> 6;
  char* ws = opqp(p.ws);
  const float2* rope = (const float2*)(ws + OFF_ROPE);
  const float* nsa_g = p.in[5] + layer * 256;
  const float* diff_g = p.in[8] + layer * 64;
  const float* mla_g = p.in[15] + layer * 192;
  const float* mem_g = p.in[18] + layer * 128;
  constexpr int N_TOK = T / 4, N_MEMT = TM / 4, N_CMP = 1024 / 4;
  const int j16 = lane & 15, g16 = lane >> 4, j8 = lane & 7;
  PrepG G;
  G.gq0 = nsa_g[2 * j16]; G.gq1 = nsa_g[2 * j16 + 1]; G.gq2 = nsa_g[32 + 2 * j16]; G.gq3 = nsa_g[33 + 2 * j16];
  const float* g2p = g16 == 0 ? nsa_g + 128 : (g16 == 1 ? nsa_g + 192 : mem_g);
  G.h0 = g2p[2 * j16]; G.h1 = g2p[2 * j16 + 1]; G.h2 = g2p[32 + 2 * j16]; G.h3 = g2p[33 + 2 * j16];
  G.m0 = mem_g[2 * j16]; G.m1 = mem_g[2 * j16 + 1]; G.m2 = mem_g[32 + 2 * j16]; G.m3 = mem_g[33 + 2 * j16];
  G.dq0 = diff_g[2 * j8]; G.dq1 = diff_g[2 * j8 + 1]; G.dq2 = diff_g[16 + 2 * j8]; G.dq3 = diff_g[17 + 2 * j8];
  G.dk0 = diff_g[32 + 2 * j8]; G.dk1 = diff_g[33 + 2 * j8]; G.dk2 = diff_g[48 + 2 * j8]; G.dk3 = diff_g[49 + 2 * j8];
  G.mgq0 = mla_g[4 * j16]; G.mgq1 = mla_g[4 * j16 + 1]; G.mgq2 = mla_g[4 * j16 + 2]; G.mgq3 = mla_g[4 * j16 + 3];
  G.mgq4 = mla_g[64 + j16]; G.mgq5 = mla_g[80 + j16];
  G.mgk0 = mla_g[96 + 4 * j16]; G.mgk1 = mla_g[96 + 4 * j16 + 1]; G.mgk2 = mla_g[96 + 4 * j16 + 2]; G.mgk3 = mla_g[96 + 4 * j16 + 3];
  G.mgk4 = mla_g[96 + 64 + j16]; G.mgk5 = mla_g[96 + 80 + j16];
  const int xcd = blockIdx.x & 7, rk = blockIdx.x >> 3, nrk = gridDim.x >> 3;
  for (int i = rk; i < 512; i += 2 * nrk) {
    const int it = xcd * 512 + i;
    const bool has2 = i + nrk < 512;
    const int it2 = has2 ? it + nrk : it;
    const int tA = it * 4 + wv, tB = it2 * 4 + wv;
    PrepR A, B;
    prep_load(ws, tA, lane, A);
    prep_load(ws, tB, lane, B);
    prep_fin(ws, tA, lane, A, G);
    if (has2) prep_fin(ws, tB, lane, B, G);
  }
  for (int i = rk; i < 96; i += nrk) {
    const int it = i < 64 ? N_TOK + xcd * 64 + i : N_TOK + N_MEMT + xcd * 32 + (i - 64);
    if (false) {
    } else if (it < N_TOK + N_MEMT) {
      const int t = (it - N_TOK) * 4 + wv;
      const int b = t >> 8, mi = t & 255;
      const bf16* kr = (const bf16*)(ws + OFF_KMEMRAW) + (size_t)t * 512;
      const int h = lane >> 4;
      uint2 vw = *(const uint2*)(kr + 256 + lane * 4);
      vec64(true, kr + h * 64, nullptr, 0, (bf16*)(ws + OFF_MK) + ((size_t)(b * 4 + h) * ML + mi) * 64, mem_g + 64, nullptr, 1.f, j16);
      *(uint2*)((bf16*)(ws + OFF_MVV) + ((size_t)(b * 4 + h) * ML + mi) * 64 + j16 * 4) = vw;
    } else {
      const int r = (it - N_TOK - N_MEMT) * 4 + wv;
      const int n = r & 127;
      const bf16* kraw = (const bf16*)(ws + OFF_CMPRAW) + (size_t)r * 128;
      const bf16* vraw = (const bf16*)(ws + OFF_CMPRAW) + (size_t)(1024 + r) * 128;
      const float* cbk = (const float*)(ws + OFF_CBF) + (layer * 2 + 0) * 64;
      const float* cbv = (const float*)(ws + OFF_CBF) + (layer * 2 + 1) * 64;
      bf16* kd = (bf16*)(ws + OFF_KCN) + (size_t)r * 64;
      bf16* vd = (bf16*)(ws + OFF_VCN) + (size_t)r * 64;
      if (n < 127) {
        const int pos = 16 * n + 31;
        const float bv = cbv[lane];
        const float vv = bf2f(vraw[lane]) + bf2f(vraw[(size_t)2 * 1024 * 128 + lane]) + bf2f(vraw[(size_t)4 * 1024 * 128 + lane]) + bf2f(vraw[(size_t)6 * 1024 * 128 + lane]) + bv;
        vec64(lane < 16, kraw, cbk, 1, kd, nsa_g + 64, rope + pos * 32, 1.f, lane & 15, kraw + (size_t)2 * 1024 * 128);
        vd[lane] = f2bf(vv);
      } else {
        kd[lane] = 0; vd[lane] = 0;
      }
    }
  }
}

DI void pl_swap(uint32_t& a, uint32_t& b) { auto r_ = __builtin_amdgcn_permlane32_swap(a, b, false, false); a = r_[0]; b = r_[1]; }
DI void ld_own(const bf16* p, uint2& lo, uint2& hi) {
  const uint4 w = *(const uint4*)p;
  lo.x = w.x; lo.y = w.y; hi.x = w.z; hi.y = w.w;
  pl_swap(lo.x, hi.x); pl_swap(lo.y, hi.y);
}
template <int MODE>
DI void attn_epi(const f32x16 (&O)[2], float scale, const bf16* zrow, const float* sg, const bf16* a1row, const bf16* a2row, bf16* orow, int half) {
#pragma unroll
  for (int dvb = 0; dvb < 2; ++dvb)
#pragma unroll
    for (int pq = 0; pq < 2; ++pq) {
      const int col16 = dvb * 32 + 16 * pq + 8 * half;
      const int dvA = dvb * 32 + 16 * pq + 4 * half;
      float va[4], vb[4];
#pragma unroll
      for (int e = 0; e < 4; ++e) { va[e] = O[dvb][8 * pq + e] * scale; vb[e] = O[dvb][8 * pq + 4 + e] * scale; }
      if (MODE == 2) {
#pragma unroll
        for (int e = 0; e < 4; ++e) { va[e] *= sg[dvA + e]; vb[e] *= sg[dvA + 8 + e]; }
      }
      if (MODE == 3) {
        uint2 clo, chi, wlo, whi;
        ld_own(a1row + col16, clo, chi);
        ld_own(a2row + col16, wlo, whi);
        va[0] += bflo(clo.x) + bflo(wlo.x); va[1] += bfhi(clo.x) + bfhi(wlo.x); va[2] += bflo(clo.y) + bflo(wlo.y); va[3] += bfhi(clo.y) + bfhi(wlo.y);
        vb[0] += bflo(chi.x) + bflo(whi.x); vb[1] += bfhi(chi.x) + bfhi(whi.x); vb[2] += bflo(chi.y) + bflo(whi.y); vb[3] += bfhi(chi.y) + bfhi(whi.y);
      }
      if (MODE >= 1) {
        uint2 zlo, zhi;
        ld_own(zrow + col16, zlo, zhi);
        va[0] *= siluf_(bflo(zlo.x)); va[1] *= siluf_(bfhi(zlo.x)); va[2] *= siluf_(bflo(zlo.y)); va[3] *= siluf_(bfhi(zlo.y));
        vb[0] *= siluf_(bflo(zhi.x)); vb[1] *= siluf_(bfhi(zhi.x)); vb[2] *= siluf_(bflo(zhi.y)); vb[3] *= siluf_(bfhi(zhi.y));
      }
      uint32_t A0 = pack2(va[0], va[1]), A1 = pack2(va[2], va[3]), B0 = pack2(vb[0], vb[1]), B1 = pack2(vb[2], vb[3]);
      pl_swap(A0, B0); pl_swap(A1, B1);
      uint4 o; o.x = A0; o.y = A1; o.z = B0; o.w = B1;
      *(uint4*)(orow + col16) = o;
    }
}
template <int MODE>
DI void attn_epi_lds(const f32x16 (&O)[2], float scale, const bf16* zb, const float* sg, const bf16* a1b, const bf16* a2b, bf16* ob, char* smem) {
  const int tid = opq(threadIdx.x), lane = tid & 63, wv = tid >> 6, half = lane >> 5, l31 = lane & 31;
  float* st = (float*)smem + wv * (32 * 68);
  __syncthreads();
#pragma unroll
  for (int dvb = 0; dvb < 2; ++dvb)
#pragma unroll
    for (int g = 0; g < 4; ++g) {
      float4 v; v.x = O[dvb][4 * g] * scale; v.y = O[dvb][4 * g + 1] * scale; v.z = O[dvb][4 * g + 2] * scale; v.w = O[dvb][4 * g + 3] * scale;
      *(float4*)(st + l31 * 68 + dvb * 32 + 8 * g + 4 * half) = v;
    }
  __syncthreads();
  const int rr = lane >> 3, c8 = (lane & 7) * 8;
#pragma unroll
  for (int i = 0; i < 4; ++i) {
    const int r = rr + 8 * i;
    float4 x0 = *(const float4*)(st + r * 68 + c8), x1 = *(const float4*)(st + r * 68 + c8 + 4);
    if (MODE == 2) {
      const float4 g0 = *(const float4*)(sg + c8), g1 = *(const float4*)(sg + c8 + 4);
      x0.x *= g0.x; x0.y *= g0.y; x0.z *= g0.z; x0.w *= g0.w; x1.x *= g1.x; x1.y *= g1.y; x1.z *= g1.z; x1.w *= g1.w;
    }
    if (MODE == 3) {
      const uint4 cw = *(const uint4*)(a1b + (size_t)r * 256 + c8), ww = *(const uint4*)(a2b + (size_t)r * 256 + c8);
      x0.x += bflo(cw.x) + bflo(ww.x); x0.y += bfhi(cw.x) + bfhi(ww.x); x0.z += bflo(cw.y) + bflo(ww.y); x0.w += bfhi(cw.y) + bfhi(ww.y);
      x1.x += bflo(cw.z) + bflo(ww.z); x1.y += bfhi(cw.z) + bfhi(ww.z); x1.z += bflo(cw.w) + bflo(ww.w); x1.w += bfhi(cw.w) + bfhi(ww.w);
    }
    const uint4 zw = *(const uint4*)(zb + (size_t)r * NP + c8);
    uint4 o;
    o.x = pack2(x0.x * siluf_(bflo(zw.x)), x0.y * siluf_(bfhi(zw.x)));
    o.y = pack2(x0.z * siluf_(bflo(zw.y)), x0.w * siluf_(bfhi(zw.y)));
    o.z = pack2(x1.x * siluf_(bflo(zw.z)), x1.y * siluf_(bfhi(zw.z)));
    o.w = pack2(x1.z * siluf_(bflo(zw.w)), x1.w * siluf_(bfhi(zw.w)));
    *(uint4*)(ob + (size_t)r * 1024 + c8) = o;
  }
}
DI void st4(bf16* dst, float a, float b, float c, float d) { uint2 o; o.x = pack2(a, b); o.y = pack2(c, d); *(uint2*)dst = o; }

DI void attn_phaseA(const Params& p, int layer, char* smem, int* ctr) {
  char* ws = opqp(p.ws);
  bf16* u = (bf16*)(ws + OFF_U);
  bf16* y = (bf16*)(ws + OFF_Y);
  const float* gt = (const float*)(ws + OFF_GT);
  int* s_item = (int*)(smem + SM_MISC);
  const int xcd = blockIdx.x & 7;
  while (true) {
    __syncthreads();
    if (threadIdx.x == 0) *s_item = atomicAdd(ctr + 24 + xcd, 1);
    __syncthreads();
    const int item = *s_item;
    if (item >= 16) break;
    {
      const int tid = opq(threadIdx.x), lane = tid & 63, wv = tid >> 6, half = lane >> 5, l31 = lane & 31;
      const int i2 = item;
      const int qb = 15 - i2, b = xcd;
      const int q0 = qb * 128, qpos = q0 + wv * 32 + l31;
      const size_t t = (size_t)b * S + qpos;
      const bf16* ub = u + (size_t)b * S * NP;
      const bf16* kc = (const bf16*)(ws + OFF_KCN) + (size_t)b * 128 * 64;
      const bf16* vc = (const bf16*)(ws + OFF_VCN) + (size_t)b * 128 * 64;
      const uint32_t tm = (q0 + 127 >= 16 * 64 + 31) ? 3u : 1u;
      float* scl = (float*)(smem + SM_SC) + wv * 32 * 33;
#pragma unroll
      for (int g = 0; g < 16; ++g) scl[l31 * 33 + 2 * g + half] = 0.f;
      const int khi = (qpos - 31) >> 4;
#pragma unroll 1
      for (int h = 0; h < 4; ++h) {
        f32x16 O[2]; float mm, ll;
        bf16x8 Qf[4];
        load_q<64>(ub + (size_t)qpos * NP + C_NQ + h * 64, Qf);
        attn_core<64>(kc, 64, vc, 64, tm, AM_CMP, qpos, 0u, Qf, O, mm, ll, smem);
        const float inv = ll > 0.f ? 1.f / ll : 0.f;
        const float sc = inv * gt[t * 12 + h];
        bf16* od = (bf16*)(ws + OFF_OCMP) + t * 256 + h * 64;
        attn_epi<0>(O, sc, nullptr, nullptr, nullptr, nullptr, od, half);
        const float mu = mm < -1e29f ? 0.f : mm;
        const bf16* Ks = (const bf16*)smem;
        float Aa[16], Cc[16];
#pragma unroll
        for (int g = 0; g < 16; ++g) { Aa[g] = 0.f; Cc[g] = 0.f; }
#pragma unroll
        for (int kt = 0; kt < 2; ++kt) {
          if (tm & (1u << kt)) {
#pragma unroll
            for (int kb = 0; kb < 2; ++kb) {
              f32x16 Sx;
#pragma unroll
              for (int i = 0; i < 16; ++i) Sx[i] = 0.f;
#pragma unroll
              for (int kcx = 0; kcx < 4; ++kcx) {
                bf16x8 a = *(const bf16x8*)(Ks + (kt * 64 + kb * 32 + l31) * 72 + kcx * 16 + half * 8);
                Sx = MFMA(a, Qf[kcx], Sx);
              }
#pragma unroll
              for (int gg = 0; gg < 4; ++gg) {
                float pv[4];
#pragma unroll
                for (int e = 0; e < 4; ++e) {
                  const int key = kt * 64 + kb * 32 + gg * 8 + half * 4 + e;
                  pv[e] = key <= khi ? fexp2(Sx[gg * 4 + e] - mu) * inv : 0.f;
                }
                Aa[kt * 8 + kb * 4 + gg] += pv[0] + 2.f * (pv[1] + pv[2] + pv[3]);
                Cc[kt * 8 + kb * 4 + gg] += pv[0];
              }
            }
          }
        }
        {
          float rc[16];
#pragma unroll
          for (int g = 0; g < 16; ++g) rc[g] = shx(Cc[g], 32);
#pragma unroll
          for (int g = 0; g < 16; ++g) {
            const float nx = half == 0 ? rc[g] : (g < 15 ? rc[g < 15 ? g + 1 : 15] : 0.f);
            scl[l31 * 33 + 2 * g + half] += Aa[g] + nx;
          }
        }
      }
      __syncthreads();
      {
        float sv[32];
        const int cur = qpos >> 6;
#pragma unroll
        for (int j = 0; j < 32; ++j) {
          float v = scl[l31 * 33 + j];
          const bool forced = (j == 0) || (j == cur) || (j == cur - 1);
          sv[j] = j > cur ? -1e30f : (forced ? 1e30f : v);
        }
        uint32_t bits = 0;
#pragma unroll 1
        for (int jj = 0; jj < 16; ++jj) {
          const int j = half * 16 + jj;
          float sj = scl[l31 * 33 + j];
          const bool fj = (j == 0) || (j == cur) || (j == cur - 1);
          sj = j > cur ? -1e30f : (fj ? 1e30f : sj);
          int rank = 0;
#pragma unroll
          for (int i = 0; i < 32; ++i) rank += (sv[i] > sj || (sv[i] == sj && i < j)) ? 1 : 0;
          if (rank < 16) bits |= 1u << j;
        }
        bits |= (uint32_t)__shfl_xor((int)bits, 32);
        if (half == 0) ((uint32_t*)(ws + OFF_SEL))[t] = bits;
      }
      wg_publish((unsigned*)(ws + OFF_FLAG) + layer * 1024 + (b * 16 + qb) * 8);
    }
  }
  while (true) {
    __syncthreads();
    if (threadIdx.x == 0) *s_item = atomicAdd(ctr + 16 + xcd, 1);
    __syncthreads();
    const int item = *s_item;
    if (item >= 128) break;
    {
      const int tid = opq(threadIdx.x), lane = tid & 63, wv = tid >> 6, half = lane >> 5, l31 = lane & 31;
      const int i2 = item;
      const int ismem = i2 >> 6, r = i2 & 63, qb = 15 - (r >> 2), b = xcd, h = r & 3;
      const int q0 = qb * 128, qpos = q0 + wv * 32 + l31;
      const size_t t = (size_t)b * S + qpos;
      const bf16* ub = u + (size_t)b * S * NP;
      f32x16 O[2]; float mm, ll;
      bf16x8 Qf[4];
      if (!ismem) {
        load_q<64>(ub + (size_t)qpos * NP + C_NQ + h * 64, Qf);
        const int kt0 = q0 >= 512 ? (q0 - 512) / 64 : 0, kt1 = 2 * qb + 2;
        const uint32_t hi = kt1 >= 32 ? 0xffffffffu : ((1u << kt1) - 1u);
        const uint32_t tm = hi & ~((1u << kt0) - 1u);
        attn_core<64>(ub + C_KW, NP, ub + C_VW, NP, tm, AM_WIN, qpos, 0u, Qf, O, mm, ll, smem);
        const float sc = (ll > 0.f ? 1.f / ll : 0.f) * gt[t * 12 + 8 + h];
        bf16* od = (bf16*)(ws + OFF_OWIN) + t * 256 + h * 64;
        attn_epi<0>(O, sc, nullptr, nullptr, nullptr, nullptr, od, half);
        wg_publish((unsigned*)(ws + OFF_FLAG) + layer * 1024 + (b * 16 + qb) * 8 + 1 + h);
      } else {
        load_q<64>(ub + (size_t)qpos * NP + C_MQ + h * 64, Qf);
        attn_core<64>((const bf16*)(ws + OFF_MK) + (size_t)(b * 4 + h) * ML * 64, 64, (const bf16*)(ws + OFF_MVV) + (size_t)(b * 4 + h) * ML * 64, 64,
                      0xfu, AM_NONE, qpos, 0u, Qf, O, mm, ll, smem);
        const float inv = ll > 0.f ? 1.f / ll : 0.f;
        attn_epi_lds<1>(O, inv, u + (t - l31) * NP + C_MEZ + h * 64, nullptr, nullptr, nullptr, y + (t - l31) * 1024 + 768 + h * 64, smem);
      }
    }
  }
  while (true) {
    __syncthreads();
    if (threadIdx.x == 0) *s_item = atomicAdd(ctr + xcd, 1);
    __syncthreads();
    const int item = *s_item;
    if (item >= 64) break;
    {
      const int tid = opq(threadIdx.x), lane = tid & 63, wv = tid >> 6, half = lane >> 5, l31 = lane & 31;
      const int qb = 15 - (item >> 2), b = xcd, h = item & 3;
      const int q0 = qb * 128, qpos = q0 + wv * 32 + l31;
      const size_t t = (size_t)b * S + qpos;
      const uint32_t tm = (qb == 15) ? 0xffffffffu : ((1u << (2 * qb + 2)) - 1u);
      f32x16 O[2]; float mm, ll;
        bf16x8 Qf[6];
        const bf16* qm = (const bf16*)(ws + OFF_QM) + (size_t)(b * 4 + h) * S * 96;
        load_q<96>(qm + (size_t)qpos * 96, Qf);
        attn_core<96>((const bf16*)(ws + OFF_KM) + (size_t)(b * 4 + h) * S * 96, 96,
                      (const bf16*)(ws + OFF_MV) + (size_t)(b * 4 + h) * S * 64, 64, tm, AM_CAUSAL, qpos, 0u, Qf, O, mm, ll, smem);
        const float inv = ll > 0.f ? 1.f / ll : 0.f;
        attn_epi_lds<1>(O, inv, u + (t - l31) * NP + C_MZ + h * 64, nullptr, nullptr, nullptr, y + (t - l31) * 1024 + 512 + h * 64, smem);
    }
  }
  while (true) {
    __syncthreads();
    if (threadIdx.x == 0) *s_item = atomicAdd(ctr + 8 + xcd, 1);
    __syncthreads();
    const int item = *s_item;
    if (item >= 64) break;
    {
      const int tid = opq(threadIdx.x), lane = tid & 63, wv = tid >> 6, half = lane >> 5, l31 = lane & 31;
      const int qb = 15 - (item >> 2), b = xcd, h = item & 3;
      const int q0 = qb * 128, qpos = q0 + wv * 32 + l31;
      const size_t t = (size_t)b * S + qpos;
      const uint32_t tm = (qb == 15) ? 0xffffffffu : ((1u << (2 * qb + 2)) - 1u);
      f32x16 O[2]; float mm, ll;
        f32x16 O1[2];
        const bf16* ub = u + (size_t)b * S * NP;
        {
          bf16x8 Qf[4];
          float l1, l2;
          load_q<64>(ub + (size_t)qpos * NP + C_DQ + h * 64, Qf);
          attn_core_dual<64>(ub + C_DK + h * 64, NP, ub + C_DV + h * 64, NP, tm, AM_CAUSAL, qpos, 0u, Qf, O1, O, l1, l2, smem);
          const float inv1 = l1 > 0.f ? 1.f / l1 : 0.f, inv = l2 > 0.f ? 1.f / l2 : 0.f;
#pragma unroll
          for (int i = 0; i < 16; ++i) { O1[0][i] *= inv1; O1[1][i] *= inv1; }
          {
            const float lam = ((const float*)(ws + OFF_LAM))[layer];
            float ss = 0.f;
#pragma unroll
            for (int i = 0; i < 16; ++i) {
              O1[0][i] -= lam * O[0][i] * inv; O1[1][i] -= lam * O[1][i] * inv;
              ss += O1[0][i] * O1[0][i] + O1[1][i] * O1[1][i];
            }
            ss += shx(ss, 32);
            const float li = opq(layer) == 0 ? 0.2f : 0.35550907f;
            const float r = rsqrtf(ss * (1.f / 64.f) + EPS) * (1.f - li);
            const float* sg = p.in[10] + layer * 64;
            attn_epi_lds<2>(O1, r, u + (t - l31) * NP + C_DZ + h * 64, sg, nullptr, nullptr, y + (t - l31) * 1024 + 256 + h * 64, smem);
          }
        }
    }
  }
}

DI void attn_phaseB(const Params& p, int layer, char* smem, int* ctr) {
  const int tid = opq(threadIdx.x), lane = tid & 63, wv = tid >> 6, half = lane >> 5, l31 = lane & 31;
  char* ws = opqp(p.ws);
  bf16* u = (bf16*)(ws + OFF_U);
  bf16* y = (bf16*)(ws + OFF_Y);
  const float* gt = (const float*)(ws + OFF_GT);
  int* s_item = (int*)(smem + SM_MISC);
  uint32_t* s_or = (uint32_t*)(smem + SM_MISC + 16);
  const int xcd = blockIdx.x & 7;
  while (true) {
    __syncthreads();
    if (tid == 0) { *s_item = atomicAdd(ctr + xcd, 1); *s_or = 0u; }
    __syncthreads();
    const int item = *s_item;
    if (item >= 64) break;
    const int qb = 15 - (item >> 2), b = xcd, h = item & 3;
    const int q0 = qb * 128, qpos = q0 + wv * 32 + l31;
    const size_t t = (size_t)b * S + qpos;
    const bf16* ub = u + (size_t)b * S * NP;
    wg_wait2((unsigned*)(ws + OFF_FLAG) + layer * 1024 + (b * 16 + qb) * 8, (unsigned*)(ws + OFF_FLAG) + layer * 1024 + (b * 16 + qb) * 8 + 1 + h);
    const uint32_t sel = ((const uint32_t*)(ws + OFF_SEL))[t];
    const uint32_t causal = (qb == 15) ? 0xffffffffu : ((1u << (2 * qb + 2)) - 1u);
    if (half == 0) atomicOr(s_or, sel);
    __syncthreads();
    const uint32_t tm = (*s_or & causal) | 1u;
    f32x16 O[2]; float mm, ll;
    bf16x8 Qf[4];
    load_q<64>(ub + (size_t)qpos * NP + C_NQ + h * 64, Qf);
    attn_core<64>(ub + C_KS, NP, ub + C_VS, NP, tm, AM_SLC, qpos, sel, Qf, O, mm, ll, smem);
    const float sc = (ll > 0.f ? 1.f / ll : 0.f) * gt[t * 12 + 4 + h];
    const bf16* oc = (const bf16*)(ws + OFF_OCMP) + t * 256 + h * 64;
    const bf16* ow = (const bf16*)(ws + OFF_OWIN) + t * 256 + h * 64;
    attn_epi_lds<3>(O, sc, u + (t - l31) * NP + C_NZ + h * 64, nullptr, oc - (size_t)l31 * 256, ow - (size_t)l31 * 256, y + (t - l31) * 1024 + h * 64, smem);
  }
  (void)layer;
}

__global__ void __launch_bounds__(256, 2) fwd_megakernel(Params p) {
  __shared__ __attribute__((aligned(16))) char smem[SMEM_BYTES];
  cg::grid_group grid = cg::this_grid();
  char* ws = opqp(p.ws);
  int* ctrs = (int*)(ws + OFF_CTR);
  __shared__ uint4 xb_words;
  if (threadIdx.x == 0) xb_words = make_uint4(0u, 0u, 0u, 0u);
  __syncthreads();
  XcdBarrier xb = xcd_barrier_post((unsigned*)(ws + OFF_BAR), (volatile LAS unsigned*)&xb_words);
  phase0(p, smem);
  if (p.out == nullptr) grid.sync();
  xcd_barrier(xb);
  if (blockIdx.x == 0) {
    const int tq = opq(threadIdx.x);
    const float* cbp = (const float*)(opqp(p.ws) + OFF_CB) + (tq >> 6) * 16 * 64 + (tq & 63);
    float a = 0.f;
#pragma unroll
    for (int sidx = 0; sidx < 16; ++sidx) a += cbp[sidx * 64];
    ((float*)(opqp(p.ws) + OFF_CBF))[tq] = a;
  }
#define PBAR(K) xcd_barrier(xb)
  for (int layer = 0; layer < 2; ++layer) {
    bf16* u = (bf16*)(ws + OFF_U);
    {
      const bf16* xbp = (const bf16*)(ws + OFF_XB);
      const bf16* wi = (const bf16*)(ws + OFF_WI + layer * SZ_WI);
      const int xcd = blockIdx.x & 7, rk = blockIdx.x >> 3, nrk = gridDim.x >> 3;
      for (int q = rk; q < 216; q += nrk) {
        if (q < 192) {
          const int mt = xcd * 8 + (q & 7), nt = q >> 3;
          gemm_big(xbp + (size_t)mt * 256 * 1024, 1024, wi + (size_t)nt * 128 * 1024, 1024, 16, smem, EPI_RS8, u, NP, mt * 256,
                   (const float*)(ws + OFF_SSQ), nullptr, nullptr, nullptr, nullptr, nt);
        } else if (q < 208) {
          const int mt = xcd * 16 + (q - 192), nt = 24;
          gemm_tile<16>(xbp + (size_t)mt * 128 * 1024, 1024, 64, wi + (size_t)nt * 128 * 1024, 1024, 16, smem);
          gemm_epi(EPI_RS8, smem, u, NP, mt * 128, (const float*)(ws + OFF_SSQ), nullptr, nullptr, nullptr, nullptr, nt);
        } else {
          const int i = xcd * 8 + (q - 208), mt = i >> 2, nt = i & 3;
          gemm_tile<16>((const bf16*)(ws + OFF_MEMB) + (size_t)mt * 128 * 1024, 1024, 64,
                    (const bf16*)(ws + OFF_WMEM + layer * SZ_WMEM) + (size_t)nt * 128 * 1024, 1024, 16, smem);
          gemm_epi(EPI_RS1, smem, (bf16*)(ws + OFF_KMEMRAW), 512, mt * 128, (const float*)(ws + OFF_RMEM), nullptr, nullptr, nullptr, nullptr, nt);
        }
      }
    }
    PBAR(0);
    {
      const int xcd = blockIdx.x & 7, rk = blockIdx.x >> 3, nrk = gridDim.x >> 3;
      for (int q = rk; q < 64; q += nrk) {
        if (q < 8) {
          const int j = q >> 2, kh = q & 3, b = xcd;
          gemm_tile<8>(u + (size_t)b * S * NP + (j ? C_VC : C_KC) + (size_t)kh * 8 * NP, 16 * NP, NP,
                       (const bf16*)(ws + OFF_WCMP + (layer * 2 + j) * SZ_WCMP) + kh * 512, 2048, 8, smem);
          gemm_epi(EPI_PLAIN, smem, (bf16*)(ws + OFF_CMPRAW) + (size_t)(kh * 2 + j) * 1024 * 128, 128, b * 128, nullptr, nullptr, nullptr, nullptr, nullptr, 0);
        } else if (q < 32) {
          const int i = q - 8, ml = i / 3, nt = i % 3, mt = xcd * 8 + ml;
          gemm_big(u + (size_t)mt * 256 * NP + C_CQ, NP, (const bf16*)(ws + OFF_WUQ + layer * SZ_WUQ) + (size_t)nt * 128 * 256, 256, 4, smem, EPI_PLAIN,
                   (bf16*)(ws + OFF_UQ + (size_t)xcd * SLAB), 384, ml * 256, nullptr, nullptr, nullptr, nullptr, nullptr, nt);
        } else {
          const int i = q - 32, ml = i >> 2, nt = i & 3, mt = xcd * 8 + ml;
          gemm_big(u + (size_t)mt * 256 * NP + C_CKV, NP, (const bf16*)(ws + OFF_WUKV + layer * SZ_WUKV) + (size_t)nt * 128 * 128, 128, 2, smem, EPI_PLAIN,
                   (bf16*)(ws + OFF_UKV + (size_t)xcd * SLAB), 512, ml * 256, nullptr, nullptr, nullptr, nullptr, nullptr, nt);
        }
      }
    }
    PBAR(1);
    prep_phase(p, layer);
    PBAR(2);
    attn_phaseA(p, layer, smem, ctrs + layer * 64);
    attn_phaseB(p, layer, smem, ctrs + layer * 64 + 32);
    PBAR(3);
    {
      const bf16* yb = (const bf16*)(ws + OFF_Y);
      const bf16* wo = (const bf16*)(ws + OFF_WO + layer * SZ_WO);
      const float* xres = layer == 0 ? p.in[0] : nullptr;
      const int xcd = blockIdx.x & 7, rk = blockIdx.x >> 3, nrk = gridDim.x >> 3;
      for (int q = rk; q < 64; q += nrk) {
        const int mt = xcd * 8 + (q & 7), nt = q >> 3;
        gemm_big(yb + (size_t)mt * 256 * 1024, 1024, wo + (size_t)nt * 128 * 1024, 1024, 16, smem, EPI_OUT, (bf16*)(ws + OFF_XB), 0, mt * 256, nullptr, xres, layer == 0 ? nullptr : p.out,
                 layer == 0 ? (bf16*)(ws + OFF_XB) : nullptr, (float*)(ws + OFF_SSQ), nt);
      }
    }
    if (layer == 0) PBAR(4);
  }
}

extern "C" void kernel_launch(void* const* d_in, const int* in_sizes, int n_in, void* d_out, int out_size, void* d_ws, size_t ws_size,
                              hipStream_t stream) {
  static int grid_blocks = 0;
  if (!grid_blocks) {
    int dev = 0, cus = 0, per_cu = 0;
    hipGetDevice(&dev);
    hipDeviceGetAttribute(&cus, hipDeviceAttributeMultiprocessorCount, dev);
    hipOccupancyMaxActiveBlocksPerMultiprocessor(&per_cu, fwd_megakernel, 256, 0);
    if (per_cu > 2) per_cu = 2;
    grid_blocks = (cus * per_cu) & ~7;
  }
  if (ws_size < WS_TOTAL) { fprintf(stderr, "workspace too small: %zu < %zu\n", ws_size, (size_t)WS_TOTAL); return; }
  Params p{};
  for (int i = 0; i < 19; ++i) p.in[i] = (const float*)d_in[i];
  p.out = (float*)d_out;
  p.ws = (char*)d_ws;
  hipMemsetAsync((char*)d_ws + OFF_CTR, 0, 1024 + 16384 + 8192 + 2048, stream);
  void* args[] = {&p};
  hipError_t e = hipLaunchCooperativeKernel((void*)fwd_megakernel, dim3(grid_blocks), dim3(256), args, 0, stream);
  if (e != hipSuccess) fprintf(stderr, "cooperative launch failed: %s (grid %d)\n", hipGetErrorString(e), grid_blocks);
}
```

```cpp
#include <hip/hip_runtime.h>
#include <hip/hip_cooperative_groups.h>
#include <stdint.h>
#include <cstdio>
namespace cg = cooperative_groups;

typedef unsigned short bf16;
using bf16x8 = __attribute__((ext_vector_type(8))) short;
using f32x16 = __attribute__((ext_vector_type(16))) float;
typedef __bf16 hbf2 __attribute__((ext_vector_type(2)));
typedef float hf2 __attribute__((ext_vector_type(2)));
typedef uint32_t u32x4 __attribute__((ext_vector_type(4)));
#define GLD16(dst, ptr) asm volatile("global_load_dwordx4 %0, %1, off" : "=&v"(dst) : "v"(ptr) : "memory")
#define WAIT_VM0() asm volatile("s_waitcnt vmcnt(0)" ::: "memory")
#define DI __device__ __forceinline__
#define MFMA(a, b, c) __builtin_amdgcn_mfma_f32_32x32x16_bf16((a), (b), (c), 0, 0, 0)

constexpr int Bn = 8, S = 2048, T = 16384, D = 1024, NP = 3200, ML = 256, TM = 2048;
constexpr float EPS = 1e-6f;
constexpr float LOG2E = 1.4426950408889634f;
constexpr int C_NQ = 0, C_KC = 256, C_VC = 320, C_KS = 384, C_VS = 448, C_KW = 512, C_VW = 576, C_NZ = 640,
              C_DQ = 896, C_DK = 1152, C_DV = 1408, C_DZ = 1664, C_CQ = 1920, C_CKV = 2176, C_KR = 2304,
              C_MZ = 2336, C_MQ = 2592, C_MEZ = 2848, C_GL = 3104;
constexpr size_t SZ_WI = (size_t)NP * 1024 * 2, SZ_WO = 1024 * 1024 * 2, SZ_WUQ = 384 * 256 * 2, SZ_WUKV = 512 * 128 * 2,
                 SZ_WMEM = 512 * 1024 * 2, SZ_WCMP = 128 * 2048 * 2;
constexpr size_t OFF_WI = 0;
constexpr size_t OFF_WO = OFF_WI + 2 * SZ_WI;
constexpr size_t OFF_WUQ = OFF_WO + 2 * SZ_WO;
constexpr size_t OFF_WUKV = OFF_WUQ + 2 * SZ_WUQ;
constexpr size_t OFF_WMEM = OFF_WUKV + 2 * SZ_WUKV;
constexpr size_t OFF_WCMP = OFF_WMEM + 2 * SZ_WMEM;
constexpr size_t OFF_CB = OFF_WCMP + 4 * SZ_WCMP;
constexpr size_t OFF_CBF = OFF_CB + 16384;
constexpr size_t OFF_LAM = OFF_CBF + 1024;
constexpr size_t OFF_CTR = OFF_LAM + 256;
constexpr size_t OFF_BAR = OFF_CTR + 1024;
constexpr size_t OFF_FLAG = OFF_BAR + 16384;
constexpr size_t OFF_PCNT = OFF_FLAG + 8192;
constexpr size_t OFF_ROPE = OFF_PCNT + 2048;
constexpr size_t OFF_SSQ = OFF_ROPE + 2048 * 32 * 8;
constexpr size_t OFF_RMEM = OFF_SSQ + (size_t)T * 8 * 4;
constexpr size_t OFF_MEMB = OFF_RMEM + 2048 * 4;
constexpr size_t OFF_XB = OFF_MEMB + (size_t)TM * 1024 * 2;
constexpr size_t OFF_U = OFF_XB + (size_t)T * 1024 * 2;
constexpr size_t OFF_R1 = OFF_U + (size_t)T * NP * 2;
constexpr size_t SLAB = (size_t)S * 1024 * 2;
constexpr size_t OFF_UQ = OFF_R1;
constexpr size_t OFF_UKV = OFF_R1 + (size_t)S * 384 * 2;
constexpr size_t OFF_Y = OFF_R1;
constexpr size_t OFF_QM = OFF_R1 + (size_t)T * 1024 * 2;
constexpr size_t OFF_KM = OFF_QM + (size_t)T * 384 * 2;
constexpr size_t OFF_MV = OFF_KM + (size_t)T * 384 * 2;
constexpr size_t OFF_KMEMRAW = OFF_MV + (size_t)T * 256 * 2;
constexpr size_t OFF_MK = OFF_KMEMRAW + (size_t)TM * 512 * 2;
constexpr size_t OFF_MVV = OFF_MK + (size_t)TM * 256 * 2;
constexpr size_t OFF_CMPRAW = OFF_MVV + (size_t)TM * 256 * 2;
constexpr size_t OFF_KCN = OFF_CMPRAW + 8 * 1024 * 128 * 2;
constexpr size_t OFF_VCN = OFF_KCN + 8 * 128 * 64 * 2;
constexpr size_t OFF_GT = OFF_VCN + 8 * 128 * 64 * 2;
constexpr size_t OFF_OCMP = OFF_GT + (size_t)T * 12 * 4;
constexpr size_t OFF_OWIN = OFF_OCMP + (size_t)T * 256 * 2;
constexpr size_t OFF_SEL = OFF_OWIN + (size_t)T * 256 * 2;
constexpr size_t WS_TOTAL = OFF_SEL + (size_t)T * 4;

constexpr int SMEM_BYTES = 73728;
constexpr int SM_VT = 2 * 64 * 104 * 2;
constexpr int SM_SC = SM_VT + 2 * 64 * 72 * 2;
constexpr int SM_MISC = SM_SC + 4 * 32 * 33 * 4;

struct Params {
  const float* in[19];
  float* out;
  char* ws;
};

DI int opq(int v) { asm volatile("" : "+v"(v)); return v; }
DI char* opqp(char* q) { size_t z = 0; asm volatile("" : "+s"(z)); return q + z; }
typedef float f32x4v __attribute__((ext_vector_type(4)));
DI float4 ld_nt4(const float4* p) { const f32x4v v = __builtin_nontemporal_load((const f32x4v*)p); float4 r; r.x = v[0]; r.y = v[1]; r.z = v[2]; r.w = v[3]; return r; }
DI void st_nt4(float4* p, const float4& a) { f32x4v v; v[0] = a.x; v[1] = a.y; v[2] = a.z; v[3] = a.w; __builtin_nontemporal_store(v, (f32x4v*)p); }
DI float bf2f(uint32_t v) { return __uint_as_float(v << 16); }
DI float bflo(uint32_t w) { return __uint_as_float(w << 16); }
DI float bfhi(uint32_t w) { return __uint_as_float(w & 0xffff0000u); }
DI uint32_t pack2(float a, float b) { hf2 f = {a, b}; hbf2 r = __builtin_convertvector(f, hbf2); return __builtin_bit_cast(uint32_t, r); }
DI bf16 f2bf(float a) { return (bf16)(pack2(a, 0.f) & 0xffffu); }
DI float fexp2(float x) { return __builtin_amdgcn_exp2f(x); }
DI float sigmoidf_(float x) { return __builtin_amdgcn_rcpf(1.f + fexp2(-LOG2E * x)); }
DI float siluf_(float x) { return x * __builtin_amdgcn_rcpf(1.f + fexp2(-LOG2E * x)); }
DI float shx(float v, int m) { return __shfl_xor(v, m); }
DI float dppf(float v, int ctrl_sel) {
  int x = __builtin_bit_cast(int, v), r;
  if (ctrl_sel == 0) r = __builtin_amdgcn_mov_dpp(x, 0xB1, 0xF, 0xF, true);
  else if (ctrl_sel == 1) r = __builtin_amdgcn_mov_dpp(x, 0x4E, 0xF, 0xF, true);
  else if (ctrl_sel == 2) r = __builtin_amdgcn_mov_dpp(x, 0x141, 0xF, 0xF, true);
  else r = __builtin_amdgcn_mov_dpp(x, 0x140, 0xF, 0xF, true);
  return __builtin_bit_cast(float, r);
}
DI float sum8(float v) { v += dppf(v, 0); v += dppf(v, 1); v += dppf(v, 2); return v; }
DI float sum16(float v) { v = sum8(v); v += dppf(v, 3); return v; }
DI float sum64(float v) { v = sum16(v); v += shx(v, 16); v += shx(v, 32); return v; }


#define XB_TMO      128
#define XB_XCNT(j)  (256  + 64 * (j))
#define XB_XSUB(j)  (1280 + 64 * (j))
#define XB_XGEN(j)  (2304 + 64 * (j))
#define XB_TOP      3328
#define XB_TOPGEN   3392
#define XB_SPIN_CAP (1u << 22)
#define LAS __attribute__((address_space(3)))
DI unsigned xb_ld(unsigned* p) { return __hip_atomic_load(p, __ATOMIC_RELAXED, __HIP_MEMORY_SCOPE_AGENT); }
DI unsigned xb_add(unsigned* p, unsigned v) { return __hip_atomic_fetch_add(p, v, __ATOMIC_RELAXED, __HIP_MEMORY_SCOPE_AGENT); }
DI unsigned xb_xcc_id() { return (unsigned)__builtin_amdgcn_readfirstlane((int)(__builtin_amdgcn_s_getreg((3 << 11) | 20) & 0xFu)); }
#define XB_SPIN(cond, bar) do { unsigned _sp = 0; while (cond) { __builtin_amdgcn_s_sleep(1); \
    if ((++_sp & 255u) == 0u) { if (xb_ld(&(bar)[XB_TMO])) break; if (_sp > XB_SPIN_CAP) { atomicAdd(&(bar)[XB_TMO], 1u); break; } } } } while (0)
struct XcdBarrier { unsigned* bar; unsigned x; volatile LAS unsigned* st; };
DI XcdBarrier xcd_barrier_post(unsigned* bar, volatile LAS unsigned* st) {
  XcdBarrier b; b.bar = bar; b.x = xb_xcc_id(); b.st = st;
  if (threadIdx.x == 0) (void)xb_add(&bar[XB_XCNT(b.x)], 1u);
  return b;
}
DI void xcd_barrier_complete(unsigned* bar, unsigned x, unsigned& nloc, unsigned& nx) {
  const unsigned G = gridDim.x * gridDim.y * gridDim.z;
  unsigned sum, cnt, mine, sp = 0u;
  for (;;) {
    sum = 0u; cnt = 0u; mine = 0u;
#pragma unroll
    for (unsigned j = 0; j < 16; ++j) { const unsigned c = xb_ld(&bar[XB_XCNT(j)]); sum += c; cnt += (c > 0u) ? 1u : 0u; mine = (j == x) ? c : mine; }
    if (sum == G) break;
    __builtin_amdgcn_s_sleep(1);
    if ((++sp & 255u) == 0u) { if (xb_ld(&bar[XB_TMO])) break; if (sp > XB_SPIN_CAP) { atomicAdd(&bar[XB_TMO], 1u); break; } }
  }
  nloc = mine > 0u ? mine : 1u; nx = cnt > 0u ? cnt : 1u;
}
DI void xcd_barrier(const XcdBarrier& b) {
  asm volatile("s_waitcnt vmcnt(0)" ::: "memory");
  __syncthreads();
  if (threadIdx.x == 0) {
    unsigned* bar = b.bar;
    const unsigned bx = xb_xcc_id();
    __builtin_amdgcn_s_waitcnt(0);
    unsigned nloc = b.st[0], nx = b.st[1];
    if (nloc == 0u) { xcd_barrier_complete(bar, bx, nloc, nx); b.st[0] = nloc; b.st[1] = nx; }
    const unsigned old = xb_add(&bar[XB_XSUB(bx)], 1u);
    const unsigned gen = old / nloc;
    if (old + 1u == (gen + 1u) * nloc) {
      __builtin_amdgcn_fence(__ATOMIC_RELEASE, "agent");
      asm volatile("s_waitcnt vmcnt(0)" ::: "memory");
      const unsigned og = xb_add(&bar[XB_TOP], 1u);
      const unsigned tg = og / nx;
      if (og + 1u == (tg + 1u) * nx) xb_add(&bar[XB_TOPGEN], 1u);
      else XB_SPIN(xb_ld(&bar[XB_TOPGEN]) == tg, bar);
      __builtin_amdgcn_fence(__ATOMIC_ACQUIRE, "agent");
      xb_add(&bar[XB_XGEN(bx)], 1u);
      asm volatile("s_waitcnt vmcnt(0)" ::: "memory");
    } else {
      XB_SPIN(xb_ld(&bar[XB_XGEN(bx)]) == gen, bar);
      __builtin_amdgcn_fence(__ATOMIC_ACQUIRE, "agent");
      asm volatile("s_waitcnt vmcnt(0)" ::: "memory");
    }
  }
  __syncthreads();
}

DI void part_barrier(unsigned* cnt, unsigned target) {
  asm volatile("s_waitcnt vmcnt(0)" ::: "memory");
  __syncthreads();
  if (threadIdx.x == 0) {
    __builtin_amdgcn_s_waitcnt(0);
    __builtin_amdgcn_fence(__ATOMIC_RELEASE, "agent");
    asm volatile("s_waitcnt vmcnt(0)" ::: "memory");
    xb_add(cnt, 1u);
    unsigned sp = 0;
    while (xb_ld(cnt) < target) { __builtin_amdgcn_s_sleep(1); if (++sp > (1u << 24)) break; }
    __builtin_amdgcn_fence(__ATOMIC_ACQUIRE, "agent");
    asm volatile("s_waitcnt vmcnt(0)" ::: "memory");
  }
  __syncthreads();
}

DI void wg_publish(unsigned* flag) {
  asm volatile("s_waitcnt vmcnt(0)" ::: "memory");
  __syncthreads();
  if (threadIdx.x == 0) {
    __builtin_amdgcn_fence(__ATOMIC_RELEASE, "agent");
    asm volatile("s_waitcnt vmcnt(0)" ::: "memory");
    xb_add(flag, 1u);
  }
}
DI void wg_wait2(unsigned* f0, unsigned* f1) {
  if (threadIdx.x == 0) {
    unsigned sp = 0;
    while (xb_ld(f0) < 1u || xb_ld(f1) < 1u) { __builtin_amdgcn_s_sleep(2); if (++sp > (1u << 22)) break; }
    __builtin_amdgcn_fence(__ATOMIC_ACQUIRE, "agent");
    asm volatile("s_waitcnt vmcnt(0)" ::: "memory");
  }
  __syncthreads();
}

DI int win_orig(int n) { return n < 640 ? n : (n < 3104 ? n + 12 : (n < 3116 ? n - 3104 + 640 : -1)); }

DI void convT_tile(const float* __restrict__ src, int Nsrc, const float* __restrict__ gain, bf16* __restrict__ dst, int K,
                   int k0, int n0, int mapmode, float* tile) {
  const int tid = opq(threadIdx.x);
  int shift = -1;
  if (mapmode == 1) { if (n0 + 63 < 640) shift = 0; else if (n0 >= 640 && n0 + 63 < 3104) shift = 12; }
  else if (n0 + 63 < Nsrc) shift = 0;
  const bool allpad = (mapmode == 1) ? (n0 >= 3116) : (n0 >= Nsrc);
  if (shift >= 0) {
    const int f = tid & 15, kr = tid >> 4;
    float4 v[4];
#pragma unroll
    for (int it = 0; it < 4; ++it) v[it] = *(const float4*)(src + (size_t)(k0 + kr + 16 * it) * Nsrc + n0 + shift + 4 * f);
    if (gain) {
#pragma unroll
      for (int it = 0; it < 4; ++it) { const float g = gain[k0 + kr + 16 * it]; v[it].x *= g; v[it].y *= g; v[it].z *= g; v[it].w *= g; }
    }
#pragma unroll
    for (int it = 0; it < 4; ++it) {
      float* tp = tile + (kr + 16 * it) * 65 + 4 * f;
      tp[0] = v[it].x; tp[1] = v[it].y; tp[2] = v[it].z; tp[3] = v[it].w;
    }
  } else {
    const int nn = tid & 63, kk = tid >> 6;
    const int n = n0 + nn;
    const int on = allpad ? -1 : (mapmode == 1 ? win_orig(n) : (n < Nsrc ? n : -1));
    float v[16];
#pragma unroll
    for (int it = 0; it < 16; ++it) {
      const int k = k0 + kk + 4 * it;
      v[it] = 0.f;
      if (on >= 0) v[it] = src[(size_t)k * Nsrc + on];
    }
    if (gain) {
#pragma unroll
      for (int it = 0; it < 16; ++it) v[it] *= gain[k0 + kk + 4 * it];
    }
#pragma unroll
    for (int it = 0; it < 16; ++it) tile[(kk + 4 * it) * 65 + nn] = v[it];
  }
  __syncthreads();
  {
    const int k8 = (tid & 7) * 8, nb = tid >> 3;
#pragma unroll
    for (int it = 0; it < 2; ++it) {
      const int n = nb + 32 * it;
      uint4 o;
      o.x = pack2(tile[(k8 + 0) * 65 + n], tile[(k8 + 1) * 65 + n]);
      o.y = pack2(tile[(k8 + 2) * 65 + n], tile[(k8 + 3) * 65 + n]);
      o.z = pack2(tile[(k8 + 4) * 65 + n], tile[(k8 + 5) * 65 + n]);
      o.w = pack2(tile[(k8 + 6) * 65 + n], tile[(k8 + 7) * 65 + n]);
      *(uint4*)(dst + (size_t)(n0 + n) * K + k0 + k8) = o;
    }
  }
  __syncthreads();
}

DI void phase0(const Params& p, char* smem) {
  const int tid = opq(threadIdx.x), lane = tid & 63, wv = tid >> 6;
  float* tile = (float*)smem;
  char* ws = opqp(p.ws);
  constexpr int N_WI = 2 * 50 * 16, N_WO = 2 * 16 * 16, N_WUQ = 2 * 6 * 4, N_WUKV = 2 * 8 * 2, N_WMEM = 2 * 8 * 16,
                N_WCMP = 4 * 2 * 32, N_X = T / 4, N_MEM = TM / 4, N_ROPE = 256, N_CB = 64, N_LAM = 1;
  constexpr int E0 = N_WI, E1 = E0 + N_WO, E2 = E1 + N_WUQ, E3 = E2 + N_WUKV, E4 = E3 + N_WMEM, E5 = E4 + N_WCMP,
                E6 = E5 + N_X, E7 = E6 + N_MEM, E8 = E7 + N_ROPE, E9 = E8 + N_CB, E10 = E9 + N_LAM;
  for (int it = blockIdx.x; it < E10; it += gridDim.x) {
    if (it < E0) {
      int l = it / 800, r = it % 800, nt = r / 16, kt = r % 16;
      convT_tile(p.in[3] + (size_t)l * 1024 * 3116, 3116, p.in[2] + l * 1024, (bf16*)(ws + OFF_WI + l * SZ_WI), 1024, kt * 64, nt * 64, 1, tile);
    } else if (it < E1) {
      int i = it - E0; int l = i / 256, r = i % 256, nt = r / 16, kt = r % 16;
      convT_tile(p.in[4] + (size_t)l * 1024 * 1024, 1024, nullptr, (bf16*)(ws + OFF_WO + l * SZ_WO), 1024, kt * 64, nt * 64, 0, tile);
    } else if (it < E2) {
      int i = it - E1; int l = i / 24, r = i % 24, nt = r / 4, kt = r % 4;
      convT_tile(p.in[13] + (size_t)l * 256 * 384, 384, p.in[11] + l * 256, (bf16*)(ws + OFF_WUQ + l * SZ_WUQ), 256, kt * 64, nt * 64, 0, tile);
    } else if (it < E3) {
      int i = it - E2; int l = i / 16, r = i % 16, nt = r / 2, kt = r % 2;
      convT_tile(p.in[14] + (size_t)l * 128 * 512, 512, p.in[12] + l * 128, (bf16*)(ws + OFF_WUKV + l * SZ_WUKV), 128, kt * 64, nt * 64, 0, tile);
    } else if (it < E4) {
      int i = it - E3; int l = i / 128, r = i % 128, nt = r / 16, kt = r % 16;
      convT_tile(p.in[17] + (size_t)l * 1024 * 512, 512, p.in[16] + l * 1024, (bf16*)(ws + OFF_WMEM + l * SZ_WMEM), 1024, kt * 64, nt * 64, 0, tile);
    } else if (it < E5) {
      int i = it - E4; int lj = i / 64, r = i % 64, nt = r / 32, kt = r % 32;
      convT_tile(p.in[7] + (size_t)lj * 2048 * 64, 64, nullptr, (bf16*)(ws + OFF_WCMP + lj * SZ_WCMP), 2048, kt * 64, nt * 64, 0, tile);
    } else if (it < E6) {
      int row = (it - E5) * 4 + wv;
      const float4* xr = (const float4*)(p.in[0] + (size_t)row * 1024);
      bf16* xb = (bf16*)(ws + OFF_XB) + (size_t)row * 1024;
      float ss = 0.f;
#pragma unroll
      for (int i = 0; i < 2; ++i) {
        const int c = lane + 64 * i;
        const float4 v = ld_nt4(xr + 2 * c), w = ld_nt4(xr + 2 * c + 1);
        ss += v.x * v.x + v.y * v.y + v.z * v.z + v.w * v.w + w.x * w.x + w.y * w.y + w.z * w.z + w.w * w.w;
        uint4 o; o.x = pack2(v.x, v.y); o.y = pack2(v.z, v.w); o.z = pack2(w.x, w.y); o.w = pack2(w.z, w.w);
        *(uint4*)(xb + c * 8) = o;
      }
      ss = sum64(ss);
      float* sq = (float*)(ws + OFF_SSQ) + (size_t)row * 8;
      if (lane < 8) sq[lane] = lane == 0 ? ss : 0.f;
    } else if (it < E7) {
      int row = (it - E6) * 4 + wv;
      const float4* xr = (const float4*)(p.in[1] + (size_t)row * 1024);
      bf16* xb = (bf16*)(ws + OFF_MEMB) + (size_t)row * 1024;
      float ss = 0.f;
#pragma unroll
      for (int i = 0; i < 2; ++i) {
        const int c = lane + 64 * i;
        const float4 v = ld_nt4(xr + 2 * c), w = ld_nt4(xr + 2 * c + 1);
        ss += v.x * v.x + v.y * v.y + v.z * v.z + v.w * v.w + w.x * w.x + w.y * w.y + w.z * w.z + w.w * w.w;
        uint4 o; o.x = pack2(v.x, v.y); o.y = pack2(v.z, v.w); o.z = pack2(w.x, w.y); o.w = pack2(w.z, w.w);
        *(uint4*)(xb + c * 8) = o;
      }
      ss = sum64(ss);
      if (lane == 0) ((float*)(ws + OFF_RMEM))[row] = rsqrtf(ss * (1.f / 1024.f) + EPS);
    } else if (it < E8) {
      int e = (it - E7) * 256 + tid;
      int pos = e >> 5, i = e & 31;
      float inv = powf(10000.f, -(float)i / 32.f);
      float ang = (float)pos * inv;
      double a = (double)ang;
      double n = rint(a * 0.15915494309189535);
      float r = (float)(a - n * 6.283185307179586);
      float2 cs; cs.x = __cosf(r); cs.y = __sinf(r);
      ((float2*)(ws + OFF_ROPE))[e] = cs;
    } else if (it < E9) {
      int lj = (it - E8) >> 4, sl = (it - E8) & 15;
      const float* pe = p.in[6] + (size_t)lj * 2048;
      const float* w = p.in[7] + (size_t)lj * 2048 * 64;
      int n = tid & 63, part = tid >> 6;
      float acc = 0.f;
      const int kb0 = sl * 128 + part * 32;
#pragma unroll 8
      for (int k = kb0; k < kb0 + 32; ++k) acc += pe[k] * w[(size_t)k * 64 + n];
      tile[tid] = acc;
      __syncthreads();
      if (tid < 64) ((float*)(ws + OFF_CB))[((it - E8)) * 64 + tid] = tile[tid] + tile[tid + 64] + tile[tid + 128] + tile[tid + 192];
      __syncthreads();
    } else {
      if (tid < 2) {
        const float* lf = p.in[9] + tid * 128;
        float s1 = 0.f, s2 = 0.f;
        for (int i = 0; i < 32; ++i) { s1 += lf[i] * lf[32 + i]; s2 += lf[64 + i] * lf[96 + i]; }
        float li = 0.8f - 0.6f * expf(-0.3f * (float)tid);
        ((float*)(ws + OFF_LAM))[tid] = expf(s1) - expf(s2) + li;
      }
    }
  }
}

template <int CH>
DI void gemm_tile(const bf16* __restrict__ Ab, long lda, long kcs, const bf16* __restrict__ Bb, long ldb, int nk, char* smem) {
  const int tid = opq(threadIdx.x), lane = tid & 63, wv = tid >> 6, half = lane >> 5, l31 = lane & 31;
  const int wm = wv >> 1, wn = wv & 1;
  bf16* As = (bf16*)smem;
  bf16* Bs = (bf16*)(smem + 36864);
  const int lrow = tid >> 3, lcol = (tid & 7) * 8;
  const bf16* ag = Ab + (long)lrow * lda + lcol;
  const bf16* bg = Bb + (long)lrow * ldb + lcol;
  f32x16 acc[2][2];
#pragma unroll
  for (int a = 0; a < 2; ++a)
#pragma unroll
    for (int b = 0; b < 2; ++b)
#pragma unroll
      for (int i = 0; i < 16; ++i) acc[a][b][i] = 0.f;
#define GCOMPUTE(BUF) do { \
    const bf16* as_ = As + (BUF) * 128 * 72 + (wm * 64 + l31) * 72 + half * 8; \
    const bf16* bs_ = Bs + (BUF) * 128 * 72 + (wn * 64 + l31) * 72 + half * 8; \
    bf16x8 fa[2][2], fb[2][2]; \
    fa[0][0] = *(const bf16x8*)(as_); fa[0][1] = *(const bf16x8*)(as_ + 32 * 72); \
    fb[0][0] = *(const bf16x8*)(bs_); fb[0][1] = *(const bf16x8*)(bs_ + 32 * 72); \
    _Pragma("unroll") for (int kc = 0; kc < 4; ++kc) { \
      if (kc < 3) { \
        fa[(kc + 1) & 1][0] = *(const bf16x8*)(as_ + (kc + 1) * 16); fa[(kc + 1) & 1][1] = *(const bf16x8*)(as_ + 32 * 72 + (kc + 1) * 16); \
        fb[(kc + 1) & 1][0] = *(const bf16x8*)(bs_ + (kc + 1) * 16); fb[(kc + 1) & 1][1] = *(const bf16x8*)(bs_ + 32 * 72 + (kc + 1) * 16); \
      } \
      _Pragma("unroll") for (int ni = 0; ni < 2; ++ni) \
        _Pragma("unroll") for (int mi = 0; mi < 2; ++mi) acc[ni][mi] = MFMA(fb[kc & 1][ni], fa[kc & 1][mi], acc[ni][mi]); \
    } } while (0)
  for (int c0 = 0; c0 < nk; c0 += CH) {
    u32x4 rs[2][8];
    const bf16* agc = ag + (long)c0 * kcs;
    const bf16* bgc = bg + (long)c0 * 64;
#pragma unroll
    for (int i = 0; i < 4; ++i) {
      rs[0][i] = *(const u32x4*)(agc + (long)(32 * i) * lda);
      rs[0][4 + i] = *(const u32x4*)(bgc + (long)(32 * i) * ldb);
    }
#pragma unroll
    for (int i = 0; i < 4; ++i) {
      *(u32x4*)(As + (lrow + 32 * i) * 72 + lcol) = rs[0][i];
      *(u32x4*)(Bs + (lrow + 32 * i) * 72 + lcol) = rs[0][4 + i];
    }
    if (CH > 1) {
#pragma unroll
      for (int i = 0; i < 4; ++i) {
        GLD16(rs[1][i], agc + (long)(32 * i) * lda + kcs);
        GLD16(rs[1][4 + i], bgc + (long)(32 * i) * ldb + 64);
      }
    }
    __syncthreads();
#pragma unroll
    for (int t = 0; t < CH; ++t) {
      const int bufc = t & 1;
      if (t + 2 < CH) {
#pragma unroll
        for (int i = 0; i < 4; ++i) {
          GLD16(rs[t & 1][i], agc + (long)(32 * i) * lda + (long)(t + 2) * kcs);
          GLD16(rs[t & 1][4 + i], bgc + (long)(32 * i) * ldb + (long)(t + 2) * 64);
        }
      }
      GCOMPUTE(bufc);
      if (t + 1 < CH) {
        u32x4(&rr)[8] = rs[(t + 1) & 1];
        if (t + 2 < CH) asm volatile("s_waitcnt vmcnt(8)" : "+v"(rr[0]), "+v"(rr[1]), "+v"(rr[2]), "+v"(rr[3]), "+v"(rr[4]), "+v"(rr[5]), "+v"(rr[6]), "+v"(rr[7]) :: "memory");
        else asm volatile("s_waitcnt vmcnt(0)" : "+v"(rr[0]), "+v"(rr[1]), "+v"(rr[2]), "+v"(rr[3]), "+v"(rr[4]), "+v"(rr[5]), "+v"(rr[6]), "+v"(rr[7]) :: "memory");
        bf16* ad = As + (bufc ^ 1) * 128 * 72; bf16* bd = Bs + (bufc ^ 1) * 128 * 72;
#pragma unroll
        for (int i = 0; i < 4; ++i) {
          *(u32x4*)(ad + (lrow + 32 * i) * 72 + lcol) = rr[i];
          *(u32x4*)(bd + (lrow + 32 * i) * 72 + lcol) = rr[4 + i];
        }
      }
      __syncthreads();
    }
  }
#undef GCOMPUTE
  float* Cs = (float*)smem;
#pragma unroll
  for (int ni = 0; ni < 2; ++ni)
#pragma unroll
    for (int mi = 0; mi < 2; ++mi)
#pragma unroll
      for (int g = 0; g < 4; ++g) {
        float4 v; v.x = acc[ni][mi][4 * g]; v.y = acc[ni][mi][4 * g + 1]; v.z = acc[ni][mi][4 * g + 2]; v.w = acc[ni][mi][4 * g + 3];
        *(float4*)(Cs + (wm * 64 + mi * 32 + l31) * 132 + wn * 64 + ni * 32 + 8 * g + 4 * half) = v;
      }
  __syncthreads();
}

enum { EPI_PLAIN = 0, EPI_RS8 = 1, EPI_RS1 = 2, EPI_OUT = 3 };
DI void gemm_epi(int mode, char* smem, bf16* __restrict__ Cb, long ldc, int row0, const float* __restrict__ rs,
                 const float* __restrict__ xres, float* __restrict__ xout, bf16* __restrict__ xbout, float* __restrict__ ssqout, int ntile) {
  const float* Cs = (const float*)smem;
  const int tid = opq(threadIdx.x);
  float* rsl = (float*)(smem + 67584);
  if (mode == EPI_RS8 || mode == EPI_RS1) {
    if (tid < 128) {
      const long grow = row0 + tid;
      float sc;
      if (mode == EPI_RS8) {
        const float4* q = (const float4*)(rs + grow * 8);
        const float4 a = q[0], b = q[1];
        sc = rsqrtf((a.x + a.y + a.z + a.w + b.x + b.y + b.z + b.w) * (1.f / 1024.f) + EPS);
      } else sc = rs[grow];
      rsl[tid] = sc;
    }
    __syncthreads();
  }
#pragma unroll 2
  for (int it = 0; it < 8; ++it) {
    const int idx = it * 256 + tid;
    const int r = idx >> 4, ch = idx & 15;
    float4 v0 = *(const float4*)(Cs + r * 132 + ch * 8);
    float4 v1 = *(const float4*)(Cs + r * 132 + ch * 8 + 4);
    const long grow = row0 + r;
    if (mode == EPI_OUT) {
      if (xres) {
        const float4* xr = (const float4*)(xres + grow * 1024 + ntile * 128 + ch * 8);
        float4 x0 = ld_nt4(xr), x1 = ld_nt4(xr + 1);
        v0.x += x0.x; v0.y += x0.y; v0.z += x0.z; v0.w += x0.w;
        v1.x += x1.x; v1.y += x1.y; v1.z += x1.z; v1.w += x1.w;
      } else {
        const uint4 xw = *(const uint4*)(Cb + grow * 1024 + ntile * 128 + ch * 8);
        v0.x += bflo(xw.x); v0.y += bfhi(xw.x); v0.z += bflo(xw.y); v0.w += bfhi(xw.y);
        v1.x += bflo(xw.z); v1.y += bfhi(xw.z); v1.z += bflo(xw.w); v1.w += bfhi(xw.w);
      }
      if (xout) {
        float4* xo = (float4*)(xout + grow * 1024 + ntile * 128 + ch * 8);
        st_nt4(xo, v0); st_nt4(xo + 1, v1);
      }
      if (xbout) {
        float ss = v0.x * v0.x + v0.y * v0.y + v0.z * v0.z + v0.w * v0.w + v1.x * v1.x + v1.y * v1.y + v1.z * v1.z + v1.w * v1.w;
        ss = sum16(ss);
        if (ch == 0) ssqout[grow * 8 + ntile] = ss;
        uint4 o; o.x = pack2(v0.x, v0.y); o.y = pack2(v0.z, v0.w); o.z = pack2(v1.x, v1.y); o.w = pack2(v1.z, v1.w);
        *(uint4*)(xbout + grow * 1024 + ntile * 128 + ch * 8) = o;
      }
    } else {
      float sc = 1.f;
      if (mode == EPI_RS8 || mode == EPI_RS1) sc = rsl[r];
      uint4 o; o.x = pack2(v0.x * sc, v0.y * sc); o.y = pack2(v0.z * sc, v0.w * sc); o.z = pack2(v1.x * sc, v1.y * sc); o.w = pack2(v1.z * sc, v1.w * sc);
      *(uint4*)(Cb + grow * ldc + ntile * 128 + ch * 8) = o;
    }
  }
  __syncthreads();
}

DI void gemm_big(const bf16* __restrict__ Ab, long lda, const bf16* __restrict__ Bb, long ldb, int nk, char* smem, int mode,
                 bf16* __restrict__ Cb, long ldc, int row0, const float* __restrict__ rs, const float* __restrict__ xres,
                 float* __restrict__ xout, bf16* __restrict__ xbout, float* __restrict__ ssqout, int ntile) {
  const int tid = opq(threadIdx.x), lane = tid & 63, wv = tid >> 6, half = lane >> 5, l31 = lane & 31;
  const int wm = wv >> 1, wn = wv & 1;
  bf16* As = (bf16*)smem;
  bf16* Bs = (bf16*)(smem + 36864);
  const int lrow = tid >> 3, lcol = (tid & 7) * 8;
  const bf16* ag = Ab + (long)lrow * lda + lcol;
  const bf16* bg = Bb + (long)lrow * ldb + lcol;
  u32x4 ra[8], rb[4];
  f32x16 acc[2][4];
#pragma unroll
  for (int a = 0; a < 2; ++a)
#pragma unroll
    for (int b = 0; b < 4; ++b)
#pragma unroll
      for (int i = 0; i < 16; ++i) acc[a][b][i] = 0.f;
#pragma unroll
  for (int i = 0; i < 8; ++i) ra[i] = *(const u32x4*)(ag + (long)(32 * i) * lda);
#pragma unroll
  for (int i = 0; i < 4; ++i) rb[i] = *(const u32x4*)(bg + (long)(32 * i) * ldb);
#pragma unroll
  for (int i = 0; i < 8; ++i) *(u32x4*)(As + (lrow + 32 * i) * 72 + lcol) = ra[i];
#pragma unroll
  for (int i = 0; i < 4; ++i) *(u32x4*)(Bs + (lrow + 32 * i) * 72 + lcol) = rb[i];
  __syncthreads();
  for (int ks = 0; ks < nk; ++ks) {
    const bool more = ks + 1 < nk;
    if (more) {
#pragma unroll
      for (int i = 0; i < 8; ++i) GLD16(ra[i], ag + (long)(32 * i) * lda + (long)(ks + 1) * 64);
#pragma unroll
      for (int i = 0; i < 4; ++i) GLD16(rb[i], bg + (long)(32 * i) * ldb + (long)(ks + 1) * 64);
    }
    const bf16* as_ = As + (wm * 128 + l31) * 72 + half * 8;
    const bf16* bs_ = Bs + (wn * 64 + l31) * 72 + half * 8;
#pragma unroll
    for (int kc = 0; kc < 4; ++kc) {
      bf16x8 fa[4], fb[2];
#pragma unroll
      for (int mi = 0; mi < 4; ++mi) fa[mi] = *(const bf16x8*)(as_ + mi * 32 * 72 + kc * 16);
#pragma unroll
      for (int ni = 0; ni < 2; ++ni) fb[ni] = *(const bf16x8*)(bs_ + ni * 32 * 72 + kc * 16);
#pragma unroll
      for (int ni = 0; ni < 2; ++ni)
#pragma unroll
        for (int mi = 0; mi < 4; ++mi) acc[ni][mi] = MFMA(fb[ni], fa[mi], acc[ni][mi]);
    }
    __syncthreads();
    if (more) {
      asm volatile("s_waitcnt vmcnt(0)" : "+v"(ra[0]), "+v"(ra[1]), "+v"(ra[2]), "+v"(ra[3]), "+v"(ra[4]), "+v"(ra[5]), "+v"(ra[6]), "+v"(ra[7]),
                   "+v"(rb[0]), "+v"(rb[1]), "+v"(rb[2]), "+v"(rb[3]) :: "memory");
#pragma unroll
      for (int i = 0; i < 8; ++i) *(u32x4*)(As + (lrow + 32 * i) * 72 + lcol) = ra[i];
#pragma unroll
      for (int i = 0; i < 4; ++i) *(u32x4*)(Bs + (lrow + 32 * i) * 72 + lcol) = rb[i];
      __syncthreads();
    }
  }
  float* Cs = (float*)smem;
#pragma unroll
  for (int h = 0; h < 2; ++h) {
    if (wm == h) {
#pragma unroll
      for (int ni = 0; ni < 2; ++ni)
#pragma unroll
        for (int mi = 0; mi < 4; ++mi)
#pragma unroll
          for (int g = 0; g < 4; ++g) {
            float4 v; v.x = acc[ni][mi][4 * g]; v.y = acc[ni][mi][4 * g + 1]; v.z = acc[ni][mi][4 * g + 2]; v.w = acc[ni][mi][4 * g + 3];
            *(float4*)(Cs + (mi * 32 + l31) * 132 + wn * 64 + ni * 32 + 8 * g + 4 * half) = v;
          }
    }
    __syncthreads();
    gemm_epi(mode, smem, Cb, ldc, row0 + h * 128, rs, xres, xout, xbout, ssqout, ntile);
  }
}

enum { AM_NONE = 0, AM_CAUSAL = 1, AM_WIN = 2, AM_CMP = 3, AM_SLC = 4 };

template <int DK>
DI void attn_core(const bf16* __restrict__ Kp, long kstride, const bf16* __restrict__ Vp, long vstride, uint32_t tilemask,
                  int mode, int qpos, uint32_t sel, const bf16x8 (&Qf)[DK / 16], f32x16 (&O)[2], float& m_out, float& l_out, char* smem) {
  constexpr int KST = DK + 8;
  constexpr int CPR = DK / 8;
  constexpr int NCH = CPR / 4;
  bf16* Ks = (bf16*)smem;
  bf16* VTs = (bf16*)(smem + SM_VT);
  const int tid = opq(threadIdx.x), lane = tid & 63, half = lane >> 5, l31 = lane & 31;
#pragma unroll
  for (int i = 0; i < 16; ++i) { O[0][i] = 0.f; O[1][i] = 0.f; }
  float l = 0.f;
  const int qw0 = __builtin_amdgcn_readfirstlane(qpos - l31);
  const bool causal_like = (mode == AM_CAUSAL || mode == AM_WIN || mode == AM_SLC);
  int klo = 0, khi = 0x7fffffff;
  if (mode == AM_CAUSAL || mode == AM_SLC) khi = qpos;
  else if (mode == AM_WIN) { khi = qpos; klo = qpos - 511; }
  else if (mode == AM_CMP) khi = (qpos - 31) >> 4;
  u32x4 rk0, rk1, rk2, rv0, rv1;
  rk0 = rk1 = rk2 = (u32x4){0u, 0u, 0u, 0u};
  const int vkp = tid & 31, vcc = tid >> 5;
  const int vcol = (vkp >> 3) * 16 + (((vkp & 1) | ((vkp & 2) << 1) | ((vkp & 4) >> 1)) * 2);
  const int c0 = tid, c1 = tid + 256, c2_ = tid + 512;
  const int kr0 = c0 / CPR, kc0 = (c0 % CPR) * 8, kr1 = c1 / CPR, kc1 = (c1 % CPR) * 8, kr2 = c2_ / CPR, kc2 = (c2_ % CPR) * 8;
#define GLOAD(KT) do { \
    GLD16(rk0, Kp + (long)((KT) * 64 + kr0) * kstride + kc0); \
    if constexpr (NCH > 1) GLD16(rk1, Kp + (long)((KT) * 64 + kr1) * kstride + kc1); \
    if constexpr (NCH > 2) GLD16(rk2, Kp + (long)((KT) * 64 + kr2) * kstride + kc2); \
    GLD16(rv0, Vp + (long)((KT) * 64 + 2 * vkp) * vstride + vcc * 8); \
    GLD16(rv1, Vp + (long)((KT) * 64 + 2 * vkp + 1) * vstride + vcc * 8); } while (0)
#define LSTORE(BUF) do { asm volatile("s_waitcnt vmcnt(0)" : "+v"(rk0), "+v"(rk1), "+v"(rk2), "+v"(rv0), "+v"(rv1) :: "memory"); \
    *(u32x4*)(Ks + ((BUF) * 64 + kr0) * KST + kc0) = rk0; \
    if constexpr (NCH > 1) *(u32x4*)(Ks + ((BUF) * 64 + kr1) * KST + kc1) = rk1; \
    if constexpr (NCH > 2) *(u32x4*)(Ks + ((BUF) * 64 + kr2) * KST + kc2) = rk2; \
    bf16* vd = VTs + ((BUF) * 64 + vcc * 8) * 72 + vcol; \
    *(uint32_t*)(vd + 0 * 72) = (rv0.x & 0xffffu) | (rv1.x << 16); \
    *(uint32_t*)(vd + 1 * 72) = (rv0.x >> 16) | (rv1.x & 0xffff0000u); \
    *(uint32_t*)(vd + 2 * 72) = (rv0.y & 0xffffu) | (rv1.y << 16); \
    *(uint32_t*)(vd + 3 * 72) = (rv0.y >> 16) | (rv1.y & 0xffff0000u); \
    *(uint32_t*)(vd + 4 * 72) = (rv0.z & 0xffffu) | (rv1.z << 16); \
    *(uint32_t*)(vd + 5 * 72) = (rv0.z >> 16) | (rv1.z & 0xffff0000u); \
    *(uint32_t*)(vd + 6 * 72) = (rv0.w & 0xffffu) | (rv1.w << 16); \
    *(uint32_t*)(vd + 7 * 72) = (rv0.w >> 16) | (rv1.w & 0xffff0000u); } while (0)
  uint32_t rem = tilemask;
  int kt = __ffs(rem) - 1; rem &= rem - 1;
  GLOAD(kt);
#pragma unroll
  for (int kc = 0; kc < DK / 16; ++kc) asm volatile("" ::"v"(Qf[kc]));
  __syncthreads();
  LSTORE(0);
  __syncthreads();
  int buf = 0;
  while (true) {
    int ktn = -1;
    if (rem) { ktn = __ffs(rem) - 1; rem &= rem - 1; GLOAD(ktn); }
    const bool wave_active = !(causal_like && kt * 64 > qw0 + 31);
    if (wave_active) {
    f32x16 Sx[2];
#pragma unroll
    for (int kb = 0; kb < 2; ++kb) {
      bf16x8 Kf[DK / 16];
#pragma unroll
      for (int kc = 0; kc < DK / 16; ++kc) Kf[kc] = *(const bf16x8*)(Ks + (buf * 64 + kb * 32 + l31) * KST + kc * 16 + half * 8);
      __builtin_amdgcn_sched_barrier(0);
#pragma unroll
      for (int i = 0; i < 16; ++i) Sx[kb][i] = 0.f;
#pragma unroll
      for (int kc = 0; kc < DK / 16; ++kc) Sx[kb] = MFMA(Kf[kc], Qf[kc], Sx[kb]);
    }
    bf16x8 Vf[2][2][2];
#pragma unroll
    for (int kb = 0; kb < 2; ++kb)
#pragma unroll
      for (int c2 = 0; c2 < 2; ++c2)
#pragma unroll
        for (int dvb = 0; dvb < 2; ++dvb)
          Vf[kb][c2][dvb] = *(const bf16x8*)(VTs + (buf * 64 + dvb * 32 + l31) * 72 + (kb * 2 + c2) * 16 + half * 8);
    __builtin_amdgcn_sched_barrier(0);
    bool need_mask = false;
    if (mode == AM_CAUSAL) need_mask = kt * 64 + 63 > qw0;
    else if (mode == AM_WIN) need_mask = (kt * 64 + 63 > qw0) || (kt * 64 < qw0 + 31 - 511);
    else if (mode == AM_CMP) need_mask = true;
    else if (mode == AM_SLC) need_mask = (kt * 64 + 63 > qw0);
    const bool keep = !(mode == AM_SLC) || (((sel >> kt) & 1u) != 0u);
    int khe = khi;
    if (mode == AM_SLC && !((sel >> kt) & 1u)) khe = -1;
    const int kbase = kt * 64 + half * 4;
#pragma unroll
    for (int kb = 0; kb < 2; ++kb) {
      if (need_mask) {
#pragma unroll
        for (int i = 0; i < 16; ++i) {
          const int key = kbase + kb * 32 + (i >> 2) * 8 + (i & 3);
          Sx[kb][i] = (key >= klo && key <= khe) ? Sx[kb][i] : -1e30f;
        }
      }
      float ps = 0.f;
#pragma unroll
      for (int i = 0; i < 16; ++i) { float pv = fexp2(Sx[kb][i]); pv = keep ? pv : 0.f; Sx[kb][i] = pv; ps += pv; }
      l += ps;
#pragma unroll
      for (int c2 = 0; c2 < 2; ++c2) {
        uint4 pw;
        pw.x = pack2(Sx[kb][8 * c2 + 0], Sx[kb][8 * c2 + 1]); pw.y = pack2(Sx[kb][8 * c2 + 2], Sx[kb][8 * c2 + 3]);
        pw.z = pack2(Sx[kb][8 * c2 + 4], Sx[kb][8 * c2 + 5]); pw.w = pack2(Sx[kb][8 * c2 + 6], Sx[kb][8 * c2 + 7]);
        const bf16x8 pf = __builtin_bit_cast(bf16x8, pw);
#pragma unroll
        for (int dvb = 0; dvb < 2; ++dvb) O[dvb] = MFMA(Vf[kb][c2][dvb], pf, O[dvb]);
      }
      __builtin_amdgcn_sched_barrier(0);
    }
    }
    if (ktn < 0) break;
    LSTORE(buf ^ 1);
    __syncthreads();
    buf ^= 1; kt = ktn;
  }
  l_out = l + shx(l, 32);
  m_out = 0.f;
#undef GLOAD
#undef LSTORE
}

template <int DK>
DI void attn_core_dual(const bf16* __restrict__ Kp, long kstride, const bf16* __restrict__ Vp, long vstride, uint32_t tilemask,
                  int mode, int qpos, uint32_t sel, const bf16x8 (&Qf)[DK / 16], f32x16 (&O)[2], f32x16 (&O2)[2], float& l_out, float& l2_out, char* smem) {
  constexpr int KST = DK + 8;
  constexpr int CPR = DK / 8;
  constexpr int NCH = CPR / 4;
  bf16* Ks = (bf16*)smem;
  bf16* VTs = (bf16*)(smem + SM_VT);
  const int tid = opq(threadIdx.x), lane = tid & 63, half = lane >> 5, l31 = lane & 31;
#pragma unroll
  for (int i = 0; i < 16; ++i) { O[0][i] = 0.f; O[1][i] = 0.f; O2[0][i] = 0.f; O2[1][i] = 0.f; }
  float l = 0.f, l2 = 0.f;
  const int qw0 = __builtin_amdgcn_readfirstlane(qpos - l31);
  const bool causal_like = (mode == AM_CAUSAL || mode == AM_WIN || mode == AM_SLC);
  int klo = 0, khi = 0x7fffffff;
  if (mode == AM_CAUSAL || mode == AM_SLC) khi = qpos;
  else if (mode == AM_WIN) { khi = qpos; klo = qpos - 511; }
  else if (mode == AM_CMP) khi = (qpos - 31) >> 4;
  u32x4 rk0, rk1, rk2, rv0, rv1;
  rk0 = rk1 = rk2 = (u32x4){0u, 0u, 0u, 0u};
  const int vkp = tid & 31, vcc = tid >> 5;
  const int vcol = (vkp >> 3) * 16 + (((vkp & 1) | ((vkp & 2) << 1) | ((vkp & 4) >> 1)) * 2);
  const int c0 = tid, c1 = tid + 256, c2_ = tid + 512;
  const int kr0 = c0 / CPR, kc0 = (c0 % CPR) * 8, kr1 = c1 / CPR, kc1 = (c1 % CPR) * 8, kr2 = c2_ / CPR, kc2 = (c2_ % CPR) * 8;
#define GLOAD(KT) do { \
    GLD16(rk0, Kp + (long)((KT) * 64 + kr0) * kstride + kc0); \
    if constexpr (NCH > 1) GLD16(rk1, Kp + (long)((KT) * 64 + kr1) * kstride + kc1); \
    if constexpr (NCH > 2) GLD16(rk2, Kp + (long)((KT) * 64 + kr2) * kstride + kc2); \
    GLD16(rv0, Vp + (long)((KT) * 64 + 2 * vkp) * vstride + vcc * 8); \
    GLD16(rv1, Vp + (long)((KT) * 64 + 2 * vkp + 1) * vstride + vcc * 8); } while (0)
#define LSTORE(BUF) do { asm volatile("s_waitcnt vmcnt(0)" : "+v"(rk0), "+v"(rk1), "+v"(rv0), "+v"(rv1) :: "memory"); \
    *(u32x4*)(Ks + ((BUF) * 64 + kr0) * KST + kc0) = rk0; \
    if constexpr (NCH > 1) *(u32x4*)(Ks + ((BUF) * 64 + kr1) * KST + kc1) = rk1; \
    if constexpr (NCH > 2) *(u32x4*)(Ks + ((BUF) * 64 + kr2) * KST + kc2) = rk2; \
    bf16* vd = VTs + ((BUF) * 64 + vcc * 8) * 72 + vcol; \
    *(uint32_t*)(vd + 0 * 72) = (rv0.x & 0xffffu) | (rv1.x << 16); \
    *(uint32_t*)(vd + 1 * 72) = (rv0.x >> 16) | (rv1.x & 0xffff0000u); \
    *(uint32_t*)(vd + 2 * 72) = (rv0.y & 0xffffu) | (rv1.y << 16); \
    *(uint32_t*)(vd + 3 * 72) = (rv0.y >> 16) | (rv1.y & 0xffff0000u); \
    *(uint32_t*)(vd + 4 * 72) = (rv0.z & 0xffffu) | (rv1.z << 16); \
    *(uint32_t*)(vd + 5 * 72) = (rv0.z >> 16) | (rv1.z & 0xffff0000u); \
    *(uint32_t*)(vd + 6 * 72) = (rv0.w & 0xffffu) | (rv1.w << 16); \
    *(uint32_t*)(vd + 7 * 72) = (rv0.w >> 16) | (rv1.w & 0xffff0000u); } while (0)
  uint32_t rem = tilemask;
  int kt = __ffs(rem) - 1; rem &= rem - 1;
  GLOAD(kt);
#pragma unroll
  for (int kc = 0; kc < DK / 16; ++kc) asm volatile("" ::"v"(Qf[kc]));
  __syncthreads();
  LSTORE(0);
  __syncthreads();
  int buf = 0;
  while (true) {
    int ktn = -1;
    if (rem) { ktn = __ffs(rem) - 1; rem &= rem - 1; GLOAD(ktn); }
    const bool wave_active = !(causal_like && kt * 64 > qw0 + 31);
    if (wave_active) {
    const bool need_mask = kt * 64 + 63 > qw0;
    const int kbase = kt * 64 + half * 4;
#pragma unroll
    for (int mp = 0; mp < 2; ++mp) {
      f32x16 Sx[2];
#pragma unroll
      for (int kb = 0; kb < 2; ++kb) {
        bf16x8 k0 = *(const bf16x8*)(Ks + (buf * 64 + kb * 32 + l31) * KST + (2 * mp) * 16 + half * 8);
        bf16x8 k1 = *(const bf16x8*)(Ks + (buf * 64 + kb * 32 + l31) * KST + (2 * mp + 1) * 16 + half * 8);
#pragma unroll
        for (int i = 0; i < 16; ++i) Sx[kb][i] = 0.f;
        Sx[kb] = MFMA(k0, Qf[2 * mp], Sx[kb]);
        Sx[kb] = MFMA(k1, Qf[2 * mp + 1], Sx[kb]);
      }
#pragma unroll
      for (int kb = 0; kb < 2; ++kb) {
        if (need_mask) {
#pragma unroll
          for (int i = 0; i < 16; ++i) {
            const int key = kbase + kb * 32 + (i >> 2) * 8 + (i & 3);
            Sx[kb][i] = (key <= khi) ? Sx[kb][i] : -1e30f;
          }
        }
        bf16x8 Vf[2][2];
#pragma unroll
        for (int c2 = 0; c2 < 2; ++c2)
#pragma unroll
          for (int dvb = 0; dvb < 2; ++dvb)
            Vf[c2][dvb] = *(const bf16x8*)(VTs + (buf * 64 + dvb * 32 + l31) * 72 + (kb * 2 + c2) * 16 + half * 8);
        float ps = 0.f;
#pragma unroll
        for (int i = 0; i < 16; ++i) { float pv = fexp2(Sx[kb][i]); Sx[kb][i] = pv; ps += pv; }
        if (mp == 0) l += ps; else l2 += ps;
#pragma unroll
        for (int c2 = 0; c2 < 2; ++c2) {
          uint4 pw;
          pw.x = pack2(Sx[kb][8 * c2 + 0], Sx[kb][8 * c2 + 1]); pw.y = pack2(Sx[kb][8 * c2 + 2], Sx[kb][8 * c2 + 3]);
          pw.z = pack2(Sx[kb][8 * c2 + 4], Sx[kb][8 * c2 + 5]); pw.w = pack2(Sx[kb][8 * c2 + 6], Sx[kb][8 * c2 + 7]);
          const bf16x8 pf = __builtin_bit_cast(bf16x8, pw);
#pragma unroll
          for (int dvb = 0; dvb < 2; ++dvb) {
            if (mp == 0) O[dvb] = MFMA(Vf[c2][dvb], pf, O[dvb]); else O2[dvb] = MFMA(Vf[c2][dvb], pf, O2[dvb]);
          }
        }
        __builtin_amdgcn_sched_barrier(0);
      }
    }
    }
    if (ktn < 0) break;
    LSTORE(buf ^ 1);
    __syncthreads();
    buf ^= 1; kt = ktn;
  }
  l_out = l + shx(l, 32);
  l2_out = l2 + shx(l2, 32);
#undef GLOAD
#undef LSTORE
}

template <int DK>
DI void load_q(const bf16* __restrict__ Qrow, bf16x8 (&Qf)[DK / 16]) {
  const int half = (opq(threadIdx.x) & 63) >> 5;
#pragma unroll
  for (int kc = 0; kc < DK / 16; ++kc) Qf[kc] = *(const bf16x8*)(Qrow + kc * 16 + half * 8);
}

DI void vec64(bool active, const bf16* src, const float* bias, int nbias, bf16* dst, const float* gain, const float2* rp, float scale, int j, const bf16* src2 = nullptr) {
  float a0 = 0.f, a1 = 0.f, b0 = 0.f, b1 = 0.f;
  if (active) {
    uint32_t lo = *(const uint32_t*)(src + 2 * j), hi = *(const uint32_t*)(src + 32 + 2 * j);
    a0 = bflo(lo); a1 = bfhi(lo); b0 = bflo(hi); b1 = bfhi(hi);
    if (src2) {
#pragma unroll
      for (int q = 0; q < 3; ++q) {
        const bf16* sq_ = src2 + (size_t)q * 2 * 1024 * 128;
        lo = *(const uint32_t*)(sq_ + 2 * j); hi = *(const uint32_t*)(sq_ + 32 + 2 * j); a0 += bflo(lo); a1 += bfhi(lo); b0 += bflo(hi); b1 += bfhi(hi);
      }
    }
    for (int sidx = 0; sidx < nbias; ++sidx) {
      const float* bb = bias + sidx * 64;
      a0 += bb[2 * j]; a1 += bb[2 * j + 1]; b0 += bb[32 + 2 * j]; b1 += bb[33 + 2 * j];
    }
  }
  float ss = a0 * a0 + a1 * a1 + b0 * b0 + b1 * b1;
  ss = sum16(ss);
  const float r = rsqrtf(ss * (1.f / 64.f) + EPS);
  if (active) {
    a0 *= r * gain[2 * j]; a1 *= r * gain[2 * j + 1]; b0 *= r * gain[32 + 2 * j]; b1 *= r * gain[33 + 2 * j];
    if (rp) {
      const float2 c0 = rp[2 * j], c1 = rp[2 * j + 1];
      const float t0 = a0 * c0.x - b0 * c0.y, u0 = b0 * c0.x + a0 * c0.y;
      const float t1 = a1 * c1.x - b1 * c1.y, u1 = b1 * c1.x + a1 * c1.y;
      a0 = t0; b0 = u0; a1 = t1; b1 = u1;
    }
    *(uint32_t*)(dst + 2 * j) = pack2(a0 * scale, a1 * scale);
    *(uint32_t*)(dst + 32 + 2 * j) = pack2(b0 * scale, b1 * scale);
  }
}
template <int G>
DI void nr4(uint32_t lo, uint32_t hi, float invn, float g0, float g1, float g2, float g3, bool rope, float2 c0, float2 c1, float scale,
            uint32_t& olo, uint32_t& ohi) {
  float a0 = bflo(lo), a1 = bfhi(lo), b0 = bflo(hi), b1 = bfhi(hi);
  float ss = a0 * a0 + a1 * a1 + b0 * b0 + b1 * b1;
  ss = (G == 16) ? sum16(ss) : sum8(ss);
  const float r = rsqrtf(ss * invn + EPS);
  a0 *= r * g0; a1 *= r * g1; b0 *= r * g2; b1 *= r * g3;
  if (rope) {
    const float t0 = a0 * c0.x - b0 * c0.y, u0 = b0 * c0.x + a0 * c0.y;
    const float t1 = a1 * c1.x - b1 * c1.y, u1 = b1 * c1.x + a1 * c1.y;
    a0 = t0; b0 = u0; a1 = t1; b1 = u1;
  }
  olo = pack2(a0 * scale, a1 * scale); ohi = pack2(b0 * scale, b1 * scale);
}

struct PrepR {
  uint32_t q_lo, q_hi, p2_lo, p2_hi, p3_lo, p3_hi, dq_lo, dq_hi, dk_lo, dk_hi, glv, ckw, uqa, uqb, kra, krb;
  uint2 cw, nw, kw2, vw;
  float2 c0, c1, e0, e1;
};
struct PrepG {
  float gq0, gq1, gq2, gq3, h0, h1, h2, h3, m0, m1, m2, m3, dq0, dq1, dq2, dq3, dk0, dk1, dk2, dk3;
  float mgq0, mgq1, mgq2, mgq3, mgq4, mgq5, mgk0, mgk1, mgk2, mgk3, mgk4, mgk5;
};
DI void prep_load(char* ws, int t, int lane, PrepR& R) {
  const int j16 = lane & 15, g16 = lane >> 4, j8 = lane & 7, g8 = lane >> 3;
  const int s = t & 2047;
  const bf16* ur = (const bf16*)(ws + OFF_U) + (size_t)t * NP;
  const float2* rp = (const float2*)(ws + OFF_ROPE) + s * 32;
  const int col2 = g16 == 0 ? C_KS : (g16 == 1 ? C_KW : C_MQ + (g16 - 2) * 64);
  const int col3 = C_MQ + (2 + (g16 & 1)) * 64;
  const bf16* uq = (const bf16*)(ws + OFF_UQ + (size_t)(t >> 11) * SLAB) + (size_t)s * 384 + g16 * 96;
  const bf16* uk = (const bf16*)(ws + OFF_UKV + (size_t)(t >> 11) * SLAB) + (size_t)s * 512 + g16 * 128;
  R.q_lo = *(const uint32_t*)(ur + C_NQ + g16 * 64 + 2 * j16); R.q_hi = *(const uint32_t*)(ur + C_NQ + g16 * 64 + 32 + 2 * j16);
  R.p2_lo = *(const uint32_t*)(ur + col2 + 2 * j16); R.p2_hi = *(const uint32_t*)(ur + col2 + 32 + 2 * j16);
  R.p3_lo = *(const uint32_t*)(ur + col3 + 2 * j16); R.p3_hi = *(const uint32_t*)(ur + col3 + 32 + 2 * j16);
  R.dq_lo = *(const uint32_t*)(ur + C_DQ + g8 * 32 + 2 * j8); R.dq_hi = *(const uint32_t*)(ur + C_DQ + g8 * 32 + 16 + 2 * j8);
  R.dk_lo = *(const uint32_t*)(ur + C_DK + g8 * 32 + 2 * j8); R.dk_hi = *(const uint32_t*)(ur + C_DK + g8 * 32 + 16 + 2 * j8);
  R.glv = ur[C_GL + (lane < 12 ? lane : 0)];
  R.cw = *(const uint2*)(ur + C_CQ + lane * 4);
  R.ckw = *(const uint32_t*)(ur + C_CKV + lane * 2);
  R.nw = *(const uint2*)(uq + 4 * j16);
  R.uqa = uq[64 + j16]; R.uqb = uq[80 + j16];
  R.kw2 = *(const uint2*)(uk + 4 * j16);
  R.vw = *(const uint2*)(uk + 64 + 4 * j16);
  R.kra = ur[C_KR + j16]; R.krb = ur[C_KR + 16 + j16];
  R.c0 = rp[2 * j16]; R.c1 = rp[2 * j16 + 1];
  R.e0 = rp[4 * j8]; R.e1 = rp[4 * j8 + 2];
}
DI void prep_fin(char* ws, int t, int lane, const PrepR& R, const PrepG& G) {
  const int j16 = lane & 15, g16 = lane >> 4, j8 = lane & 7, g8 = lane >> 3;
  const float qs64 = 0.125f * LOG2E, qs32 = 0.17677669529663687f * LOG2E, qs96 = 0.10206207261596577f * LOG2E;
  const int b = t >> 11, s = t & 2047;
  bf16* ur = (bf16*)(ws + OFF_U) + (size_t)t * NP;
  const int col2 = g16 == 0 ? C_KS : (g16 == 1 ? C_KW : C_MQ + (g16 - 2) * 64);
  const int col3 = C_MQ + (2 + (g16 & 1)) * 64;
  const float2 c0 = R.c0, c1 = R.c1, e0 = R.e0, e1 = R.e1;
  uint32_t olo, ohi;
  nr4<16>(R.q_lo, R.q_hi, 1.f / 64.f, G.gq0, G.gq1, G.gq2, G.gq3, true, c0, c1, qs64, olo, ohi);
  *(uint32_t*)(ur + C_NQ + g16 * 64 + 2 * j16) = olo; *(uint32_t*)(ur + C_NQ + g16 * 64 + 32 + 2 * j16) = ohi;
  nr4<16>(R.p2_lo, R.p2_hi, 1.f / 64.f, G.h0, G.h1, G.h2, G.h3, g16 < 2, c0, c1, g16 < 2 ? 1.f : qs64, olo, ohi);
  *(uint32_t*)(ur + col2 + 2 * j16) = olo; *(uint32_t*)(ur + col2 + 32 + 2 * j16) = ohi;
  nr4<16>(R.p3_lo, R.p3_hi, 1.f / 64.f, G.m0, G.m1, G.m2, G.m3, false, c0, c1, qs64, olo, ohi);
  if (g16 < 2) { *(uint32_t*)(ur + col3 + 2 * j16) = olo; *(uint32_t*)(ur + col3 + 32 + 2 * j16) = ohi; }
  nr4<8>(R.dq_lo, R.dq_hi, 1.f / 32.f, G.dq0, G.dq1, G.dq2, G.dq3, true, e0, e1, qs32, olo, ohi);
  *(uint32_t*)(ur + C_DQ + g8 * 32 + 2 * j8) = olo; *(uint32_t*)(ur + C_DQ + g8 * 32 + 16 + 2 * j8) = ohi;
  nr4<8>(R.dk_lo, R.dk_hi, 1.f / 32.f, G.dk0, G.dk1, G.dk2, G.dk3, true, e0, e1, 1.f, olo, ohi);
  *(uint32_t*)(ur + C_DK + g8 * 32 + 2 * j8) = olo; *(uint32_t*)(ur + C_DK + g8 * 32 + 16 + 2 * j8) = ohi;
  if (lane < 12) ((float*)(ws + OFF_GT))[(size_t)t * 12 + lane] = sigmoidf_(bf2f(R.glv));
  float sq, skv;
  {
    float c0f = bflo(R.cw.x), c1f = bfhi(R.cw.x), c2f = bflo(R.cw.y), c3f = bfhi(R.cw.y);
    float ss = c0f * c0f + c1f * c1f + c2f * c2f + c3f * c3f;
    float d0 = bflo(R.ckw), d1 = bfhi(R.ckw);
    float s2 = d0 * d0 + d1 * d1;
    ss = sum64(ss); s2 = sum64(s2);
    sq = rsqrtf(ss * (1.f / 256.f) + EPS);
    skv = rsqrtf(s2 * (1.f / 128.f) + EPS);
  }
  {
    const int h = g16, j = j16;
    float n0 = bflo(R.nw.x) * sq, n1 = bfhi(R.nw.x) * sq, n2 = bflo(R.nw.y) * sq, n3 = bfhi(R.nw.y) * sq;
    float ra = bf2f(R.uqa) * sq, rb = bf2f(R.uqb) * sq;
    float r1 = ra * c0.x - rb * c0.y, r2 = rb * c0.x + ra * c0.y;
    float ss = n0 * n0 + n1 * n1 + n2 * n2 + n3 * n3 + r1 * r1 + r2 * r2;
    ss = sum16(ss);
    float r = rsqrtf(ss * (1.f / 96.f) + EPS) * qs96;
    bf16* qd = (bf16*)(ws + OFF_QM) + ((size_t)(b * 4 + h) * S + s) * 96;
    uint2 o; o.x = pack2(n0 * r * G.mgq0, n1 * r * G.mgq1); o.y = pack2(n2 * r * G.mgq2, n3 * r * G.mgq3);
    *(uint2*)(qd + 4 * j) = o;
    qd[64 + j] = f2bf(r1 * r * G.mgq4);
    qd[80 + j] = f2bf(r2 * r * G.mgq5);
    float k0 = bflo(R.kw2.x) * skv, k1 = bfhi(R.kw2.x) * skv, k2 = bflo(R.kw2.y) * skv, k3 = bfhi(R.kw2.y) * skv;
    float ka = bf2f(R.kra), kb = bf2f(R.krb);
    float kr1 = ka * c0.x - kb * c0.y, kr2 = kb * c0.x + ka * c0.y;
    float s3 = k0 * k0 + k1 * k1 + k2 * k2 + k3 * k3 + kr1 * kr1 + kr2 * kr2;
    s3 = sum16(s3);
    float rk_ = rsqrtf(s3 * (1.f / 96.f) + EPS);
    bf16* kd = (bf16*)(ws + OFF_KM) + ((size_t)(b * 4 + h) * S + s) * 96;
    uint2 o2; o2.x = pack2(k0 * rk_ * G.mgk0, k1 * rk_ * G.mgk1); o2.y = pack2(k2 * rk_ * G.mgk2, k3 * rk_ * G.mgk3);
    *(uint2*)(kd + 4 * j) = o2;
    kd[64 + j] = f2bf(kr1 * rk_ * G.mgk4);
    kd[80 + j] = f2bf(kr2 * rk_ * G.mgk5);
    uint2 o3; o3.x = pack2(bflo(R.vw.x) * skv, bfhi(R.vw.x) * skv); o3.y = pack2(bflo(R.vw.y) * skv, bfhi(R.vw.y) * skv);
    *(uint2*)((bf16*)(ws + OFF_MV) + ((size_t)(b * 4 + h) * S + s) * 64 + 4 * j) = o3;
  }
}

DI void prep_phase(const Params& p, int layer) {
  const int tid = opq(threadIdx.x), lane = tid & 63, wv = tid >> 6;
  char* ws = opqp(p.ws);
  const float2* rope = (const float2*)(ws + OFF_ROPE);
  const float* nsa_g = p.in[5] + layer * 256;
  const float* diff_g = p.in[8] + layer * 64;
  const float* mla_g = p.in[15] + layer * 192;
  const float* mem_g = p.in[18] + layer * 128;
  constexpr int N_TOK = T / 4, N_MEMT = TM / 4, N_CMP = 1024 / 4;
  const int j16 = lane & 15, g16 = lane >> 4, j8 = lane & 7;
  PrepG G;
  G.gq0 = nsa_g[2 * j16]; G.gq1 = nsa_g[2 * j16 + 1]; G.gq2 = nsa_g[32 + 2 * j16]; G.gq3 = nsa_g[33 + 2 * j16];
  const float* g2p = g16 == 0 ? nsa_g + 128 : (g16 == 1 ? nsa_g + 192 : mem_g);
  G.h0 = g2p[2 * j16]; G.h1 = g2p[2 * j16 + 1]; G.h2 = g2p[32 + 2 * j16]; G.h3 = g2p[33 + 2 * j16];
  G.m0 = mem_g[2 * j16]; G.m1 = mem_g[2 * j16 + 1]; G.m2 = mem_g[32 + 2 * j16]; G.m3 = mem_g[33 + 2 * j16];
  G.dq0 = diff_g[2 * j8]; G.dq1 = diff_g[2 * j8 + 1]; G.dq2 = diff_g[16 + 2 * j8]; G.dq3 = diff_g[17 + 2 * j8];
  G.dk0 = diff_g[32 + 2 * j8]; G.dk1 = diff_g[33 + 2 * j8]; G.dk2 = diff_g[48 + 2 * j8]; G.dk3 = diff_g[49 + 2 * j8];
  G.mgq0 = mla_g[4 * j16]; G.mgq1 = mla_g[4 * j16 + 1]; G.mgq2 = mla_g[4 * j16 + 2]; G.mgq3 = mla_g[4 * j16 + 3];
  G.mgq4 = mla_g[64 + j16]; G.mgq5 = mla_g[80 + j16];
  G.mgk0 = mla_g[96 + 4 * j16]; G.mgk1 = mla_g[96 + 4 * j16 + 1]; G.mgk2 = mla_g[96 + 4 * j16 + 2]; G.mgk3 = mla_g[96 + 4 * j16 + 3];
  G.mgk4 = mla_g[96 + 64 + j16]; G.mgk5 = mla_g[96 + 80 + j16];
  const int xcd = blockIdx.x & 7, rk = blockIdx.x >> 3, nrk = gridDim.x >> 3;
  for (int i = rk; i < 512; i += 2 * nrk) {
    const int it = xcd * 512 + i;
    const bool has2 = i + nrk < 512;
    const int it2 = has2 ? it + nrk : it;
    const int tA = it * 4 + wv, tB = it2 * 4 + wv;
    PrepR A, B;
    prep_load(ws, tA, lane, A);
    prep_load(ws, tB, lane, B);
    prep_fin(ws, tA, lane, A, G);
    if (has2) prep_fin(ws, tB, lane, B, G);
  }
  for (int i = rk; i < 96; i += nrk) {
    const int it = i < 64 ? N_TOK + xcd * 64 + i : N_TOK + N_MEMT + xcd * 32 + (i - 64);
    if (false) {
    } else if (it < N_TOK + N_MEMT) {
      const int t = (it - N_TOK) * 4 + wv;
      const int b = t >> 8, mi = t & 255;
      const bf16* kr = (const bf16*)(ws + OFF_KMEMRAW) + (size_t)t * 512;
      const int h = lane >> 4;
      uint2 vw = *(const uint2*)(kr + 256 + lane * 4);
      vec64(true, kr + h * 64, nullptr, 0, (bf16*)(ws + OFF_MK) + ((size_t)(b * 4 + h) * ML + mi) * 64, mem_g + 64, nullptr, 1.f, j16);
      *(uint2*)((bf16*)(ws + OFF_MVV) + ((size_t)(b * 4 + h) * ML + mi) * 64 + j16 * 4) = vw;
    } else {
      const int r = (it - N_TOK - N_MEMT) * 4 + wv;
      const int n = r & 127;
      const bf16* kraw = (const bf16*)(ws + OFF_CMPRAW) + (size_t)r * 128;
      const bf16* vraw = (const bf16*)(ws + OFF_CMPRAW) + (size_t)(1024 + r) * 128;
      const float* cbk = (const float*)(ws + OFF_CBF) + (layer * 2 + 0) * 64;
      const float* cbv = (const float*)(ws + OFF_CBF) + (layer * 2 + 1) * 64;
      bf16* kd = (bf16*)(ws + OFF_KCN) + (size_t)r * 64;
      bf16* vd = (bf16*)(ws + OFF_VCN) + (size_t)r * 64;
      if (n < 127) {
        const int pos = 16 * n + 31;
        const float bv = cbv[lane];
        const float vv = bf2f(vraw[lane]) + bf2f(vraw[(size_t)2 * 1024 * 128 + lane]) + bf2f(vraw[(size_t)4 * 1024 * 128 + lane]) + bf2f(vraw[(size_t)6 * 1024 * 128 + lane]) + bv;
        vec64(lane < 16, kraw, cbk, 1, kd, nsa_g + 64, rope + pos * 32, 1.f, lane & 15, kraw + (size_t)2 * 1024 * 128);
        vd[lane] = f2bf(vv);
      } else {
        kd[lane] = 0; vd[lane] = 0;
      }
    }
  }
}

DI void pl_swap(uint32_t& a, uint32_t& b) { auto r_ = __builtin_amdgcn_permlane32_swap(a, b, false, false); a = r_[0]; b = r_[1]; }
DI void ld_own(const bf16* p, uint2& lo, uint2& hi) {
  const uint4 w = *(const uint4*)p;
  lo.x = w.x; lo.y = w.y; hi.x = w.z; hi.y = w.w;
  pl_swap(lo.x, hi.x); pl_swap(lo.y, hi.y);
}
template <int MODE>
DI void attn_epi(const f32x16 (&O)[2], float scale, const bf16* zrow, const float* sg, const bf16* a1row, const bf16* a2row, bf16* orow, int half) {
#pragma unroll
  for (int dvb = 0; dvb < 2; ++dvb)
#pragma unroll
    for (int pq = 0; pq < 2; ++pq) {
      const int col16 = dvb * 32 + 16 * pq + 8 * half;
      const int dvA = dvb * 32 + 16 * pq + 4 * half;
      float va[4], vb[4];
#pragma unroll
      for (int e = 0; e < 4; ++e) { va[e] = O[dvb][8 * pq + e] * scale; vb[e] = O[dvb][8 * pq + 4 + e] * scale; }
      if (MODE == 2) {
#pragma unroll
        for (int e = 0; e < 4; ++e) { va[e] *= sg[dvA + e]; vb[e] *= sg[dvA + 8 + e]; }
      }
      if (MODE == 3) {
        uint2 clo, chi, wlo, whi;
        ld_own(a1row + col16, clo, chi);
        ld_own(a2row + col16, wlo, whi);
        va[0] += bflo(clo.x) + bflo(wlo.x); va[1] += bfhi(clo.x) + bfhi(wlo.x); va[2] += bflo(clo.y) + bflo(wlo.y); va[3] += bfhi(clo.y) + bfhi(wlo.y);
        vb[0] += bflo(chi.x) + bflo(whi.x); vb[1] += bfhi(chi.x) + bfhi(whi.x); vb[2] += bflo(chi.y) + bflo(whi.y); vb[3] += bfhi(chi.y) + bfhi(whi.y);
      }
      if (MODE >= 1) {
        uint2 zlo, zhi;
        ld_own(zrow + col16, zlo, zhi);
        va[0] *= siluf_(bflo(zlo.x)); va[1] *= siluf_(bfhi(zlo.x)); va[2] *= siluf_(bflo(zlo.y)); va[3] *= siluf_(bfhi(zlo.y));
        vb[0] *= siluf_(bflo(zhi.x)); vb[1] *= siluf_(bfhi(zhi.x)); vb[2] *= siluf_(bflo(zhi.y)); vb[3] *= siluf_(bfhi(zhi.y));
      }
      uint32_t A0 = pack2(va[0], va[1]), A1 = pack2(va[2], va[3]), B0 = pack2(vb[0], vb[1]), B1 = pack2(vb[2], vb[3]);
      pl_swap(A0, B0); pl_swap(A1, B1);
      uint4 o; o.x = A0; o.y = A1; o.z = B0; o.w = B1;
      *(uint4*)(orow + col16) = o;
    }
}
template <int MODE>
DI void attn_epi_lds(const f32x16 (&O)[2], float scale, const bf16* zb, const float* sg, const bf16* a1b, const bf16* a2b, bf16* ob, char* smem) {
  const int tid = opq(threadIdx.x), lane = tid & 63, wv = tid >> 6, half = lane >> 5, l31 = lane & 31;
  float* st = (float*)smem + wv * (32 * 68);
  __syncthreads();
#pragma unroll
  for (int dvb = 0; dvb < 2; ++dvb)
#pragma unroll
    for (int g = 0; g < 4; ++g) {
      float4 v; v.x = O[dvb][4 * g] * scale; v.y = O[dvb][4 * g + 1] * scale; v.z = O[dvb][4 * g + 2] * scale; v.w = O[dvb][4 * g + 3] * scale;
      *(float4*)(st + l31 * 68 + dvb * 32 + 8 * g + 4 * half) = v;
    }
  __syncthreads();
  const int rr = lane >> 3, c8 = (lane & 7) * 8;
#pragma unroll
  for (int i = 0; i < 4; ++i) {
    const int r = rr + 8 * i;
    float4 x0 = *(const float4*)(st + r * 68 + c8), x1 = *(const float4*)(st + r * 68 + c8 + 4);
    if (MODE == 2) {
      const float4 g0 = *(const float4*)(sg + c8), g1 = *(const float4*)(sg + c8 + 4);
      x0.x *= g0.x; x0.y *= g0.y; x0.z *= g0.z; x0.w *= g0.w; x1.x *= g1.x; x1.y *= g1.y; x1.z *= g1.z; x1.w *= g1.w;
    }
    if (MODE == 3) {
      const uint4 cw = *(const uint4*)(a1b + (size_t)r * 256 + c8), ww = *(const uint4*)(a2b + (size_t)r * 256 + c8);
      x0.x += bflo(cw.x) + bflo(ww.x); x0.y += bfhi(cw.x) + bfhi(ww.x); x0.z += bflo(cw.y) + bflo(ww.y); x0.w += bfhi(cw.y) + bfhi(ww.y);
      x1.x += bflo(cw.z) + bflo(ww.z); x1.y += bfhi(cw.z) + bfhi(ww.z); x1.z += bflo(cw.w) + bflo(ww.w); x1.w += bfhi(cw.w) + bfhi(ww.w);
    }
    const uint4 zw = *(const uint4*)(zb + (size_t)r * NP + c8);
    uint4 o;
    o.x = pack2(x0.x * siluf_(bflo(zw.x)), x0.y * siluf_(bfhi(zw.x)));
    o.y = pack2(x0.z * siluf_(bflo(zw.y)), x0.w * siluf_(bfhi(zw.y)));
    o.z = pack2(x1.x * siluf_(bflo(zw.z)), x1.y * siluf_(bfhi(zw.z)));
    o.w = pack2(x1.z * siluf_(bflo(zw.w)), x1.w * siluf_(bfhi(zw.w)));
    *(uint4*)(ob + (size_t)r * 1024 + c8) = o;
  }
}
DI void st4(bf16* dst, float a, float b, float c, float d) { uint2 o; o.x = pack2(a, b); o.y = pack2(c, d); *(uint2*)dst = o; }

DI void attn_phaseA(const Params& p, int layer, char* smem, int* ctr) {
  char* ws = opqp(p.ws);
  bf16* u = (bf16*)(ws + OFF_U);
  bf16* y = (bf16*)(ws + OFF_Y);
  const float* gt = (const float*)(ws + OFF_GT);
  int* s_item = (int*)(smem + SM_MISC);
  const int xcd = blockIdx.x & 7;
  while (true) {
    __syncthreads();
    if (threadIdx.x == 0) *s_item = atomicAdd(ctr + 24 + xcd, 1);
    __syncthreads();
    const int item = *s_item;
    if (item >= 16) break;
    {
      const int tid = opq(threadIdx.x), lane = tid & 63, wv = tid >> 6, half = lane >> 5, l31 = lane & 31;
      const int i2 = item;
      const int qb = 15 - i2, b = xcd;
      const int q0 = qb * 128, qpos = q0 + wv * 32 + l31;
      const size_t t = (size_t)b * S + qpos;
      const bf16* ub = u + (size_t)b * S * NP;
      const bf16* kc = (const bf16*)(ws + OFF_KCN) + (size_t)b * 128 * 64;
      const bf16* vc = (const bf16*)(ws + OFF_VCN) + (size_t)b * 128 * 64;
      const uint32_t tm = (q0 + 127 >= 16 * 64 + 31) ? 3u : 1u;
      float* scl = (float*)(smem + SM_SC) + wv * 32 * 33;
#pragma unroll
      for (int g = 0; g < 16; ++g) scl[l31 * 33 + 2 * g + half] = 0.f;
      const int khi = (qpos - 31) >> 4;
#pragma unroll 1
      for (int h = 0; h < 4; ++h) {
        f32x16 O[2]; float mm, ll;
        bf16x8 Qf[4];
        load_q<64>(ub + (size_t)qpos * NP + C_NQ + h * 64, Qf);
        attn_core<64>(kc, 64, vc, 64, tm, AM_CMP, qpos, 0u, Qf, O, mm, ll, smem);
        const float inv = ll > 0.f ? 1.f / ll : 0.f;
        const float sc = inv * gt[t * 12 + h];
        bf16* od = (bf16*)(ws + OFF_OCMP) + t * 256 + h * 64;
        attn_epi<0>(O, sc, nullptr, nullptr, nullptr, nullptr, od, half);
        const float mu = mm < -1e29f ? 0.f : mm;
        const bf16* Ks = (const bf16*)smem;
        float Aa[16], Cc[16];
#pragma unroll
        for (int g = 0; g < 16; ++g) { Aa[g] = 0.f; Cc[g] = 0.f; }
#pragma unroll
        for (int kt = 0; kt < 2; ++kt) {
          if (tm & (1u << kt)) {
#pragma unroll
            for (int kb = 0; kb < 2; ++kb) {
              f32x16 Sx;
#pragma unroll
              for (int i = 0; i < 16; ++i) Sx[i] = 0.f;
#pragma unroll
              for (int kcx = 0; kcx < 4; ++kcx) {
                bf16x8 a = *(const bf16x8*)(Ks + (kt * 64 + kb * 32 + l31) * 72 + kcx * 16 + half * 8);
                Sx = MFMA(a, Qf[kcx], Sx);
              }
#pragma unroll
              for (int gg = 0; gg < 4; ++gg) {
                float pv[4];
#pragma unroll
                for (int e = 0; e < 4; ++e) {
                  const int key = kt * 64 + kb * 32 + gg * 8 + half * 4 + e;
                  pv[e] = key <= khi ? fexp2(Sx[gg * 4 + e] - mu) * inv : 0.f;
                }
                Aa[kt * 8 + kb * 4 + gg] += pv[0] + 2.f * (pv[1] + pv[2] + pv[3]);
                Cc[kt * 8 + kb * 4 + gg] += pv[0];
              }
            }
          }
        }
        {
          float rc[16];
#pragma unroll
          for (int g = 0; g < 16; ++g) rc[g] = shx(Cc[g], 32);
#pragma unroll
          for (int g = 0; g < 16; ++g) {
            const float nx = half == 0 ? rc[g] : (g < 15 ? rc[g < 15 ? g + 1 : 15] : 0.f);
            scl[l31 * 33 + 2 * g + half] += Aa[g] + nx;
          }
        }
      }
      __syncthreads();
      {
        float sv[32];
        const int cur = qpos >> 6;
#pragma unroll
        for (int j = 0; j < 32; ++j) {
          float v = scl[l31 * 33 + j];
          const bool forced = (j == 0) || (j == cur) || (j == cur - 1);
          sv[j] = j > cur ? -1e30f : (forced ? 1e30f : v);
        }
        uint32_t bits = 0;
#pragma unroll 1
        for (int jj = 0; jj < 16; ++jj) {
          const int j = half * 16 + jj;
          float sj = scl[l31 * 33 + j];
          const bool fj = (j == 0) || (j == cur) || (j == cur - 1);
          sj = j > cur ? -1e30f : (fj ? 1e30f : sj);
          int rank = 0;
#pragma unroll
          for (int i = 0; i < 32; ++i) rank += (sv[i] > sj || (sv[i] == sj && i < j)) ? 1 : 0;
          if (rank < 16) bits |= 1u << j;
        }
        bits |= (uint32_t)__shfl_xor((int)bits, 32);
        if (half == 0) ((uint32_t*)(ws + OFF_SEL))[t] = bits;
      }
      wg_publish((unsigned*)(ws + OFF_FLAG) + layer * 1024 + (b * 16 + qb) * 8);
    }
  }
  while (true) {
    __syncthreads();
    if (threadIdx.x == 0) *s_item = atomicAdd(ctr + 16 + xcd, 1);
    __syncthreads();
    const int item = *s_item;
    if (item >= 128) break;
    {
      const int tid = opq(threadIdx.x), lane = tid & 63, wv = tid >> 6, half = lane >> 5, l31 = lane & 31;
      const int i2 = item;
      const int ismem = i2 >> 6, r = i2 & 63, qb = 15 - (r >> 2), b = xcd, h = r & 3;
      const int q0 = qb * 128, qpos = q0 + wv * 32 + l31;
      const size_t t = (size_t)b * S + qpos;
      const bf16* ub = u + (size_t)b * S * NP;
      f32x16 O[2]; float mm, ll;
      bf16x8 Qf[4];
      if (!ismem) {
        load_q<64>(ub + (size_t)qpos * NP + C_NQ + h * 64, Qf);
        const int kt0 = q0 >= 512 ? (q0 - 512) / 64 : 0, kt1 = 2 * qb + 2;
        const uint32_t hi = kt1 >= 32 ? 0xffffffffu : ((1u << kt1) - 1u);
        const uint32_t tm = hi & ~((1u << kt0) - 1u);
        attn_core<64>(ub + C_KW, NP, ub + C_VW, NP, tm, AM_WIN, qpos, 0u, Qf, O, mm, ll, smem);
        const float sc = (ll > 0.f ? 1.f / ll : 0.f) * gt[t * 12 + 8 + h];
        bf16* od = (bf16*)(ws + OFF_OWIN) + t * 256 + h * 64;
        attn_epi<0>(O, sc, nullptr, nullptr, nullptr, nullptr, od, half);
        wg_publish((unsigned*)(ws + OFF_FLAG) + layer * 1024 + (b * 16 + qb) * 8 + 1 + h);
      } else {
        load_q<64>(ub + (size_t)qpos * NP + C_MQ + h * 64, Qf);
        attn_core<64>((const bf16*)(ws + OFF_MK) + (size_t)(b * 4 + h) * ML * 64, 64, (const bf16*)(ws + OFF_MVV) + (size_t)(b * 4 + h) * ML * 64, 64,
                      0xfu, AM_NONE, qpos, 0u, Qf, O, mm, ll, smem);
        const float inv = ll > 0.f ? 1.f / ll : 0.f;
        attn_epi_lds<1>(O, inv, u + (t - l31) * NP + C_MEZ + h * 64, nullptr, nullptr, nullptr, y + (t - l31) * 1024 + 768 + h * 64, smem);
      }
    }
  }
  while (true) {
    __syncthreads();
    if (threadIdx.x == 0) *s_item = atomicAdd(ctr + xcd, 1);
    __syncthreads();
    const int item = *s_item;
    if (item >= 64) break;
    {
      const int tid = opq(threadIdx.x), lane = tid & 63, wv = tid >> 6, half = lane >> 5, l31 = lane & 31;
      const int qb = 15 - (item >> 2), b = xcd, h = item & 3;
      const int q0 = qb * 128, qpos = q0 + wv * 32 + l31;
      const size_t t = (size_t)b * S + qpos;
      const uint32_t tm = (qb == 15) ? 0xffffffffu : ((1u << (2 * qb + 2)) - 1u);
      f32x16 O[2]; float mm, ll;
        bf16x8 Qf[6];
        const bf16* qm = (const bf16*)(ws + OFF_QM) + (size_t)(b * 4 + h) * S * 96;
        load_q<96>(qm + (size_t)qpos * 96, Qf);
        attn_core<96>((const bf16*)(ws + OFF_KM) + (size_t)(b * 4 + h) * S * 96, 96,
                      (const bf16*)(ws + OFF_MV) + (size_t)(b * 4 + h) * S * 64, 64, tm, AM_CAUSAL, qpos, 0u, Qf, O, mm, ll, smem);
        const float inv = ll > 0.f ? 1.f / ll : 0.f;
        attn_epi_lds<1>(O, inv, u + (t - l31) * NP + C_MZ + h * 64, nullptr, nullptr, nullptr, y + (t - l31) * 1024 + 512 + h * 64, smem);
    }
  }
  while (true) {
    __syncthreads();
    if (threadIdx.x == 0) *s_item = atomicAdd(ctr + 8 + xcd, 1);
    __syncthreads();
    const int item = *s_item;
    if (item >= 64) break;
    {
      const int tid = opq(threadIdx.x), lane = tid & 63, wv = tid >> 6, half = lane >> 5, l31 = lane & 31;
      const int qb = 15 - (item >> 2), b = xcd, h = item & 3;
      const int q0 = qb * 128, qpos = q0 + wv * 32 + l31;
      const size_t t = (size_t)b * S + qpos;
      const uint32_t tm = (qb == 15) ? 0xffffffffu : ((1u << (2 * qb + 2)) - 1u);
      f32x16 O[2]; float mm, ll;
        f32x16 O1[2];
        const bf16* ub = u + (size_t)b * S * NP;
        {
          bf16x8 Qf[4];
          float l1, l2;
          load_q<64>(ub + (size_t)qpos * NP + C_DQ + h * 64, Qf);
          attn_core_dual<64>(ub + C_DK + h * 64, NP, ub + C_DV + h * 64, NP, tm, AM_CAUSAL, qpos, 0u, Qf, O1, O, l1, l2, smem);
          const float inv1 = l1 > 0.f ? 1.f / l1 : 0.f, inv = l2 > 0.f ? 1.f / l2 : 0.f;
#pragma unroll
          for (int i = 0; i < 16; ++i) { O1[0][i] *= inv1; O1[1][i] *= inv1; }
          {
            const float lam = ((const float*)(ws + OFF_LAM))[layer];
            float ss = 0.f;
#pragma unroll
            for (int i = 0; i < 16; ++i) {
              O1[0][i] -= lam * O[0][i] * inv; O1[1][i] -= lam * O[1][i] * inv;
              ss += O1[0][i] * O1[0][i] + O1[1][i] * O1[1][i];
            }
            ss += shx(ss, 32);
            const float li = opq(layer) == 0 ? 0.2f : 0.35550907f;
            const float r = rsqrtf(ss * (1.f / 64.f) + EPS) * (1.f - li);
            const float* sg = p.in[10] + layer * 64;
            attn_epi_lds<2>(O1, r, u + (t - l31) * NP + C_DZ + h * 64, sg, nullptr, nullptr, y + (t - l31) * 1024 + 256 + h * 64, smem);
          }
        }
    }
  }
}

DI void attn_phaseB(const Params& p, int layer, char* smem, int* ctr) {
  const int tid = opq(threadIdx.x), lane = tid & 63, wv = tid >> 6, half = lane >> 5, l31 = lane & 31;
  char* ws = opqp(p.ws);
  bf16* u = (bf16*)(ws + OFF_U);
  bf16* y = (bf16*)(ws + OFF_Y);
  const float* gt = (const float*)(ws + OFF_GT);
  int* s_item = (int*)(smem + SM_MISC);
  uint32_t* s_or = (uint32_t*)(smem + SM_MISC + 16);
  const int xcd = blockIdx.x & 7;
  while (true) {
    __syncthreads();
    if (tid == 0) { *s_item = atomicAdd(ctr + xcd, 1); *s_or = 0u; }
    __syncthreads();
    const int item = *s_item;
    if (item >= 64) break;
    const int qb = 15 - (item >> 2), b = xcd, h = item & 3;
    const int q0 = qb * 128, qpos = q0 + wv * 32 + l31;
    const size_t t = (size_t)b * S + qpos;
    const bf16* ub = u + (size_t)b * S * NP;
    wg_wait2((unsigned*)(ws + OFF_FLAG) + layer * 1024 + (b * 16 + qb) * 8, (unsigned*)(ws + OFF_FLAG) + layer * 1024 + (b * 16 + qb) * 8 + 1 + h);
    const uint32_t sel = ((const uint32_t*)(ws + OFF_SEL))[t];
    const uint32_t causal = (qb == 15) ? 0xffffffffu : ((1u << (2 * qb + 2)) - 1u);
    if (half == 0) atomicOr(s_or, sel);
    __syncthreads();
    const uint32_t tm = (*s_or & causal) | 1u;
    f32x16 O[2]; float mm, ll;
    bf16x8 Qf[4];
    load_q<64>(ub + (size_t)qpos * NP + C_NQ + h * 64, Qf);
    attn_core<64>(ub + C_KS, NP, ub + C_VS, NP, tm, AM_SLC, qpos, sel, Qf, O, mm, ll, smem);
    const float sc = (ll > 0.f ? 1.f / ll : 0.f) * gt[t * 12 + 4 + h];
    const bf16* oc = (const bf16*)(ws + OFF_OCMP) + t * 256 + h * 64;
    const bf16* ow = (const bf16*)(ws + OFF_OWIN) + t * 256 + h * 64;
    attn_epi_lds<3>(O, sc, u + (t - l31) * NP + C_NZ + h * 64, nullptr, oc - (size_t)l31 * 256, ow - (size_t)l31 * 256, y + (t - l31) * 1024 + h * 64, smem);
  }
  (void)layer;
}

__global__ void __launch_bounds__(256, 2) fwd_megakernel(Params p) {
  __shared__ __attribute__((aligned(16))) char smem[SMEM_BYTES];
  cg::grid_group grid = cg::this_grid();
  char* ws = opqp(p.ws);
  int* ctrs = (int*)(ws + OFF_CTR);
  __shared__ uint4 xb_words;
  if (threadIdx.x == 0) xb_words = make_uint4(0u, 0u, 0u, 0u);
  __syncthreads();
  XcdBarrier xb = xcd_barrier_post((unsigned*)(ws + OFF_BAR), (volatile LAS unsigned*)&xb_words);
  phase0(p, smem);
  if (p.out == nullptr) grid.sync();
  xcd_barrier(xb);
  if (blockIdx.x == 0) {
    const int tq = opq(threadIdx.x);
    const float* cbp = (const float*)(opqp(p.ws) + OFF_CB) + (tq >> 6) * 16 * 64 + (tq & 63);
    float a = 0.f;
#pragma unroll
    for (int sidx = 0; sidx < 16; ++sidx) a += cbp[sidx * 64];
    ((float*)(opqp(p.ws) + OFF_CBF))[tq] = a;
  }
#define PBAR(K) xcd_barrier(xb)
  for (int layer = 0; layer < 2; ++layer) {
    bf16* u = (bf16*)(ws + OFF_U);
    {
      const bf16* xbp = (const bf16*)(ws + OFF_XB);
      const bf16* wi = (const bf16*)(ws + OFF_WI + layer * SZ_WI);
      const int xcd = blockIdx.x & 7, rk = blockIdx.x >> 3, nrk = gridDim.x >> 3;
      for (int q = rk; q < 216; q += nrk) {
        if (q < 192) {
          const int mt = xcd * 8 + (q & 7), nt = q >> 3;
          gemm_big(xbp + (size_t)mt * 256 * 1024, 1024, wi + (size_t)nt * 128 * 1024, 1024, 16, smem, EPI_RS8, u, NP, mt * 256,
                   (const float*)(ws + OFF_SSQ), nullptr, nullptr, nullptr, nullptr, nt);
        } else if (q < 208) {
          const int mt = xcd * 16 + (q - 192), nt = 24;
          gemm_tile<16>(xbp + (size_t)mt * 128 * 1024, 1024, 64, wi + (size_t)nt * 128 * 1024, 1024, 16, smem);
          gemm_epi(EPI_RS8, smem, u, NP, mt * 128, (const float*)(ws + OFF_SSQ), nullptr, nullptr, nullptr, nullptr, nt);
        } else {
          const int i = xcd * 8 + (q - 208), mt = i >> 2, nt = i & 3;
          gemm_tile<16>((const bf16*)(ws + OFF_MEMB) + (size_t)mt * 128 * 1024, 1024, 64,
                    (const bf16*)(ws + OFF_WMEM + layer * SZ_WMEM) + (size_t)nt * 128 * 1024, 1024, 16, smem);
          gemm_epi(EPI_RS1, smem, (bf16*)(ws + OFF_KMEMRAW), 512, mt * 128, (const float*)(ws + OFF_RMEM), nullptr, nullptr, nullptr, nullptr, nt);
        }
      }
    }
    PBAR(0);
    {
      const int xcd = blockIdx.x & 7, rk = blockIdx.x >> 3, nrk = gridDim.x >> 3;
      for (int q = rk; q < 64; q += nrk) {
        if (q < 8) {
          const int j = q >> 2, kh = q & 3, b = xcd;
          gemm_tile<8>(u + (size_t)b * S * NP + (j ? C_VC : C_KC) + (size_t)kh * 8 * NP, 16 * NP, NP,
                       (const bf16*)(ws + OFF_WCMP + (layer * 2 + j) * SZ_WCMP) + kh * 512, 2048, 8, smem);
          gemm_epi(EPI_PLAIN, smem, (bf16*)(ws + OFF_CMPRAW) + (size_t)(kh * 2 + j) * 1024 * 128, 128, b * 128, nullptr, nullptr, nullptr, nullptr, nullptr, 0);
        } else if (q < 32) {
          const int i = q - 8, ml = i / 3, nt = i % 3, mt = xcd * 8 + ml;
          gemm_big(u + (size_t)mt * 256 * NP + C_CQ, NP, (const bf16*)(ws + OFF_WUQ + layer * SZ_WUQ) + (size_t)nt * 128 * 256, 256, 4, smem, EPI_PLAIN,
                   (bf16*)(ws + OFF_UQ + (size_t)xcd * SLAB), 384, ml * 256, nullptr, nullptr, nullptr, nullptr, nullptr, nt);
        } else {
          const int i = q - 32, ml = i >> 2, nt = i & 3, mt = xcd * 8 + ml;
          gemm_big(u + (size_t)mt * 256 * NP + C_CKV, NP, (const bf16*)(ws + OFF_WUKV + layer * SZ_WUKV) + (size_t)nt * 128 * 128, 128, 2, smem, EPI_PLAIN,
                   (bf16*)(ws + OFF_UKV + (size_t)xcd * SLAB), 512, ml * 256, nullptr, nullptr, nullptr, nullptr, nullptr, nt);
        }
      }
    }
    PBAR(1);
    prep_phase(p, layer);
    PBAR(2);
    attn_phaseA(p, layer, smem, ctrs + layer * 64);
    attn_phaseB(p, layer, smem, ctrs + layer * 64 + 32);
    PBAR(3);
    {
      const bf16* yb = (const bf16*)(ws + OFF_Y);
      const bf16* wo = (const bf16*)(ws + OFF_WO + layer * SZ_WO);
      const float* xres = layer == 0 ? p.in[0] : nullptr;
      const int xcd = blockIdx.x & 7, rk = blockIdx.x >> 3, nrk = gridDim.x >> 3;
      for (int q = rk; q < 64; q += nrk) {
        const int mt = xcd * 8 + (q & 7), nt = q >> 3;
        gemm_big(yb + (size_t)mt * 256 * 1024, 1024, wo + (size_t)nt * 128 * 1024, 1024, 16, smem, EPI_OUT, (bf16*)(ws + OFF_XB), 0, mt * 256, nullptr, xres, layer == 0 ? nullptr : p.out,
                 layer == 0 ? (bf16*)(ws + OFF_XB) : nullptr, (float*)(ws + OFF_SSQ), nt);
      }
    }
    if (layer == 0) PBAR(4);
  }
}

extern "C" void kernel_launch(void* const* d_in, const int* in_sizes, int n_in, void* d_out, int out_size, void* d_ws, size_t ws_size,
                              hipStream_t stream) {
  static int grid_blocks = 0;
  if (!grid_blocks) {
    int dev = 0, cus = 0, per_cu = 0;
    hipGetDevice(&dev);
    hipDeviceGetAttribute(&cus, hipDeviceAttributeMultiprocessorCount, dev);
    hipOccupancyMaxActiveBlocksPerMultiprocessor(&per_cu, fwd_megakernel, 256, 0);
    if (per_cu > 2) per_cu = 2;
    grid_blocks = (cus * per_cu) & ~7;
  }
  if (ws_size < WS_TOTAL) { fprintf(stderr, "workspace too small: %zu < %zu\n", ws_size, (size_t)WS_TOTAL); return; }
  Params p{};
  for (int i = 0; i < 19; ++i) p.in[i] = (const float*)d_in[i];
  p.out = (float*)d_out;
  p.ws = (char*)d_ws;
  hipMemsetAsync((char*)d_ws + OFF_CTR, 0, 1024 + 16384 + 8192 + 2048, stream);
  void* args[] = {&p};
  hipError_t e = hipLaunchCooperativeKernel((void*)fwd_megakernel, dim3(grid_blocks), dim3(256), args, 0, stream);
  if (e != hipSuccess) fprintf(stderr, "cooperative launch failed: %s (grid %d)\n", hipGetErrorString(e), grid_blocks);
}
```

```cpp
#include <hip/hip_runtime.h>
#include <hip/hip_cooperative_groups.h>
#include <stdint.h>
#include <cstdio>
namespace cg = cooperative_groups;

typedef unsigned short bf16;
using bf16x8 = __attribute__((ext_vector_type(8))) short;
using f32x16 = __attribute__((ext_vector_type(16))) float;
typedef __bf16 hbf2 __attribute__((ext_vector_type(2)));
typedef float hf2 __attribute__((ext_vector_type(2)));
typedef uint32_t u32x4 __attribute__((ext_vector_type(4)));
#define GLD16(dst, ptr) asm volatile("global_load_dwordx4 %0, %1, off" : "=&v"(dst) : "v"(ptr) : "memory")
#define WAIT_VM0() asm volatile("s_waitcnt vmcnt(0)" ::: "memory")
#define DI __device__ __forceinline__
#define MFMA(a, b, c) __builtin_amdgcn_mfma_f32_32x32x16_bf16((a), (b), (c), 0, 0, 0)

constexpr int Bn = 8, S = 2048, T = 16384, D = 1024, NP = 3200, ML = 256, TM = 2048;
constexpr float EPS = 1e-6f;
constexpr float LOG2E = 1.4426950408889634f;
constexpr int C_NQ = 0, C_KC = 256, C_VC = 320, C_KS = 384, C_VS = 448, C_KW = 512, C_VW = 576, C_NZ = 640,
              C_DQ = 896, C_DK = 1152, C_DV = 1408, C_DZ = 1664, C_CQ = 1920, C_CKV = 2176, C_KR = 2304,
              C_MZ = 2336, C_MQ = 2592, C_MEZ = 2848, C_GL = 3104;
constexpr size_t SZ_WI = (size_t)NP * 1024 * 2, SZ_WO = 1024 * 1024 * 2, SZ_WUQ = 384 * 256 * 2, SZ_WUKV = 512 * 128 * 2,
                 SZ_WMEM = 512 * 1024 * 2, SZ_WCMP = 128 * 2048 * 2;
constexpr size_t OFF_WI = 0;
constexpr size_t OFF_WO = OFF_WI + 2 * SZ_WI;
constexpr size_t OFF_WUQ = OFF_WO + 2 * SZ_WO;
constexpr size_t OFF_WUKV = OFF_WUQ + 2 * SZ_WUQ;
constexpr size_t OFF_WMEM = OFF_WUKV + 2 * SZ_WUKV;
constexpr size_t OFF_WCMP = OFF_WMEM + 2 * SZ_WMEM;
constexpr size_t OFF_CB = OFF_WCMP + 4 * SZ_WCMP;
constexpr size_t OFF_CBF = OFF_CB + 16384;
constexpr size_t OFF_LAM = OFF_CBF + 1024;
constexpr size_t OFF_CTR = OFF_LAM + 256;
constexpr size_t OFF_BAR = OFF_CTR + 1024;
constexpr size_t OFF_FLAG = OFF_BAR + 16384;
constexpr size_t OFF_PCNT = OFF_FLAG + 8192;
constexpr size_t OFF_ROPE = OFF_PCNT + 2048;
constexpr size_t OFF_SSQ = OFF_ROPE + 2048 * 32 * 8;
constexpr size_t OFF_RMEM = OFF_SSQ + (size_t)T * 8 * 4;
constexpr size_t OFF_MEMB = OFF_RMEM + 2048 * 4;
constexpr size_t OFF_XB = OFF_MEMB + (size_t)TM * 1024 * 2;
constexpr size_t OFF_U = OFF_XB + (size_t)T * 1024 * 2;
constexpr size_t OFF_R1 = OFF_U + (size_t)T * NP * 2;
constexpr size_t SLAB = (size_t)S * 1024 * 2;
constexpr size_t OFF_UQ = OFF_R1;
constexpr size_t OFF_UKV = OFF_R1 + (size_t)S * 384 * 2;
constexpr size_t OFF_Y = OFF_R1;
constexpr size_t OFF_QM = OFF_R1 + (size_t)T * 1024 * 2;
constexpr size_t OFF_KM = OFF_QM + (size_t)T * 384 * 2;
constexpr size_t OFF_MV = OFF_KM + (size_t)T * 384 * 2;
constexpr size_t OFF_KMEMRAW = OFF_MV + (size_t)T * 256 * 2;
constexpr size_t OFF_MK = OFF_KMEMRAW + (size_t)TM * 512 * 2;
constexpr size_t OFF_MVV = OFF_MK + (size_t)TM * 256 * 2;
constexpr size_t OFF_CMPRAW = OFF_MVV + (size_t)TM * 256 * 2;
constexpr size_t OFF_KCN = OFF_CMPRAW + 8 * 1024 * 128 * 2;
constexpr size_t OFF_VCN = OFF_KCN + 8 * 128 * 64 * 2;
constexpr size_t OFF_GT = OFF_VCN + 8 * 128 * 64 * 2;
constexpr size_t OFF_OCMP = OFF_GT + (size_t)T * 12 * 4;
constexpr size_t OFF_OWIN = OFF_OCMP + (size_t)T * 256 * 2;
constexpr size_t OFF_SEL = OFF_OWIN + (size_t)T * 256 * 2;
constexpr size_t WS_TOTAL = OFF_SEL + (size_t)T * 4;

constexpr int SMEM_BYTES = 73728;
constexpr int SM_VT = 2 * 64 * 104 * 2;
constexpr int SM_SC = SM_VT + 2 * 64 * 72 * 2;
constexpr int SM_MISC = SM_SC + 4 * 32 * 33 * 4;

struct Params {
  const float* in[19];
  float* out;
  char* ws;
};

DI int opq(int v) { asm volatile("" : "+v"(v)); return v; }
DI char* opqp(char* q) { size_t z = 0; asm volatile("" : "+s"(z)); return q + z; }
typedef float f32x4v __attribute__((ext_vector_type(4)));
DI float4 ld_nt4(const float4* p) { const f32x4v v = __builtin_nontemporal_load((const f32x4v*)p); float4 r; r.x = v[0]; r.y = v[1]; r.z = v[2]; r.w = v[3]; return r; }
DI void st_nt4(float4* p, const float4& a) { f32x4v v; v[0] = a.x; v[1] = a.y; v[2] = a.z; v[3] = a.w; __builtin_nontemporal_store(v, (f32x4v*)p); }
DI float bf2f(uint32_t v) { return __uint_as_float(v << 16); }
DI float bflo(uint32_t w) { return __uint_as_float(w << 16); }
DI float bfhi(uint32_t w) { return __uint_as_float(w & 0xffff0000u); }
DI uint32_t pack2(float a, float b) { hf2 f = {a, b}; hbf2 r = __builtin_convertvector(f, hbf2); return __builtin_bit_cast(uint32_t, r); }
DI bf16 f2bf(float a) { return (bf16)(pack2(a, 0.f) & 0xffffu); }
DI float fexp2(float x) { return __builtin_amdgcn_exp2f(x); }
DI float sigmoidf_(float x) { return __builtin_amdgcn_rcpf(1.f + fexp2(-LOG2E * x)); }
DI float siluf_(float x) { return x * __builtin_amdgcn_rcpf(1.f + fexp2(-LOG2E * x)); }
DI float shx(float v, int m) { return __shfl_xor(v, m); }
DI float dppf(float v, int ctrl_sel) {
  int x = __builtin_bit_cast(int, v), r;
  if (ctrl_sel == 0) r = __builtin_amdgcn_mov_dpp(x, 0xB1, 0xF, 0xF, true);
  else if (ctrl_sel == 1) r = __builtin_amdgcn_mov_dpp(x, 0x4E, 0xF, 0xF, true);
  else if (ctrl_sel == 2) r = __builtin_amdgcn_mov_dpp(x, 0x141, 0xF, 0xF, true);
  else r = __builtin_amdgcn_mov_dpp(x, 0x140, 0xF, 0xF, true);
  return __builtin_bit_cast(float, r);
}
DI float sum8(float v) { v += dppf(v, 0); v += dppf(v, 1); v += dppf(v, 2); return v; }
DI float sum16(float v) { v = sum8(v); v += dppf(v, 3); return v; }
DI float sum64(float v) { v = sum16(v); v += shx(v, 16); v += shx(v, 32); return v; }


#define XB_TMO      128
#define XB_XCNT(j)  (256  + 64 * (j))
#define XB_XSUB(j)  (1280 + 64 * (j))
#define XB_XGEN(j)  (2304 + 64 * (j))
#define XB_TOP      3328
#define XB_TOPGEN   3392
#define XB_SPIN_CAP (1u << 22)
#define LAS __attribute__((address_space(3)))
DI unsigned xb_ld(unsigned* p) { return __hip_atomic_load(p, __ATOMIC_RELAXED, __HIP_MEMORY_SCOPE_AGENT); }
DI unsigned xb_add(unsigned* p, unsigned v) { return __hip_atomic_fetch_add(p, v, __ATOMIC_RELAXED, __HIP_MEMORY_SCOPE_AGENT); }
DI unsigned xb_xcc_id() { return (unsigned)__builtin_amdgcn_readfirstlane((int)(__builtin_amdgcn_s_getreg((3 << 11) | 20) & 0xFu)); }
#define XB_SPIN(cond, bar) do { unsigned _sp = 0; while (cond) { __builtin_amdgcn_s_sleep(1); \
    if ((++_sp & 255u) == 0u) { if (xb_ld(&(bar)[XB_TMO])) break; if (_sp > XB_SPIN_CAP) { atomicAdd(&(bar)[XB_TMO], 1u); break; } } } } while (0)
struct XcdBarrier { unsigned* bar; unsigned x; volatile LAS unsigned* st; };
DI XcdBarrier xcd_barrier_post(unsigned* bar, volatile LAS unsigned* st) {
  XcdBarrier b; b.bar = bar; b.x = xb_xcc_id(); b.st = st;
  if (threadIdx.x == 0) (void)xb_add(&bar[XB_XCNT(b.x)], 1u);
  return b;
}
DI void xcd_barrier_complete(unsigned* bar, unsigned x, unsigned& nloc, unsigned& nx) {
  const unsigned G = gridDim.x * gridDim.y * gridDim.z;
  unsigned sum, cnt, mine, sp = 0u;
  for (;;) {
    sum = 0u; cnt = 0u; mine = 0u;
#pragma unroll
    for (unsigned j = 0; j < 16; ++j) { const unsigned c = xb_ld(&bar[XB_XCNT(j)]); sum += c; cnt += (c > 0u) ? 1u : 0u; mine = (j == x) ? c : mine; }
    if (sum == G) break;
    __builtin_amdgcn_s_sleep(1);
    if ((++sp & 255u) == 0u) { if (xb_ld(&bar[XB_TMO])) break; if (sp > XB_SPIN_CAP) { atomicAdd(&bar[XB_TMO], 1u); break; } }
  }
  nloc = mine > 0u ? mine : 1u; nx = cnt > 0u ? cnt : 1u;
}
DI void xcd_barrier(const XcdBarrier& b) {
  asm volatile("s_waitcnt vmcnt(0)" ::: "memory");
  __syncthreads();
  if (threadIdx.x == 0) {
    unsigned* bar = b.bar;
    const unsigned bx = xb_xcc_id();
    __builtin_amdgcn_s_waitcnt(0);
    unsigned nloc = b.st[0], nx = b.st[1];
    if (nloc == 0u) { xcd_barrier_complete(bar, bx, nloc, nx); b.st[0] = nloc; b.st[1] = nx; }
    const unsigned old = xb_add(&bar[XB_XSUB(bx)], 1u);
    const unsigned gen = old / nloc;
    if (old + 1u == (gen + 1u) * nloc) {
      __builtin_amdgcn_fence(__ATOMIC_RELEASE, "agent");
      asm volatile("s_waitcnt vmcnt(0)" ::: "memory");
      const unsigned og = xb_add(&bar[XB_TOP], 1u);
      const unsigned tg = og / nx;
      if (og + 1u == (tg + 1u) * nx) xb_add(&bar[XB_TOPGEN], 1u);
      else XB_SPIN(xb_ld(&bar[XB_TOPGEN]) == tg, bar);
      __builtin_amdgcn_fence(__ATOMIC_ACQUIRE, "agent");
      xb_add(&bar[XB_XGEN(bx)], 1u);
      asm volatile("s_waitcnt vmcnt(0)" ::: "memory");
    } else {
      XB_SPIN(xb_ld(&bar[XB_XGEN(bx)]) == gen, bar);
      __builtin_amdgcn_fence(__ATOMIC_ACQUIRE, "agent");
      asm volatile("s_waitcnt vmcnt(0)" ::: "memory");
    }
  }
  __syncthreads();
}

DI void part_barrier(unsigned* cnt, unsigned target) {
  asm volatile("s_waitcnt vmcnt(0)" ::: "memory");
  __syncthreads();
  if (threadIdx.x == 0) {
    __builtin_amdgcn_s_waitcnt(0);
    __builtin_amdgcn_fence(__ATOMIC_RELEASE, "agent");
    asm volatile("s_waitcnt vmcnt(0)" ::: "memory");
    xb_add(cnt, 1u);
    unsigned sp = 0;
    while (xb_ld(cnt) < target) { __builtin_amdgcn_s_sleep(1); if (++sp > (1u << 24)) break; }
    __builtin_amdgcn_fence(__ATOMIC_ACQUIRE, "agent");
    asm volatile("s_waitcnt vmcnt(0)" ::: "memory");
  }
  __syncthreads();
}

DI void wg_publish(unsigned* flag) {
  asm volatile("s_waitcnt vmcnt(0)" ::: "memory");
  __syncthreads();
  if (threadIdx.x == 0) {
    __builtin_amdgcn_fence(__ATOMIC_RELEASE, "agent");
    asm volatile("s_waitcnt vmcnt(0)" ::: "memory");
    xb_add(flag, 1u);
  }
}
DI void wg_wait2(unsigned* f0, unsigned* f1) {
  if (threadIdx.x == 0) {
    unsigned sp = 0;
    while (xb_ld(f0) < 1u || xb_ld(f1) < 1u) { __builtin_amdgcn_s_sleep(2); if (++sp > (1u << 22)) break; }
    __builtin_amdgcn_fence(__ATOMIC_ACQUIRE, "agent");
    asm volatile("s_waitcnt vmcnt(0)" ::: "memory");
  }
  __syncthreads();
}

DI int win_orig(int n) { return n < 640 ? n : (n < 3104 ? n + 12 : (n < 3116 ? n - 3104 + 640 : -1)); }

DI void convT_tile(const float* __restrict__ src, int Nsrc, const float* __restrict__ gain, bf16* __restrict__ dst, int K,
                   int k0, int n0, int mapmode, float* tile) {
  const int tid = opq(threadIdx.x);
  int shift = -1;
  if (mapmode == 1) { if (n0 + 63 < 640) shift = 0; else if (n0 >= 640 && n0 + 63 < 3104) shift = 12; }
  else if (n0 + 63 < Nsrc) shift = 0;
  const bool allpad = (mapmode == 1) ? (n0 >= 3116) : (n0 >= Nsrc);
  if (shift >= 0) {
    const int f = tid & 15, kr = tid >> 4;
    float4 v[4];
#pragma unroll
    for (int it = 0; it < 4; ++it) v[it] = ld_nt4((const float4*)(src + (size_t)(k0 + kr + 16 * it) * Nsrc + n0 + shift + 4 * f));
    if (gain) {
#pragma unroll
      for (int it = 0; it < 4; ++it) { const float g = gain[k0 + kr + 16 * it]; v[it].x *= g; v[it].y *= g; v[it].z *= g; v[it].w *= g; }
    }
#pragma unroll
    for (int it = 0; it < 4; ++it) {
      float* tp = tile + (kr + 16 * it) * 65 + 4 * f;
      tp[0] = v[it].x; tp[1] = v[it].y; tp[2] = v[it].z; tp[3] = v[it].w;
    }
  } else {
    const int nn = tid & 63, kk = tid >> 6;
    const int n = n0 + nn;
    const int on = allpad ? -1 : (mapmode == 1 ? win_orig(n) : (n < Nsrc ? n : -1));
    float v[16];
#pragma unroll
    for (int it = 0; it < 16; ++it) {
      const int k = k0 + kk + 4 * it;
      v[it] = 0.f;
      if (on >= 0) v[it] = src[(size_t)k * Nsrc + on];
    }
    if (gain) {
#pragma unroll
      for (int it = 0; it < 16; ++it) v[it] *= gain[k0 + kk + 4 * it];
    }
#pragma unroll
    for (int it = 0; it < 16; ++it) tile[(kk + 4 * it) * 65 + nn] = v[it];
  }
  __syncthreads();
  {
    const int k8 = (tid & 7) * 8, nb = tid >> 3;
#pragma unroll
    for (int it = 0; it < 2; ++it) {
      const int n = nb + 32 * it;
      uint4 o;
      o.x = pack2(tile[(k8 + 0) * 65 + n], tile[(k8 + 1) * 65 + n]);
      o.y = pack2(tile[(k8 + 2) * 65 + n], tile[(k8 + 3) * 65 + n]);
      o.z = pack2(tile[(k8 + 4) * 65 + n], tile[(k8 + 5) * 65 + n]);
      o.w = pack2(tile[(k8 + 6) * 65 + n], tile[(k8 + 7) * 65 + n]);
      *(uint4*)(dst + (size_t)(n0 + n) * K + k0 + k8) = o;
    }
  }
  __syncthreads();
}

DI void phase0(const Params& p, char* smem) {
  const int tid = opq(threadIdx.x), lane = tid & 63, wv = tid >> 6;
  float* tile = (float*)smem;
  char* ws = opqp(p.ws);
  constexpr int N_WI = 2 * 50 * 16, N_WO = 2 * 16 * 16, N_WUQ = 2 * 6 * 4, N_WUKV = 2 * 8 * 2, N_WMEM = 2 * 8 * 16,
                N_WCMP = 4 * 2 * 32, N_X = T / 4, N_MEM = TM / 4, N_ROPE = 256, N_CB = 64, N_LAM = 1;
  constexpr int E0 = N_WI, E1 = E0 + N_WO, E2 = E1 + N_WUQ, E3 = E2 + N_WUKV, E4 = E3 + N_WMEM, E5 = E4 + N_WCMP,
                E6 = E5 + N_X, E7 = E6 + N_MEM, E8 = E7 + N_ROPE, E9 = E8 + N_CB, E10 = E9 + N_LAM;
  for (int it = blockIdx.x; it < E10; it += gridDim.x) {
    if (it < E0) {
      int l = it / 800, r = it % 800, nt = r / 16, kt = r % 16;
      convT_tile(p.in[3] + (size_t)l * 1024 * 3116, 3116, p.in[2] + l * 1024, (bf16*)(ws + OFF_WI + l * SZ_WI), 1024, kt * 64, nt * 64, 1, tile);
    } else if (it < E1) {
      int i = it - E0; int l = i / 256, r = i % 256, nt = r / 16, kt = r % 16;
      convT_tile(p.in[4] + (size_t)l * 1024 * 1024, 1024, nullptr, (bf16*)(ws + OFF_WO + l * SZ_WO), 1024, kt * 64, nt * 64, 0, tile);
    } else if (it < E2) {
      int i = it - E1; int l = i / 24, r = i % 24, nt = r / 4, kt = r % 4;
      convT_tile(p.in[13] + (size_t)l * 256 * 384, 384, p.in[11] + l * 256, (bf16*)(ws + OFF_WUQ + l * SZ_WUQ), 256, kt * 64, nt * 64, 0, tile);
    } else if (it < E3) {
      int i = it - E2; int l = i / 16, r = i % 16, nt = r / 2, kt = r % 2;
      convT_tile(p.in[14] + (size_t)l * 128 * 512, 512, p.in[12] + l * 128, (bf16*)(ws + OFF_WUKV + l * SZ_WUKV), 128, kt * 64, nt * 64, 0, tile);
    } else if (it < E4) {
      int i = it - E3; int l = i / 128, r = i % 128, nt = r / 16, kt = r % 16;
      convT_tile(p.in[17] + (size_t)l * 1024 * 512, 512, p.in[16] + l * 1024, (bf16*)(ws + OFF_WMEM + l * SZ_WMEM), 1024, kt * 64, nt * 64, 0, tile);
    } else if (it < E5) {
      int i = it - E4; int lj = i / 64, r = i % 64, nt = r / 32, kt = r % 32;
      convT_tile(p.in[7] + (size_t)lj * 2048 * 64, 64, nullptr, (bf16*)(ws + OFF_WCMP + lj * SZ_WCMP), 2048, kt * 64, nt * 64, 0, tile);
    } else if (it < E6) {
      int row = (it - E5) * 4 + wv;
      const float4* xr = (const float4*)(p.in[0] + (size_t)row * 1024);
      bf16* xb = (bf16*)(ws + OFF_XB) + (size_t)row * 1024;
      float ss = 0.f;
#pragma unroll
      for (int i = 0; i < 2; ++i) {
        const int c = lane + 64 * i;
        const float4 v = ld_nt4(xr + 2 * c), w = ld_nt4(xr + 2 * c + 1);
        ss += v.x * v.x + v.y * v.y + v.z * v.z + v.w * v.w + w.x * w.x + w.y * w.y + w.z * w.z + w.w * w.w;
        uint4 o; o.x = pack2(v.x, v.y); o.y = pack2(v.z, v.w); o.z = pack2(w.x, w.y); o.w = pack2(w.z, w.w);
        *(uint4*)(xb + c * 8) = o;
      }
      ss = sum64(ss);
      float* sq = (float*)(ws + OFF_SSQ) + (size_t)row * 8;
      if (lane < 8) sq[lane] = lane == 0 ? ss : 0.f;
    } else if (it < E7) {
      int row = (it - E6) * 4 + wv;
      const float4* xr = (const float4*)(p.in[1] + (size_t)row * 1024);
      bf16* xb = (bf16*)(ws + OFF_MEMB) + (size_t)row * 1024;
      float ss = 0.f;
#pragma unroll
      for (int i = 0; i < 2; ++i) {
        const int c = lane + 64 * i;
        const float4 v = ld_nt4(xr + 2 * c), w = ld_nt4(xr + 2 * c + 1);
        ss += v.x * v.x + v.y * v.y + v.z * v.z + v.w * v.w + w.x * w.x + w.y * w.y + w.z * w.z + w.w * w.w;
        uint4 o; o.x = pack2(v.x, v.y); o.y = pack2(v.z, v.w); o.z = pack2(w.x, w.y); o.w = pack2(w.z, w.w);
        *(uint4*)(xb + c * 8) = o;
      }
      ss = sum64(ss);
      if (lane == 0) ((float*)(ws + OFF_RMEM))[row] = rsqrtf(ss * (1.f / 1024.f) + EPS);
    } else if (it < E8) {
      int e = (it - E7) * 256 + tid;
      int pos = e >> 5, i = e & 31;
      float inv = powf(10000.f, -(float)i / 32.f);
      float ang = (float)pos * inv;
      double a = (double)ang;
      double n = rint(a * 0.15915494309189535);
      float r = (float)(a - n * 6.283185307179586);
      float2 cs; cs.x = __cosf(r); cs.y = __sinf(r);
      ((float2*)(ws + OFF_ROPE))[e] = cs;
    } else if (it < E9) {
      int lj = (it - E8) >> 4, sl = (it - E8) & 15;
      const float* pe = p.in[6] + (size_t)lj * 2048;
      const float* w = p.in[7] + (size_t)lj * 2048 * 64;
      int n = tid & 63, part = tid >> 6;
      float acc = 0.f;
      const int kb0 = sl * 128 + part * 32;
#pragma unroll 8
      for (int k = kb0; k < kb0 + 32; ++k) acc += pe[k] * w[(size_t)k * 64 + n];
      tile[tid] = acc;
      __syncthreads();
      if (tid < 64) ((float*)(ws + OFF_CB))[((it - E8)) * 64 + tid] = tile[tid] + tile[tid + 64] + tile[tid + 128] + tile[tid + 192];
      __syncthreads();
    } else {
      if (tid < 2) {
        const float* lf = p.in[9] + tid * 128;
        float s1 = 0.f, s2 = 0.f;
        for (int i = 0; i < 32; ++i) { s1 += lf[i] * lf[32 + i]; s2 += lf[64 + i] * lf[96 + i]; }
        float li = 0.8f - 0.6f * expf(-0.3f * (float)tid);
        ((float*)(ws + OFF_LAM))[tid] = expf(s1) - expf(s2) + li;
      }
    }
  }
}

template <int CH>
DI void gemm_tile(const bf16* __restrict__ Ab, long lda, long kcs, const bf16* __restrict__ Bb, long ldb, int nk, char* smem) {
  const int tid = opq(threadIdx.x), lane = tid & 63, wv = tid >> 6, half = lane >> 5, l31 = lane & 31;
  const int wm = wv >> 1, wn = wv & 1;
  bf16* As = (bf16*)smem;
  bf16* Bs = (bf16*)(smem + 36864);
  const int lrow = tid >> 3, lcol = (tid & 7) * 8;
  const bf16* ag = Ab + (long)lrow * lda + lcol;
  const bf16* bg = Bb + (long)lrow * ldb + lcol;
  f32x16 acc[2][2];
#pragma unroll
  for (int a = 0; a < 2; ++a)
#pragma unroll
    for (int b = 0; b < 2; ++b)
#pragma unroll
      for (int i = 0; i < 16; ++i) acc[a][b][i] = 0.f;
#define GCOMPUTE(BUF) do { \
    const bf16* as_ = As + (BUF) * 128 * 72 + (wm * 64 + l31) * 72 + half * 8; \
    const bf16* bs_ = Bs + (BUF) * 128 * 72 + (wn * 64 + l31) * 72 + half * 8; \
    bf16x8 fa[2][2], fb[2][2]; \
    fa[0][0] = *(const bf16x8*)(as_); fa[0][1] = *(const bf16x8*)(as_ + 32 * 72); \
    fb[0][0] = *(const bf16x8*)(bs_); fb[0][1] = *(const bf16x8*)(bs_ + 32 * 72); \
    _Pragma("unroll") for (int kc = 0; kc < 4; ++kc) { \
      if (kc < 3) { \
        fa[(kc + 1) & 1][0] = *(const bf16x8*)(as_ + (kc + 1) * 16); fa[(kc + 1) & 1][1] = *(const bf16x8*)(as_ + 32 * 72 + (kc + 1) * 16); \
        fb[(kc + 1) & 1][0] = *(const bf16x8*)(bs_ + (kc + 1) * 16); fb[(kc + 1) & 1][1] = *(const bf16x8*)(bs_ + 32 * 72 + (kc + 1) * 16); \
      } \
      _Pragma("unroll") for (int ni = 0; ni < 2; ++ni) \
        _Pragma("unroll") for (int mi = 0; mi < 2; ++mi) acc[ni][mi] = MFMA(fb[kc & 1][ni], fa[kc & 1][mi], acc[ni][mi]); \
    } } while (0)
  for (int c0 = 0; c0 < nk; c0 += CH) {
    u32x4 rs[2][8];
    const bf16* agc = ag + (long)c0 * kcs;
    const bf16* bgc = bg + (long)c0 * 64;
#pragma unroll
    for (int i = 0; i < 4; ++i) {
      rs[0][i] = *(const u32x4*)(agc + (long)(32 * i) * lda);
      rs[0][4 + i] = *(const u32x4*)(bgc + (long)(32 * i) * ldb);
    }
#pragma unroll
    for (int i = 0; i < 4; ++i) {
      *(u32x4*)(As + (lrow + 32 * i) * 72 + lcol) = rs[0][i];
      *(u32x4*)(Bs + (lrow + 32 * i) * 72 + lcol) = rs[0][4 + i];
    }
    if (CH > 1) {
#pragma unroll
      for (int i = 0; i < 4; ++i) {
        GLD16(rs[1][i], agc + (long)(32 * i) * lda + kcs);
        GLD16(rs[1][4 + i], bgc + (long)(32 * i) * ldb + 64);
      }
    }
    __syncthreads();
#pragma unroll
    for (int t = 0; t < CH; ++t) {
      const int bufc = t & 1;
      if (t + 2 < CH) {
#pragma unroll
        for (int i = 0; i < 4; ++i) {
          GLD16(rs[t & 1][i], agc + (long)(32 * i) * lda + (long)(t + 2) * kcs);
          GLD16(rs[t & 1][4 + i], bgc + (long)(32 * i) * ldb + (long)(t + 2) * 64);
        }
      }
      GCOMPUTE(bufc);
      if (t + 1 < CH) {
        u32x4(&rr)[8] = rs[(t + 1) & 1];
        if (t + 2 < CH) asm volatile("s_waitcnt vmcnt(8)" : "+v"(rr[0]), "+v"(rr[1]), "+v"(rr[2]), "+v"(rr[3]), "+v"(rr[4]), "+v"(rr[5]), "+v"(rr[6]), "+v"(rr[7]) :: "memory");
        else asm volatile("s_waitcnt vmcnt(0)" : "+v"(rr[0]), "+v"(rr[1]), "+v"(rr[2]), "+v"(rr[3]), "+v"(rr[4]), "+v"(rr[5]), "+v"(rr[6]), "+v"(rr[7]) :: "memory");
        bf16* ad = As + (bufc ^ 1) * 128 * 72; bf16* bd = Bs + (bufc ^ 1) * 128 * 72;
#pragma unroll
        for (int i = 0; i < 4; ++i) {
          *(u32x4*)(ad + (lrow + 32 * i) * 72 + lcol) = rr[i];
          *(u32x4*)(bd + (lrow + 32 * i) * 72 + lcol) = rr[4 + i];
        }
      }
      __syncthreads();
    }
  }
#undef GCOMPUTE
  float* Cs = (float*)smem;
#pragma unroll
  for (int ni = 0; ni < 2; ++ni)
#pragma unroll
    for (int mi = 0; mi < 2; ++mi)
#pragma unroll
      for (int g = 0; g < 4; ++g) {
        float4 v; v.x = acc[ni][mi][4 * g]; v.y = acc[ni][mi][4 * g + 1]; v.z = acc[ni][mi][4 * g + 2]; v.w = acc[ni][mi][4 * g + 3];
        *(float4*)(Cs + (wm * 64 + mi * 32 + l31) * 132 + wn * 64 + ni * 32 + 8 * g + 4 * half) = v;
      }
  __syncthreads();
}

enum { EPI_PLAIN = 0, EPI_RS8 = 1, EPI_RS1 = 2, EPI_OUT = 3 };
DI void gemm_epi(int mode, char* smem, bf16* __restrict__ Cb, long ldc, int row0, const float* __restrict__ rs,
                 const float* __restrict__ xres, float* __restrict__ xout, bf16* __restrict__ xbout, float* __restrict__ ssqout, int ntile) {
  const float* Cs = (const float*)smem;
  const int tid = opq(threadIdx.x);
  float* rsl = (float*)(smem + 67584);
  if (mode == EPI_RS8 || mode == EPI_RS1) {
    if (tid < 128) {
      const long grow = row0 + tid;
      float sc;
      if (mode == EPI_RS8) {
        const float4* q = (const float4*)(rs + grow * 8);
        const float4 a = q[0], b = q[1];
        sc = rsqrtf((a.x + a.y + a.z + a.w + b.x + b.y + b.z + b.w) * (1.f / 1024.f) + EPS);
      } else sc = rs[grow];
      rsl[tid] = sc;
    }
    __syncthreads();
  }
#pragma unroll 2
  for (int it = 0; it < 8; ++it) {
    const int idx = it * 256 + tid;
    const int r = idx >> 4, ch = idx & 15;
    float4 v0 = *(const float4*)(Cs + r * 132 + ch * 8);
    float4 v1 = *(const float4*)(Cs + r * 132 + ch * 8 + 4);
    const long grow = row0 + r;
    if (mode == EPI_OUT) {
      if (xres) {
        const float4* xr = (const float4*)(xres + grow * 1024 + ntile * 128 + ch * 8);
        float4 x0 = ld_nt4(xr), x1 = ld_nt4(xr + 1);
        v0.x += x0.x; v0.y += x0.y; v0.z += x0.z; v0.w += x0.w;
        v1.x += x1.x; v1.y += x1.y; v1.z += x1.z; v1.w += x1.w;
      } else {
        const uint4 xw = *(const uint4*)(Cb + grow * 1024 + ntile * 128 + ch * 8);
        v0.x += bflo(xw.x); v0.y += bfhi(xw.x); v0.z += bflo(xw.y); v0.w += bfhi(xw.y);
        v1.x += bflo(xw.z); v1.y += bfhi(xw.z); v1.z += bflo(xw.w); v1.w += bfhi(xw.w);
      }
      if (xout) {
        float4* xo = (float4*)(xout + grow * 1024 + ntile * 128 + ch * 8);
        st_nt4(xo, v0); st_nt4(xo + 1, v1);
      }
      if (xbout) {
        float ss = v0.x * v0.x + v0.y * v0.y + v0.z * v0.z + v0.w * v0.w + v1.x * v1.x + v1.y * v1.y + v1.z * v1.z + v1.w * v1.w;
        ss = sum16(ss);
        if (ch == 0) ssqout[grow * 8 + ntile] = ss;
        uint4 o; o.x = pack2(v0.x, v0.y); o.y = pack2(v0.z, v0.w); o.z = pack2(v1.x, v1.y); o.w = pack2(v1.z, v1.w);
        *(uint4*)(xbout + grow * 1024 + ntile * 128 + ch * 8) = o;
      }
    } else {
      float sc = 1.f;
      if (mode == EPI_RS8 || mode == EPI_RS1) sc = rsl[r];
      uint4 o; o.x = pack2(v0.x * sc, v0.y * sc); o.y = pack2(v0.z * sc, v0.w * sc); o.z = pack2(v1.x * sc, v1.y * sc); o.w = pack2(v1.z * sc, v1.w * sc);
      *(uint4*)(Cb + grow * ldc + ntile * 128 + ch * 8) = o;
    }
  }
  __syncthreads();
}

DI void gemm_big(const bf16* __restrict__ Ab, long lda, const bf16* __restrict__ Bb, long ldb, int nk, char* smem, int mode,
                 bf16* __restrict__ Cb, long ldc, int row0, const float* __restrict__ rs, const float* __restrict__ xres,
                 float* __restrict__ xout, bf16* __restrict__ xbout, float* __restrict__ ssqout, int ntile) {
  const int tid = opq(threadIdx.x), lane = tid & 63, wv = tid >> 6, half = lane >> 5, l31 = lane & 31;
  const int wm = wv >> 1, wn = wv & 1;
  bf16* As = (bf16*)smem;
  bf16* Bs = (bf16*)(smem + 36864);
  const int lrow = tid >> 3, lcol = (tid & 7) * 8;
  const bf16* ag = Ab + (long)lrow * lda + lcol;
  const bf16* bg = Bb + (long)lrow * ldb + lcol;
  u32x4 ra[8], rb[4];
  f32x16 acc[2][4];
#pragma unroll
  for (int a = 0; a < 2; ++a)
#pragma unroll
    for (int b = 0; b < 4; ++b)
#pragma unroll
      for (int i = 0; i < 16; ++i) acc[a][b][i] = 0.f;
#pragma unroll
  for (int i = 0; i < 8; ++i) ra[i] = *(const u32x4*)(ag + (long)(32 * i) * lda);
#pragma unroll
  for (int i = 0; i < 4; ++i) rb[i] = *(const u32x4*)(bg + (long)(32 * i) * ldb);
#pragma unroll
  for (int i = 0; i < 8; ++i) *(u32x4*)(As + (lrow + 32 * i) * 72 + lcol) = ra[i];
#pragma unroll
  for (int i = 0; i < 4; ++i) *(u32x4*)(Bs + (lrow + 32 * i) * 72 + lcol) = rb[i];
  __syncthreads();
  for (int ks = 0; ks < nk; ++ks) {
    const bool more = ks + 1 < nk;
    if (more) {
#pragma unroll
      for (int i = 0; i < 8; ++i) GLD16(ra[i], ag + (long)(32 * i) * lda + (long)(ks + 1) * 64);
#pragma unroll
      for (int i = 0; i < 4; ++i) GLD16(rb[i], bg + (long)(32 * i) * ldb + (long)(ks + 1) * 64);
    }
    const bf16* as_ = As + (wm * 128 + l31) * 72 + half * 8;
    const bf16* bs_ = Bs + (wn * 64 + l31) * 72 + half * 8;
#pragma unroll
    for (int kc = 0; kc < 4; ++kc) {
      bf16x8 fa[4], fb[2];
#pragma unroll
      for (int mi = 0; mi < 4; ++mi) fa[mi] = *(const bf16x8*)(as_ + mi * 32 * 72 + kc * 16);
#pragma unroll
      for (int ni = 0; ni < 2; ++ni) fb[ni] = *(const bf16x8*)(bs_ + ni * 32 * 72 + kc * 16);
#pragma unroll
      for (int ni = 0; ni < 2; ++ni)
#pragma unroll
        for (int mi = 0; mi < 4; ++mi) acc[ni][mi] = MFMA(fb[ni], fa[mi], acc[ni][mi]);
    }
    __syncthreads();
    if (more) {
      asm volatile("s_waitcnt vmcnt(0)" : "+v"(ra[0]), "+v"(ra[1]), "+v"(ra[2]), "+v"(ra[3]), "+v"(ra[4]), "+v"(ra[5]), "+v"(ra[6]), "+v"(ra[7]),
                   "+v"(rb[0]), "+v"(rb[1]), "+v"(rb[2]), "+v"(rb[3]) :: "memory");
#pragma unroll
      for (int i = 0; i < 8; ++i) *(u32x4*)(As + (lrow + 32 * i) * 72 + lcol) = ra[i];
#pragma unroll
      for (int i = 0; i < 4; ++i) *(u32x4*)(Bs + (lrow + 32 * i) * 72 + lcol) = rb[i];
      __syncthreads();
    }
  }
  float* Cs = (float*)smem;
#pragma unroll
  for (int h = 0; h < 2; ++h) {
    if (wm == h) {
#pragma unroll
      for (int ni = 0; ni < 2; ++ni)
#pragma unroll
        for (int mi = 0; mi < 4; ++mi)
#pragma unroll
          for (int g = 0; g < 4; ++g) {
            float4 v; v.x = acc[ni][mi][4 * g]; v.y = acc[ni][mi][4 * g + 1]; v.z = acc[ni][mi][4 * g + 2]; v.w = acc[ni][mi][4 * g + 3];
            *(float4*)(Cs + (mi * 32 + l31) * 132 + wn * 64 + ni * 32 + 8 * g + 4 * half) = v;
          }
    }
    __syncthreads();
    gemm_epi(mode, smem, Cb, ldc, row0 + h * 128, rs, xres, xout, xbout, ssqout, ntile);
  }
}

enum { AM_NONE = 0, AM_CAUSAL = 1, AM_WIN = 2, AM_CMP = 3, AM_SLC = 4 };

template <int DK>
DI void attn_core(const bf16* __restrict__ Kp, long kstride, const bf16* __restrict__ Vp, long vstride, uint32_t tilemask,
                  int mode, int qpos, uint32_t sel, const bf16x8 (&Qf)[DK / 16], f32x16 (&O)[2], float& m_out, float& l_out, char* smem) {
  constexpr int KST = DK + 8;
  constexpr int CPR = DK / 8;
  constexpr int NCH = CPR / 4;
  bf16* Ks = (bf16*)smem;
  bf16* VTs = (bf16*)(smem + SM_VT);
  const int tid = opq(threadIdx.x), lane = tid & 63, half = lane >> 5, l31 = lane & 31;
#pragma unroll
  for (int i = 0; i < 16; ++i) { O[0][i] = 0.f; O[1][i] = 0.f; }
  float l = 0.f;
  const int qw0 = __builtin_amdgcn_readfirstlane(qpos - l31);
  const bool causal_like = (mode == AM_CAUSAL || mode == AM_WIN || mode == AM_SLC);
  int klo = 0, khi = 0x7fffffff;
  if (mode == AM_CAUSAL || mode == AM_SLC) khi = qpos;
  else if (mode == AM_WIN) { khi = qpos; klo = qpos - 511; }
  else if (mode == AM_CMP) khi = (qpos - 31) >> 4;
  u32x4 rk0, rk1, rk2, rv0, rv1;
  rk0 = rk1 = rk2 = (u32x4){0u, 0u, 0u, 0u};
  const int vkp = tid & 31, vcc = tid >> 5;
  const int vcol = (vkp >> 3) * 16 + (((vkp & 1) | ((vkp & 2) << 1) | ((vkp & 4) >> 1)) * 2);
  const int c0 = tid, c1 = tid + 256, c2_ = tid + 512;
  const int kr0 = c0 / CPR, kc0 = (c0 % CPR) * 8, kr1 = c1 / CPR, kc1 = (c1 % CPR) * 8, kr2 = c2_ / CPR, kc2 = (c2_ % CPR) * 8;
#define GLOAD(KT) do { \
    GLD16(rk0, Kp + (long)((KT) * 64 + kr0) * kstride + kc0); \
    if constexpr (NCH > 1) GLD16(rk1, Kp + (long)((KT) * 64 + kr1) * kstride + kc1); \
    if constexpr (NCH > 2) GLD16(rk2, Kp + (long)((KT) * 64 + kr2) * kstride + kc2); \
    GLD16(rv0, Vp + (long)((KT) * 64 + 2 * vkp) * vstride + vcc * 8); \
    GLD16(rv1, Vp + (long)((KT) * 64 + 2 * vkp + 1) * vstride + vcc * 8); } while (0)
#define LSTORE(BUF) do { asm volatile("s_waitcnt vmcnt(0)" : "+v"(rk0), "+v"(rk1), "+v"(rk2), "+v"(rv0), "+v"(rv1) :: "memory"); \
    *(u32x4*)(Ks + ((BUF) * 64 + kr0) * KST + kc0) = rk0; \
    if constexpr (NCH > 1) *(u32x4*)(Ks + ((BUF) * 64 + kr1) * KST + kc1) = rk1; \
    if constexpr (NCH > 2) *(u32x4*)(Ks + ((BUF) * 64 + kr2) * KST + kc2) = rk2; \
    bf16* vd = VTs + ((BUF) * 64 + vcc * 8) * 72 + vcol; \
    *(uint32_t*)(vd + 0 * 72) = (rv0.x & 0xffffu) | (rv1.x << 16); \
    *(uint32_t*)(vd + 1 * 72) = (rv0.x >> 16) | (rv1.x & 0xffff0000u); \
    *(uint32_t*)(vd + 2 * 72) = (rv0.y & 0xffffu) | (rv1.y << 16); \
    *(uint32_t*)(vd + 3 * 72) = (rv0.y >> 16) | (rv1.y & 0xffff0000u); \
    *(uint32_t*)(vd + 4 * 72) = (rv0.z & 0xffffu) | (rv1.z << 16); \
    *(uint32_t*)(vd + 5 * 72) = (rv0.z >> 16) | (rv1.z & 0xffff0000u); \
    *(uint32_t*)(vd + 6 * 72) = (rv0.w & 0xffffu) | (rv1.w << 16); \
    *(uint32_t*)(vd + 7 * 72) = (rv0.w >> 16) | (rv1.w & 0xffff0000u); } while (0)
  uint32_t rem = tilemask;
  int kt = __ffs(rem) - 1; rem &= rem - 1;
  GLOAD(kt);
#pragma unroll
  for (int kc = 0; kc < DK / 16; ++kc) asm volatile("" ::"v"(Qf[kc]));
  __syncthreads();
  LSTORE(0);
  __syncthreads();
  int buf = 0;
  while (true) {
    int ktn = -1;
    if (rem) { ktn = __ffs(rem) - 1; rem &= rem - 1; GLOAD(ktn); }
    const bool wave_active = !(causal_like && kt * 64 > qw0 + 31);
    if (wave_active) {
    f32x16 Sx[2];
#pragma unroll
    for (int kb = 0; kb < 2; ++kb) {
      bf16x8 Kf[DK / 16];
#pragma unroll
      for (int kc = 0; kc < DK / 16; ++kc) Kf[kc] = *(const bf16x8*)(Ks + (buf * 64 + kb * 32 + l31) * KST + kc * 16 + half * 8);
      __builtin_amdgcn_sched_barrier(0);
#pragma unroll
      for (int i = 0; i < 16; ++i) Sx[kb][i] = 0.f;
#pragma unroll
      for (int kc = 0; kc < DK / 16; ++kc) Sx[kb] = MFMA(Kf[kc], Qf[kc], Sx[kb]);
    }
    bf16x8 Vf[2][2][2];
#pragma unroll
    for (int kb = 0; kb < 2; ++kb)
#pragma unroll
      for (int c2 = 0; c2 < 2; ++c2)
#pragma unroll
        for (int dvb = 0; dvb < 2; ++dvb)
          Vf[kb][c2][dvb] = *(const bf16x8*)(VTs + (buf * 64 + dvb * 32 + l31) * 72 + (kb * 2 + c2) * 16 + half * 8);
    __builtin_amdgcn_sched_barrier(0);
    bool need_mask = false;
    if (mode == AM_CAUSAL) need_mask = kt * 64 + 63 > qw0;
    else if (mode == AM_WIN) need_mask = (kt * 64 + 63 > qw0) || (kt * 64 < qw0 + 31 - 511);
    else if (mode == AM_CMP) need_mask = true;
    else if (mode == AM_SLC) need_mask = (kt * 64 + 63 > qw0);
    const bool keep = !(mode == AM_SLC) || (((sel >> kt) & 1u) != 0u);
    int khe = khi;
    if (mode == AM_SLC && !((sel >> kt) & 1u)) khe = -1;
    const int kbase = kt * 64 + half * 4;
#pragma unroll
    for (int kb = 0; kb < 2; ++kb) {
      if (need_mask) {
#pragma unroll
        for (int i = 0; i < 16; ++i) {
          const int key = kbase + kb * 32 + (i >> 2) * 8 + (i & 3);
          Sx[kb][i] = (key >= klo && key <= khe) ? Sx[kb][i] : -1e30f;
        }
      }
      float ps = 0.f;
#pragma unroll
      for (int i = 0; i < 16; ++i) { float pv = fexp2(Sx[kb][i]); pv = keep ? pv : 0.f; Sx[kb][i] = pv; ps += pv; }
      l += ps;
#pragma unroll
      for (int c2 = 0; c2 < 2; ++c2) {
        uint4 pw;
        pw.x = pack2(Sx[kb][8 * c2 + 0], Sx[kb][8 * c2 + 1]); pw.y = pack2(Sx[kb][8 * c2 + 2], Sx[kb][8 * c2 + 3]);
        pw.z = pack2(Sx[kb][8 * c2 + 4], Sx[kb][8 * c2 + 5]); pw.w = pack2(Sx[kb][8 * c2 + 6], Sx[kb][8 * c2 + 7]);
        const bf16x8 pf = __builtin_bit_cast(bf16x8, pw);
#pragma unroll
        for (int dvb = 0; dvb < 2; ++dvb) O[dvb] = MFMA(Vf[kb][c2][dvb], pf, O[dvb]);
      }
      __builtin_amdgcn_sched_barrier(0);
    }
    }
    if (ktn < 0) break;
    LSTORE(buf ^ 1);
    __syncthreads();
    buf ^= 1; kt = ktn;
  }
  l_out = l + shx(l, 32);
  m_out = 0.f;
#undef GLOAD
#undef LSTORE
}

template <int DK>
DI void attn_core_dual(const bf16* __restrict__ Kp, long kstride, const bf16* __restrict__ Vp, long vstride, uint32_t tilemask,
                  int mode, int qpos, uint32_t sel, const bf16x8 (&Qf)[DK / 16], f32x16 (&O)[2], f32x16 (&O2)[2], float& l_out, float& l2_out, char* smem) {
  constexpr int KST = DK + 8;
  constexpr int CPR = DK / 8;
  constexpr int NCH = CPR / 4;
  bf16* Ks = (bf16*)smem;
  bf16* VTs = (bf16*)(smem + SM_VT);
  const int tid = opq(threadIdx.x), lane = tid & 63, half = lane >> 5, l31 = lane & 31;
#pragma unroll
  for (int i = 0; i < 16; ++i) { O[0][i] = 0.f; O[1][i] = 0.f; O2[0][i] = 0.f; O2[1][i] = 0.f; }
  float l = 0.f, l2 = 0.f;
  const int qw0 = __builtin_amdgcn_readfirstlane(qpos - l31);
  const bool causal_like = (mode == AM_CAUSAL || mode == AM_WIN || mode == AM_SLC);
  int klo = 0, khi = 0x7fffffff;
  if (mode == AM_CAUSAL || mode == AM_SLC) khi = qpos;
  else if (mode == AM_WIN) { khi = qpos; klo = qpos - 511; }
  else if (mode == AM_CMP) khi = (qpos - 31) >> 4;
  u32x4 rk0, rk1, rk2, rv0, rv1;
  rk0 = rk1 = rk2 = (u32x4){0u, 0u, 0u, 0u};
  const int vkp = tid & 31, vcc = tid >> 5;
  const int vcol = (vkp >> 3) * 16 + (((vkp & 1) | ((vkp & 2) << 1) | ((vkp & 4) >> 1)) * 2);
  const int c0 = tid, c1 = tid + 256, c2_ = tid + 512;
  const int kr0 = c0 / CPR, kc0 = (c0 % CPR) * 8, kr1 = c1 / CPR, kc1 = (c1 % CPR) * 8, kr2 = c2_ / CPR, kc2 = (c2_ % CPR) * 8;
#define GLOAD(KT) do { \
    GLD16(rk0, Kp + (long)((KT) * 64 + kr0) * kstride + kc0); \
    if constexpr (NCH > 1) GLD16(rk1, Kp + (long)((KT) * 64 + kr1) * kstride + kc1); \
    if constexpr (NCH > 2) GLD16(rk2, Kp + (long)((KT) * 64 + kr2) * kstride + kc2); \
    GLD16(rv0, Vp + (long)((KT) * 64 + 2 * vkp) * vstride + vcc * 8); \
    GLD16(rv1, Vp + (long)((KT) * 64 + 2 * vkp + 1) * vstride + vcc * 8); } while (0)
#define LSTORE(BUF) do { asm volatile("s_waitcnt vmcnt(0)" : "+v"(rk0), "+v"(rk1), "+v"(rv0), "+v"(rv1) :: "memory"); \
    *(u32x4*)(Ks + ((BUF) * 64 + kr0) * KST + kc0) = rk0; \
    if constexpr (NCH > 1) *(u32x4*)(Ks + ((BUF) * 64 + kr1) * KST + kc1) = rk1; \
    if constexpr (NCH > 2) *(u32x4*)(Ks + ((BUF) * 64 + kr2) * KST + kc2) = rk2; \
    bf16* vd = VTs + ((BUF) * 64 + vcc * 8) * 72 + vcol; \
    *(uint32_t*)(vd + 0 * 72) = (rv0.x & 0xffffu) | (rv1.x << 16); \
    *(uint32_t*)(vd + 1 * 72) = (rv0.x >> 16) | (rv1.x & 0xffff0000u); \
    *(uint32_t*)(vd + 2 * 72) = (rv0.y & 0xffffu) | (rv1.y << 16); \
    *(uint32_t*)(vd + 3 * 72) = (rv0.y >> 16) | (rv1.y & 0xffff0000u); \
    *(uint32_t*)(vd + 4 * 72) = (rv0.z & 0xffffu) | (rv1.z << 16); \
    *(uint32_t*)(vd + 5 * 72) = (rv0.z >> 16) | (rv1.z & 0xffff0000u); \
    *(uint32_t*)(vd + 6 * 72) = (rv0.w & 0xffffu) | (rv1.w << 16); \
    *(uint32_t*)(vd + 7 * 72) = (rv0.w >> 16) | (rv1.w & 0xffff0000u); } while (0)
  uint32_t rem = tilemask;
  int kt = __ffs(rem) - 1; rem &= rem - 1;
  GLOAD(kt);
#pragma unroll
  for (int kc = 0; kc < DK / 16; ++kc) asm volatile("" ::"v"(Qf[kc]));
  __syncthreads();
  LSTORE(0);
  __syncthreads();
  int buf = 0;
  while (true) {
    int ktn = -1;
    if (rem) { ktn = __ffs(rem) - 1; rem &= rem - 1; GLOAD(ktn); }
    const bool wave_active = !(causal_like && kt * 64 > qw0 + 31);
    if (wave_active) {
    const bool need_mask = kt * 64 + 63 > qw0;
    const int kbase = kt * 64 + half * 4;
#pragma unroll
    for (int mp = 0; mp < 2; ++mp) {
      f32x16 Sx[2];
#pragma unroll
      for (int kb = 0; kb < 2; ++kb) {
        bf16x8 k0 = *(const bf16x8*)(Ks + (buf * 64 + kb * 32 + l31) * KST + (2 * mp) * 16 + half * 8);
        bf16x8 k1 = *(const bf16x8*)(Ks + (buf * 64 + kb * 32 + l31) * KST + (2 * mp + 1) * 16 + half * 8);
#pragma unroll
        for (int i = 0; i < 16; ++i) Sx[kb][i] = 0.f;
        Sx[kb] = MFMA(k0, Qf[2 * mp], Sx[kb]);
        Sx[kb] = MFMA(k1, Qf[2 * mp + 1], Sx[kb]);
      }
#pragma unroll
      for (int kb = 0; kb < 2; ++kb) {
        if (need_mask) {
#pragma unroll
          for (int i = 0; i < 16; ++i) {
            const int key = kbase + kb * 32 + (i >> 2) * 8 + (i & 3);
            Sx[kb][i] = (key <= khi) ? Sx[kb][i] : -1e30f;
          }
        }
        bf16x8 Vf[2][2];
#pragma unroll
        for (int c2 = 0; c2 < 2; ++c2)
#pragma unroll
          for (int dvb = 0; dvb < 2; ++dvb)
            Vf[c2][dvb] = *(const bf16x8*)(VTs + (buf * 64 + dvb * 32 + l31) * 72 + (kb * 2 + c2) * 16 + half * 8);
        float ps = 0.f;
#pragma unroll
        for (int i = 0; i < 16; ++i) { float pv = fexp2(Sx[kb][i]); Sx[kb][i] = pv; ps += pv; }
        if (mp == 0) l += ps; else l2 += ps;
#pragma unroll
        for (int c2 = 0; c2 < 2; ++c2) {
          uint4 pw;
          pw.x = pack2(Sx[kb][8 * c2 + 0], Sx[kb][8 * c2 + 1]); pw.y = pack2(Sx[kb][8 * c2 + 2], Sx[kb][8 * c2 + 3]);
          pw.z = pack2(Sx[kb][8 * c2 + 4], Sx[kb][8 * c2 + 5]); pw.w = pack2(Sx[kb][8 * c2 + 6], Sx[kb][8 * c2 + 7]);
          const bf16x8 pf = __builtin_bit_cast(bf16x8, pw);
#pragma unroll
          for (int dvb = 0; dvb < 2; ++dvb) {
            if (mp == 0) O[dvb] = MFMA(Vf[c2][dvb], pf, O[dvb]); else O2[dvb] = MFMA(Vf[c2][dvb], pf, O2[dvb]);
          }
        }
        __builtin_amdgcn_sched_barrier(0);
      }
    }
    }
    if (ktn < 0) break;
    LSTORE(buf ^ 1);
    __syncthreads();
    buf ^= 1; kt = ktn;
  }
  l_out = l + shx(l, 32);
  l2_out = l2 + shx(l2, 32);
#undef GLOAD
#undef LSTORE
}

template <int DK>
DI void load_q(const bf16* __restrict__ Qrow, bf16x8 (&Qf)[DK / 16]) {
  const int half = (opq(threadIdx.x) & 63) >> 5;
#pragma unroll
  for (int kc = 0; kc < DK / 16; ++kc) Qf[kc] = *(const bf16x8*)(Qrow + kc * 16 + half * 8);
}

DI void vec64(bool active, const bf16* src, const float* bias, int nbias, bf16* dst, const float* gain, const float2* rp, float scale, int j, const bf16* src2 = nullptr) {
  float a0 = 0.f, a1 = 0.f, b0 = 0.f, b1 = 0.f;
  if (active) {
    uint32_t lo = *(const uint32_t*)(src + 2 * j), hi = *(const uint32_t*)(src + 32 + 2 * j);
    a0 = bflo(lo); a1 = bfhi(lo); b0 = bflo(hi); b1 = bfhi(hi);
    if (src2) {
#pragma unroll
      for (int q = 0; q < 3; ++q) {
        const bf16* sq_ = src2 + (size_t)q * 2 * 1024 * 128;
        lo = *(const uint32_t*)(sq_ + 2 * j); hi = *(const uint32_t*)(sq_ + 32 + 2 * j); a0 += bflo(lo); a1 += bfhi(lo); b0 += bflo(hi); b1 += bfhi(hi);
      }
    }
    for (int sidx = 0; sidx < nbias; ++sidx) {
      const float* bb = bias + sidx * 64;
      a0 += bb[2 * j]; a1 += bb[2 * j + 1]; b0 += bb[32 + 2 * j]; b1 += bb[33 + 2 * j];
    }
  }
  float ss = a0 * a0 + a1 * a1 + b0 * b0 + b1 * b1;
  ss = sum16(ss);
  const float r = rsqrtf(ss * (1.f / 64.f) + EPS);
  if (active) {
    a0 *= r * gain[2 * j]; a1 *= r * gain[2 * j + 1]; b0 *= r * gain[32 + 2 * j]; b1 *= r * gain[33 + 2 * j];
    if (rp) {
      const float2 c0 = rp[2 * j], c1 = rp[2 * j + 1];
      const float t0 = a0 * c0.x - b0 * c0.y, u0 = b0 * c0.x + a0 * c0.y;
      const float t1 = a1 * c1.x - b1 * c1.y, u1 = b1 * c1.x + a1 * c1.y;
      a0 = t0; b0 = u0; a1 = t1; b1 = u1;
    }
    *(uint32_t*)(dst + 2 * j) = pack2(a0 * scale, a1 * scale);
    *(uint32_t*)(dst + 32 + 2 * j) = pack2(b0 * scale, b1 * scale);
  }
}
template <int G>
DI void nr4(uint32_t lo, uint32_t hi, float invn, float g0, float g1, float g2, float g3, bool rope, float2 c0, float2 c1, float scale,
            uint32_t& olo, uint32_t& ohi) {
  float a0 = bflo(lo), a1 = bfhi(lo), b0 = bflo(hi), b1 = bfhi(hi);
  float ss = a0 * a0 + a1 * a1 + b0 * b0 + b1 * b1;
  ss = (G == 16) ? sum16(ss) : sum8(ss);
  const float r = rsqrtf(ss * invn + EPS);
  a0 *= r * g0; a1 *= r * g1; b0 *= r * g2; b1 *= r * g3;
  if (rope) {
    const float t0 = a0 * c0.x - b0 * c0.y, u0 = b0 * c0.x + a0 * c0.y;
    const float t1 = a1 * c1.x - b1 * c1.y, u1 = b1 * c1.x + a1 * c1.y;
    a0 = t0; b0 = u0; a1 = t1; b1 = u1;
  }
  olo = pack2(a0 * scale, a1 * scale); ohi = pack2(b0 * scale, b1 * scale);
}

struct PrepR {
  uint32_t q_lo, q_hi, p2_lo, p2_hi, p3_lo, p3_hi, dq_lo, dq_hi, dk_lo, dk_hi, glv, ckw, uqa, uqb, kra, krb;
  uint2 cw, nw, kw2, vw;
  float2 c0, c1, e0, e1;
};
struct PrepG {
  float gq0, gq1, gq2, gq3, h0, h1, h2, h3, m0, m1, m2, m3, dq0, dq1, dq2, dq3, dk0, dk1, dk2, dk3;
  float mgq0, mgq1, mgq2, mgq3, mgq4, mgq5, mgk0, mgk1, mgk2, mgk3, mgk4, mgk5;
};
DI void prep_load(char* ws, int t, int lane, PrepR& R) {
  const int j16 = lane & 15, g16 = lane >> 4, j8 = lane & 7, g8 = lane >> 3;
  const int s = t & 2047;
  const bf16* ur = (const bf16*)(ws + OFF_U) + (size_t)t * NP;
  const float2* rp = (const float2*)(ws + OFF_ROPE) + s * 32;
  const int col2 = g16 == 0 ? C_KS : (g16 == 1 ? C_KW : C_MQ + (g16 - 2) * 64);
  const int col3 = C_MQ + (2 + (g16 & 1)) * 64;
  const bf16* uq = (const bf16*)(ws + OFF_UQ + (size_t)(t >> 11) * SLAB) + (size_t)s * 384 + g16 * 96;
  const bf16* uk = (const bf16*)(ws + OFF_UKV + (size_t)(t >> 11) * SLAB) + (size_t)s * 512 + g16 * 128;
  R.q_lo = *(const uint32_t*)(ur + C_NQ + g16 * 64 + 2 * j16); R.q_hi = *(const uint32_t*)(ur + C_NQ + g16 * 64 + 32 + 2 * j16);
  R.p2_lo = *(const uint32_t*)(ur + col2 + 2 * j16); R.p2_hi = *(const uint32_t*)(ur + col2 + 32 + 2 * j16);
  R.p3_lo = *(const uint32_t*)(ur + col3 + 2 * j16); R.p3_hi = *(const uint32_t*)(ur + col3 + 32 + 2 * j16);
  R.dq_lo = *(const uint32_t*)(ur + C_DQ + g8 * 32 + 2 * j8); R.dq_hi = *(const uint32_t*)(ur + C_DQ + g8 * 32 + 16 + 2 * j8);
  R.dk_lo = *(const uint32_t*)(ur + C_DK + g8 * 32 + 2 * j8); R.dk_hi = *(const uint32_t*)(ur + C_DK + g8 * 32 + 16 + 2 * j8);
  R.glv = ur[C_GL + (lane < 12 ? lane : 0)];
  R.cw = *(const uint2*)(ur + C_CQ + lane * 4);
  R.ckw = *(const uint32_t*)(ur + C_CKV + lane * 2);
  R.nw = *(const uint2*)(uq + 4 * j16);
  R.uqa = uq[64 + j16]; R.uqb = uq[80 + j16];
  R.kw2 = *(const uint2*)(uk + 4 * j16);
  R.vw = *(const uint2*)(uk + 64 + 4 * j16);
  R.kra = ur[C_KR + j16]; R.krb = ur[C_KR + 16 + j16];
  R.c0 = rp[2 * j16]; R.c1 = rp[2 * j16 + 1];
  R.e0 = rp[4 * j8]; R.e1 = rp[4 * j8 + 2];
}
DI void prep_fin(char* ws, int t, int lane, const PrepR& R, const PrepG& G) {
  const int j16 = lane & 15, g16 = lane >> 4, j8 = lane & 7, g8 = lane >> 3;
  const float qs64 = 0.125f * LOG2E, qs32 = 0.17677669529663687f * LOG2E, qs96 = 0.10206207261596577f * LOG2E;
  const int b = t >> 11, s = t & 2047;
  bf16* ur = (bf16*)(ws + OFF_U) + (size_t)t * NP;
  const int col2 = g16 == 0 ? C_KS : (g16 == 1 ? C_KW : C_MQ + (g16 - 2) * 64);
  const int col3 = C_MQ + (2 + (g16 & 1)) * 64;
  const float2 c0 = R.c0, c1 = R.c1, e0 = R.e0, e1 = R.e1;
  uint32_t olo, ohi;
  nr4<16>(R.q_lo, R.q_hi, 1.f / 64.f, G.gq0, G.gq1, G.gq2, G.gq3, true, c0, c1, qs64, olo, ohi);
  *(uint32_t*)(ur + C_NQ + g16 * 64 + 2 * j16) = olo; *(uint32_t*)(ur + C_NQ + g16 * 64 + 32 + 2 * j16) = ohi;
  nr4<16>(R.p2_lo, R.p2_hi, 1.f / 64.f, G.h0, G.h1, G.h2, G.h3, g16 < 2, c0, c1, g16 < 2 ? 1.f : qs64, olo, ohi);
  *(uint32_t*)(ur + col2 + 2 * j16) = olo; *(uint32_t*)(ur + col2 + 32 + 2 * j16) = ohi;
  nr4<16>(R.p3_lo, R.p3_hi, 1.f / 64.f, G.m0, G.m1, G.m2, G.m3, false, c0, c1, qs64, olo, ohi);
  if (g16 < 2) { *(uint32_t*)(ur + col3 + 2 * j16) = olo; *(uint32_t*)(ur + col3 + 32 + 2 * j16) = ohi; }
  nr4<8>(R.dq_lo, R.dq_hi, 1.f / 32.f, G.dq0, G.dq1, G.dq2, G.dq3, true, e0, e1, qs32, olo, ohi);
  *(uint32_t*)(ur + C_DQ + g8 * 32 + 2 * j8) = olo; *(uint32_t*)(ur + C_DQ + g8 * 32 + 16 + 2 * j8) = ohi;
  nr4<8>(R.dk_lo, R.dk_hi, 1.f / 32.f, G.dk0, G.dk1, G.dk2, G.dk3, true, e0, e1, 1.f, olo, ohi);
  *(uint32_t*)(ur + C_DK + g8 * 32 + 2 * j8) = olo; *(uint32_t*)(ur + C_DK + g8 * 32 + 16 + 2 * j8) = ohi;
  if (lane < 12) ((float*)(ws + OFF_GT))[(size_t)t * 12 + lane] = sigmoidf_(bf2f(R.glv));
  float sq, skv;
  {
    float c0f = bflo(R.cw.x), c1f = bfhi(R.cw.x), c2f = bflo(R.cw.y), c3f = bfhi(R.cw.y);
    float ss = c0f * c0f + c1f * c1f + c2f * c2f + c3f * c3f;
    float d0 = bflo(R.ckw), d1 = bfhi(R.ckw);
    float s2 = d0 * d0 + d1 * d1;
    ss = sum64(ss); s2 = sum64(s2);
    sq = rsqrtf(ss * (1.f / 256.f) + EPS);
    skv = rsqrtf(s2 * (1.f / 128.f) + EPS);
  }
  {
    const int h = g16, j = j16;
    float n0 = bflo(R.nw.x) * sq, n1 = bfhi(R.nw.x) * sq, n2 = bflo(R.nw.y) * sq, n3 = bfhi(R.nw.y) * sq;
    float ra = bf2f(R.uqa) * sq, rb = bf2f(R.uqb) * sq;
    float r1 = ra * c0.x - rb * c0.y, r2 = rb * c0.x + ra * c0.y;
    float ss = n0 * n0 + n1 * n1 + n2 * n2 + n3 * n3 + r1 * r1 + r2 * r2;
    ss = sum16(ss);
    float r = rsqrtf(ss * (1.f / 96.f) + EPS) * qs96;
    bf16* qd = (bf16*)(ws + OFF_QM) + ((size_t)(b * 4 + h) * S + s) * 96;
    uint2 o; o.x = pack2(n0 * r * G.mgq0, n1 * r * G.mgq1); o.y = pack2(n2 * r * G.mgq2, n3 * r * G.mgq3);
    *(uint2*)(qd + 4 * j) = o;
    qd[64 + j] = f2bf(r1 * r * G.mgq4);
    qd[80 + j] = f2bf(r2 * r * G.mgq5);
    float k0 = bflo(R.kw2.x) * skv, k1 = bfhi(R.kw2.x) * skv, k2 = bflo(R.kw2.y) * skv, k3 = bfhi(R.kw2.y) * skv;
    float ka = bf2f(R.kra), kb = bf2f(R.krb);
    float kr1 = ka * c0.x - kb * c0.y, kr2 = kb * c0.x + ka * c0.y;
    float s3 = k0 * k0 + k1 * k1 + k2 * k2 + k3 * k3 + kr1 * kr1 + kr2 * kr2;
    s3 = sum16(s3);
    float rk_ = rsqrtf(s3 * (1.f / 96.f) + EPS);
    bf16* kd = (bf16*)(ws + OFF_KM) + ((size_t)(b * 4 + h) * S + s) * 96;
    uint2 o2; o2.x = pack2(k0 * rk_ * G.mgk0, k1 * rk_ * G.mgk1); o2.y = pack2(k2 * rk_ * G.mgk2, k3 * rk_ * G.mgk3);
    *(uint2*)(kd + 4 * j) = o2;
    kd[64 + j] = f2bf(kr1 * rk_ * G.mgk4);
    kd[80 + j] = f2bf(kr2 * rk_ * G.mgk5);
    uint2 o3; o3.x = pack2(bflo(R.vw.x) * skv, bfhi(R.vw.x) * skv); o3.y = pack2(bflo(R.vw.y) * skv, bfhi(R.vw.y) * skv);
    *(uint2*)((bf16*)(ws + OFF_MV) + ((size_t)(b * 4 + h) * S + s) * 64 + 4 * j) = o3;
  }
}

DI void prep_phase(const Params& p, int layer) {
  const int tid = opq(threadIdx.x), lane = tid & 63, wv = tid >> 6;
  char* ws = opqp(p.ws);
  const float2* rope = (const float2*)(ws + OFF_ROPE);
  const float* nsa_g = p.in[5] + layer * 256;
  const float* diff_g = p.in[8] + layer * 64;
  const float* mla_g = p.in[15] + layer * 192;
  const float* mem_g = p.in[18] + layer * 128;
  constexpr int N_TOK = T / 4, N_MEMT = TM / 4, N_CMP = 1024 / 4;
  const int j16 = lane & 15, g16 = lane >> 4, j8 = lane & 7;
  PrepG G;
  G.gq0 = nsa_g[2 * j16]; G.gq1 = nsa_g[2 * j16 + 1]; G.gq2 = nsa_g[32 + 2 * j16]; G.gq3 = nsa_g[33 + 2 * j16];
  const float* g2p = g16 == 0 ? nsa_g + 128 : (g16 == 1 ? nsa_g + 192 : mem_g);
  G.h0 = g2p[2 * j16]; G.h1 = g2p[2 * j16 + 1]; G.h2 = g2p[32 + 2 * j16]; G.h3 = g2p[33 + 2 * j16];
  G.m0 = mem_g[2 * j16]; G.m1 = mem_g[2 * j16 + 1]; G.m2 = mem_g[32 + 2 * j16]; G.m3 = mem_g[33 + 2 * j16];
  G.dq0 = diff_g[2 * j8]; G.dq1 = diff_g[2 * j8 + 1]; G.dq2 = diff_g[16 + 2 * j8]; G.dq3 = diff_g[17 + 2 * j8];
  G.dk0 = diff_g[32 + 2 * j8]; G.dk1 = diff_g[33 + 2 * j8]; G.dk2 = diff_g[48 + 2 * j8]; G.dk3 = diff_g[49 + 2 * j8];
  G.mgq0 = mla_g[4 * j16]; G.mgq1 = mla_g[4 * j16 + 1]; G.mgq2 = mla_g[4 * j16 + 2]; G.mgq3 = mla_g[4 * j16 + 3];
  G.mgq4 = mla_g[64 + j16]; G.mgq5 = mla_g[80 + j16];
  G.mgk0 = mla_g[96 + 4 * j16]; G.mgk1 = mla_g[96 + 4 * j16 + 1]; G.mgk2 = mla_g[96 + 4 * j16 + 2]; G.mgk3 = mla_g[96 + 4 * j16 + 3];
  G.mgk4 = mla_g[96 + 64 + j16]; G.mgk5 = mla_g[96 + 80 + j16];
  const int xcd = blockIdx.x & 7, rk = blockIdx.x >> 3, nrk = gridDim.x >> 3;
  for (int i = rk; i < 512; i += 2 * nrk) {
    const int it = xcd * 512 + i;
    const bool has2 = i + nrk < 512;
    const int it2 = has2 ? it + nrk : it;
    const int tA = it * 4 + wv, tB = it2 * 4 + wv;
    PrepR A, B;
    prep_load(ws, tA, lane, A);
    prep_load(ws, tB, lane, B);
    prep_fin(ws, tA, lane, A, G);
    if (has2) prep_fin(ws, tB, lane, B, G);
  }
  for (int i = rk; i < 96; i += nrk) {
    const int it = i < 64 ? N_TOK + xcd * 64 + i : N_TOK + N_MEMT + xcd * 32 + (i - 64);
    if (false) {
    } else if (it < N_TOK + N_MEMT) {
      const int t = (it - N_TOK) * 4 + wv;
      const int b = t >> 8, mi = t & 255;
      const bf16* kr = (const bf16*)(ws + OFF_KMEMRAW) + (size_t)t * 512;
      const int h = lane >> 4;
      uint2 vw = *(const uint2*)(kr + 256 + lane * 4);
      vec64(true, kr + h * 64, nullptr, 0, (bf16*)(ws + OFF_MK) + ((size_t)(b * 4 + h) * ML + mi) * 64, mem_g + 64, nullptr, 1.f, j16);
      *(uint2*)((bf16*)(ws + OFF_MVV) + ((size_t)(b * 4 + h) * ML + mi) * 64 + j16 * 4) = vw;
    } else {
      const int r = (it - N_TOK - N_MEMT) * 4 + wv;
      const int n = r & 127;
      const bf16* kraw = (const bf16*)(ws + OFF_CMPRAW) + (size_t)r * 128;
      const bf16* vraw = (const bf16*)(ws + OFF_CMPRAW) + (size_t)(1024 + r) * 128;
      const float* cbk = (const float*)(ws + OFF_CBF) + (layer * 2 + 0) * 64;
      const float* cbv = (const float*)(ws + OFF_CBF) + (layer * 2 + 1) * 64;
      bf16* kd = (bf16*)(ws + OFF_KCN) + (size_t)r * 64;
      bf16* vd = (bf16*)(ws + OFF_VCN) + (size_t)r * 64;
      if (n < 127) {
        const int pos = 16 * n + 31;
        const float bv = cbv[lane];
        const float vv = bf2f(vraw[lane]) + bf2f(vraw[(size_t)2 * 1024 * 128 + lane]) + bf2f(vraw[(size_t)4 * 1024 * 128 + lane]) + bf2f(vraw[(size_t)6 * 1024 * 128 + lane]) + bv;
        vec64(lane < 16, kraw, cbk, 1, kd, nsa_g + 64, rope + pos * 32, 1.f, lane & 15, kraw + (size_t)2 * 1024 * 128);
        vd[lane] = f2bf(vv);
      } else {
        kd[lane] = 0; vd[lane] = 0;
      }
    }
  }
}

DI void pl_swap(uint32_t& a, uint32_t& b) { auto r_ = __builtin_amdgcn_permlane32_swap(a, b, false, false); a = r_[0]; b = r_[1]; }
DI void ld_own(const bf16* p, uint2& lo, uint2& hi) {
  const uint4 w = *(const uint4*)p;
  lo.x = w.x; lo.y = w.y; hi.x = w.z; hi.y = w.w;
  pl_swap(lo.x, hi.x); pl_swap(lo.y, hi.y);
}
template <int MODE>
DI void attn_epi(const f32x16 (&O)[2], float scale, const bf16* zrow, const float* sg, const bf16* a1row, const bf16* a2row, bf16* orow, int half) {
#pragma unroll
  for (int dvb = 0; dvb < 2; ++dvb)
#pragma unroll
    for (int pq = 0; pq < 2; ++pq) {
      const int col16 = dvb * 32 + 16 * pq + 8 * half;
      const int dvA = dvb * 32 + 16 * pq + 4 * half;
      float va[4], vb[4];
#pragma unroll
      for (int e = 0; e < 4; ++e) { va[e] = O[dvb][8 * pq + e] * scale; vb[e] = O[dvb][8 * pq + 4 + e] * scale; }
      if (MODE == 2) {
#pragma unroll
        for (int e = 0; e < 4; ++e) { va[e] *= sg[dvA + e]; vb[e] *= sg[dvA + 8 + e]; }
      }
      if (MODE == 3) {
        uint2 clo, chi, wlo, whi;
        ld_own(a1row + col16, clo, chi);
        ld_own(a2row + col16, wlo, whi);
        va[0] += bflo(clo.x) + bflo(wlo.x); va[1] += bfhi(clo.x) + bfhi(wlo.x); va[2] += bflo(clo.y) + bflo(wlo.y); va[3] += bfhi(clo.y) + bfhi(wlo.y);
        vb[0] += bflo(chi.x) + bflo(whi.x); vb[1] += bfhi(chi.x) + bfhi(whi.x); vb[2] += bflo(chi.y) + bflo(whi.y); vb[3] += bfhi(chi.y) + bfhi(whi.y);
      }
      if (MODE >= 1) {
        uint2 zlo, zhi;
        ld_own(zrow + col16, zlo, zhi);
        va[0] *= siluf_(bflo(zlo.x)); va[1] *= siluf_(bfhi(zlo.x)); va[2] *= siluf_(bflo(zlo.y)); va[3] *= siluf_(bfhi(zlo.y));
        vb[0] *= siluf_(bflo(zhi.x)); vb[1] *= siluf_(bfhi(zhi.x)); vb[2] *= siluf_(bflo(zhi.y)); vb[3] *= siluf_(bfhi(zhi.y));
      }
      uint32_t A0 = pack2(va[0], va[1]), A1 = pack2(va[2], va[3]), B0 = pack2(vb[0], vb[1]), B1 = pack2(vb[2], vb[3]);
      pl_swap(A0, B0); pl_swap(A1, B1);
      uint4 o; o.x = A0; o.y = A1; o.z = B0; o.w = B1;
      *(uint4*)(orow + col16) = o;
    }
}
template <int MODE>
DI void attn_epi_lds(const f32x16 (&O)[2], float scale, const bf16* zb, const float* sg, const bf16* a1b, const bf16* a2b, bf16* ob, char* smem) {
  const int tid = opq(threadIdx.x), lane = tid & 63, wv = tid >> 6, half = lane >> 5, l31 = lane & 31;
  float* st = (float*)smem + wv * (32 * 68);
  __syncthreads();
#pragma unroll
  for (int dvb = 0; dvb < 2; ++dvb)
#pragma unroll
    for (int g = 0; g < 4; ++g) {
      float4 v; v.x = O[dvb][4 * g] * scale; v.y = O[dvb][4 * g + 1] * scale; v.z = O[dvb][4 * g + 2] * scale; v.w = O[dvb][4 * g + 3] * scale;
      *(float4*)(st + l31 * 68 + dvb * 32 + 8 * g + 4 * half) = v;
    }
  __syncthreads();
  const int rr = lane >> 3, c8 = (lane & 7) * 8;
#pragma unroll
  for (int i = 0; i < 4; ++i) {
    const int r = rr + 8 * i;
    float4 x0 = *(const float4*)(st + r * 68 + c8), x1 = *(const float4*)(st + r * 68 + c8 + 4);
    if (MODE == 2) {
      const float4 g0 = *(const float4*)(sg + c8), g1 = *(const float4*)(sg + c8 + 4);
      x0.x *= g0.x; x0.y *= g0.y; x0.z *= g0.z; x0.w *= g0.w; x1.x *= g1.x; x1.y *= g1.y; x1.z *= g1.z; x1.w *= g1.w;
    }
    if (MODE == 3) {
      const uint4 cw = *(const uint4*)(a1b + (size_t)r * 256 + c8), ww = *(const uint4*)(a2b + (size_t)r * 256 + c8);
      x0.x += bflo(cw.x) + bflo(ww.x); x0.y += bfhi(cw.x) + bfhi(ww.x); x0.z += bflo(cw.y) + bflo(ww.y); x0.w += bfhi(cw.y) + bfhi(ww.y);
      x1.x += bflo(cw.z) + bflo(ww.z); x1.y += bfhi(cw.z) + bfhi(ww.z); x1.z += bflo(cw.w) + bflo(ww.w); x1.w += bfhi(cw.w) + bfhi(ww.w);
    }
    const uint4 zw = *(const uint4*)(zb + (size_t)r * NP + c8);
    uint4 o;
    o.x = pack2(x0.x * siluf_(bflo(zw.x)), x0.y * siluf_(bfhi(zw.x)));
    o.y = pack2(x0.z * siluf_(bflo(zw.y)), x0.w * siluf_(bfhi(zw.y)));
    o.z = pack2(x1.x * siluf_(bflo(zw.z)), x1.y * siluf_(bfhi(zw.z)));
    o.w = pack2(x1.z * siluf_(bflo(zw.w)), x1.w * siluf_(bfhi(zw.w)));
    *(uint4*)(ob + (size_t)r * 1024 + c8) = o;
  }
}
DI void st4(bf16* dst, float a, float b, float c, float d) { uint2 o; o.x = pack2(a, b); o.y = pack2(c, d); *(uint2*)dst = o; }

DI void attn_phaseA(const Params& p, int layer, char* smem, int* ctr) {
  char* ws = opqp(p.ws);
  bf16* u = (bf16*)(ws + OFF_U);
  bf16* y = (bf16*)(ws + OFF_Y);
  const float* gt = (const float*)(ws + OFF_GT);
  int* s_item = (int*)(smem + SM_MISC);
  const int xcd = blockIdx.x & 7;
  while (true) {
    __syncthreads();
    if (threadIdx.x == 0) *s_item = atomicAdd(ctr + 24 + xcd, 1);
    __syncthreads();
    const int item = *s_item;
    if (item >= 16) break;
    {
      const int tid = opq(threadIdx.x), lane = tid & 63, wv = tid >> 6, half = lane >> 5, l31 = lane & 31;
      const int i2 = item;
      const int qb = 15 - i2, b = xcd;
      const int q0 = qb * 128, qpos = q0 + wv * 32 + l31;
      const size_t t = (size_t)b * S + qpos;
      const bf16* ub = u + (size_t)b * S * NP;
      const bf16* kc = (const bf16*)(ws + OFF_KCN) + (size_t)b * 128 * 64;
      const bf16* vc = (const bf16*)(ws + OFF_VCN) + (size_t)b * 128 * 64;
      const uint32_t tm = (q0 + 127 >= 16 * 64 + 31) ? 3u : 1u;
      float* scl = (float*)(smem + SM_SC) + wv * 32 * 33;
#pragma unroll
      for (int g = 0; g < 16; ++g) scl[l31 * 33 + 2 * g + half] = 0.f;
      const int khi = (qpos - 31) >> 4;
#pragma unroll 1
      for (int h = 0; h < 4; ++h) {
        f32x16 O[2]; float mm, ll;
        bf16x8 Qf[4];
        load_q<64>(ub + (size_t)qpos * NP + C_NQ + h * 64, Qf);
        attn_core<64>(kc, 64, vc, 64, tm, AM_CMP, qpos, 0u, Qf, O, mm, ll, smem);
        const float inv = ll > 0.f ? 1.f / ll : 0.f;
        const float sc = inv * gt[t * 12 + h];
        bf16* od = (bf16*)(ws + OFF_OCMP) + t * 256 + h * 64;
        attn_epi<0>(O, sc, nullptr, nullptr, nullptr, nullptr, od, half);
        const float mu = mm < -1e29f ? 0.f : mm;
        const bf16* Ks = (const bf16*)smem;
        float Aa[16], Cc[16];
#pragma unroll
        for (int g = 0; g < 16; ++g) { Aa[g] = 0.f; Cc[g] = 0.f; }
#pragma unroll
        for (int kt = 0; kt < 2; ++kt) {
          if (tm & (1u << kt)) {
#pragma unroll
            for (int kb = 0; kb < 2; ++kb) {
              f32x16 Sx;
#pragma unroll
              for (int i = 0; i < 16; ++i) Sx[i] = 0.f;
#pragma unroll
              for (int kcx = 0; kcx < 4; ++kcx) {
                bf16x8 a = *(const bf16x8*)(Ks + (kt * 64 + kb * 32 + l31) * 72 + kcx * 16 + half * 8);
                Sx = MFMA(a, Qf[kcx], Sx);
              }
#pragma unroll
              for (int gg = 0; gg < 4; ++gg) {
                float pv[4];
#pragma unroll
                for (int e = 0; e < 4; ++e) {
                  const int key = kt * 64 + kb * 32 + gg * 8 + half * 4 + e;
                  pv[e] = key <= khi ? fexp2(Sx[gg * 4 + e] - mu) * inv : 0.f;
                }
                Aa[kt * 8 + kb * 4 + gg] += pv[0] + 2.f * (pv[1] + pv[2] + pv[3]);
                Cc[kt * 8 + kb * 4 + gg] += pv[0];
              }
            }
          }
        }
        {
          float rc[16];
#pragma unroll
          for (int g = 0; g < 16; ++g) rc[g] = shx(Cc[g], 32);
#pragma unroll
          for (int g = 0; g < 16; ++g) {
            const float nx = half == 0 ? rc[g] : (g < 15 ? rc[g < 15 ? g + 1 : 15] : 0.f);
            scl[l31 * 33 + 2 * g + half] += Aa[g] + nx;
          }
        }
      }
      __syncthreads();
      {
        float sv[32];
        const int cur = qpos >> 6;
#pragma unroll
        for (int j = 0; j < 32; ++j) {
          float v = scl[l31 * 33 + j];
          const bool forced = (j == 0) || (j == cur) || (j == cur - 1);
          sv[j] = j > cur ? -1e30f : (forced ? 1e30f : v);
        }
        uint32_t bits = 0;
#pragma unroll 1
        for (int jj = 0; jj < 16; ++jj) {
          const int j = half * 16 + jj;
          float sj = scl[l31 * 33 + j];
          const bool fj = (j == 0) || (j == cur) || (j == cur - 1);
          sj = j > cur ? -1e30f : (fj ? 1e30f : sj);
          int rank = 0;
#pragma unroll
          for (int i = 0; i < 32; ++i) rank += (sv[i] > sj || (sv[i] == sj && i < j)) ? 1 : 0;
          if (rank < 16) bits |= 1u << j;
        }
        bits |= (uint32_t)__shfl_xor((int)bits, 32);
        if (half == 0) ((uint32_t*)(ws + OFF_SEL))[t] = bits;
      }
      wg_publish((unsigned*)(ws + OFF_FLAG) + layer * 1024 + (b * 16 + qb) * 8);
    }
  }
  while (true) {
    __syncthreads();
    if (threadIdx.x == 0) *s_item = atomicAdd(ctr + 16 + xcd, 1);
    __syncthreads();
    const int item = *s_item;
    if (item >= 128) break;
    {
      const int tid = opq(threadIdx.x), lane = tid & 63, wv = tid >> 6, half = lane >> 5, l31 = lane & 31;
      const int i2 = item;
      const int ismem = i2 >> 6, r = i2 & 63, qb = 15 - (r >> 2), b = xcd, h = r & 3;
      const int q0 = qb * 128, qpos = q0 + wv * 32 + l31;
      const size_t t = (size_t)b * S + qpos;
      const bf16* ub = u + (size_t)b * S * NP;
      f32x16 O[2]; float mm, ll;
      bf16x8 Qf[4];
      if (!ismem) {
        load_q<64>(ub + (size_t)qpos * NP + C_NQ + h * 64, Qf);
        const int kt0 = q0 >= 512 ? (q0 - 512) / 64 : 0, kt1 = 2 * qb + 2;
        const uint32_t hi = kt1 >= 32 ? 0xffffffffu : ((1u << kt1) - 1u);
        const uint32_t tm = hi & ~((1u << kt0) - 1u);
        attn_core<64>(ub + C_KW, NP, ub + C_VW, NP, tm, AM_WIN, qpos, 0u, Qf, O, mm, ll, smem);
        const float sc = (ll > 0.f ? 1.f / ll : 0.f) * gt[t * 12 + 8 + h];
        bf16* od = (bf16*)(ws + OFF_OWIN) + t * 256 + h * 64;
        attn_epi<0>(O, sc, nullptr, nullptr, nullptr, nullptr, od, half);
        wg_publish((unsigned*)(ws + OFF_FLAG) + layer * 1024 + (b * 16 + qb) * 8 + 1 + h);
      } else {
        load_q<64>(ub + (size_t)qpos * NP + C_MQ + h * 64, Qf);
        attn_core<64>((const bf16*)(ws + OFF_MK) + (size_t)(b * 4 + h) * ML * 64, 64, (const bf16*)(ws + OFF_MVV) + (size_t)(b * 4 + h) * ML * 64, 64,
                      0xfu, AM_NONE, qpos, 0u, Qf, O, mm, ll, smem);
        const float inv = ll > 0.f ? 1.f / ll : 0.f;
        attn_epi_lds<1>(O, inv, u + (t - l31) * NP + C_MEZ + h * 64, nullptr, nullptr, nullptr, y + (t - l31) * 1024 + 768 + h * 64, smem);
      }
    }
  }
  while (true) {
    __syncthreads();
    if (threadIdx.x == 0) *s_item = atomicAdd(ctr + xcd, 1);
    __syncthreads();
    const int item = *s_item;
    if (item >= 64) break;
    {
      const int tid = opq(threadIdx.x), lane = tid & 63, wv = tid >> 6, half = lane >> 5, l31 = lane & 31;
      const int qb = 15 - (item >> 2), b = xcd, h = item & 3;
      const int q0 = qb * 128, qpos = q0 + wv * 32 + l31;
      const size_t t = (size_t)b * S + qpos;
      const uint32_t tm = (qb == 15) ? 0xffffffffu : ((1u << (2 * qb + 2)) - 1u);
      f32x16 O[2]; float mm, ll;
        bf16x8 Qf[6];
        const bf16* qm = (const bf16*)(ws + OFF_QM) + (size_t)(b * 4 + h) * S * 96;
        load_q<96>(qm + (size_t)qpos * 96, Qf);
        attn_core<96>((const bf16*)(ws + OFF_KM) + (size_t)(b * 4 + h) * S * 96, 96,
                      (const bf16*)(ws + OFF_MV) + (size_t)(b * 4 + h) * S * 64, 64, tm, AM_CAUSAL, qpos, 0u, Qf, O, mm, ll, smem);
        const float inv = ll > 0.f ? 1.f / ll : 0.f;
        attn_epi_lds<1>(O, inv, u + (t - l31) * NP + C_MZ + h * 64, nullptr, nullptr, nullptr, y + (t - l31) * 1024 + 512 + h * 64, smem);
    }
  }
  while (true) {
    __syncthreads();
    if (threadIdx.x == 0) *s_item = atomicAdd(ctr + 8 + xcd, 1);
    __syncthreads();
    const int item = *s_item;
    if (item >= 64) break;
    {
      const int tid = opq(threadIdx.x), lane = tid & 63, wv = tid >> 6, half = lane >> 5, l31 = lane & 31;
      const int qb = 15 - (item >> 2), b = xcd, h = item & 3;
      const int q0 = qb * 128, qpos = q0 + wv * 32 + l31;
      const size_t t = (size_t)b * S + qpos;
      const uint32_t tm = (qb == 15) ? 0xffffffffu : ((1u << (2 * qb + 2)) - 1u);
      f32x16 O[2]; float mm, ll;
        f32x16 O1[2];
        const bf16* ub = u + (size_t)b * S * NP;
        {
          bf16x8 Qf[4];
          float l1, l2;
          load_q<64>(ub + (size_t)qpos * NP + C_DQ + h * 64, Qf);
          attn_core_dual<64>(ub + C_DK + h * 64, NP, ub + C_DV + h * 64, NP, tm, AM_CAUSAL, qpos, 0u, Qf, O1, O, l1, l2, smem);
          const float inv1 = l1 > 0.f ? 1.f / l1 : 0.f, inv = l2 > 0.f ? 1.f / l2 : 0.f;
#pragma unroll
          for (int i = 0; i < 16; ++i) { O1[0][i] *= inv1; O1[1][i] *= inv1; }
          {
            const float lam = ((const float*)(ws + OFF_LAM))[layer];
            float ss = 0.f;
#pragma unroll
            for (int i = 0; i < 16; ++i) {
              O1[0][i] -= lam * O[0][i] * inv; O1[1][i] -= lam * O[1][i] * inv;
              ss += O1[0][i] * O1[0][i] + O1[1][i] * O1[1][i];
            }
            ss += shx(ss, 32);
            const float li = opq(layer) == 0 ? 0.2f : 0.35550907f;
            const float r = rsqrtf(ss * (1.f / 64.f) + EPS) * (1.f - li);
            const float* sg = p.in[10] + layer * 64;
            attn_epi_lds<2>(O1, r, u + (t - l31) * NP + C_DZ + h * 64, sg, nullptr, nullptr, y + (t - l31) * 1024 + 256 + h * 64, smem);
          }
        }
    }
  }
}

DI void attn_phaseB(const Params& p, int layer, char* smem, int* ctr) {
  const int tid = opq(threadIdx.x), lane = tid & 63, wv = tid >> 6, half = lane >> 5, l31 = lane & 31;
  char* ws = opqp(p.ws);
  bf16* u = (bf16*)(ws + OFF_U);
  bf16* y = (bf16*)(ws + OFF_Y);
  const float* gt = (const float*)(ws + OFF_GT);
  int* s_item = (int*)(smem + SM_MISC);
  uint32_t* s_or = (uint32_t*)(smem + SM_MISC + 16);
  const int xcd = blockIdx.x & 7;
  while (true) {
    __syncthreads();
    if (tid == 0) { *s_item = atomicAdd(ctr + xcd, 1); *s_or = 0u; }
    __syncthreads();
    const int item = *s_item;
    if (item >= 64) break;
    const int qb = 15 - (item >> 2), b = xcd, h = item & 3;
    const int q0 = qb * 128, qpos = q0 + wv * 32 + l31;
    const size_t t = (size_t)b * S + qpos;
    const bf16* ub = u + (size_t)b * S * NP;
    wg_wait2((unsigned*)(ws + OFF_FLAG) + layer * 1024 + (b * 16 + qb) * 8, (unsigned*)(ws + OFF_FLAG) + layer * 1024 + (b * 16 + qb) * 8 + 1 + h);
    const uint32_t sel = ((const uint32_t*)(ws + OFF_SEL))[t];
    const uint32_t causal = (qb == 15) ? 0xffffffffu : ((1u << (2 * qb + 2)) - 1u);
    if (half == 0) atomicOr(s_or, sel);
    __syncthreads();
    const uint32_t tm = (*s_or & causal) | 1u;
    f32x16 O[2]; float mm, ll;
    bf16x8 Qf[4];
    load_q<64>(ub + (size_t)qpos * NP + C_NQ + h * 64, Qf);
    attn_core<64>(ub + C_KS, NP, ub + C_VS, NP, tm, AM_SLC, qpos, sel, Qf, O, mm, ll, smem);
    const float sc = (ll > 0.f ? 1.f / ll : 0.f) * gt[t * 12 + 4 + h];
    const bf16* oc = (const bf16*)(ws + OFF_OCMP) + t * 256 + h * 64;
    const bf16* ow = (const bf16*)(ws + OFF_OWIN) + t * 256 + h * 64;
    attn_epi_lds<3>(O, sc, u + (t - l31) * NP + C_NZ + h * 64, nullptr, oc - (size_t)l31 * 256, ow - (size_t)l31 * 256, y + (t - l31) * 1024 + h * 64, smem);
  }
  (void)layer;
}

__global__ void __launch_bounds__(256, 2) fwd_megakernel(Params p) {
  __shared__ __attribute__((aligned(16))) char smem[SMEM_BYTES];
  cg::grid_group grid = cg::this_grid();
  char* ws = opqp(p.ws);
  int* ctrs = (int*)(ws + OFF_CTR);
  __shared__ uint4 xb_words;
  if (threadIdx.x == 0) xb_words = make_uint4(0u, 0u, 0u, 0u);
  __syncthreads();
  XcdBarrier xb = xcd_barrier_post((unsigned*)(ws + OFF_BAR), (volatile LAS unsigned*)&xb_words);
  phase0(p, smem);
  if (p.out == nullptr) grid.sync();
  xcd_barrier(xb);
  if (blockIdx.x == 0) {
    const int tq = opq(threadIdx.x);
    const float* cbp = (const float*)(opqp(p.ws) + OFF_CB) + (tq >> 6) * 16 * 64 + (tq & 63);
    float a = 0.f;
#pragma unroll
    for (int sidx = 0; sidx < 16; ++sidx) a += cbp[sidx * 64];
    ((float*)(opqp(p.ws) + OFF_CBF))[tq] = a;
  }
#define PBAR(K) xcd_barrier(xb)
  for (int layer = 0; layer < 2; ++layer) {
    bf16* u = (bf16*)(ws + OFF_U);
    {
      const bf16* xbp = (const bf16*)(ws + OFF_XB);
      const bf16* wi = (const bf16*)(ws + OFF_WI + layer * SZ_WI);
      const int xcd = blockIdx.x & 7, rk = blockIdx.x >> 3, nrk = gridDim.x >> 3;
      for (int q = rk; q < 216; q += nrk) {
        if (q < 192) {
          const int mt = xcd * 8 + (q & 7), nt = q >> 3;
          gemm_big(xbp + (size_t)mt * 256 * 1024, 1024, wi + (size_t)nt * 128 * 1024, 1024, 16, smem, EPI_RS8, u, NP, mt * 256,
                   (const float*)(ws + OFF_SSQ), nullptr, nullptr, nullptr, nullptr, nt);
        } else if (q < 208) {
          const int mt = xcd * 16 + (q - 192), nt = 24;
          gemm_tile<16>(xbp + (size_t)mt * 128 * 1024, 1024, 64, wi + (size_t)nt * 128 * 1024, 1024, 16, smem);
          gemm_epi(EPI_RS8, smem, u, NP, mt * 128, (const float*)(ws + OFF_SSQ), nullptr, nullptr, nullptr, nullptr, nt);
        } else {
          const int i = xcd * 8 + (q - 208), mt = i >> 2, nt = i & 3;
          gemm_tile<16>((const bf16*)(ws + OFF_MEMB) + (size_t)mt * 128 * 1024, 1024, 64,
                    (const bf16*)(ws + OFF_WMEM + layer * SZ_WMEM) + (size_t)nt * 128 * 1024, 1024, 16, smem);
          gemm_epi(EPI_RS1, smem, (bf16*)(ws + OFF_KMEMRAW), 512, mt * 128, (const float*)(ws + OFF_RMEM), nullptr, nullptr, nullptr, nullptr, nt);
        }
      }
    }
    PBAR(0);
    {
      const int xcd = blockIdx.x & 7, rk = blockIdx.x >> 3, nrk = gridDim.x >> 3;
      for (int q = rk; q < 64; q += nrk) {
        if (q < 8) {
          const int j = q >> 2, kh = q & 3, b = xcd;
          gemm_tile<8>(u + (size_t)b * S * NP + (j ? C_VC : C_KC) + (size_t)kh * 8 * NP, 16 * NP, NP,
                       (const bf16*)(ws + OFF_WCMP + (layer * 2 + j) * SZ_WCMP) + kh * 512, 2048, 8, smem);
          gemm_epi(EPI_PLAIN, smem, (bf16*)(ws + OFF_CMPRAW) + (size_t)(kh * 2 + j) * 1024 * 128, 128, b * 128, nullptr, nullptr, nullptr, nullptr, nullptr, 0);
        } else if (q < 32) {
          const int i = q - 8, ml = i / 3, nt = i % 3, mt = xcd * 8 + ml;
          gemm_big(u + (size_t)mt * 256 * NP + C_CQ, NP, (const bf16*)(ws + OFF_WUQ + layer * SZ_WUQ) + (size_t)nt * 128 * 256, 256, 4, smem, EPI_PLAIN,
                   (bf16*)(ws + OFF_UQ + (size_t)xcd * SLAB), 384, ml * 256, nullptr, nullptr, nullptr, nullptr, nullptr, nt);
        } else {
          const int i = q - 32, ml = i >> 2, nt = i & 3, mt = xcd * 8 + ml;
          gemm_big(u + (size_t)mt * 256 * NP + C_CKV, NP, (const bf16*)(ws + OFF_WUKV + layer * SZ_WUKV) + (size_t)nt * 128 * 128, 128, 2, smem, EPI_PLAIN,
                   (bf16*)(ws + OFF_UKV + (size_t)xcd * SLAB), 512, ml * 256, nullptr, nullptr, nullptr, nullptr, nullptr, nt);
        }
      }
    }
    PBAR(1);
    prep_phase(p, layer);
    PBAR(2);
    attn_phaseA(p, layer, smem, ctrs + layer * 64);
    attn_phaseB(p, layer, smem, ctrs + layer * 64 + 32);
    PBAR(3);
    {
      const bf16* yb = (const bf16*)(ws + OFF_Y);
      const bf16* wo = (const bf16*)(ws + OFF_WO + layer * SZ_WO);
      const float* xres = layer == 0 ? p.in[0] : nullptr;
      const int xcd = blockIdx.x & 7, rk = blockIdx.x >> 3, nrk = gridDim.x >> 3;
      for (int q = rk; q < 64; q += nrk) {
        const int mt = xcd * 8 + (q & 7), nt = q >> 3;
        gemm_big(yb + (size_t)mt * 256 * 1024, 1024, wo + (size_t)nt * 128 * 1024, 1024, 16, smem, EPI_OUT, (bf16*)(ws + OFF_XB), 0, mt * 256, nullptr, xres, layer == 0 ? nullptr : p.out,
                 layer == 0 ? (bf16*)(ws + OFF_XB) : nullptr, (float*)(ws + OFF_SSQ), nt);
      }
    }
    if (layer == 0) PBAR(4);
  }
}

extern "C" void kernel_launch(void* const* d_in, const int* in_sizes, int n_in, void* d_out, int out_size, void* d_ws, size_t ws_size,
                              hipStream_t stream) {
  static int grid_blocks = 0;
  if (!grid_blocks) {
    int dev = 0, cus = 0, per_cu = 0;
    hipGetDevice(&dev);
    hipDeviceGetAttribute(&cus, hipDeviceAttributeMultiprocessorCount, dev);
    hipOccupancyMaxActiveBlocksPerMultiprocessor(&per_cu, fwd_megakernel, 256, 0);
    if (per_cu > 2) per_cu = 2;
    grid_blocks = (cus * per_cu) & ~7;
  }
  if (ws_size < WS_TOTAL) { fprintf(stderr, "workspace too small: %zu < %zu\n", ws_size, (size_t)WS_TOTAL); return; }
  Params p{};
  for (int i = 0; i < 19; ++i) p.in[i] = (const float*)d_in[i];
  p.out = (float*)d_out;
  p.ws = (char*)d_ws;
  hipMemsetAsync((char*)d_ws + OFF_CTR, 0, 1024 + 16384 + 8192 + 2048, stream);
  void* args[] = {&p};
  hipError_t e = hipLaunchCooperativeKernel((void*)fwd_megakernel, dim3(grid_blocks), dim3(256), args, 0, stream);
  if (e != hipSuccess) fprintf(stderr, "cooperative launch failed: %s (grid %d)\n", hipGetErrorString(e), grid_blocks);
}
```
